# Optimizing an MI355X kernel written in HIP

```python
import jax
import jax.numpy as jnp
from jax import lax
import numpy as np

D_MODEL = 1024
BATCH = 8
SEQ = 2048
DEPTH = 1

MEM_LEN = 256
GRID_W = 64
EPS = 1e-6
D_MIX = D_MODEL
ATT_HEADS = 8
ATT_KV_HEADS = 2
HEAD_DIM = 64
D_ATT = ATT_HEADS * HEAD_DIM
D_KV = ATT_KV_HEADS * HEAD_DIM
Q_BLOCK = 128
ROPE_THETA = 10000.0
D_SSM = D_MIX - D_ATT
SSM_GROUP = 16
SSM_GROUPS = D_SSM // SSM_GROUP
SSM_STATE = 64
DT_MIN = 1e-3
DT_MAX = 1e-1
D_IN = D_ATT + 2 * D_KV + D_SSM
XA_HEADS = 4
XA_HEAD_DIM = D_MODEL // XA_HEADS
N_EXPERT_GROUPS = 4
EXPERTS_PER_GROUP = 4
N_EXPERTS = N_EXPERT_GROUPS * EXPERTS_PER_GROUP
TOP_K = 2
D_EXPERT = D_MODEL // 2

kernel_name = "hybrid_attn_s5_xattn_hmoe_encoder"


def rmsnorm(x, g):
    xf = x.astype(jnp.float32)
    y = xf * lax.rsqrt(jnp.mean(xf * xf, axis=-1, keepdims=True) + EPS)
    return y.astype(x.dtype) * g


def rope_1d(x, pos):
    half = x.shape[-1] // 2
    freqs = ROPE_THETA ** (-jnp.arange(half, dtype=jnp.float32) / half)
    ang = pos.astype(jnp.float32)[:, None] * freqs[None, :]
    cos = jnp.cos(ang)[:, None, :].astype(x.dtype)
    sin = jnp.sin(ang)[:, None, :].astype(x.dtype)
    x1, x2 = x[..., :half], x[..., half:]
    return jnp.concatenate([x1 * cos - x2 * sin, x2 * cos + x1 * sin], axis=-1)


def axial_rope(x, row, col):
    half = HEAD_DIM // 2
    return jnp.concatenate([rope_1d(x[..., :half], row), rope_1d(x[..., half:], col)], axis=-1)


def gqa_blocked(q, k, v):
    B, S, H, Dh = q.shape
    KV = k.shape[2]
    G = H // KV
    nb = S // Q_BLOCK
    qb = q.reshape(B, nb, Q_BLOCK, KV, G, Dh).transpose(1, 0, 2, 3, 4, 5)
    scale = Dh ** -0.5

    def one_block(q_blk):
        s = jnp.einsum('bqkgd,bskd->bkgqs', q_blk, k).astype(jnp.float32) * scale
        p = jax.nn.softmax(s, axis=-1).astype(v.dtype)
        return jnp.einsum('bkgqs,bskd->bqkgd', p, v)

    o = lax.map(one_block, qb)
    return o.transpose(1, 0, 2, 3, 4, 5).reshape(B, S, H * Dh)


def _complex_affine_combine(e1, e2):
    a1r, a1i, b1r, b1i = e1
    a2r, a2i, b2r, b2i = e2
    return (a2r * a1r - a2i * a1i,
            a2r * a1i + a2i * a1r,
            a2r * b1r - a2i * b1i + b2r,
            a2r * b1i + a2i * b1r + b2i)


def s5_direction(u, lam_re, lam_im, log_step, b_re, b_im, c_re, c_im, reverse):
    f32 = jnp.float32
    lr = jnp.minimum(lam_re.astype(f32), -1e-4)
    li = lam_im.astype(f32)
    dt = jnp.exp(log_step.astype(f32))[:, None]
    mag = jnp.exp(lr * dt)
    ab_r = mag * jnp.cos(li * dt)
    ab_i = mag * jnp.sin(li * dt)
    den = lr * lr + li * li
    nr = ab_r - 1.0
    f_r = (nr * lr + ab_i * li) / den
    f_i = (ab_i * lr - nr * li) / den
    br = b_re.astype(f32)
    bi = b_im.astype(f32)
    bb_r = f_r[..., None] * br - f_i[..., None] * bi
    bb_i = f_r[..., None] * bi + f_i[..., None] * br
    bu_r = jnp.einsum('bsgc,gpc->bsgp', u, bb_r)
    bu_i = jnp.einsum('bsgc,gpc->bsgp', u, bb_i)
    a_r = jnp.broadcast_to(ab_r, bu_r.shape)
    a_i = jnp.broadcast_to(ab_i, bu_i.shape)
    _, _, s_r, s_i = lax.associative_scan(
        _complex_affine_combine, (a_r, a_i, bu_r, bu_i), axis=1, reverse=reverse)
    return (jnp.einsum('bsgp,gcp->bsgc', s_r, c_re.astype(f32))
            - jnp.einsum('bsgp,gcp->bsgc', s_i, c_im.astype(f32)))


def s5_mixer(u, lam_re, lam_im, log_step, b_re, b_im, c_re, c_im, ssm_d, glu_w, glu_b):
    B, S, _ = u.shape
    uf = u.astype(jnp.float32)
    ug = uf.reshape(B, S, SSM_GROUPS, SSM_GROUP)
    y = (s5_direction(ug, lam_re[0], lam_im[0], log_step[0], b_re[0], b_im[0], c_re[0], c_im[0], False)
         + s5_direction(ug, lam_re[1], lam_im[1], log_step[1], b_re[1], b_im[1], c_re[1], c_im[1], True))
    y = (y.reshape(B, S, D_SSM) + ssm_d.astype(jnp.float32) * uf).astype(u.dtype)
    z = jax.nn.gelu(y)
    return z * jax.nn.sigmoid(z @ glu_w + glu_b)


def hybrid_mixer(x, norm_g, w_in, q_norm_g, k_norm_g, lam_re, lam_im, log_step, b_re, b_im,
                 c_re, c_im, ssm_d, glu_w, glu_b, att_out_g, ssm_out_g, w_out, row, col):
    B, S, _ = x.shape
    h = rmsnorm(x, norm_g)
    proj = h @ w_in
    q, k, v, u = jnp.split(proj, [D_ATT, D_ATT + D_KV, D_ATT + 2 * D_KV], axis=-1)
    q = rmsnorm(q.reshape(B, S, ATT_HEADS, HEAD_DIM), q_norm_g)
    k = rmsnorm(k.reshape(B, S, ATT_KV_HEADS, HEAD_DIM), k_norm_g)
    v = v.reshape(B, S, ATT_KV_HEADS, HEAD_DIM)
    q = axial_rope(q, row, col)
    k = axial_rope(k, row, col)
    y_att = gqa_blocked(q, k, v)
    y_ssm = s5_mixer(u, lam_re, lam_im, log_step, b_re, b_im, c_re, c_im, ssm_d, glu_w, glu_b)
    y = jnp.concatenate([rmsnorm(y_att, att_out_g), rmsnorm(y_ssm, ssm_out_g)], axis=-1)
    return y @ w_out


def memory_cross_attn(x, mem, xa_norm_g, mem_norm_g, wq, wk, wv, wo):
    B, S, _ = x.shape
    M = mem.shape[1]
    hq = rmsnorm(x, xa_norm_g)
    hm = rmsnorm(mem, mem_norm_g)
    q = (hq @ wq).reshape(B, S, XA_HEADS, XA_HEAD_DIM)
    k = (hm @ wk).reshape(B, M, XA_HEADS, XA_HEAD_DIM)
    v = (hm @ wv).reshape(B, M, XA_HEADS, XA_HEAD_DIM)
    s = jnp.einsum('bqhd,bmhd->bhqm', q, k).astype(jnp.float32) * (XA_HEAD_DIM ** -0.5)
    p = jax.nn.softmax(s, axis=-1).astype(v.dtype)
    o = jnp.einsum('bhqm,bmhd->bqhd', p, v).reshape(B, S, D_MODEL)
    return o @ wo


def hier_moe(x, norm_g, grp_w, grp_b, exp_w, exp_b, w_gate, w_up, w_down):
    B, S, D = x.shape
    T = B * S
    h = rmsnorm(x, norm_g).reshape(T, D)
    grp_prob = jax.nn.softmax((h @ grp_w).astype(jnp.float32) + grp_b, axis=-1)
    g_w, g_sel = lax.top_k(grp_prob, 1)
    exp_logits = ((h @ exp_w).astype(jnp.float32) + exp_b).reshape(T, N_EXPERT_GROUPS, EXPERTS_PER_GROUP)
    idx = jnp.broadcast_to(g_sel[:, :, None], (T, 1, EXPERTS_PER_GROUP))
    in_grp = jnp.take_along_axis(exp_logits, idx, axis=1)[:, 0]
    top_v, top_i = lax.top_k(in_grp, TOP_K)
    w = jax.nn.softmax(top_v, axis=-1) * g_w
    e_idx = g_sel * EXPERTS_PER_GROUP + top_i
    gates = jnp.sum(jax.nn.one_hot(e_idx, N_EXPERTS, dtype=jnp.float32) * w[..., None], axis=1)
    gates = gates.astype(h.dtype)
    y = jnp.zeros_like(h)
    for e in range(N_EXPERTS):
        a = jax.nn.silu(h @ w_gate[e]) * (h @ w_up[e])
        y = y + (a * gates[:, e:e + 1]) @ w_down[e]
    return y.reshape(B, S, D)


def setup_inputs(seed: int = 0) -> dict:
    key = jax.random.key(seed)
    ks = jax.random.split(key, 34)
    f32 = jnp.float32
    L = DEPTH

    def nrm(k, shape, scale):
        return jax.random.normal(k, shape, f32) * scale

    def gain(k, shape):
        return 1.0 + nrm(k, shape, 0.02)

    n_idx = jnp.arange(SSM_STATE, dtype=f32)
    lam_im0 = jnp.broadcast_to(jnp.pi * n_idx, (L, 2, SSM_GROUPS, SSM_STATE))
    return {
        'x': nrm(ks[0], (BATCH, SEQ, D_MODEL), 1.0),
        'mem': nrm(ks[1], (BATCH, MEM_LEN, D_MODEL), 1.0),
        'mix_norm_g': gain(ks[2], (L, D_MODEL)),
        'w_in': nrm(ks[3], (L, D_MODEL, D_IN), D_MODEL ** -0.5),
        'q_norm_g': gain(ks[4], (L, HEAD_DIM)),
        'k_norm_g': gain(ks[5], (L, HEAD_DIM)),
        'ssm_lambda_re': -0.5 + nrm(ks[6], (L, 2, SSM_GROUPS, SSM_STATE), 0.01),
        'ssm_lambda_im': lam_im0 + nrm(ks[7], (L, 2, SSM_GROUPS, SSM_STATE), 0.01),
        'ssm_log_step': jax.random.uniform(ks[8], (L, 2, SSM_GROUPS), f32,
                                           minval=float(np.log(DT_MIN)), maxval=float(np.log(DT_MAX))),
        'ssm_b_re': nrm(ks[9], (L, 2, SSM_GROUPS, SSM_STATE, SSM_GROUP), (2 * SSM_GROUP) ** -0.5),
        'ssm_b_im': nrm(ks[10], (L, 2, SSM_GROUPS, SSM_STATE, SSM_GROUP), (2 * SSM_GROUP) ** -0.5),
        'ssm_c_re': nrm(ks[11], (L, 2, SSM_GROUPS, SSM_GROUP, SSM_STATE), (2 * SSM_STATE) ** -0.5),
        'ssm_c_im': nrm(ks[12], (L, 2, SSM_GROUPS, SSM_GROUP, SSM_STATE), (2 * SSM_STATE) ** -0.5),
        'ssm_d': nrm(ks[13], (L, D_SSM), 1.0),
        'ssm_glu_w': nrm(ks[14], (L, D_SSM, D_SSM), D_SSM ** -0.5),
        'ssm_glu_b': nrm(ks[15], (L, D_SSM), 0.01),
        'att_out_g': gain(ks[16], (L, D_ATT)),
        'ssm_out_g': gain(ks[17], (L, D_SSM)),
        'w_out': nrm(ks[18], (L, D_MIX, D_MODEL), D_MIX ** -0.5),
        'xa_norm_g': gain(ks[19], (L, D_MODEL)),
        'mem_norm_g': gain(ks[20], (L, D_MODEL)),
        'xa_wq': nrm(ks[21], (L, D_MODEL, D_MODEL), D_MODEL ** -0.5),
        'xa_wk': nrm(ks[22], (L, D_MODEL, D_MODEL), D_MODEL ** -0.5),
        'xa_wv': nrm(ks[23], (L, D_MODEL, D_MODEL), D_MODEL ** -0.5),
        'xa_wo': nrm(ks[24], (L, D_MODEL, D_MODEL), D_MODEL ** -0.5),
        'moe_norm_g': gain(ks[25], (L, D_MODEL)),
        'router_grp_w': nrm(ks[26], (L, D_MODEL, N_EXPERT_GROUPS), D_MODEL ** -0.5),
        'router_grp_b': nrm(ks[27], (L, N_EXPERT_GROUPS), 0.01),
        'router_exp_w': nrm(ks[28], (L, D_MODEL, N_EXPERTS), D_MODEL ** -0.5),
        'router_exp_b': nrm(ks[29], (L, N_EXPERTS), 0.01),
        'exp_w_gate': nrm(ks[30], (L, N_EXPERTS, D_MODEL, D_EXPERT), D_MODEL ** -0.5),
        'exp_w_up': nrm(ks[31], (L, N_EXPERTS, D_MODEL, D_EXPERT), D_MODEL ** -0.5),
        'exp_w_down': nrm(ks[32], (L, N_EXPERTS, D_EXPERT, D_MODEL), D_EXPERT ** -0.5),
        'final_norm_g': gain(ks[33], (D_MODEL,)),
    }


def reference(x, mem, mix_norm_g, w_in, q_norm_g, k_norm_g, ssm_lambda_re, ssm_lambda_im,
              ssm_log_step, ssm_b_re, ssm_b_im, ssm_c_re, ssm_c_im, ssm_d, ssm_glu_w, ssm_glu_b,
              att_out_g, ssm_out_g, w_out, xa_norm_g, mem_norm_g, xa_wq, xa_wk, xa_wv, xa_wo,
              moe_norm_g, router_grp_w, router_grp_b, router_exp_w, router_exp_b,
              exp_w_gate, exp_w_up, exp_w_down, final_norm_g):
    S = x.shape[1]
    rows = S // GRID_W
    row = jnp.repeat(jnp.arange(rows, dtype=jnp.int32), GRID_W)
    col = jnp.tile(jnp.arange(GRID_W, dtype=jnp.int32), rows)
    for l in range(DEPTH):
        x = x + hybrid_mixer(x, mix_norm_g[l], w_in[l], q_norm_g[l], k_norm_g[l],
                             ssm_lambda_re[l], ssm_lambda_im[l], ssm_log_step[l],
                             ssm_b_re[l], ssm_b_im[l], ssm_c_re[l], ssm_c_im[l],
                             ssm_d[l], ssm_glu_w[l], ssm_glu_b[l],
                             att_out_g[l], ssm_out_g[l], w_out[l], row, col)
        x = x + memory_cross_attn(x, mem, xa_norm_g[l], mem_norm_g[l],
                                  xa_wq[l], xa_wk[l], xa_wv[l], xa_wo[l])
        x = x + hier_moe(x, moe_norm_g[l], router_grp_w[l], router_grp_b[l],
                         router_exp_w[l], router_exp_b[l],
                         exp_w_gate[l], exp_w_up[l], exp_w_down[l])
    return rmsnorm(x, final_norm_g)
```

```cpp
#include <hip/hip_runtime.h>
#include <stdint.h>
#include <stdio.h>
#include <math.h>

namespace {
constexpr int D_MODEL = 1024, BATCH = 8, SEQ = 2048, T = BATCH * SEQ;
constexpr int MEM_LEN = 256, GRID_W = 64;
constexpr float EPS = 1e-6f;
constexpr int ATT_HEADS = 8, ATT_KV = 2, HD = 64, D_ATT = 512, D_KV = 128;
constexpr int D_SSM = 512, SSM_GROUP = 16, SSM_GROUPS = 32, SSM_STATE = 64;
constexpr int D_IN = 1280;
constexpr int XA_HEADS = 4, XA_HD = 256;
constexpr int NG = 4, EPG = 4, NE = 16, D_EXP = 512;

__device__ __forceinline__ float wave_sum(float v) {
#pragma unroll
    for (int o = 32; o > 0; o >>= 1) v += __shfl_xor(v, o);
    return v;
}
__device__ __forceinline__ float wave_max(float v) {
#pragma unroll
    for (int o = 32; o > 0; o >>= 1) v = fmaxf(v, __shfl_xor(v, o));
    return v;
}

__global__ __launch_bounds__(256) void rmsnorm_k(const float* x, int ldx, const float* add, int ldadd, const float* g, float* out, int ldo, int rows, int dim) {
    const int row = blockIdx.x * 4 + (threadIdx.x >> 6), lane = threadIdx.x & 63;
    if (row >= rows) return;
    const float* xr = x + (size_t)row * ldx;
    const float* ar = add ? add + (size_t)row * ldadd : nullptr;
    float s = 0.f;
    for (int c = lane; c < dim; c += 64) { float v = xr[c] + (ar ? ar[c] : 0.f); s += v * v; }
    s = wave_sum(s);
    const float r = rsqrtf(s / (float)dim + EPS);
    float* orow = out + (size_t)row * ldo;
    for (int c = lane; c < dim; c += 64) { float v = xr[c] + (ar ? ar[c] : 0.f); orow[c] = v * r * g[c]; }
}

struct GemmArgs {
    const float* A; const int* arow; const float* B; float* C; const int* crow; const float* rowscale; const float* bias; const int* Mdev;
    int lda, ldb, ldc, M, N, K, accumulate, pad;
};
__global__ __launch_bounds__(256) void sgemm_k(GemmArgs g) {
    __shared__ float As[16][68];
    __shared__ float Bs[16][64];
    const int M = g.Mdev ? *g.Mdev : g.M;
    const int m0 = blockIdx.y * 64, n0 = blockIdx.x * 64;
    if (m0 >= M) return;
    const int tid = threadIdx.x, tx = tid & 15, ty = tid >> 4;
    float acc[4][4];
#pragma unroll
    for (int i = 0; i < 4; ++i)
#pragma unroll
        for (int j = 0; j < 4; ++j) acc[i][j] = 0.f;
    const int ar = tid >> 2, ak = (tid & 3) * 4;
    const int grow = m0 + ar;
    const bool av = grow < M;
    const int srow = av ? (g.arow ? g.arow[grow] : grow) : 0;
    const float* ap = g.A + (size_t)srow * g.lda + ak;
    const int bk = tid >> 4, bn = (tid & 15) * 4;
    const float* bp = g.B + (size_t)bk * g.ldb + n0 + bn;
    for (int k0 = 0; k0 < g.K; k0 += 16) {
        float4 a = av ? *(const float4*)(ap + k0) : make_float4(0.f, 0.f, 0.f, 0.f);
        float4 b = *(const float4*)(bp + (size_t)k0 * g.ldb);
        As[ak + 0][ar] = a.x; As[ak + 1][ar] = a.y; As[ak + 2][ar] = a.z; As[ak + 3][ar] = a.w;
        *(float4*)&Bs[bk][bn] = b;
        __syncthreads();
#pragma unroll
        for (int kk = 0; kk < 16; ++kk) {
            float4 av4 = *(const float4*)&As[kk][ty * 4];
            float4 bv4 = *(const float4*)&Bs[kk][tx * 4];
            const float aa[4] = {av4.x, av4.y, av4.z, av4.w}, bb[4] = {bv4.x, bv4.y, bv4.z, bv4.w};
#pragma unroll
            for (int i = 0; i < 4; ++i)
#pragma unroll
                for (int j = 0; j < 4; ++j) acc[i][j] = fmaf(aa[i], bb[j], acc[i][j]);
        }
        __syncthreads();
    }
#pragma unroll
    for (int i = 0; i < 4; ++i) {
        const int row = m0 + ty * 4 + i;
        if (row < M) {
            const int orow = g.crow ? g.crow[row] : row;
            const float sc = g.rowscale ? g.rowscale[row] : 1.f;
            float* cp = g.C + (size_t)orow * g.ldc + n0 + tx * 4;
#pragma unroll
            for (int j = 0; j < 4; ++j) {
                float v = acc[i][j] * sc + (g.bias ? g.bias[n0 + tx * 4 + j] : 0.f);
                cp[j] = g.accumulate ? cp[j] + v : v;
            }
        }
    }
}

__global__ __launch_bounds__(256) void qk_norm_rope_k(float* proj, const float* qg, const float* kg) {
    const int w = blockIdx.x * 4 + (threadIdx.x >> 6), lane = threadIdx.x & 63;
    const int t = w / 10, hs = w % 10;
    if (t >= T) return;
    float* p = proj + (size_t)t * D_IN + hs * 64;
    const float x = p[lane];
    const float ss = wave_sum(x * x);
    const float g = hs < 8 ? qg[lane] : kg[lane];
    const float y = x * rsqrtf(ss * (1.f / 64.f) + EPS) * g;
    const int s = t % SEQ;
    const int pos = (lane < 32) ? (s / GRID_W) : (s % GRID_W);
    const int i = lane & 15;
    const float freq = powf(10000.f, -(float)i / 16.f);
    const float ang = (float)pos * freq;
    const float c = cosf(ang), sn = sinf(ang);
    const float other = __shfl_xor(y, 16);
    const bool second = (lane & 16) != 0;
    p[lane] = second ? (y * c + other * sn) : (y * c - other * sn);
}

__global__ __launch_bounds__(64) void attn_k(const float* proj, float* ycat) {
    const int blk = blockIdx.x;
    const int qblk = blk % 32, h = (blk / 32) % 8, b = blk / 256;
    const int kvh = h / 4;
    const int trow = b * SEQ + qblk * 64 + threadIdx.x;
    const float* qp = proj + (size_t)trow * D_IN + h * 64;
    float q[64], o[64];
#pragma unroll
    for (int d = 0; d < 64; ++d) { q[d] = qp[d] * 0.125f; o[d] = 0.f; }
    float m = -INFINITY, l = 0.f;
    const float* kb = proj + (size_t)b * SEQ * D_IN + 512 + kvh * 64;
    const float* vb = proj + (size_t)b * SEQ * D_IN + 640 + kvh * 64;
    for (int j = 0; j < SEQ; ++j) {
        const float* kr = kb + (size_t)j * D_IN;
        const float* vr = vb + (size_t)j * D_IN;
        float s = 0.f;
#pragma unroll
        for (int d = 0; d < 64; ++d) s = fmaf(q[d], kr[d], s);
        const float mn = fmaxf(m, s);
        const float alpha = __expf(m - mn), p = __expf(s - mn);
        l = l * alpha + p;
#pragma unroll
        for (int d = 0; d < 64; ++d) o[d] = fmaf(p, vr[d], o[d] * alpha);
        m = mn;
    }
    const float inv = 1.f / l;
    float* op = ycat + (size_t)trow * 1024 + h * 64;
#pragma unroll
    for (int d = 0; d < 64; ++d) op[d] = o[d] * inv;
}

__global__ __launch_bounds__(64) void s5_scan_k(const float* proj, const float* lam_re, const float* lam_im, const float* log_step,
                                               const float* b_re, const float* b_im, const float* c_re, const float* c_im, float* ycat) {
    const int g = blockIdx.x % SSM_GROUPS, b = blockIdx.x / SSM_GROUPS, p = threadIdx.x;
    for (int dir = 0; dir < 2; ++dir) {
        const int gp = (dir * SSM_GROUPS + g) * SSM_STATE + p;
        const float lr = fminf(lam_re[gp], -1e-4f), li = lam_im[gp];
        const float dt = expf(log_step[dir * SSM_GROUPS + g]);
        const float mag = expf(lr * dt);
        const float ab_r = mag * cosf(li * dt), ab_i = mag * sinf(li * dt);
        const float den = lr * lr + li * li, nr = ab_r - 1.f;
        const float f_r = (nr * lr + ab_i * li) / den, f_i = (ab_i * lr - nr * li) / den;
        float bbr[16], bbi[16], cr[16], ci[16];
#pragma unroll
        for (int c = 0; c < 16; ++c) {
            const float br = b_re[(size_t)gp * 16 + c], bi = b_im[(size_t)gp * 16 + c];
            bbr[c] = f_r * br - f_i * bi; bbi[c] = f_r * bi + f_i * br;
            cr[c] = c_re[((size_t)(dir * SSM_GROUPS + g) * 16 + c) * SSM_STATE + p];
            ci[c] = c_im[((size_t)(dir * SSM_GROUPS + g) * 16 + c) * SSM_STATE + p];
        }
        float sr = 0.f, si = 0.f;
        for (int step = 0; step < SEQ; ++step) {
            const int s = dir ? (SEQ - 1 - step) : step;
            const size_t trow = (size_t)b * SEQ + s;
            const float* up = proj + trow * D_IN + 768 + g * 16;
            float bur = 0.f, bui = 0.f;
#pragma unroll
            for (int c = 0; c < 16; ++c) { const float u = up[c]; bur = fmaf(bbr[c], u, bur); bui = fmaf(bbi[c], u, bui); }
            const float nsr = ab_r * sr - ab_i * si + bur;
            const float nsi = ab_r * si + ab_i * sr + bui;
            sr = nsr; si = nsi;
            float outv = 0.f;
#pragma unroll
            for (int c = 0; c < 16; ++c) {
                const float v = wave_sum(cr[c] * sr - ci[c] * si);
                outv = (p == c) ? v : outv;
            }
            if (p < 16) {
                float* yp = ycat + trow * 1024 + 512 + g * 16 + p;
                *yp = dir ? (*yp + outv) : outv;
            }
        }
    }
}

__global__ __launch_bounds__(256) void s5_gelu_k(const float* proj, const float* dpar, float* ycat) {
    const size_t idx = (size_t)blockIdx.x * 256 + threadIdx.x;
    const size_t t = idx / 512; const int c = idx % 512;
    if (t >= T) return;
    float* yp = ycat + t * 1024 + 512 + c;
    const float y = *yp + dpar[c] * proj[t * D_IN + 768 + c];
    const float z = 0.5f * y * (1.f + tanhf(0.7978845608028654f * (y + 0.044715f * y * y * y)));
    *yp = z;
}
__global__ __launch_bounds__(256) void s5_glu_k(const float* lin, float* ycat) {
    const size_t idx = (size_t)blockIdx.x * 256 + threadIdx.x;
    const size_t t = idx / 512; const int c = idx % 512;
    if (t >= T) return;
    float* yp = ycat + t * 1024 + 512 + c;
    const float z = *yp, a = lin[t * 512 + c];
    *yp = z / (1.f + expf(-a));
}

__global__ __launch_bounds__(256) void xattn_k(const float* q, const float* km, const float* vm, float* o) {
    const int w = blockIdx.x * 4 + (threadIdx.x >> 6), lane = threadIdx.x & 63;
    const int t = w / XA_HEADS, h = w % XA_HEADS;
    if (t >= T) return;
    const int b = t / SEQ;
    const float* qp = q + (size_t)t * 1024 + h * XA_HD;
    const float* kb = km + (size_t)b * MEM_LEN * 1024 + h * XA_HD;
    const float* vb = vm + (size_t)b * MEM_LEN * 1024 + h * XA_HD;
    float s0 = 0.f, s1 = 0.f, s2 = 0.f, s3 = 0.f;
    for (int d = 0; d < XA_HD; ++d) {
        const float qd = qp[d];
        s0 = fmaf(qd, kb[(size_t)(lane) * 1024 + d], s0);
        s1 = fmaf(qd, kb[(size_t)(lane + 64) * 1024 + d], s1);
        s2 = fmaf(qd, kb[(size_t)(lane + 128) * 1024 + d], s2);
        s3 = fmaf(qd, kb[(size_t)(lane + 192) * 1024 + d], s3);
    }
    const float sc = 0.0625f;
    s0 *= sc; s1 *= sc; s2 *= sc; s3 *= sc;
    const float mx = wave_max(fmaxf(fmaxf(s0, s1), fmaxf(s2, s3)));
    float p0 = expf(s0 - mx), p1 = expf(s1 - mx), p2 = expf(s2 - mx), p3 = expf(s3 - mx);
    const float inv = 1.f / wave_sum(p0 + p1 + p2 + p3);
    p0 *= inv; p1 *= inv; p2 *= inv; p3 *= inv;
    float o0 = 0.f, o1 = 0.f, o2 = 0.f, o3 = 0.f;
    for (int j = 0; j < 64; ++j) {
        const float a0 = __shfl(p0, j), a1 = __shfl(p1, j), a2 = __shfl(p2, j), a3 = __shfl(p3, j);
        const float* v0 = vb + (size_t)j * 1024; const float* v1 = vb + (size_t)(j + 64) * 1024;
        const float* v2 = vb + (size_t)(j + 128) * 1024; const float* v3 = vb + (size_t)(j + 192) * 1024;
        o0 += a0 * v0[lane] + a1 * v1[lane] + a2 * v2[lane] + a3 * v3[lane];
        o1 += a0 * v0[lane + 64] + a1 * v1[lane + 64] + a2 * v2[lane + 64] + a3 * v3[lane + 64];
        o2 += a0 * v0[lane + 128] + a1 * v1[lane + 128] + a2 * v2[lane + 128] + a3 * v3[lane + 128];
        o3 += a0 * v0[lane + 192] + a1 * v1[lane + 192] + a2 * v2[lane + 192] + a3 * v3[lane + 192];
    }
    float* op = o + (size_t)t * 1024 + h * XA_HD;
    op[lane] = o0; op[lane + 64] = o1; op[lane + 128] = o2; op[lane + 192] = o3;
}

__global__ __launch_bounds__(256) void router_k(const float* h, const float* grp_w, const float* grp_b, const float* exp_w, const float* exp_b,
                                               int* cnt, int* list, float* wlist) {
    const int t = blockIdx.x * 4 + (threadIdx.x >> 6), lane = threadIdx.x & 63;
    if (t >= T) return;
    const float* hr = h + (size_t)t * 1024;
    float gl[4], el[16];
#pragma unroll
    for (int i = 0; i < 4; ++i) gl[i] = 0.f;
#pragma unroll
    for (int i = 0; i < 16; ++i) el[i] = 0.f;
    for (int k = lane; k < 1024; k += 64) {
        const float x = hr[k];
        const float4 gw = *(const float4*)(grp_w + (size_t)k * 4);
        gl[0] = fmaf(x, gw.x, gl[0]); gl[1] = fmaf(x, gw.y, gl[1]); gl[2] = fmaf(x, gw.z, gl[2]); gl[3] = fmaf(x, gw.w, gl[3]);
#pragma unroll
        for (int i4 = 0; i4 < 4; ++i4) {
            const float4 ew = *(const float4*)(exp_w + (size_t)k * 16 + i4 * 4);
            el[i4 * 4 + 0] = fmaf(x, ew.x, el[i4 * 4 + 0]); el[i4 * 4 + 1] = fmaf(x, ew.y, el[i4 * 4 + 1]);
            el[i4 * 4 + 2] = fmaf(x, ew.z, el[i4 * 4 + 2]); el[i4 * 4 + 3] = fmaf(x, ew.w, el[i4 * 4 + 3]);
        }
    }
#pragma unroll
    for (int i = 0; i < 4; ++i) gl[i] = wave_sum(gl[i]) + grp_b[i];
#pragma unroll
    for (int i = 0; i < 16; ++i) el[i] = wave_sum(el[i]) + exp_b[i];
    if (lane == 0) {
        const float gm = fmaxf(fmaxf(gl[0], gl[1]), fmaxf(gl[2], gl[3]));
        const float e0 = expf(gl[0] - gm), e1 = expf(gl[1] - gm), e2 = expf(gl[2] - gm), e3 = expf(gl[3] - gm);
        const float gs = e0 + e1 + e2 + e3;
        int gsel = 0; float gbest = e0;
        if (e1 > gbest) { gbest = e1; gsel = 1; }
        if (e2 > gbest) { gbest = e2; gsel = 2; }
        if (e3 > gbest) { gbest = e3; gsel = 3; }
        const float gw = gbest / gs;
        float v0, v1, v2, v3;
        v0 = gsel == 0 ? el[0] : gsel == 1 ? el[4] : gsel == 2 ? el[8] : el[12];
        v1 = gsel == 0 ? el[1] : gsel == 1 ? el[5] : gsel == 2 ? el[9] : el[13];
        v2 = gsel == 0 ? el[2] : gsel == 1 ? el[6] : gsel == 2 ? el[10] : el[14];
        v3 = gsel == 0 ? el[3] : gsel == 1 ? el[7] : gsel == 2 ? el[11] : el[15];
        int i1 = 0; float b1 = v0;
        if (v1 > b1) { b1 = v1; i1 = 1; }
        if (v2 > b1) { b1 = v2; i1 = 2; }
        if (v3 > b1) { b1 = v3; i1 = 3; }
        int i2 = -1; float b2 = -INFINITY;
        if (i1 != 0 && v0 > b2) { b2 = v0; i2 = 0; }
        if (i1 != 1 && v1 > b2) { b2 = v1; i2 = 1; }
        if (i1 != 2 && v2 > b2) { b2 = v2; i2 = 2; }
        if (i1 != 3 && v3 > b2) { b2 = v3; i2 = 3; }
        const float ex2 = expf(b2 - b1);
        const float w1 = gw / (1.f + ex2), w2 = gw * ex2 / (1.f + ex2);
        const int ea = gsel * 4 + i1, eb = gsel * 4 + i2;
        const int pa = atomicAdd(&cnt[ea], 1); list[ea * T + pa] = t; wlist[ea * T + pa] = w1;
        const int pb = atomicAdd(&cnt[eb], 1); list[eb * T + pb] = t; wlist[eb * T + pb] = w2;
    }
}

__global__ __launch_bounds__(256) void silu_mul_k(float* gbuf, const float* ubuf, const int* cnt) {
    const size_t idx = (size_t)blockIdx.x * 256 + threadIdx.x;
    const size_t r = idx / 512;
    if (r >= (size_t)*cnt) return;
    const float g = gbuf[idx], u = ubuf[idx];
    gbuf[idx] = g / (1.f + expf(-g)) * u;
}

void launch_gemm(hipStream_t st, const float* A, int lda, const int* arow, const float* B, int ldb, float* C, int ldc, const int* crow,
                 const float* rowscale, const float* bias, int M, const int* Mdev, int N, int K, int accumulate) {
    GemmArgs g{};
    g.A = A; g.arow = arow; g.B = B; g.C = C; g.crow = crow; g.rowscale = rowscale; g.bias = bias; g.Mdev = Mdev;
    g.lda = lda; g.ldb = ldb; g.ldc = ldc; g.M = M; g.N = N; g.K = K; g.accumulate = accumulate; g.pad = 0;
    hipLaunchKernelGGL(sgemm_k, dim3(N / 64, (M + 63) / 64), dim3(256), 0, st, g);
}
}

extern "C" void kernel_launch(void* const* d_in, const int* in_sizes, int n_in, void* d_out, int out_size, void* d_ws, size_t ws_size,
                              hipStream_t stream) {
    const float* x = (const float*)d_in[0];
    const float* mem = (const float*)d_in[1];
    const float* mix_g = (const float*)d_in[2];
    const float* w_in = (const float*)d_in[3];
    const float* qg = (const float*)d_in[4];
    const float* kg = (const float*)d_in[5];
    const float* lam_re = (const float*)d_in[6];
    const float* lam_im = (const float*)d_in[7];
    const float* log_step = (const float*)d_in[8];
    const float* b_re = (const float*)d_in[9];
    const float* b_im = (const float*)d_in[10];
    const float* c_re = (const float*)d_in[11];
    const float* c_im = (const float*)d_in[12];
    const float* ssm_d = (const float*)d_in[13];
    const float* glu_w = (const float*)d_in[14];
    const float* glu_b = (const float*)d_in[15];
    const float* att_g = (const float*)d_in[16];
    const float* ssm_g = (const float*)d_in[17];
    const float* w_out = (const float*)d_in[18];
    const float* xa_g = (const float*)d_in[19];
    const float* mem_g = (const float*)d_in[20];
    const float* wq = (const float*)d_in[21];
    const float* wk = (const float*)d_in[22];
    const float* wv = (const float*)d_in[23];
    const float* wo = (const float*)d_in[24];
    const float* moe_g = (const float*)d_in[25];
    const float* grp_w = (const float*)d_in[26];
    const float* grp_b = (const float*)d_in[27];
    const float* exp_w = (const float*)d_in[28];
    const float* exp_b = (const float*)d_in[29];
    const float* w_gate = (const float*)d_in[30];
    const float* w_up = (const float*)d_in[31];
    const float* w_down = (const float*)d_in[32];
    const float* fin_g = (const float*)d_in[33];
    float* out = (float*)d_out;

    const size_t MiB = 1u << 20;
    char* ws = (char*)d_ws;
    float* H = (float*)(ws);
    float* PROJ = (float*)(ws + 64 * MiB);
    float* YCAT = (float*)(ws + 144 * MiB);
    float* HM = (float*)(ws + 208 * MiB);
    float* KM = (float*)(ws + 216 * MiB);
    float* VM = (float*)(ws + 224 * MiB);
    int* LIST = (int*)(ws + 232 * MiB);
    float* WLIST = (float*)(ws + 233 * MiB);
    int* CNT = (int*)(ws + 234 * MiB);
    if (ws_size < 235 * MiB) { fprintf(stderr, "ws too small: %zu\n", ws_size); return; }

    hipLaunchKernelGGL(rmsnorm_k, dim3(T / 4), dim3(256), 0, stream, x, 1024, (const float*)nullptr, 0, mix_g, H, 1024, T, 1024);
    launch_gemm(stream, H, 1024, nullptr, w_in, D_IN, PROJ, D_IN, nullptr, nullptr, nullptr, T, nullptr, D_IN, 1024, 0);
    hipLaunchKernelGGL(qk_norm_rope_k, dim3(T * 10 / 4), dim3(256), 0, stream, PROJ, qg, kg);
    hipLaunchKernelGGL(attn_k, dim3(BATCH * ATT_HEADS * (SEQ / 64)), dim3(64), 0, stream, PROJ, YCAT);
    hipLaunchKernelGGL(s5_scan_k, dim3(BATCH * SSM_GROUPS), dim3(64), 0, stream, PROJ, lam_re, lam_im, log_step, b_re, b_im, c_re, c_im, YCAT);
    hipLaunchKernelGGL(s5_gelu_k, dim3(T * 512 / 256), dim3(256), 0, stream, PROJ, ssm_d, YCAT);
    launch_gemm(stream, YCAT + 512, 1024, nullptr, glu_w, 512, H, 512, nullptr, nullptr, glu_b, T, nullptr, 512, 512, 0);
    hipLaunchKernelGGL(s5_glu_k, dim3(T * 512 / 256), dim3(256), 0, stream, H, YCAT);
    hipLaunchKernelGGL(rmsnorm_k, dim3(T / 4), dim3(256), 0, stream, YCAT, 1024, (const float*)nullptr, 0, att_g, YCAT, 1024, T, 512);
    hipLaunchKernelGGL(rmsnorm_k, dim3(T / 4), dim3(256), 0, stream, YCAT + 512, 1024, (const float*)nullptr, 0, ssm_g, YCAT + 512, 1024, T, 512);
    hipMemcpyAsync(out, x, (size_t)T * 1024 * 4, hipMemcpyDeviceToDevice, stream);
    launch_gemm(stream, YCAT, 1024, nullptr, w_out, 1024, out, 1024, nullptr, nullptr, nullptr, T, nullptr, 1024, 1024, 1);

    hipLaunchKernelGGL(rmsnorm_k, dim3(T / 4), dim3(256), 0, stream, out, 1024, (const float*)nullptr, 0, xa_g, H, 1024, T, 1024);
    hipLaunchKernelGGL(rmsnorm_k, dim3(BATCH * MEM_LEN / 4), dim3(256), 0, stream, mem, 1024, (const float*)nullptr, 0, mem_g, HM, 1024, BATCH * MEM_LEN, 1024);
    launch_gemm(stream, H, 1024, nullptr, wq, 1024, PROJ, 1024, nullptr, nullptr, nullptr, T, nullptr, 1024, 1024, 0);
    launch_gemm(stream, HM, 1024, nullptr, wk, 1024, KM, 1024, nullptr, nullptr, nullptr, BATCH * MEM_LEN, nullptr, 1024, 1024, 0);
    launch_gemm(stream, HM, 1024, nullptr, wv, 1024, VM, 1024, nullptr, nullptr, nullptr, BATCH * MEM_LEN, nullptr, 1024, 1024, 0);
    hipLaunchKernelGGL(xattn_k, dim3(T * XA_HEADS / 4), dim3(256), 0, stream, PROJ, KM, VM, YCAT);
    launch_gemm(stream, YCAT, 1024, nullptr, wo, 1024, out, 1024, nullptr, nullptr, nullptr, T, nullptr, 1024, 1024, 1);

    hipLaunchKernelGGL(rmsnorm_k, dim3(T / 4), dim3(256), 0, stream, out, 1024, (const float*)nullptr, 0, moe_g, H, 1024, T, 1024);
    hipMemsetAsync(CNT, 0, 64, stream);
    hipMemsetAsync(YCAT, 0, (size_t)T * 1024 * 4, stream);
    hipLaunchKernelGGL(router_k, dim3(T / 4), dim3(256), 0, stream, H, grp_w, grp_b, exp_w, exp_b, CNT, LIST, WLIST);
    float* GB = PROJ;
    float* UB = PROJ + (size_t)T * 512;
    for (int e = 0; e < NE; ++e) {
        const int* le = LIST + (size_t)e * T;
        launch_gemm(stream, H, 1024, le, w_gate + (size_t)e * 1024 * 512, 512, GB, 512, nullptr, nullptr, nullptr, T, CNT + e, 512, 1024, 0);
        launch_gemm(stream, H, 1024, le, w_up + (size_t)e * 1024 * 512, 512, UB, 512, nullptr, nullptr, nullptr, T, CNT + e, 512, 1024, 0);
        hipLaunchKernelGGL(silu_mul_k, dim3(T * 512 / 256), dim3(256), 0, stream, GB, UB, CNT + e);
        launch_gemm(stream, GB, 512, nullptr, w_down + (size_t)e * 512 * 1024, 1024, YCAT, 1024, le, WLIST + (size_t)e * T, nullptr, T, CNT + e, 1024, 512, 1);
    }
    hipLaunchKernelGGL(rmsnorm_k, dim3(T / 4), dim3(256), 0, stream, out, 1024, YCAT, 1024, fin_g, out, 1024, T, 1024);
}
```

```cpp
#include <hip/hip_runtime.h>
#include <hip/hip_bf16.h>
#include <cmath>
#include <stdint.h>
#include <stdio.h>
#include <hip/hip_cooperative_groups.h>
namespace fk {
namespace cg = cooperative_groups;
#define FK_LAS __attribute__((address_space(3)))
#define FK_GAS __attribute__((address_space(1)))
typedef unsigned short bf16_t;
typedef short bf16x8 __attribute__((ext_vector_type(8)));
typedef float f32x4 __attribute__((ext_vector_type(4)));
typedef float f32x2 __attribute__((ext_vector_type(2)));
typedef unsigned u32x4 __attribute__((ext_vector_type(4)));
typedef unsigned u32x2 __attribute__((ext_vector_type(2)));

constexpr int T = 16384, SEQ = 2048, BATCH = 8, DM = 1024, MEMLEN = 256, MTOK = BATCH * MEMLEN;
constexpr float EPS = 1e-6f;
constexpr float LOG2E = 1.4426950408889634f;
constexpr float QSCALE = 0.125f * LOG2E;
constexpr float XQSCALE = 0.0625f * LOG2E;
constexpr int NWAVES = 8, NTHREADS = 512;
constexpr int SL = 32, NCH = SEQ / SL;
constexpr int SUP = 768;
constexpr int SROWS = BATCH * NCH;

constexpr size_t MiB = 1u << 20;
constexpr size_t WS_CTL = 0;
constexpr size_t WS_WIN = 1 * MiB;
constexpr size_t WS_GLU = 4 * MiB;
constexpr size_t WS_WOUT = 5 * MiB;
constexpr size_t WS_WQ = 7 * MiB, WS_WK = 9 * MiB, WS_WV = 11 * MiB, WS_WO = 13 * MiB;
constexpr size_t WS_W1 = 15 * MiB;
constexpr size_t WS_W2 = 23 * MiB;
constexpr size_t WS_WGU = 47 * MiB;
constexpr size_t WS_WD = 79 * MiB;
constexpr size_t WS_R0 = 95 * MiB;
constexpr size_t WS_ROPE = WS_R0 + 65536;
constexpr size_t WS_R2 = WS_ROPE + 65536;
constexpr size_t WS_SSATT = 95 * MiB + 512 * 1024;
constexpr size_t WS_SSSSM = 96 * MiB;
constexpr size_t WS_SSX1 = 96 * MiB + 512 * 1024;
constexpr size_t WS_LIST = 102 * MiB;
constexpr size_t WS_WL = 103 * MiB;
constexpr size_t WS_XB = 105 * MiB;
constexpr size_t WS_HM = 137 * MiB;
constexpr size_t WS_Q = 141 * MiB;
constexpr size_t WS_K = 157 * MiB;
constexpr size_t WS_V = 161 * MiB;
constexpr size_t WS_SU = 165 * MiB;
constexpr size_t WS_SLOC = 189 * MiB;
constexpr size_t WS_KM = 205 * MiB;
constexpr size_t WS_VT = 209 * MiB;
constexpr size_t WS_YCAT = 213 * MiB;
constexpr size_t WS_END = 245 * MiB;
constexpr size_t WS_Z = WS_Q, WS_X1B = WS_SU, WS_QX = WS_XB, WS_PB = WS_YCAT, WS_ACT = WS_XB;
constexpr int CW_CNT = 64;
constexpr int CW_BAR = 4096;

constexpr int RING_BYTES = 131072, XTRA_OFF = RING_BYTES, LDS_BYTES = 147456;

__device__ __forceinline__ unsigned f2bf(float f) { unsigned u = __builtin_bit_cast(unsigned, f); return (u + 0x7fffu + ((u >> 16) & 1u)) >> 16; }
__device__ __forceinline__ unsigned pk2(float lo, float hi) { return f2bf(lo) | (f2bf(hi) << 16); }
__device__ __forceinline__ float bf2f(unsigned short b) { return __builtin_bit_cast(float, (unsigned)b << 16); }
__device__ __forceinline__ float bflo(unsigned w) { return __builtin_bit_cast(float, w << 16); }
__device__ __forceinline__ float bfhi(unsigned w) { return __builtin_bit_cast(float, w & 0xffff0000u); }
__device__ __forceinline__ float wsum(float v) {
#pragma unroll
    for (int o = 1; o < 64; o <<= 1) v += __shfl_xor(v, o);
    return v;
}

namespace pg8 {
constexpr int BM = 256, BK = 64, HALF = 128, HTB = HALF * BK * 2, STAGE_BYTES = 8 * HTB, NXCD = 8, WGM = 8;
__host__ __device__ __forceinline__ int lds_byte(int r, int c) { const int st = (r >> 4) * 2 + (c >> 5), rr = r & 15, cc = c & 31, ob = rr * 64 + cc * 2; return st * 1024 + (ob ^ (((ob >> 9) & 1) << 5)); }
__host__ __device__ __forceinline__ void stage_rc(int b, int& R, int& C) { const int st = b / 1024, sb = b % 1024, swz = sb ^ (((sb >> 9) & 1) << 5); R = (st >> 1) * 16 + swz / 64; C = (st & 1) * 32 + (swz % 64) / 2; }
__host__ __device__ __forceinline__ int perm32(int rho) { const int n = rho >> 4, i = rho & 15; return 8 * (i >> 2) + 4 * n + (i & 3); }

struct Unit { unsigned a_off, b_off; int pm, pn, kind, aux; };
struct Gemm { const char* base; int lda, ldb, K; };

__device__ __forceinline__ void tile_order(int L, int nM, int nN, int& pm, int& pn) {
    const int nwg = nM * nN; int wgid = L;
    { const int q = nwg / NXCD, r = nwg % NXCD, xcd = wgid % NXCD, off = wgid / NXCD; wgid = (xcd < r ? xcd * (q + 1) : r * (q + 1) + (xcd - r) * q) + off; }
    const int nig = WGM * nN, gid = wgid / nig, fm = gid * WGM, gsz = (nM - fm) < WGM ? (nM - fm) : WGM;
    pm = fm + ((wgid % nig) % gsz); pn = (wgid % nig) / gsz;
}

__device__ __forceinline__ unsigned cvt_pk_bf16(float lo, float hi) { unsigned r; asm volatile("v_cvt_pk_bf16_f32 %0, %1, %2" : "=v"(r) : "v"(lo), "v"(hi)); return r; }

template <class Epi, class Sched, bool ALIGN_EPI, bool SP2, bool KEEP_ACC>
__device__ __forceinline__ void gemm_phase(FK_LAS unsigned char* lds, const Gemm g, const Sched& S, const Epi& E, f32x4 (&acc)[2][2][4][2]) {
    int tid_ = threadIdx.x; asm volatile("" : "+v"(tid_));
    const int tid = tid_, wid = __builtin_amdgcn_readfirstlane(tid >> 6), lane = tid & 63, wr = wid >> 2, wc = wid & 3, fr = lane & 15, fq = lane >> 4;
    const int K = g.K, nt = K / BK;
    int R0, C0; stage_rc(tid * 16, R0, C0);
    unsigned voffB[2];
#pragma unroll
    for (int i = 0; i < 2; ++i) { const int R = R0 + 64 * i; const int Rb = Epi::PERM ? ((R & ~31) + perm32(R & 31)) : R; voffB[i] = (unsigned)(Rb * g.ldb + C0) * 2u; }
    const size_t kstep = (size_t)(BK * 2);
    const size_t hstepB = (size_t)HALF * g.ldb * 2;
    const unsigned ldsw = (unsigned)wid * 1024u;
    const int aoff = lds_byte(wr * 64 + fr, fq * 8), boff = lds_byte(wc * 32 + fr, fq * 8);
#define PG8_SA(b, h) (((b) * 2 + (h)) * HTB)
#define PG8_SB(b, h) ((4 + (b) * 2 + (h)) * HTB)
#define PG8_STAGE(bufoff, gbase, voff) do { _Pragma("unroll") for (int _i = 0; _i < 2; ++_i) \
        __builtin_amdgcn_global_load_lds((const unsigned*)((const char*)(gbase) + (voff)[_i]), (FK_LAS unsigned*)(lds + (bufoff) + ldsw + _i * 8192), 16, 0, 0); } while (0)
#define PG8_STAGEA(bufoff, gbase, h) do { _Pragma("unroll") for (int _i = 0; _i < 2; ++_i) \
        __builtin_amdgcn_global_load_lds((const unsigned*)((const char*)(gbase) + voffA[2 * (h) + _i]), (FK_LAS unsigned*)(lds + (bufoff) + ldsw + _i * 8192), 16, 0, 0); } while (0)
#define PG8_LDA(dst, b, h) do { _Pragma("unroll") for (int m = 0; m < 4; ++m) _Pragma("unroll") for (int k = 0; k < 2; ++k) dst[m][k] = *(const FK_LAS bf16x8*)(lds + PG8_SA(b, h) + aoff + m * 2048 + k * 1024); } while (0)
#define PG8_LDB(dst, b, h) do { _Pragma("unroll") for (int n = 0; n < 2; ++n) _Pragma("unroll") for (int k = 0; k < 2; ++k) dst[n][k] = *(const FK_LAS bf16x8*)(lds + PG8_SB(b, h) + boff + n * 2048 + k * 1024); } while (0)
#define PG8_MMA(ai, bj, At, Bt) do { __builtin_amdgcn_s_setprio(1); _Pragma("unroll") for (int m = 0; m < 4; ++m) _Pragma("unroll") for (int n = 0; n < 2; ++n) _Pragma("unroll") for (int k = 0; k < 2; ++k) \
        acc[ai][bj][m][n] = __builtin_amdgcn_mfma_f32_16x16x32_bf16(Bt[n][k], At[m][k], acc[ai][bj][m][n], 0, 0, 0); __builtin_amdgcn_s_setprio(0); } while (0)
#define PG8_WAIT_V(n) asm volatile("s_waitcnt vmcnt(" #n ")" ::: "memory")
#define PG8_WAIT_L(n) asm volatile("s_waitcnt lgkmcnt(" #n ")" ::: "memory")
#define PG8_BAR __builtin_amdgcn_s_barrier()
#define PG8_SCHED __builtin_amdgcn_sched_barrier(0)
    Unit cur, nxt; int ui = 0;
    if (!S.next(0, cur)) return;
    if constexpr (!KEEP_ACC) {
#pragma unroll
        for (int a = 0; a < 2; ++a)
#pragma unroll
            for (int b = 0; b < 2; ++b)
#pragma unroll
                for (int m = 0; m < 4; ++m)
#pragma unroll
                    for (int n = 0; n < 2; ++n) acc[a][b][m][n] = (f32x4){0.f, 0.f, 0.f, 0.f};
    }
    bf16x8 At[4][2], B0[2][2], B1[2][2];
    unsigned voffA[4];
#pragma unroll
    for (int q = 0; q < 4; ++q) voffA[q] = S.row_off(cur, R0 + 64 * q) + (unsigned)C0 * 2u;
    const char* Ab = g.base;
    const char* cB = g.base + cur.b_off;
    if constexpr (SP2) {
        PG8_STAGE(PG8_SB(0, 0), cB, voffB); PG8_STAGE(PG8_SB(0, 1), cB + hstepB, voffB); PG8_STAGEA(PG8_SA(0, 0), Ab, 0); PG8_STAGEA(PG8_SA(0, 1), Ab, 1);
        if (wr == 1) PG8_BAR;
        PG8_WAIT_V(2); PG8_BAR;
        PG8_STAGE(PG8_SB(1, 0), cB + kstep, voffB); PG8_STAGEA(PG8_SA(1, 0), Ab + kstep, 0); PG8_STAGE(PG8_SB(1, 1), cB + hstepB + kstep, voffB);
        PG8_WAIT_V(6); PG8_BAR;
    } else {
        PG8_STAGE(PG8_SB(0, 0), cB, voffB); PG8_STAGEA(PG8_SA(0, 0), Ab, 0); PG8_STAGE(PG8_SB(0, 1), cB + hstepB, voffB); PG8_STAGEA(PG8_SA(0, 1), Ab, 1);
        if (wr == 1) PG8_BAR;
        PG8_WAIT_V(4); PG8_BAR;
        PG8_STAGE(PG8_SB(1, 0), cB + kstep, voffB); PG8_STAGEA(PG8_SA(1, 0), Ab + kstep, 0); PG8_STAGE(PG8_SB(1, 1), cB + hstepB + kstep, voffB);
        PG8_WAIT_V(6); PG8_BAR;
    }
    for (;;) {
        const bool has_next = S.next(ui + 1, nxt);
        const char* nB = has_next ? g.base + nxt.b_off : cB;
        for (int t = 0; t < nt; t += 2) {
            const bool last = (t == nt - 2);
            const char* a1 = Ab + (size_t)(t + 1) * kstep;
            const char* a2 = last ? Ab : Ab + (size_t)(t + 2) * kstep; const char* b2 = last ? nB : cB + (size_t)(t + 2) * kstep;
            const char* a3 = a2 + kstep; const char* b3 = b2 + kstep;
            if constexpr (SP2) {
            PG8_LDB(B0, 0, 0); PG8_LDB(B1, 0, 1); PG8_SCHED; PG8_LDA(At, 0, 0); PG8_STAGEA(PG8_SA(1, 1), a1, 1);
            if (last && has_next) {
#pragma unroll
                for (int q = 0; q < 4; ++q) voffA[q] = S.row_off(nxt, R0 + 64 * q) + (unsigned)C0 * 2u;
            }
            PG8_WAIT_V(8); PG8_WAIT_L(0); PG8_BAR; PG8_MMA(0, 0, At, B0); PG8_MMA(0, 1, At, B1); PG8_BAR; PG8_SCHED;
            PG8_LDA(At, 0, 1); PG8_STAGE(PG8_SB(0, 0), b2, voffB); PG8_STAGE(PG8_SB(0, 1), b2 + hstepB, voffB); PG8_STAGEA(PG8_SA(0, 0), a2, 0);
            PG8_WAIT_V(8); PG8_WAIT_L(0); PG8_BAR; PG8_MMA(1, 0, At, B0); PG8_MMA(1, 1, At, B1); PG8_BAR; PG8_SCHED;
            PG8_LDB(B0, 1, 0); PG8_LDB(B1, 1, 1); PG8_SCHED; PG8_LDA(At, 1, 0); PG8_STAGEA(PG8_SA(0, 1), a2, 1);
            PG8_WAIT_V(8); PG8_WAIT_L(0); PG8_BAR; PG8_MMA(0, 0, At, B0); PG8_MMA(0, 1, At, B1); PG8_BAR; PG8_SCHED;
            PG8_LDA(At, 1, 1); PG8_STAGE(PG8_SB(1, 0), b3, voffB); PG8_STAGE(PG8_SB(1, 1), b3 + hstepB, voffB); PG8_STAGEA(PG8_SA(1, 0), a3, 0);
            PG8_WAIT_V(8); PG8_WAIT_L(0); PG8_BAR; PG8_MMA(1, 0, At, B0); PG8_MMA(1, 1, At, B1); PG8_BAR; PG8_SCHED;
            } else {
            PG8_LDB(B0, 0, 0); PG8_SCHED; PG8_LDA(At, 0, 0); PG8_STAGEA(PG8_SA(1, 1), a1, 1);
            if (last && has_next) {
#pragma unroll
                for (int q = 0; q < 4; ++q) voffA[q] = S.row_off(nxt, R0 + 64 * q) + (unsigned)C0 * 2u;
            }
            PG8_WAIT_L(8); PG8_BAR; PG8_WAIT_L(0); PG8_MMA(0, 0, At, B0); PG8_BAR; PG8_SCHED;
            PG8_LDB(B1, 0, 1); PG8_STAGE(PG8_SB(0, 0), b2, voffB);
            PG8_BAR; PG8_WAIT_L(0); PG8_MMA(0, 1, At, B1); PG8_BAR;
            PG8_LDA(At, 0, 1); PG8_STAGEA(PG8_SA(0, 0), a2, 0);
            PG8_BAR; PG8_WAIT_L(0); PG8_MMA(1, 0, At, B0); PG8_BAR; PG8_SCHED;
            PG8_STAGE(PG8_SB(0, 1), b2 + hstepB, voffB);
            PG8_WAIT_V(6); PG8_BAR; PG8_MMA(1, 1, At, B1); PG8_BAR;
            PG8_LDB(B0, 1, 0); PG8_SCHED; PG8_LDA(At, 1, 0); PG8_STAGEA(PG8_SA(0, 1), a2, 1);
            PG8_WAIT_L(8); PG8_BAR; PG8_WAIT_L(0); PG8_MMA(0, 0, At, B0); PG8_BAR; PG8_SCHED;
            PG8_LDB(B1, 1, 1); PG8_STAGE(PG8_SB(1, 0), b3, voffB);
            PG8_BAR; PG8_WAIT_L(0); PG8_MMA(0, 1, At, B1); PG8_BAR;
            PG8_LDA(At, 1, 1); PG8_STAGEA(PG8_SA(1, 0), a3, 0);
            PG8_BAR; PG8_WAIT_L(0); PG8_MMA(1, 0, At, B0); PG8_BAR; PG8_SCHED;
            PG8_STAGE(PG8_SB(1, 1), b3 + hstepB, voffB);
            PG8_WAIT_V(6); PG8_BAR; PG8_MMA(1, 1, At, B1); PG8_BAR;
            }
        }
        if constexpr (ALIGN_EPI) { if (wr == 0) PG8_BAR; }
        if constexpr (!Epi::AFTER_DRAIN) { int fr_e = fr, fq_e = fq, lane_e = lane; asm volatile("" : "+v"(fr_e), "+v"(fq_e), "+v"(lane_e)); E(acc, cur, wr, wc, fr_e, fq_e, lds, wid, lane_e); }
        if (!has_next) break;
#pragma unroll
        for (int a = 0; a < 2; ++a)
#pragma unroll
            for (int b = 0; b < 2; ++b)
#pragma unroll
                for (int m = 0; m < 4; ++m)
#pragma unroll
                    for (int n = 0; n < 2; ++n) acc[a][b][m][n] = (f32x4){0.f, 0.f, 0.f, 0.f};
        cur = nxt; cB = nB; ++ui;
        if constexpr (ALIGN_EPI) { if (wr == 1) PG8_BAR; }
    }
    PG8_WAIT_V(0);
    if constexpr (!ALIGN_EPI) { if (wr == 0) PG8_BAR; }
    PG8_BAR;
    if constexpr (Epi::AFTER_DRAIN) { int fr_e = fr, fq_e = fq, lane_e = lane; asm volatile("" : "+v"(fr_e), "+v"(fq_e), "+v"(lane_e)); E(acc, cur, wr, wc, fr_e, fq_e, lds, wid, lane_e); }
#undef PG8_SA
#undef PG8_SB
#undef PG8_STAGE
#undef PG8_STAGEA
#undef PG8_LDA
#undef PG8_LDB
#undef PG8_MMA
#undef PG8_WAIT_V
#undef PG8_WAIT_L
#undef PG8_BAR
#undef PG8_SCHED
}
}
namespace attn_body {
using bf16=__hip_bfloat16;
using bf16x8=__attribute__((ext_vector_type(8)))short;
using s16x4=__attribute__((ext_vector_type(4)))short;
using f32x16=__attribute__((ext_vector_type(16)))float;
using u32x4=__attribute__((ext_vector_type(4)))unsigned;
constexpr int BATCH=8,NHEAD=8,SEQ=2048,D=64,QP=512,KP=128,OP=1024;
constexpr int NW=8,QBLK=32,QB=QBLK*NW,KVBLK=64,NQB=SEQ/QB;
constexpr int ATTN_UNIT_ROWS=QB;
__device__ __forceinline__ int crow(int r,int hi){return (r&3)+8*(r>>2)+4*hi;}
#define SBAR() __builtin_amdgcn_sched_barrier(0)
__device__ __forceinline__ void cmask(f32x16&p0,f32x16&p1,int jb,int qrel,int hi){
  const float NEG=-INFINITY; int kb=64*jb+4*hi;
  #pragma unroll
  for(int r=0;r<16;++r){int kv=kb+(r&3)+8*(r>>2); if(kv>qrel)p0[r]=NEG; if(kv+32>qrel)p1[r]=NEG;}
}

constexpr int NSLOT=3, SLOTB=8192;
constexpr int LDS_K=0, LDS_V=NSLOT*SLOTB, LDS_WS=2*NSLOT*SLOTB, LDS_OST=LDS_WS+NW*64*4, LDS_BYTES=LDS_OST+NW*4096;
constexpr float C2=0.125f*1.4426950408889634f;
__device__ __forceinline__ void glds16(const void*gsrc,unsigned lds_dst){unsigned keep;
  asm volatile("s_mov_b32 %0, m0\n\ts_mov_b32 m0, %2\n\ts_nop 0\n\tglobal_load_lds_dwordx4 %1, off\n\ts_mov_b32 m0, %0":"=&s"(keep):"v"(gsrc),"s"(lds_dst):"memory");}
__device__ __forceinline__ float max3f(float a,float b,float c){float r;asm("v_max3_f32 %0, %1, %2, %3":"=v"(r):"v"(a),"v"(b),"v"(c));return r;}
__device__ __forceinline__ float max2f(float a,float b){float r;asm("v_max_f32_e32 %0, %1, %2":"=v"(r):"v"(a),"v"(b));return r;}
__device__ __forceinline__ float fadd_s(float a,float b){float r;asm("v_add_f32_e32 %0, %1, %2":"=v"(r):"v"(a),"v"(b));return r;}
__device__ __forceinline__ float fsub_s(float a,float b){float r;asm("v_sub_f32_e32 %0, %1, %2":"=v"(r):"v"(a),"v"(b));return r;}
typedef float f32x2_t __attribute__((ext_vector_type(2))); typedef __bf16 bf16x2_t __attribute__((ext_vector_type(2)));
__device__ __forceinline__ unsigned cvtpk_s(float lo,float hi){f32x2_t v={lo,hi};bf16x2_t b=__builtin_convertvector(v,bf16x2_t);return __builtin_bit_cast(unsigned,b);}
#define WAIT_BAR(N) asm volatile("s_waitcnt vmcnt(" #N ") lgkmcnt(0)\n\ts_barrier":::"memory")

__device__ __forceinline__ void qkt(f32x16&p0,f32x16&p1,const char*Kslot,const bf16x8*qr,const f32x16&negm,int r32,int hi){
  const char*kb=Kslot+hi*1024+r32*16;
  #pragma unroll
  for(int d0=0;d0<4;++d0){
    const bf16x8 b0=*reinterpret_cast<const bf16x8*>(kb+d0*2048);
    const bf16x8 b1=*reinterpret_cast<const bf16x8*>(kb+d0*2048+512);
    if(d0==0){p0=__builtin_amdgcn_mfma_f32_32x32x16_bf16(b0,qr[0],negm,0,0,0);p1=__builtin_amdgcn_mfma_f32_32x32x16_bf16(b1,qr[0],negm,0,0,0);}
    else{p0=__builtin_amdgcn_mfma_f32_32x32x16_bf16(b0,qr[d0],p0,0,0,0);p1=__builtin_amdgcn_mfma_f32_32x32x16_bf16(b1,qr[d0],p1,0,0,0);}}
}
typedef __attribute__((address_space(3))) const char* lds_cptr;
typedef short v4i16_t __attribute__((ext_vector_type(4)));
__device__ __forceinline__ void kload8(bf16x8*kf,lds_cptr kp){
  kf[0]=*(const __attribute__((address_space(3))) bf16x8*)(kp);      kf[1]=*(const __attribute__((address_space(3))) bf16x8*)(kp+512);
  kf[2]=*(const __attribute__((address_space(3))) bf16x8*)(kp+2048); kf[3]=*(const __attribute__((address_space(3))) bf16x8*)(kp+2560);
  kf[4]=*(const __attribute__((address_space(3))) bf16x8*)(kp+4096); kf[5]=*(const __attribute__((address_space(3))) bf16x8*)(kp+4608);
  kf[6]=*(const __attribute__((address_space(3))) bf16x8*)(kp+6144); kf[7]=*(const __attribute__((address_space(3))) bf16x8*)(kp+6656);
}
__device__ __forceinline__ void kload2(bf16x8*kf,lds_cptr kp,int j){ kf[2*j]=*(const __attribute__((address_space(3))) bf16x8*)(kp+j*2048); kf[2*j+1]=*(const __attribute__((address_space(3))) bf16x8*)(kp+j*2048+512); }
__device__ __forceinline__ s16x4 vtr(lds_cptr p){ return __builtin_bit_cast(s16x4,__builtin_amdgcn_ds_read_tr16_b64_v4i16((__attribute__((address_space(3))) v4i16_t*)p)); }
__device__ __forceinline__ float rowmax(const f32x16&p0,const f32x16&p1){
  float a=max3f(p0[0],p0[1],p1[0]),b=max3f(p0[2],p0[3],p1[1]);a=max3f(a,p1[2],p1[3]);
  #pragma unroll
  for(int r=4;r<16;r+=4){a=max3f(a,p0[r],p0[r+1]);b=max3f(b,p0[r+2],p0[r+3]);a=max3f(a,p1[r],p1[r+1]);b=max3f(b,p1[r+2],p1[r+3]);}
  const float m=max2f(a,b);
  auto rr=__builtin_amdgcn_permlane32_swap(__float_as_uint(m),__float_as_uint(m),false,false);
  return max2f(__uint_as_float(rr[0]),__uint_as_float(rr[1]));
}
__device__ __forceinline__ void pv(f32x16*o,int vb,bf16x8 pa0,bf16x8 pa1,bf16x8 pa2,bf16x8 pa3){
  #pragma unroll
  for(int d0=0;d0<2;++d0){s16x4 lo[4],hi[4];
    #pragma unroll
    for(int ks=0;ks<4;++ks){
      asm volatile("ds_read_b64_tr_b16 %0,%1 offset:%c2":"=&v"(lo[ks]):"v"(vb),"i"(d0*4096+ks*1024):"memory");
      asm volatile("ds_read_b64_tr_b16 %0,%1 offset:%c2":"=&v"(hi[ks]):"v"(vb),"i"(d0*4096+ks*1024+512):"memory");}
    asm volatile("s_waitcnt lgkmcnt(0)":::"memory");SBAR();
    #define PK(k) (bf16x8){lo[k][0],lo[k][1],lo[k][2],lo[k][3],hi[k][0],hi[k][1],hi[k][2],hi[k][3]}
    o[d0]=__builtin_amdgcn_mfma_f32_32x32x16_bf16(pa0,PK(0),o[d0],0,0,0);
    o[d0]=__builtin_amdgcn_mfma_f32_32x32x16_bf16(pa1,PK(1),o[d0],0,0,0);
    o[d0]=__builtin_amdgcn_mfma_f32_32x32x16_bf16(pa2,PK(2),o[d0],0,0,0);
    o[d0]=__builtin_amdgcn_mfma_f32_32x32x16_bf16(pa3,PK(3),o[d0],0,0,0);
    #undef PK
  }
}

#ifndef ATTN_STORE16
#define ATTN_STORE16(p,v) (*(u32x4*)(p)=(v))
#endif
template<int THRL> __device__ __forceinline__ void attn_unit(int b,int h,int qb,const bf16*Q,const bf16*__restrict__ K,const bf16*__restrict__ V,bf16*O,float*SS,char*shm){
  const int tid=threadIdx.x,lane=tid&63,r32=lane&31,hi=lane>>5; const int wid=__builtin_amdgcn_readfirstlane(tid>>6);
  const long rowbase=(long)b*SEQ; const int q0=qb*QB;
  const bf16*Qw=Q+(rowbase+q0+wid*QBLK)*QP+h*D;
  const bf16*Kh=K+rowbase*KP+(h>>2)*D,*Vh=V+rowbase*KP+(h>>2)*D;
  const unsigned lds0=(unsigned)(uintptr_t)shm;
  float*wsf=(float*)(shm+LDS_WS)+wid*64;
  const bf16*ksrc=Kh+(long)lane*KP+wid*8;
  const bf16*vsrc=Vh+(long)(16*(wid&3)+(lane>>2))*KP+(wid>>2)*32+(lane&3)*8;
  const unsigned kdst=lds0+LDS_K+wid*1024, vdst=lds0+LDS_V+wid*1024;
  #define DMA_K(t,slot) glds16(ksrc+(long)(t)*KVBLK*KP,(unsigned)__builtin_amdgcn_readfirstlane(kdst+(slot)))
  #define DMA_V(t,slot) glds16(vsrc+(long)(t)*KVBLK*KP,(unsigned)__builtin_amdgcn_readfirstlane(vdst+(slot)))
  const int vb0=(int)(lds0+LDS_V)+((lane>>4)&1)*32+(lane&3)*8+(4*hi+((lane&15)>>2))*64;
  const char*Kbase=shm+LDS_K; bf16x8 kf[8];
  const lds_cptr shm3=(lds_cptr)shm; const lds_cptr kp0=shm3+LDS_K+hi*1024+r32*16; const lds_cptr vp0=shm3+LDS_V+((lane>>4)&1)*32+(lane&3)*8+(4*hi+((lane&15)>>2))*64;
  const int NT=SEQ/KVBLK;
  DMA_K(0,0);DMA_V(0,0);DMA_K(1,SLOTB);
  bf16x8 qr[4];
  #pragma unroll
  for(int d0=0;d0<4;++d0)qr[d0]=*reinterpret_cast<const bf16x8*>(&Qw[(long)r32*QP+d0*16+hi*8]);
  float mhat=0.f,l_reg=0.f;f32x16 o[2];o[0]=f32x16{};o[1]=f32x16{};f32x16 negm=f32x16{};asm volatile("":"+v"(negm));
  const int qrel=wid*QBLK+r32;
  #define CMASK(P0,P1,t) do{}while(0)
  bool resc=false;
  #define START(P0,P1) do{ const float rm=rowmax(P0,P1); resc=false; \
    { const float dl=rm; mhat=fadd_s(mhat,dl); \
      _Pragma("unroll") for(int r=0;r<16;++r){P0[r]=fsub_s(P0[r],dl);P1[r]=fsub_s(P1[r],dl);} \
      _Pragma("unroll") for(int r=0;r<16;++r)negm[r]=-mhat; asm volatile("":"+v"(negm)); } \
    _Pragma("unroll") for(int r=0;r<16;++r)P0[r]=__builtin_amdgcn_exp2f(P0[r]); }while(0)
  #define RESC() do{ if(resc){ asm volatile("s_waitcnt lgkmcnt(0)":::"memory"); \
      _Pragma("unroll") for(int d_=0;d_<2;++d_) _Pragma("unroll") for(int r=0;r<16;++r)o[d_][r]*=wsf[crow(r,hi)]; } }while(0)
  f32x16 pA0,pA1,pB0,pB1;
  int sl_prev=0,sl_cur=0,sl_next=SLOTB;
  #define ROT() do{sl_prev=sl_cur;sl_cur=sl_next;sl_next=(sl_next==(NSLOT-1)*SLOTB)?0:sl_next+SLOTB;}while(0)
  DMA_K(2,2*SLOTB);
  WAIT_BAR(3);
  qkt(pA0,pA1,Kbase,qr,negm,r32,hi);asm volatile("s_nop 15\n\ts_nop 7":"+v"(pA0),"+v"(pA1));CMASK(pA0,pA1,0);
  START(pA0,pA1);
  _Pragma("unroll") for(int r=0;r<16;++r)pA1[r]=__builtin_amdgcn_exp2f(pA1[r]);
  WAIT_BAR(0);
  DMA_K(3,0);DMA_V(1,SLOTB);
  ROT();
  kload8(kf,kp0+sl_cur);
  WAIT_BAR(2);
  s16x4 vlo[8],vhi[8]; u32x4 pw0,pw1,pw2,pw3;
  #define PKW(P,B) cvtpk_s(P[B],P[B+1])
  #define PAF(k) __builtin_bit_cast(bf16x8,pw##k)
  #define VFR(i) (bf16x8){vlo[i][0],vlo[i][1],vlo[i][2],vlo[i][3],vhi[i][0],vhi[i][1],vhi[i][2],vhi[i][3]}
  #define PIN(x) asm volatile("":"+v"(x))
  #define MX3(a,b,c) __builtin_fmaxf(__builtin_fmaxf((a),(b)),(c))
  #define GAPA(MF,A0,A1,A2,A3,W0,W1,PW) do{ MF; sacc+=A0; sacc+=A1; sacc+=A2; sacc+=A3; PIN(sacc); W0; W1; PIN(PW); SBAR(); }while(0)
  #define EX(v) __builtin_amdgcn_exp2f(v)
  #define GAPB(MF,X,B) do{ MF; X[B]=EX(X[B]); X[B+1]=EX(X[B+1]); X[B+2]=EX(X[B+2]); X[B+3]=EX(X[B+3]); PIN(X); SBAR(); }while(0)
  #define VRD(i) do{ vlo[i]=vtr(vp_+(((i)>>2)*4096+((i)&3)*1024)); vhi[i]=vtr(vp_+(((i)>>2)*4096+((i)&3)*1024+512)); }while(0)
  #define KRD(G,j) do{ if(G){ kload2(kf,kp0+sl_next,j); SBAR(); } }while(0)
  #define STEP(C0,C1,P0,P1,t,GK,GV,GL) do{ SBAR(); \
    const lds_cptr vp_=vp0+sl_prev; \
    VRD(0); SBAR(); float sacc=(P0[0]+P0[1]); \
    GAPA(C0=__builtin_amdgcn_mfma_f32_32x32x16_bf16(kf[0],qr[0],negm,0,0,0), P0[2],P0[3],P0[4],P0[5],     pw0[0]=PKW(P0,0), pw0[1]=PKW(P0,2), pw0); \
    VRD(4); SBAR(); GAPA(C1=__builtin_amdgcn_mfma_f32_32x32x16_bf16(kf[1],qr[0],negm,0,0,0), P0[6],P0[7],P0[8],P0[9],     pw0[2]=PKW(P0,4), pw0[3]=PKW(P0,6), pw0); \
    VRD(1); SBAR(); GAPA(C0=__builtin_amdgcn_mfma_f32_32x32x16_bf16(kf[2],qr[1],C0,0,0,0),   P0[10],P0[11],P0[12],P0[13], pw1[0]=PKW(P0,8), pw1[1]=PKW(P0,10), pw1); \
    VRD(5); SBAR(); GAPA(C1=__builtin_amdgcn_mfma_f32_32x32x16_bf16(kf[3],qr[1],C1,0,0,0),   P0[14],P0[15],P1[0],P1[1],   pw1[2]=PKW(P0,12),pw1[3]=PKW(P0,14), pw1); \
    VRD(2); SBAR(); GAPA(C0=__builtin_amdgcn_mfma_f32_32x32x16_bf16(kf[4],qr[2],C0,0,0,0),   P1[2],P1[3],P1[4],P1[5],     pw2[0]=PKW(P1,0), pw2[1]=PKW(P1,2), pw2); \
    VRD(6); SBAR(); GAPA(C1=__builtin_amdgcn_mfma_f32_32x32x16_bf16(kf[5],qr[2],C1,0,0,0),   P1[6],P1[7],P1[8],P1[9],     pw2[2]=PKW(P1,4), pw2[3]=PKW(P1,6), pw2); \
    VRD(3); SBAR(); GAPA(C0=__builtin_amdgcn_mfma_f32_32x32x16_bf16(kf[6],qr[3],C0,0,0,0),   P1[10],P1[11],P1[12],P1[13], pw3[0]=PKW(P1,8), pw3[1]=PKW(P1,10), pw3); \
    VRD(7); SBAR(); GAPA(C1=__builtin_amdgcn_mfma_f32_32x32x16_bf16(kf[7],qr[3],C1,0,0,0),   P1[14],P1[15],0.f,0.f,       pw3[2]=PKW(P1,12),pw3[3]=PKW(P1,14), pw3); \
    l_reg+=sacc; \
    if(GK){DMA_K((t)+3,sl_cur);} if(GV){DMA_V((t)+1,sl_next);} \
    CMASK(C0,C1,t); \
    { float a=MX3(C0[0],C0[1],C1[0]),b=MX3(C0[2],C0[3],C1[1]); a=MX3(a,C1[2],C1[3]); \
      _Pragma("unroll") for(int r=4;r<16;r+=4){a=MX3(a,C0[r],C0[r+1]);b=MX3(b,C0[r+2],C0[r+3]);a=MX3(a,C1[r],C1[r+1]);b=MX3(b,C1[r+2],C1[r+3]);} \
      float rm=__builtin_fmaxf(a,b); { auto rr=__builtin_amdgcn_permlane32_swap(__float_as_uint(rm),__float_as_uint(rm),false,false); rm=__builtin_fmaxf(__uint_as_float(rr[0]),__uint_as_float(rr[1])); } \
      resc=false; \
      if(__builtin_expect(__any(rm>(float)THRL),0)){ const float dl=__builtin_fmaxf(rm,0.f); mhat+=dl; \
        _Pragma("unroll") for(int r=0;r<16;++r){C0[r]-=dl;C1[r]-=dl;} \
        _Pragma("unroll") for(int r=0;r<16;++r)negm[r]=-mhat; asm volatile("":"+v"(negm)); \
        const float f=__builtin_amdgcn_exp2f(-dl); l_reg*=f; if(hi==0)wsf[r32]=f; resc=true; } } \
    SBAR(); \
    GAPB(o[0]=__builtin_amdgcn_mfma_f32_32x32x16_bf16(PAF(0),VFR(0),o[0],0,0,0), C0,0); \
    GAPB(o[1]=__builtin_amdgcn_mfma_f32_32x32x16_bf16(PAF(0),VFR(4),o[1],0,0,0), C0,4); \
    KRD(GL,0); GAPB(o[0]=__builtin_amdgcn_mfma_f32_32x32x16_bf16(PAF(1),VFR(1),o[0],0,0,0), C0,8); \
    KRD(GL,1); GAPB(o[1]=__builtin_amdgcn_mfma_f32_32x32x16_bf16(PAF(1),VFR(5),o[1],0,0,0), C0,12); \
    KRD(GL,2); GAPB(o[0]=__builtin_amdgcn_mfma_f32_32x32x16_bf16(PAF(2),VFR(2),o[0],0,0,0), C1,0); \
    KRD(GL,3); GAPB(o[1]=__builtin_amdgcn_mfma_f32_32x32x16_bf16(PAF(2),VFR(6),o[1],0,0,0), C1,4); \
    GAPB(o[0]=__builtin_amdgcn_mfma_f32_32x32x16_bf16(PAF(3),VFR(3),o[0],0,0,0), C1,8); \
    GAPB(o[1]=__builtin_amdgcn_mfma_f32_32x32x16_bf16(PAF(3),VFR(7),o[1],0,0,0), C1,12); \
    }while(0)
  int t=1;
  #undef CMASK
  #define CMASK(P0,P1,t) do{}while(0)
  for(;t+5<NT;t+=2){
    STEP(pB0,pB1,pA0,pA1,t,true,true,true);     WAIT_BAR(2); RESC(); ROT();
    STEP(pA0,pA1,pB0,pB1,t+1,true,true,true);   WAIT_BAR(2); RESC(); ROT();
  }
  #undef CMASK
  #define CMASK(P0,P1,t) do{}while(0)
  #define ENDW(tt) do{ if((tt)+3<NT){WAIT_BAR(2);} else if((tt)+2<NT){WAIT_BAR(1);} else {WAIT_BAR(0);} }while(0)
  for(;t+1<NT;t+=2){
    STEP(pB0,pB1,pA0,pA1,t,(t+3<NT),(t+1<NT),(t+1<NT));       ENDW(t);   RESC(); ROT();
    STEP(pA0,pA1,pB0,pB1,t+1,(t+4<NT),(t+2<NT),(t+2<NT));     ENDW(t+1); RESC(); ROT();
  }
  STEP(pB0,pB1,pA0,pA1,NT-1,false,false,false); RESC();
  { float sacc=pB0[0]+pB0[1]; _Pragma("unroll") for(int r=2;r<16;++r)sacc+=pB0[r]; _Pragma("unroll") for(int r=0;r<16;++r)sacc+=pB1[r]; l_reg+=sacc;
    pw0=(u32x4){PKW(pB0,0),PKW(pB0,2),PKW(pB0,4),PKW(pB0,6)};pw1=(u32x4){PKW(pB0,8),PKW(pB0,10),PKW(pB0,12),PKW(pB0,14)};pw2=(u32x4){PKW(pB1,0),PKW(pB1,2),PKW(pB1,4),PKW(pB1,6)};pw3=(u32x4){PKW(pB1,8),PKW(pB1,10),PKW(pB1,12),PKW(pB1,14)};
    SBAR(); pv(o,vb0+sl_cur,PAF(0),PAF(1),PAF(2),PAF(3)); }
  #undef PKW
  #undef PAF
  #undef VFR
  #undef PIN
  #undef MX3
  #undef GAPA
  #undef GAPB
  #undef EX
  #undef VRD
  #undef KRD
  #undef STEP
  #undef ENDW
  {auto rr=__builtin_amdgcn_permlane32_swap(__float_as_uint(l_reg),__float_as_uint(l_reg),false,false);l_reg=__uint_as_float(rr[0])+__uint_as_float(rr[1]);}
  if(hi==0)wsf[32+r32]=l_reg;asm volatile("s_waitcnt lgkmcnt(0)":::"memory");
  float rli[16];
  #pragma unroll
  for(int r=0;r<16;++r)rli[r]=__builtin_amdgcn_rcpf(wsf[32+crow(r,hi)]);
  bf16*Ow=O+(rowbase+q0+wid*QBLK)*OP+h*D; float*SSw=SS+((rowbase+q0+wid*QBLK)*8+h);
  { bf16*stg=(bf16*)(shm+LDS_OST)+wid*2048;
    #pragma unroll
    for(int r=0;r<16;++r){const int orow=crow(r,hi);
      #pragma unroll
      for(int d0=0;d0<2;++d0)stg[orow*64+d0*32+r32]=__float2bfloat16(o[d0][r]*rli[r]);}
    asm volatile("s_waitcnt lgkmcnt(0)":::"memory");
    #pragma unroll
    for(int i=0;i<4;++i){const int row=i*8+(lane>>3),ch=lane&7; const u32x4 v=*(const u32x4*)(stg+row*64+ch*8); ATTN_STORE16(Ow+(long)row*OP+ch*8,v);
      float ss_=0.f; _Pragma("unroll") for(int e_=0;e_<4;++e_){const unsigned w_=v[e_]; const float a_=__uint_as_float(w_<<16),b_=__uint_as_float(w_&0xffff0000u); ss_+=a_*a_+b_*b_;}
      ss_+=__shfl_xor(ss_,1); ss_+=__shfl_xor(ss_,2); ss_+=__shfl_xor(ss_,4); if(ch==0)SSw[(long)row*8]=ss_;} }
  asm volatile("s_waitcnt lgkmcnt(0)\n\ts_barrier":::"memory");
  #undef DMA_K
  #undef DMA_V
  #undef CMASK
  #undef START
  #undef RESC
  #undef ROT
}
constexpr int ATTN_LDS_BYTES=LDS_BYTES;
template<int THRL=8> __device__ __forceinline__ void attn_phase(char*lds,const bf16*Q,const bf16*K,const bf16*V,bf16*O,float*SS,int G,int vcu){
  for(int uid=vcu;uid<512;uid+=G){ const int pair=uid>>5,b=pair>>1,h=(pair&1)*4+((uid>>3)&3),qb=uid&7; attn_unit<THRL>(b,h,qb,Q,K,V,O,SS,lds); }
}
#undef SBAR
#undef WAIT_BAR
}
struct Params {
    const float* in[34];
    float* out;
    unsigned char* ws;
    int ph_lo, ph_hi;
};
using pg8::Unit; using pg8::Gemm;

template <class RowMap>
__device__ __forceinline__ void transpose_item(const float* W, int K, int N, const float* gain, bf16_t* WT, const RowMap& rm, FK_LAS float* scr, int item, int lane) {
    const int nblk = N / 32, kb = item / nblk, nb = item % nblk, k0 = 64 * kb, n0 = 32 * nb;
#pragma unroll 8
    for (int i = 0; i < 32; ++i) { const int kk = 2 * i + (lane >> 5); const float gv = gain ? gain[k0 + kk] : 1.f; scr[kk * 33 + (lane & 31)] = W[(size_t)(k0 + kk) * N + n0 + (lane & 31)] * gv; }
    asm volatile("s_waitcnt lgkmcnt(0)" ::: "memory");
    const int c = lane & 7;
#pragma unroll
    for (int j = 0; j < 4; ++j) { const int n = (lane >> 3) + 8 * j; const FK_LAS float* s = scr + (8 * c) * 33 + n;
        u32x4 o; o.x = pk2(s[0 * 33], s[1 * 33]); o.y = pk2(s[2 * 33], s[3 * 33]); o.z = pk2(s[4 * 33], s[5 * 33]); o.w = pk2(s[6 * 33], s[7 * 33]);
        *(u32x4*)(WT + (size_t)rm(n0 + n) * K + k0 + 8 * c) = o; }
    asm volatile("s_waitcnt lgkmcnt(0)" ::: "memory");
}
struct RmId { __device__ __forceinline__ int operator()(int n) const { return n; } };
struct RmWin { __device__ __forceinline__ int operator()(int n) const { if (n >= 768) return n; const int head = n >> 6, dim = n & 63; return 256 * (head >> 2) + 128 * (dim >> 5) + 32 * (head & 3) + (dim & 31); } };
struct RmGU { int up; __device__ __forceinline__ int operator()(int n) const { return (n >> 7) * 256 + up * 128 + (n & 127); } };

__device__ __forceinline__ void row_to_bf16(const float* xrow, bf16_t* orow, float* rout, const float* gain, bool normalise, int lane) {
    const f32x4* xr = (const f32x4*)xrow + lane;
    f32x4 v[4]; float s = 0.f;
#pragma unroll
    for (int j = 0; j < 4; ++j) { v[j] = xr[64 * j]; s += (v[j].x * v[j].x + v[j].y * v[j].y) + (v[j].z * v[j].z + v[j].w * v[j].w); }
    const float r = rsqrtf(wsum(s) * (1.f / 1024.f) + EPS);
    if (rout && lane == 0) *rout = r;
    unsigned long long* o8 = (unsigned long long*)orow + lane;
#pragma unroll
    for (int j = 0; j < 4; ++j) {
        f32x4 w = v[j];
        if (normalise) { const f32x4 gv = ((const f32x4*)gain)[lane + 64 * j]; w = w * r * gv; }
        o8[64 * j] = (unsigned long long)pk2(w.x, w.y) | ((unsigned long long)pk2(w.z, w.w) << 32);
    }
}

__device__ __forceinline__ void s5_prep_group(const Params& p, int g, FK_LAS float* L, int tid) {
    const float* lam_re = p.in[6]; const float* lam_im = p.in[7]; const float* log_step = p.in[8];
    const float* b_re = p.in[9]; const float* b_im = p.in[10]; const float* c_re = p.in[11]; const float* c_im = p.in[12]; const float* dpar = p.in[13];
    FK_LAS float* LPr = L;
    FK_LAS float* LPi = LPr + 2 * 33 * 64;
    FK_LAS float* BBr = LPi + 2 * 33 * 64;
    FK_LAS float* BBi = BBr + 2 * 1024;
    FK_LAS float* CCr = BBi + 2 * 1024;
    FK_LAS float* CCi = CCr + 2 * 1024;
    FK_LAS float* KT = CCi + 2 * 1024;
    for (int idx = tid; idx < 2 * 33 * 64; idx += NTHREADS) {
        const int dir = idx / (33 * 64), e = (idx / 64) % 33, pp = idx & 63;
        const int gp = (dir * 32 + g) * 64 + pp;
        const float lr = fminf(lam_re[gp], -1e-4f), li = lam_im[gp], dt = expf(log_step[dir * 32 + g]);
        const float mag = expf(lr * dt * (float)e), ang = li * dt * (float)e;
        LPr[idx] = mag * cosf(ang); LPi[idx] = mag * sinf(ang);
    }
    for (int idx = tid; idx < 2 * 1024; idx += NTHREADS) {
        const int dir = idx >> 10, pp = (idx >> 4) & 63, c = idx & 15;
        const int gp = (dir * 32 + g) * 64 + pp;
        const float lr = fminf(lam_re[gp], -1e-4f), li = lam_im[gp], dt = expf(log_step[dir * 32 + g]);
        const float mag = expf(lr * dt), ab_r = mag * cosf(li * dt), ab_i = mag * sinf(li * dt);
        const float den = lr * lr + li * li, nr = ab_r - 1.f;
        const float f_r = (nr * lr + ab_i * li) / den, f_i = (ab_i * lr - nr * li) / den;
        const float br = b_re[(size_t)gp * 16 + c], bi = b_im[(size_t)gp * 16 + c];
        BBr[idx] = f_r * br - f_i * bi; BBi[idx] = f_r * bi + f_i * br;
        const int cc = (idx >> 6) & 15, p2 = idx & 63;
        CCr[idx] = c_re[((size_t)(dir * 32 + g) * 16 + cc) * 64 + p2];
        CCi[idx] = c_im[((size_t)(dir * 32 + g) * 16 + cc) * 64 + p2];
    }
    __syncthreads();
    for (int idx = tid; idx < 2 * 32 * 256; idx += NTHREADS) {
        const int dir = idx >> 13, tau = (idx >> 8) & 31, cc = (idx >> 4) & 15, c = idx & 15;
        const FK_LAS float* cr = CCr + dir * 1024 + cc * 64; const FK_LAS float* ci = CCi + dir * 1024 + cc * 64;
        const FK_LAS float* lr = LPr + (dir * 33 + tau) * 64; const FK_LAS float* li = LPi + (dir * 33 + tau) * 64;
        const FK_LAS float* br = BBr + dir * 1024 + c; const FK_LAS float* bi = BBi + dir * 1024 + c;
        float acc = 0.f;
#pragma unroll 8
        for (int pp = 0; pp < 64; ++pp) {
            const float tr = cr[pp] * lr[pp] - ci[pp] * li[pp], ti = cr[pp] * li[pp] + ci[pp] * lr[pp];
            acc += tr * br[pp * 16] - ti * bi[pp * 16];
        }
        KT[idx] = acc;
    }
    __syncthreads();
    bf16_t* W1 = (bf16_t*)(p.ws + WS_W1) + (size_t)g * 256 * 512;
    for (int ch = tid; ch < 256 * 64; ch += NTHREADS) {
        const int n = ch >> 6, kk0 = (ch & 63) * 8, j = kk0 >> 4, c0 = kk0 & 15;
        const int dir = n >> 7, ri = (n >> 6) & 1, pp = n & 63, e = dir ? j : 31 - j;
        const float lr = LPr[(dir * 33 + e) * 64 + pp], li = LPi[(dir * 33 + e) * 64 + pp];
        float v[8];
#pragma unroll
        for (int q = 0; q < 8; ++q) { const float br = BBr[dir * 1024 + pp * 16 + c0 + q], bi = BBi[dir * 1024 + pp * 16 + c0 + q]; v[q] = ri ? (lr * bi + li * br) : (lr * br - li * bi); }
        u32x4 o; o.x = pk2(v[0], v[1]); o.y = pk2(v[2], v[3]); o.z = pk2(v[4], v[5]); o.w = pk2(v[6], v[7]);
        *(u32x4*)(W1 + (size_t)n * 512 + kk0) = o;
    }
    bf16_t* W2 = (bf16_t*)(p.ws + WS_W2) + (size_t)g * 512 * SUP;
    for (int ch = tid; ch < 512 * 96; ch += NTHREADS) {
        const int nn = ch / 96, kk0 = (ch % 96) * 8, j = nn >> 4, cc = nn & 15;
        float v[8];
        if (kk0 < 256) {
            const int dir = kk0 >> 7, ri = (kk0 >> 6) & 1, p0 = kk0 & 63, e = dir ? 32 - j : j + 1;
#pragma unroll
            for (int q = 0; q < 8; ++q) {
                const int pp = p0 + q;
                const float cr = CCr[dir * 1024 + cc * 64 + pp], ci = CCi[dir * 1024 + cc * 64 + pp];
                const float lr = LPr[(dir * 33 + e) * 64 + pp], li = LPi[(dir * 33 + e) * 64 + pp];
                v[q] = ri ? -(cr * li + ci * lr) : (cr * lr - ci * li);
            }
        } else {
            const int j2 = (kk0 - 256) >> 4, c0 = kk0 & 15;
#pragma unroll
            for (int q = 0; q < 8; ++q) {
                const int c = c0 + q; float a = 0.f;
                if (j2 <= j) a += KT[(0 * 32 + (j - j2)) * 256 + cc * 16 + c];
                if (j2 >= j) a += KT[(1 * 32 + (j2 - j)) * 256 + cc * 16 + c];
                if (j2 == j && c == cc) a += dpar[g * 16 + c];
                v[q] = a;
            }
        }
        u32x4 o; o.x = pk2(v[0], v[1]); o.y = pk2(v[2], v[3]); o.z = pk2(v[4], v[5]); o.w = pk2(v[6], v[7]);
        *(u32x4*)(W2 + (size_t)nn * SUP + kk0) = o;
    }
    __syncthreads();
}

__device__ __forceinline__ void p0_prologue(const Params& p, FK_LAS unsigned char* lds, int vcu, int G, int tid, int lane, int wave) {
    unsigned char* ws = p.ws;
    if (vcu >= G - 32) s5_prep_group(p, vcu - (G - 32), (FK_LAS float*)lds, tid);
    if (vcu == 0) {
        for (int idx = tid; idx < 1024; idx += NTHREADS) {
            const int pos = idx >> 4, i = idx & 15;
            const float ang = (float)pos * powf(10000.f, -(float)i / 16.f);
            ((f32x2*)(ws + WS_ROPE))[idx] = (f32x2){cosf(ang), sinf(ang)};
        }
    }
    FK_LAS float* scr = (FK_LAS float*)(lds + wave * 16384);
    const int gw = vcu * NWAVES + wave, NGW = G * NWAVES;
    constexpr int I_WIN = 16 * 40, I_GLU = 8 * 16, I_SQ = 16 * 32, I_GU = 16 * 16, I_DN = 8 * 32;
    constexpr int NITEMS = I_WIN + I_GLU + 5 * I_SQ + 16 * (2 * I_GU + I_DN);
    for (int it = gw; it < NITEMS; it += NGW) {
        int r = it;
        if (r < I_WIN) { transpose_item(p.in[3], 1024, 1280, p.in[2], (bf16_t*)(ws + WS_WIN), RmWin{}, scr, r, lane); continue; } r -= I_WIN;
        if (r < I_GLU) { transpose_item(p.in[14], 512, 512, nullptr, (bf16_t*)(ws + WS_GLU), RmId{}, scr, r, lane); continue; } r -= I_GLU;
        if (r < I_SQ) {
            const int kb = r / 32; const float* gain = kb < 8 ? p.in[16] : p.in[17] - 512;
            transpose_item(p.in[18], 1024, 1024, gain, (bf16_t*)(ws + WS_WOUT), RmId{}, scr, r, lane); continue; } r -= I_SQ;
        if (r < I_SQ) { transpose_item(p.in[21], 1024, 1024, p.in[19], (bf16_t*)(ws + WS_WQ), RmId{}, scr, r, lane); continue; } r -= I_SQ;
        if (r < I_SQ) { transpose_item(p.in[22], 1024, 1024, nullptr, (bf16_t*)(ws + WS_WK), RmId{}, scr, r, lane); continue; } r -= I_SQ;
        if (r < I_SQ) { transpose_item(p.in[23], 1024, 1024, nullptr, (bf16_t*)(ws + WS_WV), RmId{}, scr, r, lane); continue; } r -= I_SQ;
        if (r < I_SQ) { transpose_item(p.in[24], 1024, 1024, nullptr, (bf16_t*)(ws + WS_WO), RmId{}, scr, r, lane); continue; } r -= I_SQ;
        const int e = r / (2 * I_GU + I_DN); r -= e * (2 * I_GU + I_DN);
        bf16_t* wgu = (bf16_t*)(ws + WS_WGU) + (size_t)e * 1024 * 1024;
        if (r < I_GU) { transpose_item(p.in[30] + (size_t)e * 1024 * 512, 1024, 512, p.in[25], wgu, RmGU{0}, scr, r, lane); continue; } r -= I_GU;
        if (r < I_GU) { transpose_item(p.in[31] + (size_t)e * 1024 * 512, 1024, 512, p.in[25], wgu, RmGU{1}, scr, r, lane); continue; } r -= I_GU;
        transpose_item(p.in[32] + (size_t)e * 512 * 1024, 512, 1024, nullptr, (bf16_t*)(ws + WS_WD) + (size_t)e * 1024 * 512, RmId{}, scr, r, lane);
    }
    for (int m = gw; m < T; m += NGW) row_to_bf16(p.in[0] + (size_t)m * 1024, (bf16_t*)(ws + WS_XB) + (size_t)m * 1024, (float*)(ws + WS_R0) + m, nullptr, false, lane);
    for (int m = gw; m < MTOK; m += NGW) row_to_bf16(p.in[1] + (size_t)m * 1024, (bf16_t*)(ws + WS_HM) + (size_t)m * 1024, nullptr, p.in[20], true, lane);
}

struct SchedP1 {
    int G, c;
    __device__ __forceinline__ bool next(int i, Unit& u) const {
        const int L = i * G + c;
        int pm = 0, pn = 0, kind = 0; unsigned a_off = 0, b_off = 0;
        if (L < 320) {
            pg8::tile_order(L, 64, 5, pm, pn);
            a_off = (unsigned)(WS_XB + (size_t)pm * 256 * 1024 * 2); b_off = (unsigned)(WS_WIN + (size_t)pn * 256 * 1024 * 2);
            kind = pn < 3 ? 0 : 1;
        } else if (L < 352) { const int r = L - 320; pm = r >> 2; pn = r & 3; kind = 2;
            a_off = (unsigned)(WS_HM + (size_t)pm * 256 * 1024 * 2); b_off = (unsigned)(WS_WK + (size_t)pn * 256 * 1024 * 2);
        } else { const int q = L - 352; pm = (q >> 3) & 3; pn = q & 7; kind = 3;
            a_off = (unsigned)(WS_WV + (size_t)pm * 256 * 1024 * 2); b_off = (unsigned)(WS_HM + (size_t)pn * 256 * 1024 * 2); }
        u.a_off = a_off; u.b_off = b_off; u.pm = pm; u.pn = pn; u.kind = kind; u.aux = 0;
        return L < 384;
    }
    __device__ __forceinline__ unsigned row_off(const Unit& u, int r) const { return u.a_off + (unsigned)r * 2048u; }
};
struct EpiP1 {
    static constexpr bool PERM = false, AFTER_DRAIN = false;
    unsigned char* ws; const float* qg; const float* kg;
    __device__ __forceinline__ void operator()(f32x4 (&acc)[2][2][4][2], const Unit& u, int wr, int wc, int fr, int fq, FK_LAS unsigned char*, int, int) const {
        if (u.kind == 0) {
            const int head = 4 * u.pn + wc;
            const float* r0 = (const float*)(ws + WS_R0);
            const f32x2* rope = (const f32x2*)(ws + WS_ROPE);
            if (head < 10) {
                const float* gn = head < 8 ? qg : kg;
                f32x4 gv[2][2];
#pragma unroll
                for (int bj = 0; bj < 2; ++bj)
#pragma unroll
                    for (int n = 0; n < 2; ++n) gv[bj][n] = *(const f32x4*)(gn + 32 * bj + 16 * n + 4 * fq);
                const float osc = head < 8 ? QSCALE : 1.f;
#pragma unroll
                for (int ai = 0; ai < 2; ++ai)
#pragma unroll
                    for (int m = 0; m < 4; ++m) {
                        const int row = u.pm * 256 + ai * 128 + wr * 64 + m * 16 + fr;
                        float ss = 0.f;
#pragma unroll
                        for (int bj = 0; bj < 2; ++bj)
#pragma unroll
                            for (int n = 0; n < 2; ++n) { const f32x4 x = acc[ai][bj][m][n]; ss += (x[0] * x[0] + x[1] * x[1]) + (x[2] * x[2] + x[3] * x[3]); }
                        ss += __shfl_xor(ss, 16); ss += __shfl_xor(ss, 32);
                        const float rr = r0[row];
                        const float hs = rr * rsqrtf(rr * rr * ss * (1.f / 64.f) + EPS) * osc;
                        const int s = row & (SEQ - 1);
                        bf16_t* dst = head < 8 ? (bf16_t*)(ws + WS_Q) + (size_t)row * 512 + head * 64 : (bf16_t*)(ws + WS_K) + (size_t)row * 128 + (head - 8) * 64;
#pragma unroll
                        for (int bj = 0; bj < 2; ++bj) {
                            const int pos = bj == 0 ? (s >> 6) : (s & 63);
                            f32x4 x1 = acc[ai][bj][m][0] * hs * gv[bj][0], x2 = acc[ai][bj][m][1] * hs * gv[bj][1], o1, o2;
#pragma unroll
                            for (int j = 0; j < 4; ++j) { const f32x2 cs = rope[pos * 16 + 4 * fq + j]; o1[j] = x1[j] * cs.x - x2[j] * cs.y; o2[j] = x2[j] * cs.x + x1[j] * cs.y; }
                            u32x2 w1, w2; w1.x = pg8::cvt_pk_bf16(o1[0], o1[1]); w1.y = pg8::cvt_pk_bf16(o1[2], o1[3]); w2.x = pg8::cvt_pk_bf16(o2[0], o2[1]); w2.y = pg8::cvt_pk_bf16(o2[2], o2[3]);
                            *(u32x2*)(dst + 32 * bj + 4 * fq) = w1; *(u32x2*)(dst + 32 * bj + 16 + 4 * fq) = w2;
                        }
                    }
            } else {
#pragma unroll
                for (int ai = 0; ai < 2; ++ai)
#pragma unroll
                    for (int m = 0; m < 4; ++m) {
                        const int row = u.pm * 256 + ai * 128 + wr * 64 + m * 16 + fr;
                        const float rr = r0[row];
                        bf16_t* dst = (bf16_t*)(ws + WS_V) + (size_t)row * 128 + (head - 10) * 64;
#pragma unroll
                        for (int bj = 0; bj < 2; ++bj)
#pragma unroll
                            for (int n = 0; n < 2; ++n) { const f32x4 x = acc[ai][bj][m][n] * rr; u32x2 w; w.x = pg8::cvt_pk_bf16(x[0], x[1]); w.y = pg8::cvt_pk_bf16(x[2], x[3]);
                                *(u32x2*)(dst + 32 * bj + 16 * n + 4 * fq) = w; }
                    }
            }
        } else if (u.kind == 1) {
            const float* r0 = (const float*)(ws + WS_R0);
#pragma unroll
            for (int ai = 0; ai < 2; ++ai)
#pragma unroll
                for (int m = 0; m < 4; ++m) {
                    const int row = u.pm * 256 + ai * 128 + wr * 64 + m * 16 + fr;
                    const float rr = r0[row];
                    const int b = row >> 11, s = row & (SEQ - 1), k = s >> 5, jj = s & 31;
#pragma unroll
                    for (int bj = 0; bj < 2; ++bj)
#pragma unroll
                        for (int n = 0; n < 2; ++n) {
                            const int gidx = 16 * (u.pn - 3) + 8 * bj + 2 * wc + n;
                            bf16_t* dst = (bf16_t*)(ws + WS_SU) + ((size_t)gidx * SROWS + b * NCH + k) * SUP + 256 + jj * 16 + 4 * fq;
                            const f32x4 x = acc[ai][bj][m][n] * rr; u32x2 w; w.x = pg8::cvt_pk_bf16(x[0], x[1]); w.y = pg8::cvt_pk_bf16(x[2], x[3]);
                            *(u32x2*)dst = w;
                        }
                }
        } else {
            bf16_t* base = u.kind == 2 ? (bf16_t*)(ws + WS_KM) + (size_t)u.pm * 256 * 1024 + u.pn * 256 : (bf16_t*)(ws + WS_VT) + ((size_t)u.pn * 1024 + u.pm * 256) * 256;
            const int ldc = u.kind == 2 ? 1024 : 256;
#pragma unroll
            for (int ai = 0; ai < 2; ++ai)
#pragma unroll
                for (int m = 0; m < 4; ++m) {
                    bf16_t* rowp = base + (size_t)(ai * 128 + wr * 64 + m * 16 + fr) * ldc + wc * 32 + 4 * fq;
#pragma unroll
                    for (int bj = 0; bj < 2; ++bj)
#pragma unroll
                        for (int n = 0; n < 2; ++n) { const f32x4 x = acc[ai][bj][m][n]; u32x2 w; w.x = pg8::cvt_pk_bf16(x[0], x[1]); w.y = pg8::cvt_pk_bf16(x[2], x[3]);
                            *(u32x2*)(rowp + 128 * bj + 16 * n) = w; }
                }
        }
    }
};
struct SchedOne {
    Unit u; unsigned a_pitch;
    __device__ __forceinline__ bool next(int i, Unit& o) const { o = u; return i == 0; }
    __device__ __forceinline__ unsigned row_off(const Unit& x, int r) const { return x.a_off + (unsigned)r * a_pitch; }
};
__device__ __forceinline__ Unit mk_unit(unsigned a_off, unsigned b_off, int pm, int pn, int kind) { Unit u; u.a_off = a_off; u.b_off = b_off; u.pm = pm; u.pn = pn; u.kind = kind; u.aux = 0; return u; }

struct EpiSloc {
    static constexpr bool PERM = false, AFTER_DRAIN = false;
    float* C;
    __device__ __forceinline__ void operator()(f32x4 (&acc)[2][2][4][2], const Unit& u, int wr, int wc, int fr, int fq, FK_LAS unsigned char*, int, int) const {
#pragma unroll
        for (int ai = 0; ai < 2; ++ai)
#pragma unroll
            for (int m = 0; m < 4; ++m) {
                float* rowp = C + (size_t)(u.pm * 256 + ai * 128 + wr * 64 + m * 16 + fr) * 256 + wc * 32 + 4 * fq;
#pragma unroll
                for (int bj = 0; bj < 2; ++bj)
#pragma unroll
                    for (int n = 0; n < 2; ++n) *(f32x4*)(rowp + 128 * bj + 16 * n) = acc[ai][bj][m][n];
            }
    }
};
__device__ __forceinline__ void s5_scan(const Params& p, int g, int mt, int tid) {
    const int bl = tid >> 7, dir = (tid >> 6) & 1, pp = tid & 63;
    const int gp = (dir * 32 + g) * 64 + pp;
    const float lr = fminf(p.in[6][gp], -1e-4f), li = p.in[7][gp], dt = expf(p.in[8][dir * 32 + g]);
    const float mag = expf(lr * dt * (float)SL), ang = li * dt * (float)SL;
    const float ar = mag * cosf(ang), ai = mag * sinf(ang);
    const float* sl = (const float*)(p.ws + WS_SLOC) + ((size_t)g * SROWS + mt * 256 + bl * 64) * 256 + dir * 128 + pp;
    bf16_t* su = (bf16_t*)(p.ws + WS_SU) + ((size_t)g * SROWS + mt * 256 + bl * 64) * SUP + dir * 128 + pp;
    float sr = 0.f, si = 0.f;
#pragma unroll 8
    for (int s = 0; s < NCH; ++s) {
        const int k = dir ? (NCH - 1 - s) : s;
        su[(size_t)k * SUP] = (bf16_t)f2bf(sr); su[(size_t)k * SUP + 64] = (bf16_t)f2bf(si);
        const float lr_ = sl[(size_t)k * 256], li_ = sl[(size_t)k * 256 + 64];
        const float nr = ar * sr - ai * si + lr_, ni = ar * si + ai * sr + li_;
        sr = nr; si = ni;
    }
}
struct EpiS5Out {
    static constexpr bool PERM = false, AFTER_DRAIN = false;
    bf16_t* Z; int g, mt, ntile;
    __device__ __forceinline__ void operator()(f32x4 (&acc)[2][2][4][2], const Unit& u, int wr, int wc, int fr, int fq, FK_LAS unsigned char*, int, int) const {
#pragma unroll
        for (int ai = 0; ai < 2; ++ai)
#pragma unroll
            for (int m = 0; m < 4; ++m) {
                const int R = mt * 256 + ai * 128 + wr * 64 + m * 16 + fr, b = R >> 6, k = R & 63;
#pragma unroll
                for (int bj = 0; bj < 2; ++bj)
#pragma unroll
                    for (int n = 0; n < 2; ++n) {
                        const int j = 16 * ntile + 8 * bj + 2 * wc + n;
                        const size_t t = (size_t)b * SEQ + k * SL + j;
                        f32x4 y = acc[ai][bj][m][n], z;
#pragma unroll
                        for (int i = 0; i < 4; ++i) { const float a2 = 1.5957691216057308f * (y[i] + 0.044715f * y[i] * y[i] * y[i]); z[i] = y[i] / (1.f + __expf(-a2)); }
                        u32x2 w; w.x = pg8::cvt_pk_bf16(z[0], z[1]); w.y = pg8::cvt_pk_bf16(z[2], z[3]);
                        *(u32x2*)(Z + t * 512 + g * 16 + 4 * fq) = w;
                    }
            }
    }
};
struct EpiGlu {
    static constexpr bool PERM = false, AFTER_DRAIN = false;
    const bf16_t* Z; bf16_t* Y; float* SS; const float* bias;
    __device__ __forceinline__ void operator()(f32x4 (&acc)[2][2][4][2], const Unit& u, int wr, int wc, int fr, int fq, FK_LAS unsigned char*, int, int) const {
        const int col0 = u.pn * 256 + wc * 32 + 4 * fq;
        f32x4 bv[2][2];
#pragma unroll
        for (int bj = 0; bj < 2; ++bj)
#pragma unroll
            for (int n = 0; n < 2; ++n) bv[bj][n] = *(const f32x4*)(bias + col0 + 128 * bj + 16 * n);
#pragma unroll
        for (int ai = 0; ai < 2; ++ai)
#pragma unroll
            for (int m = 0; m < 4; ++m) {
                const size_t row = (size_t)u.pm * 256 + ai * 128 + wr * 64 + m * 16 + fr;
                float ss = 0.f;
#pragma unroll
                for (int bj = 0; bj < 2; ++bj)
#pragma unroll
                    for (int n = 0; n < 2; ++n) {
                        const int col = col0 + 128 * bj + 16 * n;
                        const u32x2 zw = *(const u32x2*)(Z + row * 512 + col);
                        const f32x4 lin = acc[ai][bj][m][n] + bv[bj][n];
                        const float z0 = bflo(zw.x), z1 = bfhi(zw.x), z2 = bflo(zw.y), z3 = bfhi(zw.y);
                        const float y0 = z0 / (1.f + __expf(-lin[0])), y1 = z1 / (1.f + __expf(-lin[1])), y2 = z2 / (1.f + __expf(-lin[2])), y3 = z3 / (1.f + __expf(-lin[3]));
                        u32x2 w; w.x = pg8::cvt_pk_bf16(y0, y1); w.y = pg8::cvt_pk_bf16(y2, y3);
                        *(u32x2*)(Y + row * 1024 + 512 + col) = w;
                        const float r0 = bflo(w.x), r1 = bfhi(w.x), r2 = bflo(w.y), r3 = bfhi(w.y);
                        ss += (r0 * r0 + r1 * r1) + (r2 * r2 + r3 * r3);
                    }
                ss += __shfl_xor(ss, 16); ss += __shfl_xor(ss, 32);
                if (fq == 0) SS[row * 8 + u.pn * 4 + wc] = ss;
                asm volatile("" ::: "memory");
            }
    }
};
__device__ __forceinline__ float rs8(const float* ss, size_t row, float inv_n) {
    const f32x4 a = *(const f32x4*)(ss + row * 8), b = *(const f32x4*)(ss + row * 8 + 4);
    return rsqrtf(((a[0] + a[1]) + (a[2] + a[3]) + (b[0] + b[1]) + (b[2] + b[3])) * inv_n + EPS);
}
struct EpiWoutMid {
    static constexpr bool PERM = false, AFTER_DRAIN = false;
    const FK_LAS float* xt;
    __device__ __forceinline__ void operator()(f32x4 (&acc)[2][2][4][2], const Unit& u, int wr, int wc, int fr, int fq, FK_LAS unsigned char*, int, int) const {
#pragma unroll
        for (int ai = 0; ai < 2; ++ai)
#pragma unroll
            for (int m = 0; m < 4; ++m) {
                const float f = xt[ai * 128 + wr * 64 + m * 16 + fr];
#pragma unroll
                for (int bj = 0; bj < 2; ++bj)
#pragma unroll
                    for (int n = 0; n < 2; ++n) acc[ai][bj][m][n] = acc[ai][bj][m][n] * f;
            }
    }
};
struct EpiWoutFin {
    static constexpr bool PERM = false, AFTER_DRAIN = false;
    const FK_LAS float* xt; const bf16_t* XB; bf16_t* X1; float* SS1;
    __device__ __forceinline__ void operator()(f32x4 (&acc)[2][2][4][2], const Unit& u, int wr, int wc, int fr, int fq, FK_LAS unsigned char*, int, int) const {
        const int col0 = u.pn * 256 + wc * 32 + 4 * fq;
#pragma unroll
        for (int ai = 0; ai < 2; ++ai)
#pragma unroll
            for (int m = 0; m < 4; ++m) {
                const size_t row = (size_t)u.pm * 256 + ai * 128 + wr * 64 + m * 16 + fr;
                const float rs = xt[256 + ai * 128 + wr * 64 + m * 16 + fr];
                float ss = 0.f;
#pragma unroll
                for (int bj = 0; bj < 2; ++bj)
#pragma unroll
                    for (int n = 0; n < 2; ++n) {
                        const int col = col0 + 128 * bj + 16 * n;
                        const u32x2 xw = *(const u32x2*)(XB + row * 1024 + col);
                        const f32x4 a = acc[ai][bj][m][n] * rs;
                        u32x2 w; w.x = pg8::cvt_pk_bf16(bflo(xw.x) + a[0], bfhi(xw.x) + a[1]); w.y = pg8::cvt_pk_bf16(bflo(xw.y) + a[2], bfhi(xw.y) + a[3]);
                        *(u32x2*)(X1 + row * 1024 + col) = w;
                        const float r0 = bflo(w.x), r1 = bfhi(w.x), r2 = bflo(w.y), r3 = bfhi(w.y);
                        ss += (r0 * r0 + r1 * r1) + (r2 * r2 + r3 * r3);
                    }
                ss += __shfl_xor(ss, 16); ss += __shfl_xor(ss, 32);
                if (fq == 0) SS1[row * 16 + u.pn * 4 + wc] = ss;
                asm volatile("" ::: "memory");
            }
    }
};
struct EpiScaleBf16 {
    static constexpr bool PERM = false, AFTER_DRAIN = false;
    bf16_t* O; int ldc; const FK_LAS float* xt; float sc;
    __device__ __forceinline__ void operator()(f32x4 (&acc)[2][2][4][2], const Unit& u, int wr, int wc, int fr, int fq, FK_LAS unsigned char*, int, int) const {
#pragma unroll
        for (int ai = 0; ai < 2; ++ai)
#pragma unroll
            for (int m = 0; m < 4; ++m) {
                const int r = ai * 128 + wr * 64 + m * 16 + fr;
                const float f = xt ? xt[r] * sc : sc;
                bf16_t* rowp = O + (size_t)r * ldc + wc * 32 + 4 * fq;
#pragma unroll
                for (int bj = 0; bj < 2; ++bj)
#pragma unroll
                    for (int n = 0; n < 2; ++n) { const f32x4 x = acc[ai][bj][m][n] * f; u32x2 w; w.x = pg8::cvt_pk_bf16(x[0], x[1]); w.y = pg8::cvt_pk_bf16(x[2], x[3]);
                        *(u32x2*)(rowp + 128 * bj + 16 * n) = w; }
            }
    }
};
struct EpiSoftmax {
    static constexpr bool PERM = false, AFTER_DRAIN = true;
    bf16_t* O; int ldc;
    __device__ __forceinline__ void operator()(f32x4 (&acc)[2][2][4][2], const Unit& u, int wr, int wc, int fr, int fq, FK_LAS unsigned char* lds, int, int) const {
        FK_LAS float* Pm = (FK_LAS float*)lds;
        FK_LAS float* Ps = (FK_LAS float*)(lds + 4096);
#pragma unroll
        for (int ai = 0; ai < 2; ++ai)
#pragma unroll
            for (int m = 0; m < 4; ++m) {
                float mx = -INFINITY;
#pragma unroll
                for (int bj = 0; bj < 2; ++bj)
#pragma unroll
                    for (int n = 0; n < 2; ++n) { const f32x4 x = acc[ai][bj][m][n]; mx = fmaxf(mx, fmaxf(fmaxf(x[0], x[1]), fmaxf(x[2], x[3]))); }
                mx = fmaxf(mx, __shfl_xor(mx, 16)); mx = fmaxf(mx, __shfl_xor(mx, 32));
                if (fq == 0) Pm[(ai * 128 + wr * 64 + m * 16 + fr) * 4 + wc] = mx;
            }
        asm volatile("s_waitcnt lgkmcnt(0)" ::: "memory"); __builtin_amdgcn_s_barrier(); asm volatile("" ::: "memory");
#pragma unroll
        for (int ai = 0; ai < 2; ++ai)
#pragma unroll
            for (int m = 0; m < 4; ++m) {
                const int r = ai * 128 + wr * 64 + m * 16 + fr;
                const f32x4 pm4 = *(const FK_LAS f32x4*)(Pm + r * 4);
                const float M = fmaxf(fmaxf(pm4[0], pm4[1]), fmaxf(pm4[2], pm4[3]));
                float sm = 0.f;
#pragma unroll
                for (int bj = 0; bj < 2; ++bj)
#pragma unroll
                    for (int n = 0; n < 2; ++n) { f32x4 x = acc[ai][bj][m][n];
#pragma unroll
                        for (int i = 0; i < 4; ++i) { x[i] = __builtin_amdgcn_exp2f(x[i] - M); sm += x[i]; }
                        acc[ai][bj][m][n] = x; }
                sm += __shfl_xor(sm, 16); sm += __shfl_xor(sm, 32);
                if (fq == 0) Ps[r * 4 + wc] = sm;
            }
        asm volatile("s_waitcnt lgkmcnt(0)" ::: "memory"); __builtin_amdgcn_s_barrier(); asm volatile("" ::: "memory");
#pragma unroll
        for (int ai = 0; ai < 2; ++ai)
#pragma unroll
            for (int m = 0; m < 4; ++m) {
                const int r = ai * 128 + wr * 64 + m * 16 + fr;
                const f32x4 ps4 = *(const FK_LAS f32x4*)(Ps + r * 4);
                const float inv = 1.f / ((ps4[0] + ps4[1]) + (ps4[2] + ps4[3]));
                bf16_t* rowp = O + (size_t)r * ldc + wc * 32 + 4 * fq;
#pragma unroll
                for (int bj = 0; bj < 2; ++bj)
#pragma unroll
                    for (int n = 0; n < 2; ++n) { const f32x4 x = acc[ai][bj][m][n] * inv; u32x2 w; w.x = pg8::cvt_pk_bf16(x[0], x[1]); w.y = pg8::cvt_pk_bf16(x[2], x[3]);
                        *(u32x2*)(rowp + 128 * bj + 16 * n) = w; }
            }
        asm volatile("s_waitcnt lgkmcnt(0)" ::: "memory"); __builtin_amdgcn_s_barrier(); asm volatile("" ::: "memory");
    }
};
struct EpiResid {
    static constexpr bool PERM = false, AFTER_DRAIN = false;
    bf16_t* X; int ldc;
    __device__ __forceinline__ void operator()(f32x4 (&acc)[2][2][4][2], const Unit& u, int wr, int wc, int fr, int fq, FK_LAS unsigned char*, int, int) const {
#pragma unroll
        for (int ai = 0; ai < 2; ++ai)
#pragma unroll
            for (int m = 0; m < 4; ++m) {
                bf16_t* rowp = X + (size_t)(ai * 128 + wr * 64 + m * 16 + fr) * ldc + wc * 32 + 4 * fq;
#pragma unroll
                for (int bj = 0; bj < 2; ++bj)
#pragma unroll
                    for (int n = 0; n < 2; ++n) { const u32x2 xw = *(const u32x2*)(rowp + 128 * bj + 16 * n); const f32x4 a = acc[ai][bj][m][n];
                        u32x2 w; w.x = pg8::cvt_pk_bf16(bflo(xw.x) + a[0], bfhi(xw.x) + a[1]); w.y = pg8::cvt_pk_bf16(bflo(xw.y) + a[2], bfhi(xw.y) + a[3]);
                        *(u32x2*)(rowp + 128 * bj + 16 * n) = w; }
                asm volatile("" ::: "memory");
            }
    }
};
__device__ __forceinline__ void router_phase(const Params& p, FK_LAS unsigned char* lds, int vcu, int G, int tid, int lane, int wave) {
    unsigned char* ws = p.ws;
    FK_LAS float* RW = (FK_LAS float*)lds;
    const float* gw = p.in[26]; const float* ew = p.in[28]; const float* mg = p.in[25];
    for (int idx = tid; idx < 1024 * 20; idx += NTHREADS) { const int k = idx / 20, i = idx % 20; RW[idx] = mg[k] * (i < 4 ? gw[k * 4 + i] : ew[k * 16 + (i - 4)]); }
    __syncthreads();
    const bf16_t* X2 = (const bf16_t*)(ws + WS_X1B);
    int* cnt = (int*)(ws + WS_CTL) + CW_CNT; int* list = (int*)(ws + WS_LIST); float* wl = (float*)(ws + WS_WL); float* r2o = (float*)(ws + WS_R2);
    const int gwv = vcu * NWAVES + wave, NGW = G * NWAVES;
    for (int t = gwv; t < T; t += NGW) {
        float lg[20];
#pragma unroll
        for (int i = 0; i < 20; ++i) lg[i] = 0.f;
        float ss = 0.f;
#pragma unroll
        for (int j = 0; j < 2; ++j) {
            const int k0 = j * 512 + lane * 8;
            const u32x4 xw = *(const u32x4*)(X2 + (size_t)t * 1024 + k0);
#pragma unroll
            for (int e = 0; e < 8; ++e) {
                const unsigned w = xw[e >> 1]; const float x = (e & 1) ? bfhi(w) : bflo(w);
                ss += x * x;
                const FK_LAS f32x4* rw = (const FK_LAS f32x4*)(RW + (k0 + e) * 20);
#pragma unroll
                for (int q = 0; q < 5; ++q) { const f32x4 wv = rw[q]; lg[4 * q + 0] = fmaf(x, wv[0], lg[4 * q + 0]); lg[4 * q + 1] = fmaf(x, wv[1], lg[4 * q + 1]); lg[4 * q + 2] = fmaf(x, wv[2], lg[4 * q + 2]); lg[4 * q + 3] = fmaf(x, wv[3], lg[4 * q + 3]); }
                asm volatile("" ::: "memory");
            }
        }
        ss = wsum(ss);
        const float r2 = rsqrtf(ss * (1.f / 1024.f) + EPS);
#pragma unroll
        for (int i = 0; i < 20; ++i) lg[i] = wsum(lg[i]) * r2 + (i < 4 ? p.in[27][i] : p.in[29][i - 4]);
        if (lane == 0) {
            r2o[t] = r2;
            const float gm = fmaxf(fmaxf(lg[0], lg[1]), fmaxf(lg[2], lg[3]));
            const float e0 = expf(lg[0] - gm), e1 = expf(lg[1] - gm), e2 = expf(lg[2] - gm), e3 = expf(lg[3] - gm);
            const float gs = e0 + e1 + e2 + e3;
            int gsel = 0; float gbest = e0;
            if (e1 > gbest) { gbest = e1; gsel = 1; }
            if (e2 > gbest) { gbest = e2; gsel = 2; }
            if (e3 > gbest) { gbest = e3; gsel = 3; }
            const float gwt = gbest / gs;
            const float v0 = gsel == 0 ? lg[4] : gsel == 1 ? lg[8] : gsel == 2 ? lg[12] : lg[16];
            const float v1 = gsel == 0 ? lg[5] : gsel == 1 ? lg[9] : gsel == 2 ? lg[13] : lg[17];
            const float v2 = gsel == 0 ? lg[6] : gsel == 1 ? lg[10] : gsel == 2 ? lg[14] : lg[18];
            const float v3 = gsel == 0 ? lg[7] : gsel == 1 ? lg[11] : gsel == 2 ? lg[15] : lg[19];
            int i1 = 0; float b1 = v0;
            if (v1 > b1) { b1 = v1; i1 = 1; }
            if (v2 > b1) { b1 = v2; i1 = 2; }
            if (v3 > b1) { b1 = v3; i1 = 3; }
            int i2 = 0; float b2 = -INFINITY;
            if (i1 != 0 && v0 > b2) { b2 = v0; i2 = 0; }
            if (i1 != 1 && v1 > b2) { b2 = v1; i2 = 1; }
            if (i1 != 2 && v2 > b2) { b2 = v2; i2 = 2; }
            if (i1 != 3 && v3 > b2) { b2 = v3; i2 = 3; }
            const float ex2 = expf(b2 - b1);
            const float w1 = gwt / (1.f + ex2), w2 = gwt * ex2 / (1.f + ex2);
            const int ea = gsel * 4 + i1, eb = gsel * 4 + i2;
            const int pa = atomicAdd(&cnt[ea], 1); list[ea * T + pa] = t * 2; wl[ea * T + pa] = w1;
            const int pb = atomicAdd(&cnt[eb], 1); list[eb * T + pb] = t * 2 + 1; wl[eb * T + pb] = w2;
        }
    }
}
struct MoeTab {
    const FK_LAS int* t;
    __device__ __forceinline__ int total_tiles() const { return __builtin_amdgcn_readfirstlane(t[16]); }
    __device__ __forceinline__ void decode(int mtile, int& e, int& mt, int& ce) const {
        int ee = 0;
#pragma unroll
        for (int j = 1; j < 16; ++j) ee += (mtile >= __builtin_amdgcn_readfirstlane(t[j])) ? 1 : 0;
        e = ee; mt = mtile - __builtin_amdgcn_readfirstlane(t[ee]); ce = __builtin_amdgcn_readfirstlane(t[17 + ee]);
    }
};
__device__ __forceinline__ void moe_tab_init(FK_LAS int* t, const int* cnt, int tid) {
    if (tid == 0) { int acc = 0; t[0] = 0;
        for (int j = 0; j < 16; ++j) { const int c = cnt[j]; t[17 + j] = c; acc += (c + 255) >> 8; t[j + 1] = acc; } }
    __syncthreads();
}
struct SchedMoe1 {
    MoeTab tab; int G, c; const FK_LAS unsigned* xo;
    __device__ __forceinline__ bool next(int i, Unit& u) const {
        const int L = i * G + c; const int nun = tab.total_tiles() * 4;
        int e, mt, ce; tab.decode(L >> 2, e, mt, ce);
        u.a_off = 0; u.b_off = (unsigned)(WS_WGU + ((size_t)e * 1024 + (L & 3) * 256) * 1024 * 2); u.pm = L >> 2; u.pn = L & 3; u.kind = e; u.aux = i;
        return L < nun;
    }
    __device__ __forceinline__ unsigned row_off(const Unit& u, int r) const { return xo[u.aux * 256 + r]; }
};
struct EpiMoe1 {
    static constexpr bool PERM = false, AFTER_DRAIN = false;
    bf16_t* ACT; const FK_LAS float* xf;
    __device__ __forceinline__ void operator()(f32x4 (&acc)[2][2][4][2], const Unit& u, int wr, int wc, int fr, int fq, FK_LAS unsigned char*, int, int) const {
#pragma unroll
        for (int ai = 0; ai < 2; ++ai)
#pragma unroll
            for (int m = 0; m < 4; ++m) {
                const int r = ai * 128 + wr * 64 + m * 16 + fr;
                const float f1 = xf[u.aux * 512 + r], f2 = xf[u.aux * 512 + 256 + r];
                bf16_t* rowp = ACT + ((size_t)u.pm * 256 + r) * 512 + u.pn * 128 + wc * 32 + 4 * fq;
#pragma unroll
                for (int n = 0; n < 2; ++n) {
                    const f32x4 g = acc[ai][0][m][n] * f1, up = acc[ai][1][m][n] * f2; f32x4 a;
#pragma unroll
                    for (int i = 0; i < 4; ++i) a[i] = g[i] / (1.f + __expf(-g[i])) * up[i];
                    u32x2 w; w.x = pg8::cvt_pk_bf16(a[0], a[1]); w.y = pg8::cvt_pk_bf16(a[2], a[3]);
                    *(u32x2*)(rowp + 16 * n) = w;
                }
            }
    }
};
struct SchedMoe2 {
    MoeTab tab; int G, c;
    __device__ __forceinline__ bool next(int i, Unit& u) const {
        const int L = i * G + c; const int nun = tab.total_tiles() * 4;
        int e, mt, ce; tab.decode(L >> 2, e, mt, ce);
        u.a_off = (unsigned)(WS_ACT + (size_t)(L >> 2) * 256 * 512 * 2); u.b_off = (unsigned)(WS_WD + ((size_t)e * 1024 + (L & 3) * 256) * 512 * 2); u.pm = L >> 2; u.pn = L & 3; u.kind = e; u.aux = i;
        return L < nun;
    }
    __device__ __forceinline__ unsigned row_off(const Unit& u, int r) const { return u.a_off + (unsigned)r * 1024u; }
};
struct EpiMoe2 {
    static constexpr bool PERM = false, AFTER_DRAIN = false;
    bf16_t* YM; const FK_LAS int* xe;
    __device__ __forceinline__ void operator()(f32x4 (&acc)[2][2][4][2], const Unit& u, int wr, int wc, int fr, int fq, FK_LAS unsigned char*, int, int) const {
#pragma unroll
        for (int ai = 0; ai < 2; ++ai)
#pragma unroll
            for (int m = 0; m < 4; ++m) {
                const int r = ai * 128 + wr * 64 + m * 16 + fr;
                const int ent = xe[u.aux * 256 + r];
                if (ent >= 0) {
                    bf16_t* rowp = YM + (size_t)ent * 1024 + u.pn * 256 + wc * 32 + 4 * fq;
#pragma unroll
                    for (int bj = 0; bj < 2; ++bj)
#pragma unroll
                        for (int n = 0; n < 2; ++n) { const f32x4 x = acc[ai][bj][m][n]; u32x2 w; w.x = pg8::cvt_pk_bf16(x[0], x[1]); w.y = pg8::cvt_pk_bf16(x[2], x[3]);
                            *(u32x2*)(rowp + 128 * bj + 16 * n) = w; }
                }
            }
    }
};
__device__ __forceinline__ void final_phase(const Params& p, int vcu, int G, int lane, int wave) {
    const bf16_t* X2 = (const bf16_t*)(p.ws + WS_X1B); const bf16_t* YM = (const bf16_t*)p.out; const float* fg = p.in[33];
    const int gwv = vcu * NWAVES + wave, NGW = G * NWAVES;
    for (int t = gwv; t < T; t += NGW) {
        float v[16]; float ss = 0.f;
#pragma unroll
        for (int j = 0; j < 2; ++j) {
            const int k0 = j * 512 + lane * 8;
            const u32x4 a = *(const u32x4*)(X2 + (size_t)t * 1024 + k0), b = *(const u32x4*)(YM + (size_t)t * 2048 + k0), c = *(const u32x4*)(YM + (size_t)t * 2048 + 1024 + k0);
#pragma unroll
            for (int e = 0; e < 4; ++e) { v[j * 8 + 2 * e] = bflo(a[e]) + bflo(b[e]) + bflo(c[e]); v[j * 8 + 2 * e + 1] = bfhi(a[e]) + bfhi(b[e]) + bfhi(c[e]); }
        }
#pragma unroll
        for (int i = 0; i < 16; ++i) ss += v[i] * v[i];
        ss = wsum(ss);
        const float r = rsqrtf(ss * (1.f / 1024.f) + EPS);
        float* orow = p.out + (size_t)t * 1024;
#pragma unroll
        for (int j = 0; j < 2; ++j) {
            const int k0 = j * 512 + lane * 8;
            const f32x4 g0 = *(const f32x4*)(fg + k0), g1 = *(const f32x4*)(fg + k0 + 4);
            f32x4 o0, o1;
#pragma unroll
            for (int e = 0; e < 4; ++e) { o0[e] = v[j * 8 + e] * r * g0[e]; o1[e] = v[j * 8 + 4 + e] * r * g1[e]; }
            *(f32x4*)(orow + k0) = o0; *(f32x4*)(orow + k0 + 4) = o1;
        }
    }
}
__global__ void __launch_bounds__(NTHREADS, 2) mk(Params p) {
    extern __shared__ __attribute__((aligned(16))) unsigned char lds_raw[];
    FK_LAS unsigned char* lds = (FK_LAS unsigned char*)lds_raw;
    const int tid = threadIdx.x, lane = tid & 63, wave = __builtin_amdgcn_readfirstlane(tid >> 6);
    const int G = gridDim.x, bx = blockIdx.x;
    const int vcu = (G % 8 == 0) ? (bx % 8) * (G / 8) + bx / 8 : bx;
    unsigned char* ws = p.ws;
#define IN(k) (p.ph_lo <= (k) && (k) < p.ph_hi)
    if (IN(0)) { p0_prologue(p, lds, vcu, G, tid, lane, wave); }
    if (IN(1)) {
        Gemm g{(const char*)ws, 1024, 1024, 1024};
        SchedP1 S{G, bx};
        EpiP1 E{ws, p.in[4], p.in[5]};
        f32x4 acc[2][2][4][2];
        pg8::gemm_phase<EpiP1, SchedP1, true, true, false>(lds, g, S, E, acc);
    }
    if (IN(2)) {
        attn_body::attn_phase<8>((char*)lds_raw, (const attn_body::bf16*)(ws + WS_Q), (const attn_body::bf16*)(ws + WS_K), (const attn_body::bf16*)(ws + WS_V),
                                 (attn_body::bf16*)(ws + WS_YCAT), (float*)(ws + WS_SSATT), G, vcu);
    }
    if (IN(3)) {
        for (int L = bx; L < 64; L += G) {
            const int g = L >> 1, mt = L & 1;
            Gemm gm{(const char*)ws, SUP, 512, 512};
            SchedOne S{mk_unit((unsigned)(WS_SU + (((size_t)g * SROWS + mt * 256) * SUP + 256) * 2), (unsigned)(WS_W1 + (size_t)g * 256 * 512 * 2), mt, 0, 0), SUP * 2};
            EpiSloc E{(float*)(ws + WS_SLOC) + (size_t)g * SROWS * 256};
            f32x4 acc[2][2][4][2];
            pg8::gemm_phase<EpiSloc, SchedOne, false, true, false>(lds, gm, S, E, acc);
        }
    }
    if (IN(4)) {
        for (int L = bx; L < 128; L += G) {
            const int g = L >> 2, mt = (L >> 1) & 1, ntile = L & 1;
            s5_scan(p, g, mt, tid);
            __threadfence(); __syncthreads();
            Gemm gm{(const char*)ws, SUP, SUP, SUP};
            SchedOne S{mk_unit((unsigned)(WS_SU + ((size_t)g * SROWS + mt * 256) * SUP * 2), (unsigned)(WS_W2 + ((size_t)g * 512 + ntile * 256) * SUP * 2), mt, ntile, 0), SUP * 2};
            EpiS5Out E{(bf16_t*)(ws + WS_Z), g, mt, ntile};
            f32x4 acc[2][2][4][2];
            pg8::gemm_phase<EpiS5Out, SchedOne, false, true, false>(lds, gm, S, E, acc);
        }
    }
    if (IN(5)) {
        for (int L = bx; L < 128; L += G) {
            int pm, pn; pg8::tile_order(L, 64, 2, pm, pn);
            Gemm gm{(const char*)ws, 512, 512, 512};
            SchedOne S{mk_unit((unsigned)(WS_Z + (size_t)pm * 256 * 512 * 2), (unsigned)(WS_GLU + (size_t)pn * 256 * 512 * 2), pm, pn, 0), 512 * 2};
            EpiGlu E{(const bf16_t*)(ws + WS_Z), (bf16_t*)(ws + WS_YCAT), (float*)(ws + WS_SSSSM), p.in[15]};
            f32x4 acc[2][2][4][2];
            pg8::gemm_phase<EpiGlu, SchedOne, false, true, false>(lds, gm, S, E, acc);
        }
    }
    if (IN(6)) {
        for (int L = bx; L < 256; L += G) {
            int pm, pn; pg8::tile_order(L, 64, 4, pm, pn);
            Gemm gm{(const char*)ws, 1024, 1024, 512};
            const unsigned a0 = (unsigned)(WS_YCAT + (size_t)pm * 256 * 1024 * 2), b0 = (unsigned)(WS_WOUT + (size_t)pn * 256 * 1024 * 2);
            f32x4 acc[2][2][4][2];
            FK_LAS float* xt = (FK_LAS float*)(lds + XTRA_OFF);
            { int t2 = threadIdx.x; asm volatile("" : "+v"(t2));
              if (t2 < 256) { const size_t row = (size_t)pm * 256 + t2; const float ra = rs8((const float*)(ws + WS_SSATT), row, 1.f / 512.f), rs = rs8((const float*)(ws + WS_SSSSM), row, 1.f / 512.f); xt[t2] = ra / rs; xt[256 + t2] = rs; }
              __syncthreads(); }
            { SchedOne S{mk_unit(a0, b0, pm, pn, 0), 2048}; EpiWoutMid E{xt};
              pg8::gemm_phase<EpiWoutMid, SchedOne, false, true, false>(lds, gm, S, E, acc); }
            { SchedOne S{mk_unit(a0 + 1024, b0 + 1024, pm, pn, 0), 2048}; EpiWoutFin E{xt, (const bf16_t*)(ws + WS_XB), (bf16_t*)(ws + WS_X1B), (float*)(ws + WS_SSX1)};
              pg8::gemm_phase<EpiWoutFin, SchedOne, false, true, true>(lds, gm, S, E, acc); }
        }
    }
    if (IN(7)) {
        for (int L = bx; L < 256; L += G) {
            int pm, pn; pg8::tile_order(L, 64, 4, pm, pn);
            const int b = pm >> 3;
            FK_LAS float* xt = (FK_LAS float*)(lds + XTRA_OFF);
            { int t2 = threadIdx.x; asm volatile("" : "+v"(t2));
              if (t2 < 256) { const float* s1 = (const float*)(ws + WS_SSX1) + ((size_t)pm * 256 + t2) * 16; const f32x4 a = *(const f32x4*)s1, b4 = *(const f32x4*)(s1 + 4), c = *(const f32x4*)(s1 + 8), d = *(const f32x4*)(s1 + 12);
                  xt[t2] = rsqrtf((((a[0] + a[1]) + (a[2] + a[3])) + ((b4[0] + b4[1]) + (b4[2] + b4[3])) + ((c[0] + c[1]) + (c[2] + c[3])) + ((d[0] + d[1]) + (d[2] + d[3]))) * (1.f / 1024.f) + EPS); }
              __syncthreads(); }
            const size_t tile = ((size_t)pm * 256 * 1024 + pn * 256) * 2;
            f32x4 acc[2][2][4][2];
            { Gemm gm{(const char*)ws, 1024, 1024, 1024};
              SchedOne S{mk_unit((unsigned)(WS_X1B + (size_t)pm * 256 * 1024 * 2), (unsigned)(WS_WQ + (size_t)pn * 256 * 1024 * 2), pm, pn, 0), 2048};
              EpiScaleBf16 E{(bf16_t*)(ws + WS_QX + tile), 1024, xt, XQSCALE};
              pg8::gemm_phase<EpiScaleBf16, SchedOne, false, true, false>(lds, gm, S, E, acc); }
            __threadfence(); __syncthreads();
            { Gemm gm{(const char*)ws, 1024, 1024, 256};
              SchedOne S{mk_unit((unsigned)(WS_QX + tile), (unsigned)(WS_KM + ((size_t)b * 256 * 1024 + pn * 256) * 2), pm, pn, 0), 2048};
              EpiSoftmax E{(bf16_t*)(ws + WS_PB + tile), 1024};
              pg8::gemm_phase<EpiSoftmax, SchedOne, false, true, false>(lds, gm, S, E, acc); }
            __threadfence(); __syncthreads();
            { Gemm gm{(const char*)ws, 1024, 256, 256};
              SchedOne S{mk_unit((unsigned)(WS_PB + tile), (unsigned)(WS_VT + ((size_t)b * 1024 + pn * 256) * 256 * 2), pm, pn, 0), 2048};
              EpiScaleBf16 E{(bf16_t*)(ws + WS_QX + tile), 1024, nullptr, 1.f};
              pg8::gemm_phase<EpiScaleBf16, SchedOne, false, true, false>(lds, gm, S, E, acc); }
        }
    }
    if (IN(8)) {
        for (int L = bx; L < 256; L += G) {
            int pm, pn; pg8::tile_order(L, 64, 4, pm, pn);
            const size_t tile = ((size_t)pm * 256 * 1024 + pn * 256) * 2;
            Gemm gm{(const char*)ws, 1024, 1024, 1024};
            SchedOne S{mk_unit((unsigned)(WS_QX + (size_t)pm * 256 * 1024 * 2), (unsigned)(WS_WO + (size_t)pn * 256 * 1024 * 2), pm, pn, 0), 2048};
            EpiResid E{(bf16_t*)(ws + WS_X1B + tile), 1024};
            f32x4 acc[2][2][4][2];
            pg8::gemm_phase<EpiResid, SchedOne, false, true, false>(lds, gm, S, E, acc);
        }
    }
    if (IN(9)) { router_phase(p, lds, vcu, G, tid, lane, wave); }
    if (IN(10)) {
        FK_LAS int* tabp = (FK_LAS int*)(lds + XTRA_OFF + 15 * 1024); moe_tab_init(tabp, (const int*)(ws + WS_CTL) + CW_CNT, threadIdx.x); MoeTab tab{tabp};
        FK_LAS unsigned* xo = (FK_LAS unsigned*)(lds + XTRA_OFF);
        FK_LAS float* xf = (FK_LAS float*)(lds + XTRA_OFF + 5 * 1024);
        { int t2 = threadIdx.x; asm volatile("" : "+v"(t2));
          const int nun = tab.total_tiles() * 4; int i = 0;
          for (int L = bx; L < nun && i < 5; L += G, ++i) {
              if (t2 < 256) { int e, mt, ce; tab.decode(L >> 2, e, mt, ce); const int idx = mt * 256 + t2; const bool valid = idx < ce;
                  const int ent = valid ? ((const int*)(ws + WS_LIST))[e * T + idx] : 0; const int tok = ent >> 1;
                  xo[i * 256 + t2] = (unsigned)(WS_X1B + (size_t)tok * 2048);
                  const float r2 = ((const float*)(ws + WS_R2))[tok];
                  xf[i * 512 + t2] = r2; xf[i * 512 + 256 + t2] = valid ? r2 * ((const float*)(ws + WS_WL))[e * T + idx] : 0.f; }
          }
          __syncthreads(); }
        Gemm gm{(const char*)ws, 1024, 1024, 1024};
        SchedMoe1 S{tab, G, bx, xo};
        EpiMoe1 E{(bf16_t*)(ws + WS_ACT), xf};
        f32x4 acc[2][2][4][2];
        pg8::gemm_phase<EpiMoe1, SchedMoe1, true, true, false>(lds, gm, S, E, acc);
    }
    if (IN(11)) {
        FK_LAS int* tabp = (FK_LAS int*)(lds + XTRA_OFF + 15 * 1024); moe_tab_init(tabp, (const int*)(ws + WS_CTL) + CW_CNT, threadIdx.x); MoeTab tab{tabp};
        FK_LAS int* xe = (FK_LAS int*)(lds + XTRA_OFF);
        { int t2 = threadIdx.x; asm volatile("" : "+v"(t2));
          const int nun = tab.total_tiles() * 4; int i = 0;
          for (int L = bx; L < nun && i < 5; L += G, ++i) {
              if (t2 < 256) { int e, mt, ce; tab.decode(L >> 2, e, mt, ce); const int idx = mt * 256 + t2;
                  xe[i * 256 + t2] = idx < ce ? ((const int*)(ws + WS_LIST))[e * T + idx] : -1; }
          }
          __syncthreads(); }
        Gemm gm{(const char*)ws, 512, 512, 512};
        SchedMoe2 S{tab, G, bx};
        EpiMoe2 E{(bf16_t*)p.out, xe};
        f32x4 acc[2][2][4][2];
        pg8::gemm_phase<EpiMoe2, SchedMoe2, true, true, false>(lds, gm, S, E, acc);
    }
    if (IN(12)) { final_phase(p, vcu, G, lane, wave); }
#undef IN
}

}
extern "C" void kernel_launch(void* const* d_in, const int* in_sizes, int n_in, void* d_out, int out_size, void* d_ws, size_t ws_size, hipStream_t stream) {
    static int inited = 0;
    if (!inited) { (void)hipFuncSetAttribute((const void*)fk::mk, hipFuncAttributeMaxDynamicSharedMemorySize, fk::LDS_BYTES); inited = 1; }
    if (ws_size < fk::WS_END) { fprintf(stderr, "workspace too small\n"); return; }
    (void)hipMemsetAsync(d_ws, 0, 1u << 20, stream);
    fk::Params p{};
    for (int i = 0; i < 34; ++i) p.in[i] = (const float*)d_in[i];
    p.out = (float*)d_out; p.ws = (unsigned char*)d_ws;
    for (int ph = 0; ph < 13; ++ph) { p.ph_lo = ph; p.ph_hi = ph + 1; hipLaunchKernelGGL(fk::mk, dim3(256), dim3(fk::NTHREADS), fk::LDS_BYTES, stream, p); }
}
```

```cpp
#include <hip/hip_runtime.h>
#include <hip/hip_bf16.h>
#include <cmath>
#include <stdint.h>
#include <stdio.h>
#include <hip/hip_cooperative_groups.h>
namespace fk {
namespace cg = cooperative_groups;
#define FK_LAS __attribute__((address_space(3)))
#define FK_GAS __attribute__((address_space(1)))
typedef unsigned short bf16_t;
typedef short bf16x8 __attribute__((ext_vector_type(8)));
typedef float f32x4 __attribute__((ext_vector_type(4)));
typedef float f32x2 __attribute__((ext_vector_type(2)));
typedef unsigned u32x4 __attribute__((ext_vector_type(4)));
typedef unsigned u32x2 __attribute__((ext_vector_type(2)));

constexpr int T = 16384, SEQ = 2048, BATCH = 8, DM = 1024, MEMLEN = 256, MTOK = BATCH * MEMLEN;
constexpr float EPS = 1e-6f;
constexpr float LOG2E = 1.4426950408889634f;
constexpr float QSCALE = 0.125f * LOG2E;
constexpr float XQSCALE = 0.0625f * LOG2E;
constexpr int NWAVES = 8, NTHREADS = 512;
constexpr int SL = 32, NCH = SEQ / SL;
constexpr int SUP = 768;
constexpr int SROWS = BATCH * NCH;

constexpr size_t MiB = 1u << 20;
constexpr size_t WS_CTL = 0;
constexpr size_t WS_WIN = 1 * MiB;
constexpr size_t WS_GLU = 4 * MiB;
constexpr size_t WS_WOUT = 5 * MiB;
constexpr size_t WS_WQ = 7 * MiB, WS_WK = 9 * MiB, WS_WV = 11 * MiB, WS_WO = 13 * MiB;
constexpr size_t WS_W1 = 15 * MiB;
constexpr size_t WS_W2 = 23 * MiB;
constexpr size_t WS_WGU = 47 * MiB;
constexpr size_t WS_WD = 79 * MiB;
constexpr size_t WS_R0 = 95 * MiB;
constexpr size_t WS_ROPE = WS_R0 + 65536;
constexpr size_t WS_R2 = WS_ROPE + 65536;
constexpr size_t WS_SSATT = 95 * MiB + 512 * 1024;
constexpr size_t WS_SSSSM = 96 * MiB;
constexpr size_t WS_SSX1 = 96 * MiB + 512 * 1024;
constexpr size_t WS_LIST = 102 * MiB;
constexpr size_t WS_WL = 103 * MiB;
constexpr size_t WS_XB = 105 * MiB;
constexpr size_t WS_HM = 137 * MiB;
constexpr size_t WS_Q = 141 * MiB;
constexpr size_t WS_K = 157 * MiB;
constexpr size_t WS_V = 161 * MiB;
constexpr size_t WS_SU = 165 * MiB;
constexpr size_t WS_SLOC = 189 * MiB;
constexpr size_t WS_KM = 205 * MiB;
constexpr size_t WS_VT = 209 * MiB;
constexpr size_t WS_YCAT = 213 * MiB;
constexpr size_t WS_END = 245 * MiB;
constexpr size_t WS_Z = WS_Q, WS_X1B = WS_SU, WS_QX = WS_XB, WS_PB = WS_YCAT, WS_ACT = WS_XB;
constexpr int CW_CNT = 64;
constexpr int CW_BAR = 4096;

constexpr int RING_BYTES = 131072, XTRA_OFF = RING_BYTES, LDS_BYTES = 147456;

__device__ __forceinline__ unsigned f2bf(float f) { unsigned u = __builtin_bit_cast(unsigned, f); return (u + 0x7fffu + ((u >> 16) & 1u)) >> 16; }
__device__ __forceinline__ unsigned pk2(float lo, float hi) { return f2bf(lo) | (f2bf(hi) << 16); }
__device__ __forceinline__ float bf2f(unsigned short b) { return __builtin_bit_cast(float, (unsigned)b << 16); }
__device__ __forceinline__ float bflo(unsigned w) { return __builtin_bit_cast(float, w << 16); }
__device__ __forceinline__ float bfhi(unsigned w) { return __builtin_bit_cast(float, w & 0xffff0000u); }
__device__ __forceinline__ float wsum(float v) {
#pragma unroll
    for (int o = 1; o < 64; o <<= 1) v += __shfl_xor(v, o);
    return v;
}

namespace pg8 {
constexpr int BM = 256, BK = 64, HALF = 128, HTB = HALF * BK * 2, STAGE_BYTES = 8 * HTB, NXCD = 8, WGM = 8;
__host__ __device__ __forceinline__ int lds_byte(int r, int c) { const int st = (r >> 4) * 2 + (c >> 5), rr = r & 15, cc = c & 31, ob = rr * 64 + cc * 2; return st * 1024 + (ob ^ (((ob >> 9) & 1) << 5)); }
__host__ __device__ __forceinline__ void stage_rc(int b, int& R, int& C) { const int st = b / 1024, sb = b % 1024, swz = sb ^ (((sb >> 9) & 1) << 5); R = (st >> 1) * 16 + swz / 64; C = (st & 1) * 32 + (swz % 64) / 2; }
__host__ __device__ __forceinline__ int perm32(int rho) { const int n = rho >> 4, i = rho & 15; return 8 * (i >> 2) + 4 * n + (i & 3); }

struct Unit { unsigned a_off, b_off; int pm, pn, kind, aux; };
struct Gemm { const char* base; int lda, ldb, K; };

__device__ __forceinline__ void tile_order(int L, int nM, int nN, int& pm, int& pn) {
    const int nwg = nM * nN; int wgid = L;
    { const int q = nwg / NXCD, r = nwg % NXCD, xcd = wgid % NXCD, off = wgid / NXCD; wgid = (xcd < r ? xcd * (q + 1) : r * (q + 1) + (xcd - r) * q) + off; }
    const int nig = WGM * nN, gid = wgid / nig, fm = gid * WGM, gsz = (nM - fm) < WGM ? (nM - fm) : WGM;
    pm = fm + ((wgid % nig) % gsz); pn = (wgid % nig) / gsz;
}

__device__ __forceinline__ unsigned cvt_pk_bf16(float lo, float hi) { unsigned r; asm volatile("v_cvt_pk_bf16_f32 %0, %1, %2" : "=v"(r) : "v"(lo), "v"(hi)); return r; }

template <class Epi, class Sched, bool ALIGN_EPI, bool SP2, bool KEEP_ACC>
__device__ __forceinline__ void gemm_phase(FK_LAS unsigned char* lds, const Gemm g, const Sched& S, const Epi& E, f32x4 (&acc)[2][2][4][2]) {
    int tid_ = threadIdx.x; asm volatile("" : "+v"(tid_));
    const int tid = tid_, wid = __builtin_amdgcn_readfirstlane(tid >> 6), lane = tid & 63, wr = wid >> 2, wc = wid & 3, fr = lane & 15, fq = lane >> 4;
    const int K = g.K, nt = K / BK;
    int R0, C0; stage_rc(tid * 16, R0, C0);
    unsigned voffB[2];
#pragma unroll
    for (int i = 0; i < 2; ++i) { const int R = R0 + 64 * i; const int Rb = Epi::PERM ? ((R & ~31) + perm32(R & 31)) : R; voffB[i] = (unsigned)(Rb * g.ldb + C0) * 2u; }
    const size_t kstep = (size_t)(BK * 2);
    const size_t hstepB = (size_t)HALF * g.ldb * 2;
    const unsigned ldsw = (unsigned)wid * 1024u;
    const int aoff = lds_byte(wr * 64 + fr, fq * 8), boff = lds_byte(wc * 32 + fr, fq * 8);
#define PG8_SA(b, h) (((b) * 2 + (h)) * HTB)
#define PG8_SB(b, h) ((4 + (b) * 2 + (h)) * HTB)
#define PG8_STAGE(bufoff, gbase, voff) do { _Pragma("unroll") for (int _i = 0; _i < 2; ++_i) \
        __builtin_amdgcn_global_load_lds((const unsigned*)((const char*)(gbase) + (voff)[_i]), (FK_LAS unsigned*)(lds + (bufoff) + ldsw + _i * 8192), 16, 0, 0); } while (0)
#define PG8_STAGEA(bufoff, gbase, h) do { _Pragma("unroll") for (int _i = 0; _i < 2; ++_i) \
        __builtin_amdgcn_global_load_lds((const unsigned*)((const char*)(gbase) + voffA[2 * (h) + _i]), (FK_LAS unsigned*)(lds + (bufoff) + ldsw + _i * 8192), 16, 0, 0); } while (0)
#define PG8_LDA(dst, b, h) do { _Pragma("unroll") for (int m = 0; m < 4; ++m) _Pragma("unroll") for (int k = 0; k < 2; ++k) dst[m][k] = *(const FK_LAS bf16x8*)(lds + PG8_SA(b, h) + aoff + m * 2048 + k * 1024); } while (0)
#define PG8_LDB(dst, b, h) do { _Pragma("unroll") for (int n = 0; n < 2; ++n) _Pragma("unroll") for (int k = 0; k < 2; ++k) dst[n][k] = *(const FK_LAS bf16x8*)(lds + PG8_SB(b, h) + boff + n * 2048 + k * 1024); } while (0)
#define PG8_MMA(ai, bj, At, Bt) do { __builtin_amdgcn_s_setprio(1); _Pragma("unroll") for (int m = 0; m < 4; ++m) _Pragma("unroll") for (int n = 0; n < 2; ++n) _Pragma("unroll") for (int k = 0; k < 2; ++k) \
        acc[ai][bj][m][n] = __builtin_amdgcn_mfma_f32_16x16x32_bf16(Bt[n][k], At[m][k], acc[ai][bj][m][n], 0, 0, 0); __builtin_amdgcn_s_setprio(0); } while (0)
#define PG8_WAIT_V(n) asm volatile("s_waitcnt vmcnt(" #n ")" ::: "memory")
#define PG8_WAIT_L(n) asm volatile("s_waitcnt lgkmcnt(" #n ")" ::: "memory")
#define PG8_BAR __builtin_amdgcn_s_barrier()
#define PG8_SCHED __builtin_amdgcn_sched_barrier(0)
    Unit cur, nxt; int ui = 0;
    if (!S.next(0, cur)) return;
    if constexpr (!KEEP_ACC) {
#pragma unroll
        for (int a = 0; a < 2; ++a)
#pragma unroll
            for (int b = 0; b < 2; ++b)
#pragma unroll
                for (int m = 0; m < 4; ++m)
#pragma unroll
                    for (int n = 0; n < 2; ++n) acc[a][b][m][n] = (f32x4){0.f, 0.f, 0.f, 0.f};
    }
    bf16x8 At[4][2], B0[2][2], B1[2][2];
    unsigned voffA[4];
#pragma unroll
    for (int q = 0; q < 4; ++q) voffA[q] = S.row_off(cur, R0 + 64 * q) + (unsigned)C0 * 2u;
    const char* Ab = g.base;
    const char* cB = g.base + cur.b_off;
    if constexpr (SP2) {
        PG8_STAGE(PG8_SB(0, 0), cB, voffB); PG8_STAGE(PG8_SB(0, 1), cB + hstepB, voffB); PG8_STAGEA(PG8_SA(0, 0), Ab, 0); PG8_STAGEA(PG8_SA(0, 1), Ab, 1);
        if (wr == 1) PG8_BAR;
        PG8_WAIT_V(2); PG8_BAR;
        PG8_STAGE(PG8_SB(1, 0), cB + kstep, voffB); PG8_STAGEA(PG8_SA(1, 0), Ab + kstep, 0); PG8_STAGE(PG8_SB(1, 1), cB + hstepB + kstep, voffB);
        PG8_WAIT_V(6); PG8_BAR;
    } else {
        PG8_STAGE(PG8_SB(0, 0), cB, voffB); PG8_STAGEA(PG8_SA(0, 0), Ab, 0); PG8_STAGE(PG8_SB(0, 1), cB + hstepB, voffB); PG8_STAGEA(PG8_SA(0, 1), Ab, 1);
        if (wr == 1) PG8_BAR;
        PG8_WAIT_V(4); PG8_BAR;
        PG8_STAGE(PG8_SB(1, 0), cB + kstep, voffB); PG8_STAGEA(PG8_SA(1, 0), Ab + kstep, 0); PG8_STAGE(PG8_SB(1, 1), cB + hstepB + kstep, voffB);
        PG8_WAIT_V(6); PG8_BAR;
    }
    for (;;) {
        const bool has_next = S.next(ui + 1, nxt);
        const char* nB = has_next ? g.base + nxt.b_off : cB;
        for (int t = 0; t < nt; t += 2) {
            const bool last = (t == nt - 2);
            const char* a1 = Ab + (size_t)(t + 1) * kstep;
            const char* a2 = last ? Ab : Ab + (size_t)(t + 2) * kstep; const char* b2 = last ? nB : cB + (size_t)(t + 2) * kstep;
            const char* a3 = a2 + kstep; const char* b3 = b2 + kstep;
            if constexpr (SP2) {
            PG8_LDB(B0, 0, 0); PG8_LDB(B1, 0, 1); PG8_SCHED; PG8_LDA(At, 0, 0); PG8_STAGEA(PG8_SA(1, 1), a1, 1);
            if (last && has_next) {
#pragma unroll
                for (int q = 0; q < 4; ++q) voffA[q] = S.row_off(nxt, R0 + 64 * q) + (unsigned)C0 * 2u;
            }
            PG8_WAIT_V(8); PG8_WAIT_L(0); PG8_BAR; PG8_MMA(0, 0, At, B0); PG8_MMA(0, 1, At, B1); PG8_BAR; PG8_SCHED;
            PG8_LDA(At, 0, 1); PG8_STAGE(PG8_SB(0, 0), b2, voffB); PG8_STAGE(PG8_SB(0, 1), b2 + hstepB, voffB); PG8_STAGEA(PG8_SA(0, 0), a2, 0);
            PG8_WAIT_V(8); PG8_WAIT_L(0); PG8_BAR; PG8_MMA(1, 0, At, B0); PG8_MMA(1, 1, At, B1); PG8_BAR; PG8_SCHED;
            PG8_LDB(B0, 1, 0); PG8_LDB(B1, 1, 1); PG8_SCHED; PG8_LDA(At, 1, 0); PG8_STAGEA(PG8_SA(0, 1), a2, 1);
            PG8_WAIT_V(8); PG8_WAIT_L(0); PG8_BAR; PG8_MMA(0, 0, At, B0); PG8_MMA(0, 1, At, B1); PG8_BAR; PG8_SCHED;
            PG8_LDA(At, 1, 1); PG8_STAGE(PG8_SB(1, 0), b3, voffB); PG8_STAGE(PG8_SB(1, 1), b3 + hstepB, voffB); PG8_STAGEA(PG8_SA(1, 0), a3, 0);
            PG8_WAIT_V(8); PG8_WAIT_L(0); PG8_BAR; PG8_MMA(1, 0, At, B0); PG8_MMA(1, 1, At, B1); PG8_BAR; PG8_SCHED;
            } else {
            PG8_LDB(B0, 0, 0); PG8_SCHED; PG8_LDA(At, 0, 0); PG8_STAGEA(PG8_SA(1, 1), a1, 1);
            if (last && has_next) {
#pragma unroll
                for (int q = 0; q < 4; ++q) voffA[q] = S.row_off(nxt, R0 + 64 * q) + (unsigned)C0 * 2u;
            }
            PG8_WAIT_L(8); PG8_BAR; PG8_WAIT_L(0); PG8_MMA(0, 0, At, B0); PG8_BAR; PG8_SCHED;
            PG8_LDB(B1, 0, 1); PG8_STAGE(PG8_SB(0, 0), b2, voffB);
            PG8_BAR; PG8_WAIT_L(0); PG8_MMA(0, 1, At, B1); PG8_BAR;
            PG8_LDA(At, 0, 1); PG8_STAGEA(PG8_SA(0, 0), a2, 0);
            PG8_BAR; PG8_WAIT_L(0); PG8_MMA(1, 0, At, B0); PG8_BAR; PG8_SCHED;
            PG8_STAGE(PG8_SB(0, 1), b2 + hstepB, voffB);
            PG8_WAIT_V(6); PG8_BAR; PG8_MMA(1, 1, At, B1); PG8_BAR;
            PG8_LDB(B0, 1, 0); PG8_SCHED; PG8_LDA(At, 1, 0); PG8_STAGEA(PG8_SA(0, 1), a2, 1);
            PG8_WAIT_L(8); PG8_BAR; PG8_WAIT_L(0); PG8_MMA(0, 0, At, B0); PG8_BAR; PG8_SCHED;
            PG8_LDB(B1, 1, 1); PG8_STAGE(PG8_SB(1, 0), b3, voffB);
            PG8_BAR; PG8_WAIT_L(0); PG8_MMA(0, 1, At, B1); PG8_BAR;
            PG8_LDA(At, 1, 1); PG8_STAGEA(PG8_SA(1, 0), a3, 0);
            PG8_BAR; PG8_WAIT_L(0); PG8_MMA(1, 0, At, B0); PG8_BAR; PG8_SCHED;
            PG8_STAGE(PG8_SB(1, 1), b3 + hstepB, voffB);
            PG8_WAIT_V(6); PG8_BAR; PG8_MMA(1, 1, At, B1); PG8_BAR;
            }
        }
        if constexpr (ALIGN_EPI) { if (wr == 0) PG8_BAR; }
        if constexpr (!Epi::AFTER_DRAIN) { int fr_e = fr, fq_e = fq, lane_e = lane; asm volatile("" : "+v"(fr_e), "+v"(fq_e), "+v"(lane_e)); E(acc, cur, wr, wc, fr_e, fq_e, lds, wid, lane_e); }
        if (!has_next) break;
#pragma unroll
        for (int a = 0; a < 2; ++a)
#pragma unroll
            for (int b = 0; b < 2; ++b)
#pragma unroll
                for (int m = 0; m < 4; ++m)
#pragma unroll
                    for (int n = 0; n < 2; ++n) acc[a][b][m][n] = (f32x4){0.f, 0.f, 0.f, 0.f};
        cur = nxt; cB = nB; ++ui;
        if constexpr (ALIGN_EPI) { if (wr == 1) PG8_BAR; }
    }
    PG8_WAIT_V(0);
    if constexpr (!ALIGN_EPI) { if (wr == 0) PG8_BAR; }
    PG8_BAR;
    if constexpr (Epi::AFTER_DRAIN) { int fr_e = fr, fq_e = fq, lane_e = lane; asm volatile("" : "+v"(fr_e), "+v"(fq_e), "+v"(lane_e)); E(acc, cur, wr, wc, fr_e, fq_e, lds, wid, lane_e); }
#undef PG8_SA
#undef PG8_SB
#undef PG8_STAGE
#undef PG8_STAGEA
#undef PG8_LDA
#undef PG8_LDB
#undef PG8_MMA
#undef PG8_WAIT_V
#undef PG8_WAIT_L
#undef PG8_BAR
#undef PG8_SCHED
}
}
namespace attn_body {
using bf16=__hip_bfloat16;
using bf16x8=__attribute__((ext_vector_type(8)))short;
using s16x4=__attribute__((ext_vector_type(4)))short;
using f32x16=__attribute__((ext_vector_type(16)))float;
using u32x4=__attribute__((ext_vector_type(4)))unsigned;
constexpr int BATCH=8,NHEAD=8,SEQ=2048,D=64,QP=512,KP=128,OP=1024;
constexpr int NW=8,QBLK=32,QB=QBLK*NW,KVBLK=64,NQB=SEQ/QB;
constexpr int ATTN_UNIT_ROWS=QB;
__device__ __forceinline__ int crow(int r,int hi){return (r&3)+8*(r>>2)+4*hi;}
#define SBAR() __builtin_amdgcn_sched_barrier(0)
__device__ __forceinline__ void cmask(f32x16&p0,f32x16&p1,int jb,int qrel,int hi){
  const float NEG=-INFINITY; int kb=64*jb+4*hi;
  #pragma unroll
  for(int r=0;r<16;++r){int kv=kb+(r&3)+8*(r>>2); if(kv>qrel)p0[r]=NEG; if(kv+32>qrel)p1[r]=NEG;}
}

constexpr int NSLOT=3, SLOTB=8192;
constexpr int LDS_K=0, LDS_V=NSLOT*SLOTB, LDS_WS=2*NSLOT*SLOTB, LDS_OST=LDS_WS+NW*64*4, LDS_BYTES=LDS_OST+NW*4096;
constexpr float C2=0.125f*1.4426950408889634f;
__device__ __forceinline__ void glds16(const void*gsrc,unsigned lds_dst){unsigned keep;
  asm volatile("s_mov_b32 %0, m0\n\ts_mov_b32 m0, %2\n\ts_nop 0\n\tglobal_load_lds_dwordx4 %1, off\n\ts_mov_b32 m0, %0":"=&s"(keep):"v"(gsrc),"s"(lds_dst):"memory");}
__device__ __forceinline__ float max3f(float a,float b,float c){float r;asm("v_max3_f32 %0, %1, %2, %3":"=v"(r):"v"(a),"v"(b),"v"(c));return r;}
__device__ __forceinline__ float max2f(float a,float b){float r;asm("v_max_f32_e32 %0, %1, %2":"=v"(r):"v"(a),"v"(b));return r;}
__device__ __forceinline__ float fadd_s(float a,float b){float r;asm("v_add_f32_e32 %0, %1, %2":"=v"(r):"v"(a),"v"(b));return r;}
__device__ __forceinline__ float fsub_s(float a,float b){float r;asm("v_sub_f32_e32 %0, %1, %2":"=v"(r):"v"(a),"v"(b));return r;}
typedef float f32x2_t __attribute__((ext_vector_type(2))); typedef __bf16 bf16x2_t __attribute__((ext_vector_type(2)));
__device__ __forceinline__ unsigned cvtpk_s(float lo,float hi){f32x2_t v={lo,hi};bf16x2_t b=__builtin_convertvector(v,bf16x2_t);return __builtin_bit_cast(unsigned,b);}
#define WAIT_BAR(N) asm volatile("s_waitcnt vmcnt(" #N ") lgkmcnt(0)\n\ts_barrier":::"memory")

__device__ __forceinline__ void qkt(f32x16&p0,f32x16&p1,const char*Kslot,const bf16x8*qr,const f32x16&negm,int r32,int hi){
  const char*kb=Kslot+hi*1024+r32*16;
  #pragma unroll
  for(int d0=0;d0<4;++d0){
    const bf16x8 b0=*reinterpret_cast<const bf16x8*>(kb+d0*2048);
    const bf16x8 b1=*reinterpret_cast<const bf16x8*>(kb+d0*2048+512);
    if(d0==0){p0=__builtin_amdgcn_mfma_f32_32x32x16_bf16(b0,qr[0],negm,0,0,0);p1=__builtin_amdgcn_mfma_f32_32x32x16_bf16(b1,qr[0],negm,0,0,0);}
    else{p0=__builtin_amdgcn_mfma_f32_32x32x16_bf16(b0,qr[d0],p0,0,0,0);p1=__builtin_amdgcn_mfma_f32_32x32x16_bf16(b1,qr[d0],p1,0,0,0);}}
}
typedef __attribute__((address_space(3))) const char* lds_cptr;
typedef short v4i16_t __attribute__((ext_vector_type(4)));
__device__ __forceinline__ void kload8(bf16x8*kf,lds_cptr kp){
  kf[0]=*(const __attribute__((address_space(3))) bf16x8*)(kp);      kf[1]=*(const __attribute__((address_space(3))) bf16x8*)(kp+512);
  kf[2]=*(const __attribute__((address_space(3))) bf16x8*)(kp+2048); kf[3]=*(const __attribute__((address_space(3))) bf16x8*)(kp+2560);
  kf[4]=*(const __attribute__((address_space(3))) bf16x8*)(kp+4096); kf[5]=*(const __attribute__((address_space(3))) bf16x8*)(kp+4608);
  kf[6]=*(const __attribute__((address_space(3))) bf16x8*)(kp+6144); kf[7]=*(const __attribute__((address_space(3))) bf16x8*)(kp+6656);
}
__device__ __forceinline__ void kload2(bf16x8*kf,lds_cptr kp,int j){ kf[2*j]=*(const __attribute__((address_space(3))) bf16x8*)(kp+j*2048); kf[2*j+1]=*(const __attribute__((address_space(3))) bf16x8*)(kp+j*2048+512); }
__device__ __forceinline__ s16x4 vtr(lds_cptr p){ return __builtin_bit_cast(s16x4,__builtin_amdgcn_ds_read_tr16_b64_v4i16((__attribute__((address_space(3))) v4i16_t*)p)); }
__device__ __forceinline__ float rowmax(const f32x16&p0,const f32x16&p1){
  float a=max3f(p0[0],p0[1],p1[0]),b=max3f(p0[2],p0[3],p1[1]);a=max3f(a,p1[2],p1[3]);
  #pragma unroll
  for(int r=4;r<16;r+=4){a=max3f(a,p0[r],p0[r+1]);b=max3f(b,p0[r+2],p0[r+3]);a=max3f(a,p1[r],p1[r+1]);b=max3f(b,p1[r+2],p1[r+3]);}
  const float m=max2f(a,b);
  auto rr=__builtin_amdgcn_permlane32_swap(__float_as_uint(m),__float_as_uint(m),false,false);
  return max2f(__uint_as_float(rr[0]),__uint_as_float(rr[1]));
}
__device__ __forceinline__ void pv(f32x16*o,int vb,bf16x8 pa0,bf16x8 pa1,bf16x8 pa2,bf16x8 pa3){
  #pragma unroll
  for(int d0=0;d0<2;++d0){s16x4 lo[4],hi[4];
    #pragma unroll
    for(int ks=0;ks<4;++ks){
      asm volatile("ds_read_b64_tr_b16 %0,%1 offset:%c2":"=&v"(lo[ks]):"v"(vb),"i"(d0*4096+ks*1024):"memory");
      asm volatile("ds_read_b64_tr_b16 %0,%1 offset:%c2":"=&v"(hi[ks]):"v"(vb),"i"(d0*4096+ks*1024+512):"memory");}
    asm volatile("s_waitcnt lgkmcnt(0)":::"memory");SBAR();
    #define PK(k) (bf16x8){lo[k][0],lo[k][1],lo[k][2],lo[k][3],hi[k][0],hi[k][1],hi[k][2],hi[k][3]}
    o[d0]=__builtin_amdgcn_mfma_f32_32x32x16_bf16(pa0,PK(0),o[d0],0,0,0);
    o[d0]=__builtin_amdgcn_mfma_f32_32x32x16_bf16(pa1,PK(1),o[d0],0,0,0);
    o[d0]=__builtin_amdgcn_mfma_f32_32x32x16_bf16(pa2,PK(2),o[d0],0,0,0);
    o[d0]=__builtin_amdgcn_mfma_f32_32x32x16_bf16(pa3,PK(3),o[d0],0,0,0);
    #undef PK
  }
}

#ifndef ATTN_STORE16
#define ATTN_STORE16(p,v) (*(u32x4*)(p)=(v))
#endif
template<int THRL> __device__ __forceinline__ void attn_unit(int b,int h,int qb,const bf16*Q,const bf16*__restrict__ K,const bf16*__restrict__ V,bf16*O,float*SS,char*shm){
  const int tid=threadIdx.x,lane=tid&63,r32=lane&31,hi=lane>>5; const int wid=__builtin_amdgcn_readfirstlane(tid>>6);
  const long rowbase=(long)b*SEQ; const int q0=qb*QB;
  const bf16*Qw=Q+(rowbase+q0+wid*QBLK)*QP+h*D;
  const bf16*Kh=K+rowbase*KP+(h>>2)*D,*Vh=V+rowbase*KP+(h>>2)*D;
  const unsigned lds0=(unsigned)(uintptr_t)shm;
  float*wsf=(float*)(shm+LDS_WS)+wid*64;
  const bf16*ksrc=Kh+(long)lane*KP+wid*8;
  const bf16*vsrc=Vh+(long)(16*(wid&3)+(lane>>2))*KP+(wid>>2)*32+(lane&3)*8;
  const unsigned kdst=lds0+LDS_K+wid*1024, vdst=lds0+LDS_V+wid*1024;
  #define DMA_K(t,slot) glds16(ksrc+(long)(t)*KVBLK*KP,(unsigned)__builtin_amdgcn_readfirstlane(kdst+(slot)))
  #define DMA_V(t,slot) glds16(vsrc+(long)(t)*KVBLK*KP,(unsigned)__builtin_amdgcn_readfirstlane(vdst+(slot)))
  const int vb0=(int)(lds0+LDS_V)+((lane>>4)&1)*32+(lane&3)*8+(4*hi+((lane&15)>>2))*64;
  const char*Kbase=shm+LDS_K; bf16x8 kf[8];
  const lds_cptr shm3=(lds_cptr)shm; const lds_cptr kp0=shm3+LDS_K+hi*1024+r32*16; const lds_cptr vp0=shm3+LDS_V+((lane>>4)&1)*32+(lane&3)*8+(4*hi+((lane&15)>>2))*64;
  const int NT=SEQ/KVBLK;
  DMA_K(0,0);DMA_V(0,0);DMA_K(1,SLOTB);
  bf16x8 qr[4];
  #pragma unroll
  for(int d0=0;d0<4;++d0)qr[d0]=*reinterpret_cast<const bf16x8*>(&Qw[(long)r32*QP+d0*16+hi*8]);
  float mhat=0.f,l_reg=0.f;f32x16 o[2];o[0]=f32x16{};o[1]=f32x16{};f32x16 negm=f32x16{};asm volatile("":"+v"(negm));
  const int qrel=wid*QBLK+r32;
  #define CMASK(P0,P1,t) do{}while(0)
  bool resc=false;
  #define START(P0,P1) do{ const float rm=rowmax(P0,P1); resc=false; \
    { const float dl=rm; mhat=fadd_s(mhat,dl); \
      _Pragma("unroll") for(int r=0;r<16;++r){P0[r]=fsub_s(P0[r],dl);P1[r]=fsub_s(P1[r],dl);} \
      _Pragma("unroll") for(int r=0;r<16;++r)negm[r]=-mhat; asm volatile("":"+v"(negm)); } \
    _Pragma("unroll") for(int r=0;r<16;++r)P0[r]=__builtin_amdgcn_exp2f(P0[r]); }while(0)
  #define RESC() do{ if(resc){ asm volatile("s_waitcnt lgkmcnt(0)":::"memory"); \
      _Pragma("unroll") for(int d_=0;d_<2;++d_) _Pragma("unroll") for(int r=0;r<16;++r)o[d_][r]*=wsf[crow(r,hi)]; } }while(0)
  f32x16 pA0,pA1,pB0,pB1;
  int sl_prev=0,sl_cur=0,sl_next=SLOTB;
  #define ROT() do{sl_prev=sl_cur;sl_cur=sl_next;sl_next=(sl_next==(NSLOT-1)*SLOTB)?0:sl_next+SLOTB;}while(0)
  DMA_K(2,2*SLOTB);
  WAIT_BAR(3);
  qkt(pA0,pA1,Kbase,qr,negm,r32,hi);asm volatile("s_nop 15\n\ts_nop 7":"+v"(pA0),"+v"(pA1));CMASK(pA0,pA1,0);
  START(pA0,pA1);
  _Pragma("unroll") for(int r=0;r<16;++r)pA1[r]=__builtin_amdgcn_exp2f(pA1[r]);
  WAIT_BAR(0);
  DMA_K(3,0);DMA_V(1,SLOTB);
  ROT();
  kload8(kf,kp0+sl_cur);
  WAIT_BAR(2);
  s16x4 vlo[8],vhi[8]; u32x4 pw0,pw1,pw2,pw3;
  #define PKW(P,B) cvtpk_s(P[B],P[B+1])
  #define PAF(k) __builtin_bit_cast(bf16x8,pw##k)
  #define VFR(i) (bf16x8){vlo[i][0],vlo[i][1],vlo[i][2],vlo[i][3],vhi[i][0],vhi[i][1],vhi[i][2],vhi[i][3]}
  #define PIN(x) asm volatile("":"+v"(x))
  #define MX3(a,b,c) __builtin_fmaxf(__builtin_fmaxf((a),(b)),(c))
  #define GAPA(MF,A0,A1,A2,A3,W0,W1,PW) do{ MF; sacc+=A0; sacc+=A1; sacc+=A2; sacc+=A3; PIN(sacc); W0; W1; PIN(PW); SBAR(); }while(0)
  #define EX(v) __builtin_amdgcn_exp2f(v)
  #define GAPB(MF,X,B) do{ MF; X[B]=EX(X[B]); X[B+1]=EX(X[B+1]); X[B+2]=EX(X[B+2]); X[B+3]=EX(X[B+3]); PIN(X); SBAR(); }while(0)
  #define VRD(i) do{ vlo[i]=vtr(vp_+(((i)>>2)*4096+((i)&3)*1024)); vhi[i]=vtr(vp_+(((i)>>2)*4096+((i)&3)*1024+512)); }while(0)
  #define KRD(G,j) do{ if(G){ kload2(kf,kp0+sl_next,j); SBAR(); } }while(0)
  #define STEP(C0,C1,P0,P1,t,GK,GV,GL) do{ SBAR(); \
    const lds_cptr vp_=vp0+sl_prev; \
    VRD(0); SBAR(); float sacc=(P0[0]+P0[1]); \
    GAPA(C0=__builtin_amdgcn_mfma_f32_32x32x16_bf16(kf[0],qr[0],negm,0,0,0), P0[2],P0[3],P0[4],P0[5],     pw0[0]=PKW(P0,0), pw0[1]=PKW(P0,2), pw0); \
    VRD(4); SBAR(); GAPA(C1=__builtin_amdgcn_mfma_f32_32x32x16_bf16(kf[1],qr[0],negm,0,0,0), P0[6],P0[7],P0[8],P0[9],     pw0[2]=PKW(P0,4), pw0[3]=PKW(P0,6), pw0); \
    VRD(1); SBAR(); GAPA(C0=__builtin_amdgcn_mfma_f32_32x32x16_bf16(kf[2],qr[1],C0,0,0,0),   P0[10],P0[11],P0[12],P0[13], pw1[0]=PKW(P0,8), pw1[1]=PKW(P0,10), pw1); \
    VRD(5); SBAR(); GAPA(C1=__builtin_amdgcn_mfma_f32_32x32x16_bf16(kf[3],qr[1],C1,0,0,0),   P0[14],P0[15],P1[0],P1[1],   pw1[2]=PKW(P0,12),pw1[3]=PKW(P0,14), pw1); \
    VRD(2); SBAR(); GAPA(C0=__builtin_amdgcn_mfma_f32_32x32x16_bf16(kf[4],qr[2],C0,0,0,0),   P1[2],P1[3],P1[4],P1[5],     pw2[0]=PKW(P1,0), pw2[1]=PKW(P1,2), pw2); \
    VRD(6); SBAR(); GAPA(C1=__builtin_amdgcn_mfma_f32_32x32x16_bf16(kf[5],qr[2],C1,0,0,0),   P1[6],P1[7],P1[8],P1[9],     pw2[2]=PKW(P1,4), pw2[3]=PKW(P1,6), pw2); \
    VRD(3); SBAR(); GAPA(C0=__builtin_amdgcn_mfma_f32_32x32x16_bf16(kf[6],qr[3],C0,0,0,0),   P1[10],P1[11],P1[12],P1[13], pw3[0]=PKW(P1,8), pw3[1]=PKW(P1,10), pw3); \
    VRD(7); SBAR(); GAPA(C1=__builtin_amdgcn_mfma_f32_32x32x16_bf16(kf[7],qr[3],C1,0,0,0),   P1[14],P1[15],0.f,0.f,       pw3[2]=PKW(P1,12),pw3[3]=PKW(P1,14), pw3); \
    l_reg+=sacc; \
    if(GK){DMA_K((t)+3,sl_cur);} if(GV){DMA_V((t)+1,sl_next);} \
    CMASK(C0,C1,t); \
    { float a=MX3(C0[0],C0[1],C1[0]),b=MX3(C0[2],C0[3],C1[1]); a=MX3(a,C1[2],C1[3]); \
      _Pragma("unroll") for(int r=4;r<16;r+=4){a=MX3(a,C0[r],C0[r+1]);b=MX3(b,C0[r+2],C0[r+3]);a=MX3(a,C1[r],C1[r+1]);b=MX3(b,C1[r+2],C1[r+3]);} \
      float rm=__builtin_fmaxf(a,b); { auto rr=__builtin_amdgcn_permlane32_swap(__float_as_uint(rm),__float_as_uint(rm),false,false); rm=__builtin_fmaxf(__uint_as_float(rr[0]),__uint_as_float(rr[1])); } \
      resc=false; \
      if(__builtin_expect(__any(rm>(float)THRL),0)){ const float dl=__builtin_fmaxf(rm,0.f); mhat+=dl; \
        _Pragma("unroll") for(int r=0;r<16;++r){C0[r]-=dl;C1[r]-=dl;} \
        _Pragma("unroll") for(int r=0;r<16;++r)negm[r]=-mhat; asm volatile("":"+v"(negm)); \
        const float f=__builtin_amdgcn_exp2f(-dl); l_reg*=f; if(hi==0)wsf[r32]=f; resc=true; } } \
    SBAR(); \
    GAPB(o[0]=__builtin_amdgcn_mfma_f32_32x32x16_bf16(PAF(0),VFR(0),o[0],0,0,0), C0,0); \
    GAPB(o[1]=__builtin_amdgcn_mfma_f32_32x32x16_bf16(PAF(0),VFR(4),o[1],0,0,0), C0,4); \
    KRD(GL,0); GAPB(o[0]=__builtin_amdgcn_mfma_f32_32x32x16_bf16(PAF(1),VFR(1),o[0],0,0,0), C0,8); \
    KRD(GL,1); GAPB(o[1]=__builtin_amdgcn_mfma_f32_32x32x16_bf16(PAF(1),VFR(5),o[1],0,0,0), C0,12); \
    KRD(GL,2); GAPB(o[0]=__builtin_amdgcn_mfma_f32_32x32x16_bf16(PAF(2),VFR(2),o[0],0,0,0), C1,0); \
    KRD(GL,3); GAPB(o[1]=__builtin_amdgcn_mfma_f32_32x32x16_bf16(PAF(2),VFR(6),o[1],0,0,0), C1,4); \
    GAPB(o[0]=__builtin_amdgcn_mfma_f32_32x32x16_bf16(PAF(3),VFR(3),o[0],0,0,0), C1,8); \
    GAPB(o[1]=__builtin_amdgcn_mfma_f32_32x32x16_bf16(PAF(3),VFR(7),o[1],0,0,0), C1,12); \
    }while(0)
  int t=1;
  #undef CMASK
  #define CMASK(P0,P1,t) do{}while(0)
  for(;t+5<NT;t+=2){
    STEP(pB0,pB1,pA0,pA1,t,true,true,true);     WAIT_BAR(2); RESC(); ROT();
    STEP(pA0,pA1,pB0,pB1,t+1,true,true,true);   WAIT_BAR(2); RESC(); ROT();
  }
  #undef CMASK
  #define CMASK(P0,P1,t) do{}while(0)
  #define ENDW(tt) do{ if((tt)+3<NT){WAIT_BAR(2);} else if((tt)+2<NT){WAIT_BAR(1);} else {WAIT_BAR(0);} }while(0)
  for(;t+1<NT;t+=2){
    STEP(pB0,pB1,pA0,pA1,t,(t+3<NT),(t+1<NT),(t+1<NT));       ENDW(t);   RESC(); ROT();
    STEP(pA0,pA1,pB0,pB1,t+1,(t+4<NT),(t+2<NT),(t+2<NT));     ENDW(t+1); RESC(); ROT();
  }
  STEP(pB0,pB1,pA0,pA1,NT-1,false,false,false); RESC();
  { float sacc=pB0[0]+pB0[1]; _Pragma("unroll") for(int r=2;r<16;++r)sacc+=pB0[r]; _Pragma("unroll") for(int r=0;r<16;++r)sacc+=pB1[r]; l_reg+=sacc;
    pw0=(u32x4){PKW(pB0,0),PKW(pB0,2),PKW(pB0,4),PKW(pB0,6)};pw1=(u32x4){PKW(pB0,8),PKW(pB0,10),PKW(pB0,12),PKW(pB0,14)};pw2=(u32x4){PKW(pB1,0),PKW(pB1,2),PKW(pB1,4),PKW(pB1,6)};pw3=(u32x4){PKW(pB1,8),PKW(pB1,10),PKW(pB1,12),PKW(pB1,14)};
    SBAR(); pv(o,vb0+sl_cur,PAF(0),PAF(1),PAF(2),PAF(3)); }
  #undef PKW
  #undef PAF
  #undef VFR
  #undef PIN
  #undef MX3
  #undef GAPA
  #undef GAPB
  #undef EX
  #undef VRD
  #undef KRD
  #undef STEP
  #undef ENDW
  {auto rr=__builtin_amdgcn_permlane32_swap(__float_as_uint(l_reg),__float_as_uint(l_reg),false,false);l_reg=__uint_as_float(rr[0])+__uint_as_float(rr[1]);}
  if(hi==0)wsf[32+r32]=l_reg;asm volatile("s_waitcnt lgkmcnt(0)":::"memory");
  float rli[16];
  #pragma unroll
  for(int r=0;r<16;++r)rli[r]=__builtin_amdgcn_rcpf(wsf[32+crow(r,hi)]);
  bf16*Ow=O+(rowbase+q0+wid*QBLK)*OP+h*D; float*SSw=SS+((rowbase+q0+wid*QBLK)*8+h);
  { bf16*stg=(bf16*)(shm+LDS_OST)+wid*2048;
    #pragma unroll
    for(int r=0;r<16;++r){const int orow=crow(r,hi);
      #pragma unroll
      for(int d0=0;d0<2;++d0)stg[orow*64+d0*32+r32]=__float2bfloat16(o[d0][r]*rli[r]);}
    asm volatile("s_waitcnt lgkmcnt(0)":::"memory");
    #pragma unroll
    for(int i=0;i<4;++i){const int row=i*8+(lane>>3),ch=lane&7; const u32x4 v=*(const u32x4*)(stg+row*64+ch*8); ATTN_STORE16(Ow+(long)row*OP+ch*8,v);
      float ss_=0.f; _Pragma("unroll") for(int e_=0;e_<4;++e_){const unsigned w_=v[e_]; const float a_=__uint_as_float(w_<<16),b_=__uint_as_float(w_&0xffff0000u); ss_+=a_*a_+b_*b_;}
      ss_+=__shfl_xor(ss_,1); ss_+=__shfl_xor(ss_,2); ss_+=__shfl_xor(ss_,4); if(ch==0)SSw[(long)row*8]=ss_;} }
  asm volatile("s_waitcnt lgkmcnt(0)\n\ts_barrier":::"memory");
  #undef DMA_K
  #undef DMA_V
  #undef CMASK
  #undef START
  #undef RESC
  #undef ROT
}
constexpr int ATTN_LDS_BYTES=LDS_BYTES;
template<int THRL=8> __device__ __forceinline__ void attn_phase(char*lds,const bf16*Q,const bf16*K,const bf16*V,bf16*O,float*SS,int G,int vcu){
  for(int uid=vcu;uid<512;uid+=G){ const int pair=uid>>5,b=pair>>1,h=(pair&1)*4+((uid>>3)&3),qb=uid&7; attn_unit<THRL>(b,h,qb,Q,K,V,O,SS,lds); }
}
#undef SBAR
#undef WAIT_BAR
}
typedef FK_GAS unsigned gu32;
#define LAS FK_LAS
#define XB_TMO      128
#define XB_XCNT(j)  (256  + 64 * (j))
#define XB_XSUB(j)  (1280 + 64 * (j))
#define XB_XGEN(j)  (2304 + 64 * (j))
#define XB_TOP      3328
#define XB_TOPGEN   3392
#define XCD_BAR_WORDS 3456
#define XB_SPIN_CAP (1u << 18)

__device__ __forceinline__ unsigned xb_ld(unsigned* p)              { return __hip_atomic_load(p, __ATOMIC_RELAXED, __HIP_MEMORY_SCOPE_AGENT); }
__device__ __forceinline__ unsigned xb_add(unsigned* p, unsigned v) { return __hip_atomic_fetch_add(p, v, __ATOMIC_RELAXED, __HIP_MEMORY_SCOPE_AGENT); }
__device__ __forceinline__ unsigned xb_xcc_id() { return (unsigned)__builtin_amdgcn_s_getreg((3 << 11) | 20) & 0xFu; }
#define XB_SPIN(cond, bar) do { unsigned _sp = 0; while (cond) { __builtin_amdgcn_s_sleep(1); \
    if ((++_sp & 255u) == 0u) { if (xb_ld(&(bar)[XB_TMO])) break; if (_sp > XB_SPIN_CAP) { atomicAdd(&(bar)[XB_TMO], 1u); break; } } } } while (0)

struct XcdBarrier {
    unsigned* bar; unsigned x;
    volatile LAS unsigned* st;
};

__device__ __forceinline__ XcdBarrier xcd_barrier_post(unsigned* bar, volatile LAS unsigned* st) {
    XcdBarrier b; b.bar = bar; b.x = xb_xcc_id(); b.st = st;
    if (threadIdx.x == 0) (void)xb_add(&bar[XB_XCNT(b.x)], 1u);
    return b;
}
__device__ __forceinline__ void xcd_barrier_complete(unsigned* bar, unsigned x, unsigned& nloc, unsigned& nx) {
    const unsigned G = gridDim.x * gridDim.y * gridDim.z;
    unsigned sum, cnt, mine, sp = 0u;
    for (;;) {
        sum = 0u; cnt = 0u; mine = 0u;
#pragma unroll
        for (unsigned j = 0; j < 16; ++j) { const unsigned c = xb_ld(&bar[XB_XCNT(j)]); sum += c; cnt += (c > 0u) ? 1u : 0u; mine = (j == x) ? c : mine; }
        if (sum == G) break;
        __builtin_amdgcn_s_sleep(1);
        if ((++sp & 255u) == 0u) { if (xb_ld(&bar[XB_TMO])) break; if (sp > XB_SPIN_CAP) { atomicAdd(&bar[XB_TMO], 1u); break; } }
    }
    nloc = mine > 0u ? mine : 1u; nx = cnt > 0u ? cnt : 1u;
}

__device__ __forceinline__ void xcd_barrier(const XcdBarrier& b) {
    asm volatile("s_waitcnt vmcnt(0)" ::: "memory");
    __syncthreads();
    if (threadIdx.x == 0) {
        unsigned* bar = b.bar;
        __builtin_amdgcn_s_waitcnt(0);
        unsigned nloc = b.st[0], nx = b.st[1];
        if (nloc == 0u) { xcd_barrier_complete(bar, b.x, nloc, nx); b.st[0] = nloc; b.st[1] = nx; }
        const unsigned old = xb_add(&bar[XB_XSUB(b.x)], 1u);
        const unsigned gen = old / nloc;
        if (old + 1u == (gen + 1u) * nloc) {
            __builtin_amdgcn_fence(__ATOMIC_RELEASE, "agent");
            asm volatile("s_waitcnt vmcnt(0)" ::: "memory");
            const unsigned og = xb_add(&bar[XB_TOP], 1u);
            const unsigned tg = og / nx;
            if (og + 1u == (tg + 1u) * nx) xb_add(&bar[XB_TOPGEN], 1u);
            else XB_SPIN(xb_ld(&bar[XB_TOPGEN]) == tg, bar);
            __builtin_amdgcn_fence(__ATOMIC_ACQUIRE, "agent");
            xb_add(&bar[XB_XGEN(b.x)], 1u);
            asm volatile("s_waitcnt vmcnt(0)" ::: "memory");
        } else {
            XB_SPIN(xb_ld(&bar[XB_XGEN(b.x)]) == gen, bar);
            __builtin_amdgcn_fence(__ATOMIC_ACQUIRE, "agent");
            asm volatile("s_waitcnt vmcnt(0)" ::: "memory");
        }
    }
    __syncthreads();
}
#undef LAS
struct Params {
    const float* in[34];
    float* out;
    unsigned char* ws;
    int ph_lo, ph_hi;
};
using pg8::Unit; using pg8::Gemm;

template <class RowMap>
__device__ __forceinline__ void transpose_item(const float* W, int K, int N, const float* gain, bf16_t* WT, const RowMap& rm, FK_LAS float* scr, int item, int lane) {
    const int nblk = N / 32, kb = item / nblk, nb = item % nblk, k0 = 64 * kb, n0 = 32 * nb;
#pragma unroll 8
    for (int i = 0; i < 32; ++i) { const int kk = 2 * i + (lane >> 5); const float gv = gain ? gain[k0 + kk] : 1.f; scr[kk * 33 + (lane & 31)] = W[(size_t)(k0 + kk) * N + n0 + (lane & 31)] * gv; }
    asm volatile("s_waitcnt lgkmcnt(0)" ::: "memory");
    const int c = lane & 7;
#pragma unroll
    for (int j = 0; j < 4; ++j) { const int n = (lane >> 3) + 8 * j; const FK_LAS float* s = scr + (8 * c) * 33 + n;
        u32x4 o; o.x = pk2(s[0 * 33], s[1 * 33]); o.y = pk2(s[2 * 33], s[3 * 33]); o.z = pk2(s[4 * 33], s[5 * 33]); o.w = pk2(s[6 * 33], s[7 * 33]);
        *(u32x4*)(WT + (size_t)rm(n0 + n) * K + k0 + 8 * c) = o; }
    asm volatile("s_waitcnt lgkmcnt(0)" ::: "memory");
}
struct RmId { __device__ __forceinline__ int operator()(int n) const { return n; } };
struct RmWin { __device__ __forceinline__ int operator()(int n) const { if (n >= 768) return n; const int head = n >> 6, dim = n & 63; return 256 * (head >> 2) + 128 * (dim >> 5) + 32 * (head & 3) + (dim & 31); } };
struct RmGU { int up; __device__ __forceinline__ int operator()(int n) const { return (n >> 7) * 256 + up * 128 + (n & 127); } };

__device__ __forceinline__ void row_to_bf16(const float* xrow, bf16_t* orow, float* rout, const float* gain, bool normalise, int lane) {
    const f32x4* xr = (const f32x4*)xrow + lane;
    f32x4 v[4]; float s = 0.f;
#pragma unroll
    for (int j = 0; j < 4; ++j) { v[j] = xr[64 * j]; s += (v[j].x * v[j].x + v[j].y * v[j].y) + (v[j].z * v[j].z + v[j].w * v[j].w); }
    const float r = rsqrtf(wsum(s) * (1.f / 1024.f) + EPS);
    if (rout && lane == 0) *rout = r;
    unsigned long long* o8 = (unsigned long long*)orow + lane;
#pragma unroll
    for (int j = 0; j < 4; ++j) {
        f32x4 w = v[j];
        if (normalise) { const f32x4 gv = ((const f32x4*)gain)[lane + 64 * j]; w = w * r * gv; }
        o8[64 * j] = (unsigned long long)pk2(w.x, w.y) | ((unsigned long long)pk2(w.z, w.w) << 32);
    }
}

__device__ __forceinline__ void s5_prep_group(const Params& p, int g, FK_LAS float* L, int tid) {
    const float* lam_re = p.in[6]; const float* lam_im = p.in[7]; const float* log_step = p.in[8];
    const float* b_re = p.in[9]; const float* b_im = p.in[10]; const float* c_re = p.in[11]; const float* c_im = p.in[12]; const float* dpar = p.in[13];
    FK_LAS float* LPr = L;
    FK_LAS float* LPi = LPr + 2 * 33 * 64;
    FK_LAS float* BBr = LPi + 2 * 33 * 64;
    FK_LAS float* BBi = BBr + 2 * 1024;
    FK_LAS float* CCr = BBi + 2 * 1024;
    FK_LAS float* CCi = CCr + 2 * 1024;
    FK_LAS float* KT = CCi + 2 * 1024;
    for (int idx = tid; idx < 2 * 33 * 64; idx += NTHREADS) {
        const int dir = idx / (33 * 64), e = (idx / 64) % 33, pp = idx & 63;
        const int gp = (dir * 32 + g) * 64 + pp;
        const float lr = fminf(lam_re[gp], -1e-4f), li = lam_im[gp], dt = expf(log_step[dir * 32 + g]);
        const float mag = expf(lr * dt * (float)e), ang = li * dt * (float)e;
        LPr[idx] = mag * cosf(ang); LPi[idx] = mag * sinf(ang);
    }
    for (int idx = tid; idx < 2 * 1024; idx += NTHREADS) {
        const int dir = idx >> 10, pp = (idx >> 4) & 63, c = idx & 15;
        const int gp = (dir * 32 + g) * 64 + pp;
        const float lr = fminf(lam_re[gp], -1e-4f), li = lam_im[gp], dt = expf(log_step[dir * 32 + g]);
        const float mag = expf(lr * dt), ab_r = mag * cosf(li * dt), ab_i = mag * sinf(li * dt);
        const float den = lr * lr + li * li, nr = ab_r - 1.f;
        const float f_r = (nr * lr + ab_i * li) / den, f_i = (ab_i * lr - nr * li) / den;
        const float br = b_re[(size_t)gp * 16 + c], bi = b_im[(size_t)gp * 16 + c];
        BBr[idx] = f_r * br - f_i * bi; BBi[idx] = f_r * bi + f_i * br;
        const int cc = (idx >> 6) & 15, p2 = idx & 63;
        CCr[idx] = c_re[((size_t)(dir * 32 + g) * 16 + cc) * 64 + p2];
        CCi[idx] = c_im[((size_t)(dir * 32 + g) * 16 + cc) * 64 + p2];
    }
    __syncthreads();
    for (int idx = tid; idx < 2 * 32 * 256; idx += NTHREADS) {
        const int dir = idx >> 13, tau = (idx >> 8) & 31, cc = (idx >> 4) & 15, c = idx & 15;
        const FK_LAS float* cr = CCr + dir * 1024 + cc * 64; const FK_LAS float* ci = CCi + dir * 1024 + cc * 64;
        const FK_LAS float* lr = LPr + (dir * 33 + tau) * 64; const FK_LAS float* li = LPi + (dir * 33 + tau) * 64;
        const FK_LAS float* br = BBr + dir * 1024 + c; const FK_LAS float* bi = BBi + dir * 1024 + c;
        float acc = 0.f;
#pragma unroll 8
        for (int pp = 0; pp < 64; ++pp) {
            const float tr = cr[pp] * lr[pp] - ci[pp] * li[pp], ti = cr[pp] * li[pp] + ci[pp] * lr[pp];
            acc += tr * br[pp * 16] - ti * bi[pp * 16];
        }
        KT[idx] = acc;
    }
    __syncthreads();
    bf16_t* W1 = (bf16_t*)(p.ws + WS_W1) + (size_t)g * 256 * 512;
    for (int ch = tid; ch < 256 * 64; ch += NTHREADS) {
        const int n = ch >> 6, kk0 = (ch & 63) * 8, j = kk0 >> 4, c0 = kk0 & 15;
        const int dir = n >> 7, ri = (n >> 6) & 1, pp = n & 63, e = dir ? j : 31 - j;
        const float lr = LPr[(dir * 33 + e) * 64 + pp], li = LPi[(dir * 33 + e) * 64 + pp];
        float v[8];
#pragma unroll
        for (int q = 0; q < 8; ++q) { const float br = BBr[dir * 1024 + pp * 16 + c0 + q], bi = BBi[dir * 1024 + pp * 16 + c0 + q]; v[q] = ri ? (lr * bi + li * br) : (lr * br - li * bi); }
        u32x4 o; o.x = pk2(v[0], v[1]); o.y = pk2(v[2], v[3]); o.z = pk2(v[4], v[5]); o.w = pk2(v[6], v[7]);
        *(u32x4*)(W1 + (size_t)n * 512 + kk0) = o;
    }
    bf16_t* W2 = (bf16_t*)(p.ws + WS_W2) + (size_t)g * 512 * SUP;
    for (int ch = tid; ch < 512 * 96; ch += NTHREADS) {
        const int nn = ch / 96, kk0 = (ch % 96) * 8, j = nn >> 4, cc = nn & 15;
        float v[8];
        if (kk0 < 256) {
            const int dir = kk0 >> 7, ri = (kk0 >> 6) & 1, p0 = kk0 & 63, e = dir ? 32 - j : j + 1;
#pragma unroll
            for (int q = 0; q < 8; ++q) {
                const int pp = p0 + q;
                const float cr = CCr[dir * 1024 + cc * 64 + pp], ci = CCi[dir * 1024 + cc * 64 + pp];
                const float lr = LPr[(dir * 33 + e) * 64 + pp], li = LPi[(dir * 33 + e) * 64 + pp];
                v[q] = ri ? -(cr * li + ci * lr) : (cr * lr - ci * li);
            }
        } else {
            const int j2 = (kk0 - 256) >> 4, c0 = kk0 & 15;
#pragma unroll
            for (int q = 0; q < 8; ++q) {
                const int c = c0 + q; float a = 0.f;
                if (j2 <= j) a += KT[(0 * 32 + (j - j2)) * 256 + cc * 16 + c];
                if (j2 >= j) a += KT[(1 * 32 + (j2 - j)) * 256 + cc * 16 + c];
                if (j2 == j && c == cc) a += dpar[g * 16 + c];
                v[q] = a;
            }
        }
        u32x4 o; o.x = pk2(v[0], v[1]); o.y = pk2(v[2], v[3]); o.z = pk2(v[4], v[5]); o.w = pk2(v[6], v[7]);
        *(u32x4*)(W2 + (size_t)nn * SUP + kk0) = o;
    }
    __syncthreads();
}

__device__ __forceinline__ void p0_prologue(const Params& p, FK_LAS unsigned char* lds, int vcu, int G, int tid, int lane, int wave) {
    unsigned char* ws = p.ws;
    if (vcu >= G - 32) s5_prep_group(p, vcu - (G - 32), (FK_LAS float*)lds, tid);
    if (vcu == 0) {
        for (int idx = tid; idx < 1024; idx += NTHREADS) {
            const int pos = idx >> 4, i = idx & 15;
            const float ang = (float)pos * powf(10000.f, -(float)i / 16.f);
            ((f32x2*)(ws + WS_ROPE))[idx] = (f32x2){cosf(ang), sinf(ang)};
        }
    }
    FK_LAS float* scr = (FK_LAS float*)(lds + wave * 16384);
    const int gw = vcu * NWAVES + wave, NGW = G * NWAVES;
    constexpr int I_WIN = 16 * 40, I_GLU = 8 * 16, I_SQ = 16 * 32, I_GU = 16 * 16, I_DN = 8 * 32;
    constexpr int NITEMS = I_WIN + I_GLU + 5 * I_SQ + 16 * (2 * I_GU + I_DN);
    for (int it = gw; it < NITEMS; it += NGW) {
        int r = it;
        if (r < I_WIN) { transpose_item(p.in[3], 1024, 1280, p.in[2], (bf16_t*)(ws + WS_WIN), RmWin{}, scr, r, lane); continue; } r -= I_WIN;
        if (r < I_GLU) { transpose_item(p.in[14], 512, 512, nullptr, (bf16_t*)(ws + WS_GLU), RmId{}, scr, r, lane); continue; } r -= I_GLU;
        if (r < I_SQ) {
            const int kb = r / 32; const float* gain = kb < 8 ? p.in[16] : p.in[17] - 512;
            transpose_item(p.in[18], 1024, 1024, gain, (bf16_t*)(ws + WS_WOUT), RmId{}, scr, r, lane); continue; } r -= I_SQ;
        if (r < I_SQ) { transpose_item(p.in[21], 1024, 1024, p.in[19], (bf16_t*)(ws + WS_WQ), RmId{}, scr, r, lane); continue; } r -= I_SQ;
        if (r < I_SQ) { transpose_item(p.in[22], 1024, 1024, nullptr, (bf16_t*)(ws + WS_WK), RmId{}, scr, r, lane); continue; } r -= I_SQ;
        if (r < I_SQ) { transpose_item(p.in[23], 1024, 1024, nullptr, (bf16_t*)(ws + WS_WV), RmId{}, scr, r, lane); continue; } r -= I_SQ;
        if (r < I_SQ) { transpose_item(p.in[24], 1024, 1024, nullptr, (bf16_t*)(ws + WS_WO), RmId{}, scr, r, lane); continue; } r -= I_SQ;
        const int e = r / (2 * I_GU + I_DN); r -= e * (2 * I_GU + I_DN);
        bf16_t* wgu = (bf16_t*)(ws + WS_WGU) + (size_t)e * 1024 * 1024;
        if (r < I_GU) { transpose_item(p.in[30] + (size_t)e * 1024 * 512, 1024, 512, p.in[25], wgu, RmGU{0}, scr, r, lane); continue; } r -= I_GU;
        if (r < I_GU) { transpose_item(p.in[31] + (size_t)e * 1024 * 512, 1024, 512, p.in[25], wgu, RmGU{1}, scr, r, lane); continue; } r -= I_GU;
        transpose_item(p.in[32] + (size_t)e * 512 * 1024, 512, 1024, nullptr, (bf16_t*)(ws + WS_WD) + (size_t)e * 1024 * 512, RmId{}, scr, r, lane);
    }
    for (int m = gw; m < T; m += NGW) row_to_bf16(p.in[0] + (size_t)m * 1024, (bf16_t*)(ws + WS_XB) + (size_t)m * 1024, (float*)(ws + WS_R0) + m, nullptr, false, lane);
    for (int m = gw; m < MTOK; m += NGW) row_to_bf16(p.in[1] + (size_t)m * 1024, (bf16_t*)(ws + WS_HM) + (size_t)m * 1024, nullptr, p.in[20], true, lane);
}

struct SchedP1 {
    int G, c;
    __device__ __forceinline__ bool next(int i, Unit& u) const {
        const int L = i * G + c;
        int pm = 0, pn = 0, kind = 0; unsigned a_off = 0, b_off = 0;
        if (L < 320) {
            pg8::tile_order(L, 64, 5, pm, pn);
            a_off = (unsigned)(WS_XB + (size_t)pm * 256 * 1024 * 2); b_off = (unsigned)(WS_WIN + (size_t)pn * 256 * 1024 * 2);
            kind = pn < 3 ? 0 : 1;
        } else if (L < 352) { const int r = L - 320; pm = r >> 2; pn = r & 3; kind = 2;
            a_off = (unsigned)(WS_HM + (size_t)pm * 256 * 1024 * 2); b_off = (unsigned)(WS_WK + (size_t)pn * 256 * 1024 * 2);
        } else { const int q = L - 352; pm = (q >> 3) & 3; pn = q & 7; kind = 3;
            a_off = (unsigned)(WS_WV + (size_t)pm * 256 * 1024 * 2); b_off = (unsigned)(WS_HM + (size_t)pn * 256 * 1024 * 2); }
        u.a_off = a_off; u.b_off = b_off; u.pm = pm; u.pn = pn; u.kind = kind; u.aux = 0;
        return L < 384;
    }
    __device__ __forceinline__ unsigned row_off(const Unit& u, int r) const { return u.a_off + (unsigned)r * 2048u; }
};
struct EpiP1 {
    static constexpr bool PERM = false, AFTER_DRAIN = false;
    unsigned char* ws; const float* qg; const float* kg;
    __device__ __forceinline__ void operator()(f32x4 (&acc)[2][2][4][2], const Unit& u, int wr, int wc, int fr, int fq, FK_LAS unsigned char*, int, int) const {
        if (u.kind == 0) {
            const int head = 4 * u.pn + wc;
            const float* r0 = (const float*)(ws + WS_R0);
            const f32x2* rope = (const f32x2*)(ws + WS_ROPE);
            if (head < 10) {
                const float* gn = head < 8 ? qg : kg;
                f32x4 gv[2][2];
#pragma unroll
                for (int bj = 0; bj < 2; ++bj)
#pragma unroll
                    for (int n = 0; n < 2; ++n) gv[bj][n] = *(const f32x4*)(gn + 32 * bj + 16 * n + 4 * fq);
                const float osc = head < 8 ? QSCALE : 1.f;
#pragma unroll
                for (int ai = 0; ai < 2; ++ai)
#pragma unroll
                    for (int m = 0; m < 4; ++m) {
                        const int row = u.pm * 256 + ai * 128 + wr * 64 + m * 16 + fr;
                        float ss = 0.f;
#pragma unroll
                        for (int bj = 0; bj < 2; ++bj)
#pragma unroll
                            for (int n = 0; n < 2; ++n) { const f32x4 x = acc[ai][bj][m][n]; ss += (x[0] * x[0] + x[1] * x[1]) + (x[2] * x[2] + x[3] * x[3]); }
                        ss += __shfl_xor(ss, 16); ss += __shfl_xor(ss, 32);
                        const float rr = r0[row];
                        const float hs = rr * rsqrtf(rr * rr * ss * (1.f / 64.f) + EPS) * osc;
                        const int s = row & (SEQ - 1);
                        bf16_t* dst = head < 8 ? (bf16_t*)(ws + WS_Q) + (size_t)row * 512 + head * 64 : (bf16_t*)(ws + WS_K) + (size_t)row * 128 + (head - 8) * 64;
#pragma unroll
                        for (int bj = 0; bj < 2; ++bj) {
                            const int pos = bj == 0 ? (s >> 6) : (s & 63);
                            f32x4 x1 = acc[ai][bj][m][0] * hs * gv[bj][0], x2 = acc[ai][bj][m][1] * hs * gv[bj][1], o1, o2;
#pragma unroll
                            for (int j = 0; j < 4; ++j) { const f32x2 cs = rope[pos * 16 + 4 * fq + j]; o1[j] = x1[j] * cs.x - x2[j] * cs.y; o2[j] = x2[j] * cs.x + x1[j] * cs.y; }
                            u32x2 w1, w2; w1.x = pg8::cvt_pk_bf16(o1[0], o1[1]); w1.y = pg8::cvt_pk_bf16(o1[2], o1[3]); w2.x = pg8::cvt_pk_bf16(o2[0], o2[1]); w2.y = pg8::cvt_pk_bf16(o2[2], o2[3]);
                            *(u32x2*)(dst + 32 * bj + 4 * fq) = w1; *(u32x2*)(dst + 32 * bj + 16 + 4 * fq) = w2;
                        }
                    }
            } else {
#pragma unroll
                for (int ai = 0; ai < 2; ++ai)
#pragma unroll
                    for (int m = 0; m < 4; ++m) {
                        const int row = u.pm * 256 + ai * 128 + wr * 64 + m * 16 + fr;
                        const float rr = r0[row];
                        bf16_t* dst = (bf16_t*)(ws + WS_V) + (size_t)row * 128 + (head - 10) * 64;
#pragma unroll
                        for (int bj = 0; bj < 2; ++bj)
#pragma unroll
                            for (int n = 0; n < 2; ++n) { const f32x4 x = acc[ai][bj][m][n] * rr; u32x2 w; w.x = pg8::cvt_pk_bf16(x[0], x[1]); w.y = pg8::cvt_pk_bf16(x[2], x[3]);
                                *(u32x2*)(dst + 32 * bj + 16 * n + 4 * fq) = w; }
                    }
            }
        } else if (u.kind == 1) {
            const float* r0 = (const float*)(ws + WS_R0);
#pragma unroll
            for (int ai = 0; ai < 2; ++ai)
#pragma unroll
                for (int m = 0; m < 4; ++m) {
                    const int row = u.pm * 256 + ai * 128 + wr * 64 + m * 16 + fr;
                    const float rr = r0[row];
                    const int b = row >> 11, s = row & (SEQ - 1), k = s >> 5, jj = s & 31;
#pragma unroll
                    for (int bj = 0; bj < 2; ++bj)
#pragma unroll
                        for (int n = 0; n < 2; ++n) {
                            const int gidx = 16 * (u.pn - 3) + 8 * bj + 2 * wc + n;
                            bf16_t* dst = (bf16_t*)(ws + WS_SU) + ((size_t)gidx * SROWS + b * NCH + k) * SUP + 256 + jj * 16 + 4 * fq;
                            const f32x4 x = acc[ai][bj][m][n] * rr; u32x2 w; w.x = pg8::cvt_pk_bf16(x[0], x[1]); w.y = pg8::cvt_pk_bf16(x[2], x[3]);
                            *(u32x2*)dst = w;
                        }
                }
        } else {
            bf16_t* base = u.kind == 2 ? (bf16_t*)(ws + WS_KM) + (size_t)u.pm * 256 * 1024 + u.pn * 256 : (bf16_t*)(ws + WS_VT) + ((size_t)u.pn * 1024 + u.pm * 256) * 256;
            const int ldc = u.kind == 2 ? 1024 : 256;
#pragma unroll
            for (int ai = 0; ai < 2; ++ai)
#pragma unroll
                for (int m = 0; m < 4; ++m) {
                    bf16_t* rowp = base + (size_t)(ai * 128 + wr * 64 + m * 16 + fr) * ldc + wc * 32 + 4 * fq;
#pragma unroll
                    for (int bj = 0; bj < 2; ++bj)
#pragma unroll
                        for (int n = 0; n < 2; ++n) { const f32x4 x = acc[ai][bj][m][n]; u32x2 w; w.x = pg8::cvt_pk_bf16(x[0], x[1]); w.y = pg8::cvt_pk_bf16(x[2], x[3]);
                            *(u32x2*)(rowp + 128 * bj + 16 * n) = w; }
                }
        }
    }
};
struct SchedOne {
    Unit u; unsigned a_pitch;
    __device__ __forceinline__ bool next(int i, Unit& o) const { o = u; return i == 0; }
    __device__ __forceinline__ unsigned row_off(const Unit& x, int r) const { return x.a_off + (unsigned)r * a_pitch; }
};
__device__ __forceinline__ Unit mk_unit(unsigned a_off, unsigned b_off, int pm, int pn, int kind) { Unit u; u.a_off = a_off; u.b_off = b_off; u.pm = pm; u.pn = pn; u.kind = kind; u.aux = 0; return u; }

struct EpiSloc {
    static constexpr bool PERM = false, AFTER_DRAIN = false;
    float* C;
    __device__ __forceinline__ void operator()(f32x4 (&acc)[2][2][4][2], const Unit& u, int wr, int wc, int fr, int fq, FK_LAS unsigned char*, int, int) const {
#pragma unroll
        for (int ai = 0; ai < 2; ++ai)
#pragma unroll
            for (int m = 0; m < 4; ++m) {
                float* rowp = C + (size_t)(u.pm * 256 + ai * 128 + wr * 64 + m * 16 + fr) * 256 + wc * 32 + 4 * fq;
#pragma unroll
                for (int bj = 0; bj < 2; ++bj)
#pragma unroll
                    for (int n = 0; n < 2; ++n) *(f32x4*)(rowp + 128 * bj + 16 * n) = acc[ai][bj][m][n];
            }
    }
};
__device__ __forceinline__ void s5_scan(const Params& p, int g, int mt, int tid) {
    const int bl = tid >> 7, dir = (tid >> 6) & 1, pp = tid & 63;
    const int gp = (dir * 32 + g) * 64 + pp;
    const float lr = fminf(p.in[6][gp], -1e-4f), li = p.in[7][gp], dt = expf(p.in[8][dir * 32 + g]);
    const float mag = expf(lr * dt * (float)SL), ang = li * dt * (float)SL;
    const float ar = mag * cosf(ang), ai = mag * sinf(ang);
    const float* sl = (const float*)(p.ws + WS_SLOC) + ((size_t)g * SROWS + mt * 256 + bl * 64) * 256 + dir * 128 + pp;
    bf16_t* su = (bf16_t*)(p.ws + WS_SU) + ((size_t)g * SROWS + mt * 256 + bl * 64) * SUP + dir * 128 + pp;
    float sr = 0.f, si = 0.f;
#pragma unroll 8
    for (int s = 0; s < NCH; ++s) {
        const int k = dir ? (NCH - 1 - s) : s;
        su[(size_t)k * SUP] = (bf16_t)f2bf(sr); su[(size_t)k * SUP + 64] = (bf16_t)f2bf(si);
        const float lr_ = sl[(size_t)k * 256], li_ = sl[(size_t)k * 256 + 64];
        const float nr = ar * sr - ai * si + lr_, ni = ar * si + ai * sr + li_;
        sr = nr; si = ni;
    }
}
struct EpiS5Out {
    static constexpr bool PERM = false, AFTER_DRAIN = false;
    bf16_t* Z; int g, mt, ntile;
    __device__ __forceinline__ void operator()(f32x4 (&acc)[2][2][4][2], const Unit& u, int wr, int wc, int fr, int fq, FK_LAS unsigned char*, int, int) const {
#pragma unroll
        for (int ai = 0; ai < 2; ++ai)
#pragma unroll
            for (int m = 0; m < 4; ++m) {
                const int R = mt * 256 + ai * 128 + wr * 64 + m * 16 + fr, b = R >> 6, k = R & 63;
#pragma unroll
                for (int bj = 0; bj < 2; ++bj)
#pragma unroll
                    for (int n = 0; n < 2; ++n) {
                        const int j = 16 * ntile + 8 * bj + 2 * wc + n;
                        const size_t t = (size_t)b * SEQ + k * SL + j;
                        f32x4 y = acc[ai][bj][m][n], z;
#pragma unroll
                        for (int i = 0; i < 4; ++i) { const float a2 = 1.5957691216057308f * (y[i] + 0.044715f * y[i] * y[i] * y[i]); z[i] = y[i] / (1.f + __expf(-a2)); }
                        u32x2 w; w.x = pg8::cvt_pk_bf16(z[0], z[1]); w.y = pg8::cvt_pk_bf16(z[2], z[3]);
                        *(u32x2*)(Z + t * 512 + g * 16 + 4 * fq) = w;
                    }
            }
    }
};
struct EpiGlu {
    static constexpr bool PERM = false, AFTER_DRAIN = false;
    const bf16_t* Z; bf16_t* Y; float* SS; const float* bias;
    __device__ __forceinline__ void operator()(f32x4 (&acc)[2][2][4][2], const Unit& u, int wr, int wc, int fr, int fq, FK_LAS unsigned char*, int, int) const {
        const int col0 = u.pn * 256 + wc * 32 + 4 * fq;
        f32x4 bv[2][2];
#pragma unroll
        for (int bj = 0; bj < 2; ++bj)
#pragma unroll
            for (int n = 0; n < 2; ++n) bv[bj][n] = *(const f32x4*)(bias + col0 + 128 * bj + 16 * n);
#pragma unroll
        for (int ai = 0; ai < 2; ++ai)
#pragma unroll
            for (int m = 0; m < 4; ++m) {
                const size_t row = (size_t)u.pm * 256 + ai * 128 + wr * 64 + m * 16 + fr;
                float ss = 0.f;
#pragma unroll
                for (int bj = 0; bj < 2; ++bj)
#pragma unroll
                    for (int n = 0; n < 2; ++n) {
                        const int col = col0 + 128 * bj + 16 * n;
                        const u32x2 zw = *(const u32x2*)(Z + row * 512 + col);
                        const f32x4 lin = acc[ai][bj][m][n] + bv[bj][n];
                        const float z0 = bflo(zw.x), z1 = bfhi(zw.x), z2 = bflo(zw.y), z3 = bfhi(zw.y);
                        const float y0 = z0 / (1.f + __expf(-lin[0])), y1 = z1 / (1.f + __expf(-lin[1])), y2 = z2 / (1.f + __expf(-lin[2])), y3 = z3 / (1.f + __expf(-lin[3]));
                        u32x2 w; w.x = pg8::cvt_pk_bf16(y0, y1); w.y = pg8::cvt_pk_bf16(y2, y3);
                        *(u32x2*)(Y + row * 1024 + 512 + col) = w;
                        const float r0 = bflo(w.x), r1 = bfhi(w.x), r2 = bflo(w.y), r3 = bfhi(w.y);
                        ss += (r0 * r0 + r1 * r1) + (r2 * r2 + r3 * r3);
                    }
                ss += __shfl_xor(ss, 16); ss += __shfl_xor(ss, 32);
                if (fq == 0) SS[row * 8 + u.pn * 4 + wc] = ss;
                asm volatile("" ::: "memory");
            }
    }
};
__device__ __forceinline__ float rs8(const float* ss, size_t row, float inv_n) {
    const f32x4 a = *(const f32x4*)(ss + row * 8), b = *(const f32x4*)(ss + row * 8 + 4);
    return rsqrtf(((a[0] + a[1]) + (a[2] + a[3]) + (b[0] + b[1]) + (b[2] + b[3])) * inv_n + EPS);
}
struct EpiWoutMid {
    static constexpr bool PERM = false, AFTER_DRAIN = false;
    const FK_LAS float* xt;
    __device__ __forceinline__ void operator()(f32x4 (&acc)[2][2][4][2], const Unit& u, int wr, int wc, int fr, int fq, FK_LAS unsigned char*, int, int) const {
#pragma unroll
        for (int ai = 0; ai < 2; ++ai)
#pragma unroll
            for (int m = 0; m < 4; ++m) {
                const float f = xt[ai * 128 + wr * 64 + m * 16 + fr];
#pragma unroll
                for (int bj = 0; bj < 2; ++bj)
#pragma unroll
                    for (int n = 0; n < 2; ++n) acc[ai][bj][m][n] = acc[ai][bj][m][n] * f;
            }
    }
};
struct EpiWoutFin {
    static constexpr bool PERM = false, AFTER_DRAIN = false;
    const FK_LAS float* xt; const bf16_t* XB; bf16_t* X1; float* SS1;
    __device__ __forceinline__ void operator()(f32x4 (&acc)[2][2][4][2], const Unit& u, int wr, int wc, int fr, int fq, FK_LAS unsigned char*, int, int) const {
        const int col0 = u.pn * 256 + wc * 32 + 4 * fq;
#pragma unroll
        for (int ai = 0; ai < 2; ++ai)
#pragma unroll
            for (int m = 0; m < 4; ++m) {
                const size_t row = (size_t)u.pm * 256 + ai * 128 + wr * 64 + m * 16 + fr;
                const float rs = xt[256 + ai * 128 + wr * 64 + m * 16 + fr];
                float ss = 0.f;
#pragma unroll
                for (int bj = 0; bj < 2; ++bj)
#pragma unroll
                    for (int n = 0; n < 2; ++n) {
                        const int col = col0 + 128 * bj + 16 * n;
                        const u32x2 xw = *(const u32x2*)(XB + row * 1024 + col);
                        const f32x4 a = acc[ai][bj][m][n] * rs;
                        u32x2 w; w.x = pg8::cvt_pk_bf16(bflo(xw.x) + a[0], bfhi(xw.x) + a[1]); w.y = pg8::cvt_pk_bf16(bflo(xw.y) + a[2], bfhi(xw.y) + a[3]);
                        *(u32x2*)(X1 + row * 1024 + col) = w;
                        const float r0 = bflo(w.x), r1 = bfhi(w.x), r2 = bflo(w.y), r3 = bfhi(w.y);
                        ss += (r0 * r0 + r1 * r1) + (r2 * r2 + r3 * r3);
                    }
                ss += __shfl_xor(ss, 16); ss += __shfl_xor(ss, 32);
                if (fq == 0) SS1[row * 16 + u.pn * 4 + wc] = ss;
                asm volatile("" ::: "memory");
            }
    }
};
struct EpiScaleBf16 {
    static constexpr bool PERM = false, AFTER_DRAIN = false;
    bf16_t* O; int ldc; const FK_LAS float* xt; float sc;
    __device__ __forceinline__ void operator()(f32x4 (&acc)[2][2][4][2], const Unit& u, int wr, int wc, int fr, int fq, FK_LAS unsigned char*, int, int) const {
#pragma unroll
        for (int ai = 0; ai < 2; ++ai)
#pragma unroll
            for (int m = 0; m < 4; ++m) {
                const int r = ai * 128 + wr * 64 + m * 16 + fr;
                const float f = xt ? xt[r] * sc : sc;
                bf16_t* rowp = O + (size_t)r * ldc + wc * 32 + 4 * fq;
#pragma unroll
                for (int bj = 0; bj < 2; ++bj)
#pragma unroll
                    for (int n = 0; n < 2; ++n) { const f32x4 x = acc[ai][bj][m][n] * f; u32x2 w; w.x = pg8::cvt_pk_bf16(x[0], x[1]); w.y = pg8::cvt_pk_bf16(x[2], x[3]);
                        *(u32x2*)(rowp + 128 * bj + 16 * n) = w; }
            }
    }
};
struct EpiSoftmax {
    static constexpr bool PERM = false, AFTER_DRAIN = true;
    bf16_t* O; int ldc;
    __device__ __forceinline__ void operator()(f32x4 (&acc)[2][2][4][2], const Unit& u, int wr, int wc, int fr, int fq, FK_LAS unsigned char* lds, int, int) const {
        FK_LAS float* Pm = (FK_LAS float*)lds;
        FK_LAS float* Ps = (FK_LAS float*)(lds + 4096);
#pragma unroll
        for (int ai = 0; ai < 2; ++ai)
#pragma unroll
            for (int m = 0; m < 4; ++m) {
                float mx = -INFINITY;
#pragma unroll
                for (int bj = 0; bj < 2; ++bj)
#pragma unroll
                    for (int n = 0; n < 2; ++n) { const f32x4 x = acc[ai][bj][m][n]; mx = fmaxf(mx, fmaxf(fmaxf(x[0], x[1]), fmaxf(x[2], x[3]))); }
                mx = fmaxf(mx, __shfl_xor(mx, 16)); mx = fmaxf(mx, __shfl_xor(mx, 32));
                if (fq == 0) Pm[(ai * 128 + wr * 64 + m * 16 + fr) * 4 + wc] = mx;
            }
        asm volatile("s_waitcnt lgkmcnt(0)" ::: "memory"); __builtin_amdgcn_s_barrier(); asm volatile("" ::: "memory");
#pragma unroll
        for (int ai = 0; ai < 2; ++ai)
#pragma unroll
            for (int m = 0; m < 4; ++m) {
                const int r = ai * 128 + wr * 64 + m * 16 + fr;
                const f32x4 pm4 = *(const FK_LAS f32x4*)(Pm + r * 4);
                const float M = fmaxf(fmaxf(pm4[0], pm4[1]), fmaxf(pm4[2], pm4[3]));
                float sm = 0.f;
#pragma unroll
                for (int bj = 0; bj < 2; ++bj)
#pragma unroll
                    for (int n = 0; n < 2; ++n) { f32x4 x = acc[ai][bj][m][n];
#pragma unroll
                        for (int i = 0; i < 4; ++i) { x[i] = __builtin_amdgcn_exp2f(x[i] - M); sm += x[i]; }
                        acc[ai][bj][m][n] = x; }
                sm += __shfl_xor(sm, 16); sm += __shfl_xor(sm, 32);
                if (fq == 0) Ps[r * 4 + wc] = sm;
            }
        asm volatile("s_waitcnt lgkmcnt(0)" ::: "memory"); __builtin_amdgcn_s_barrier(); asm volatile("" ::: "memory");
#pragma unroll
        for (int ai = 0; ai < 2; ++ai)
#pragma unroll
            for (int m = 0; m < 4; ++m) {
                const int r = ai * 128 + wr * 64 + m * 16 + fr;
                const f32x4 ps4 = *(const FK_LAS f32x4*)(Ps + r * 4);
                const float inv = 1.f / ((ps4[0] + ps4[1]) + (ps4[2] + ps4[3]));
                bf16_t* rowp = O + (size_t)r * ldc + wc * 32 + 4 * fq;
#pragma unroll
                for (int bj = 0; bj < 2; ++bj)
#pragma unroll
                    for (int n = 0; n < 2; ++n) { const f32x4 x = acc[ai][bj][m][n] * inv; u32x2 w; w.x = pg8::cvt_pk_bf16(x[0], x[1]); w.y = pg8::cvt_pk_bf16(x[2], x[3]);
                        *(u32x2*)(rowp + 128 * bj + 16 * n) = w; }
            }
        asm volatile("s_waitcnt lgkmcnt(0)" ::: "memory"); __builtin_amdgcn_s_barrier(); asm volatile("" ::: "memory");
    }
};
struct EpiResid {
    static constexpr bool PERM = false, AFTER_DRAIN = false;
    bf16_t* X; int ldc;
    __device__ __forceinline__ void operator()(f32x4 (&acc)[2][2][4][2], const Unit& u, int wr, int wc, int fr, int fq, FK_LAS unsigned char*, int, int) const {
#pragma unroll
        for (int ai = 0; ai < 2; ++ai)
#pragma unroll
            for (int m = 0; m < 4; ++m) {
                bf16_t* rowp = X + (size_t)(ai * 128 + wr * 64 + m * 16 + fr) * ldc + wc * 32 + 4 * fq;
#pragma unroll
                for (int bj = 0; bj < 2; ++bj)
#pragma unroll
                    for (int n = 0; n < 2; ++n) { const u32x2 xw = *(const u32x2*)(rowp + 128 * bj + 16 * n); const f32x4 a = acc[ai][bj][m][n];
                        u32x2 w; w.x = pg8::cvt_pk_bf16(bflo(xw.x) + a[0], bfhi(xw.x) + a[1]); w.y = pg8::cvt_pk_bf16(bflo(xw.y) + a[2], bfhi(xw.y) + a[3]);
                        *(u32x2*)(rowp + 128 * bj + 16 * n) = w; }
                asm volatile("" ::: "memory");
            }
    }
};
__device__ __forceinline__ void router_phase(const Params& p, FK_LAS unsigned char* lds, int vcu, int G, int tid, int lane, int wave) {
    unsigned char* ws = p.ws;
    FK_LAS float* RW = (FK_LAS float*)lds;
    const float* gw = p.in[26]; const float* ew = p.in[28]; const float* mg = p.in[25];
    for (int idx = tid; idx < 1024 * 20; idx += NTHREADS) { const int k = idx / 20, i = idx % 20; RW[idx] = mg[k] * (i < 4 ? gw[k * 4 + i] : ew[k * 16 + (i - 4)]); }
    __syncthreads();
    const bf16_t* X2 = (const bf16_t*)(ws + WS_X1B);
    int* cnt = (int*)(ws + WS_CTL) + CW_CNT; int* list = (int*)(ws + WS_LIST); float* wl = (float*)(ws + WS_WL); float* r2o = (float*)(ws + WS_R2);
    const int gwv = vcu * NWAVES + wave, NGW = G * NWAVES;
    for (int t = gwv; t < T; t += NGW) {
        float lg[20];
#pragma unroll
        for (int i = 0; i < 20; ++i) lg[i] = 0.f;
        float ss = 0.f;
#pragma unroll
        for (int j = 0; j < 2; ++j) {
            const int k0 = j * 512 + lane * 8;
            const u32x4 xw = *(const u32x4*)(X2 + (size_t)t * 1024 + k0);
#pragma unroll
            for (int e = 0; e < 8; ++e) {
                const unsigned w = xw[e >> 1]; const float x = (e & 1) ? bfhi(w) : bflo(w);
                ss += x * x;
                const FK_LAS f32x4* rw = (const FK_LAS f32x4*)(RW + (k0 + e) * 20);
#pragma unroll
                for (int q = 0; q < 5; ++q) { const f32x4 wv = rw[q]; lg[4 * q + 0] = fmaf(x, wv[0], lg[4 * q + 0]); lg[4 * q + 1] = fmaf(x, wv[1], lg[4 * q + 1]); lg[4 * q + 2] = fmaf(x, wv[2], lg[4 * q + 2]); lg[4 * q + 3] = fmaf(x, wv[3], lg[4 * q + 3]); }
                asm volatile("" ::: "memory");
            }
        }
        ss = wsum(ss);
        const float r2 = rsqrtf(ss * (1.f / 1024.f) + EPS);
#pragma unroll
        for (int i = 0; i < 20; ++i) lg[i] = wsum(lg[i]) * r2 + (i < 4 ? p.in[27][i] : p.in[29][i - 4]);
        if (lane == 0) {
            r2o[t] = r2;
            const float gm = fmaxf(fmaxf(lg[0], lg[1]), fmaxf(lg[2], lg[3]));
            const float e0 = expf(lg[0] - gm), e1 = expf(lg[1] - gm), e2 = expf(lg[2] - gm), e3 = expf(lg[3] - gm);
            const float gs = e0 + e1 + e2 + e3;
            int gsel = 0; float gbest = e0;
            if (e1 > gbest) { gbest = e1; gsel = 1; }
            if (e2 > gbest) { gbest = e2; gsel = 2; }
            if (e3 > gbest) { gbest = e3; gsel = 3; }
            const float gwt = gbest / gs;
            const float v0 = gsel == 0 ? lg[4] : gsel == 1 ? lg[8] : gsel == 2 ? lg[12] : lg[16];
            const float v1 = gsel == 0 ? lg[5] : gsel == 1 ? lg[9] : gsel == 2 ? lg[13] : lg[17];
            const float v2 = gsel == 0 ? lg[6] : gsel == 1 ? lg[10] : gsel == 2 ? lg[14] : lg[18];
            const float v3 = gsel == 0 ? lg[7] : gsel == 1 ? lg[11] : gsel == 2 ? lg[15] : lg[19];
            int i1 = 0; float b1 = v0;
            if (v1 > b1) { b1 = v1; i1 = 1; }
            if (v2 > b1) { b1 = v2; i1 = 2; }
            if (v3 > b1) { b1 = v3; i1 = 3; }
            int i2 = 0; float b2 = -INFINITY;
            if (i1 != 0 && v0 > b2) { b2 = v0; i2 = 0; }
            if (i1 != 1 && v1 > b2) { b2 = v1; i2 = 1; }
            if (i1 != 2 && v2 > b2) { b2 = v2; i2 = 2; }
            if (i1 != 3 && v3 > b2) { b2 = v3; i2 = 3; }
            const float ex2 = expf(b2 - b1);
            const float w1 = gwt / (1.f + ex2), w2 = gwt * ex2 / (1.f + ex2);
            const int ea = gsel * 4 + i1, eb = gsel * 4 + i2;
            const int pa = atomicAdd(&cnt[ea], 1); list[ea * T + pa] = t * 2; wl[ea * T + pa] = w1;
            const int pb = atomicAdd(&cnt[eb], 1); list[eb * T + pb] = t * 2 + 1; wl[eb * T + pb] = w2;
        }
    }
}
struct MoeTab {
    const FK_LAS int* t;
    __device__ __forceinline__ int total_tiles() const { return __builtin_amdgcn_readfirstlane(t[16]); }
    __device__ __forceinline__ void decode(int mtile, int& e, int& mt, int& ce) const {
        int ee = 0;
#pragma unroll
        for (int j = 1; j < 16; ++j) ee += (mtile >= __builtin_amdgcn_readfirstlane(t[j])) ? 1 : 0;
        e = ee; mt = mtile - __builtin_amdgcn_readfirstlane(t[ee]); ce = __builtin_amdgcn_readfirstlane(t[17 + ee]);
    }
};
__device__ __forceinline__ void moe_tab_init(FK_LAS int* t, const int* cnt, int tid) {
    if (tid == 0) { int acc = 0; t[0] = 0;
        for (int j = 0; j < 16; ++j) { const int c = __hip_atomic_load(cnt + j, __ATOMIC_RELAXED, __HIP_MEMORY_SCOPE_AGENT); t[17 + j] = c; acc += (c + 255) >> 8; t[j + 1] = acc; } }
    __syncthreads();
}
struct SchedMoe1 {
    MoeTab tab; int G, c; const FK_LAS unsigned* xo;
    __device__ __forceinline__ bool next(int i, Unit& u) const {
        const int L = i * G + c; const int nun = tab.total_tiles() * 4;
        int e, mt, ce; tab.decode(L >> 2, e, mt, ce);
        u.a_off = 0; u.b_off = (unsigned)(WS_WGU + ((size_t)e * 1024 + (L & 3) * 256) * 1024 * 2); u.pm = L >> 2; u.pn = L & 3; u.kind = e; u.aux = i;
        return L < nun;
    }
    __device__ __forceinline__ unsigned row_off(const Unit& u, int r) const { return xo[u.aux * 256 + r]; }
};
struct EpiMoe1 {
    static constexpr bool PERM = false, AFTER_DRAIN = false;
    bf16_t* ACT; const FK_LAS float* xf;
    __device__ __forceinline__ void operator()(f32x4 (&acc)[2][2][4][2], const Unit& u, int wr, int wc, int fr, int fq, FK_LAS unsigned char*, int, int) const {
#pragma unroll
        for (int ai = 0; ai < 2; ++ai)
#pragma unroll
            for (int m = 0; m < 4; ++m) {
                const int r = ai * 128 + wr * 64 + m * 16 + fr;
                const float f1 = xf[u.aux * 512 + r], f2 = xf[u.aux * 512 + 256 + r];
                bf16_t* rowp = ACT + ((size_t)u.pm * 256 + r) * 512 + u.pn * 128 + wc * 32 + 4 * fq;
#pragma unroll
                for (int n = 0; n < 2; ++n) {
                    const f32x4 g = acc[ai][0][m][n] * f1, up = acc[ai][1][m][n] * f2; f32x4 a;
#pragma unroll
                    for (int i = 0; i < 4; ++i) a[i] = g[i] / (1.f + __expf(-g[i])) * up[i];
                    u32x2 w; w.x = pg8::cvt_pk_bf16(a[0], a[1]); w.y = pg8::cvt_pk_bf16(a[2], a[3]);
                    *(u32x2*)(rowp + 16 * n) = w;
                }
            }
    }
};
struct SchedMoe2 {
    MoeTab tab; int G, c;
    __device__ __forceinline__ bool next(int i, Unit& u) const {
        const int L = i * G + c; const int nun = tab.total_tiles() * 4;
        int e, mt, ce; tab.decode(L >> 2, e, mt, ce);
        u.a_off = (unsigned)(WS_ACT + (size_t)(L >> 2) * 256 * 512 * 2); u.b_off = (unsigned)(WS_WD + ((size_t)e * 1024 + (L & 3) * 256) * 512 * 2); u.pm = L >> 2; u.pn = L & 3; u.kind = e; u.aux = i;
        return L < nun;
    }
    __device__ __forceinline__ unsigned row_off(const Unit& u, int r) const { return u.a_off + (unsigned)r * 1024u; }
};
struct EpiMoe2 {
    static constexpr bool PERM = false, AFTER_DRAIN = false;
    bf16_t* YM; const FK_LAS int* xe;
    __device__ __forceinline__ void operator()(f32x4 (&acc)[2][2][4][2], const Unit& u, int wr, int wc, int fr, int fq, FK_LAS unsigned char*, int, int) const {
#pragma unroll
        for (int ai = 0; ai < 2; ++ai)
#pragma unroll
            for (int m = 0; m < 4; ++m) {
                const int r = ai * 128 + wr * 64 + m * 16 + fr;
                const int ent = xe[u.aux * 256 + r];
                if (ent >= 0) {
                    bf16_t* rowp = YM + (size_t)ent * 1024 + u.pn * 256 + wc * 32 + 4 * fq;
#pragma unroll
                    for (int bj = 0; bj < 2; ++bj)
#pragma unroll
                        for (int n = 0; n < 2; ++n) { const f32x4 x = acc[ai][bj][m][n]; u32x2 w; w.x = pg8::cvt_pk_bf16(x[0], x[1]); w.y = pg8::cvt_pk_bf16(x[2], x[3]);
                            *(u32x2*)(rowp + 128 * bj + 16 * n) = w; }
                }
            }
    }
};
__device__ __forceinline__ void final_phase(const Params& p, int vcu, int G, int lane, int wave) {
    const bf16_t* X2 = (const bf16_t*)(p.ws + WS_X1B); const bf16_t* YM = (const bf16_t*)p.out; const float* fg = p.in[33];
    const int gwv = vcu * NWAVES + wave, NGW = G * NWAVES;
    for (int t = gwv; t < T; t += NGW) {
        float v[16]; float ss = 0.f;
#pragma unroll
        for (int j = 0; j < 2; ++j) {
            const int k0 = j * 512 + lane * 8;
            const u32x4 a = *(const u32x4*)(X2 + (size_t)t * 1024 + k0), b = *(const u32x4*)(YM + (size_t)t * 2048 + k0), c = *(const u32x4*)(YM + (size_t)t * 2048 + 1024 + k0);
#pragma unroll
            for (int e = 0; e < 4; ++e) { v[j * 8 + 2 * e] = bflo(a[e]) + bflo(b[e]) + bflo(c[e]); v[j * 8 + 2 * e + 1] = bfhi(a[e]) + bfhi(b[e]) + bfhi(c[e]); }
        }
#pragma unroll
        for (int i = 0; i < 16; ++i) ss += v[i] * v[i];
        ss = wsum(ss);
        const float r = rsqrtf(ss * (1.f / 1024.f) + EPS);
        float* orow = p.out + (size_t)t * 1024;
#pragma unroll
        for (int j = 0; j < 2; ++j) {
            const int k0 = j * 512 + lane * 8;
            const f32x4 g0 = *(const f32x4*)(fg + k0), g1 = *(const f32x4*)(fg + k0 + 4);
            f32x4 o0, o1;
#pragma unroll
            for (int e = 0; e < 4; ++e) { o0[e] = v[j * 8 + e] * r * g0[e]; o1[e] = v[j * 8 + 4 + e] * r * g1[e]; }
            *(f32x4*)(orow + k0) = o0; *(f32x4*)(orow + k0 + 4) = o1;
        }
    }
}
__global__ void __launch_bounds__(NTHREADS, 2) mk(Params p) {
    extern __shared__ __attribute__((aligned(16))) unsigned char lds_raw[];
    FK_LAS unsigned char* lds = (FK_LAS unsigned char*)lds_raw;
    const int tid = threadIdx.x, lane = tid & 63, wave = __builtin_amdgcn_readfirstlane(tid >> 6);
    const int G = gridDim.x, bx = blockIdx.x;
    const int vcu = (G % 8 == 0) ? (bx % 8) * (G / 8) + bx / 8 : bx;
    unsigned char* ws = p.ws;
    volatile FK_LAS unsigned* bst = (volatile FK_LAS unsigned*)(lds + LDS_BYTES - 64);
    if (tid < 2) bst[tid] = 0u;
    __syncthreads();
    XcdBarrier bar = xcd_barrier_post((unsigned*)(ws + WS_CTL) + CW_BAR, bst);
#define IN(k) (p.ph_lo <= (k) && (k) < p.ph_hi)
#define SEAM(k) do { if (IN(k) && IN((k) + 1)) xcd_barrier(bar); } while (0)
    if (IN(0)) { p0_prologue(p, lds, vcu, G, tid, lane, wave); }
    SEAM(0);
    if (IN(1)) {
        Gemm g{(const char*)ws, 1024, 1024, 1024};
        SchedP1 S{G, bx};
        EpiP1 E{ws, p.in[4], p.in[5]};
        f32x4 acc[2][2][4][2];
        pg8::gemm_phase<EpiP1, SchedP1, true, true, false>(lds, g, S, E, acc);
    }
    SEAM(1);
    if (IN(2)) {
        attn_body::attn_phase<8>((char*)lds_raw, (const attn_body::bf16*)(ws + WS_Q), (const attn_body::bf16*)(ws + WS_K), (const attn_body::bf16*)(ws + WS_V),
                                 (attn_body::bf16*)(ws + WS_YCAT), (float*)(ws + WS_SSATT), G, vcu);
    }
    SEAM(2);
    if (IN(3)) {
        for (int L = bx; L < 64; L += G) {
            const int g = L >> 1, mt = L & 1;
            Gemm gm{(const char*)ws, SUP, 512, 512};
            SchedOne S{mk_unit((unsigned)(WS_SU + (((size_t)g * SROWS + mt * 256) * SUP + 256) * 2), (unsigned)(WS_W1 + (size_t)g * 256 * 512 * 2), mt, 0, 0), SUP * 2};
            EpiSloc E{(float*)(ws + WS_SLOC) + (size_t)g * SROWS * 256};
            f32x4 acc[2][2][4][2];
            pg8::gemm_phase<EpiSloc, SchedOne, false, true, false>(lds, gm, S, E, acc);
        }
    }
    SEAM(3);
    if (IN(4)) {
        for (int L = bx; L < 128; L += G) {
            const int g = L >> 2, mt = (L >> 1) & 1, ntile = L & 1;
            s5_scan(p, g, mt, tid);
            __threadfence(); __syncthreads();
            Gemm gm{(const char*)ws, SUP, SUP, SUP};
            SchedOne S{mk_unit((unsigned)(WS_SU + ((size_t)g * SROWS + mt * 256) * SUP * 2), (unsigned)(WS_W2 + ((size_t)g * 512 + ntile * 256) * SUP * 2), mt, ntile, 0), SUP * 2};
            EpiS5Out E{(bf16_t*)(ws + WS_Z), g, mt, ntile};
            f32x4 acc[2][2][4][2];
            pg8::gemm_phase<EpiS5Out, SchedOne, false, true, false>(lds, gm, S, E, acc);
        }
    }
    SEAM(4);
    if (IN(5)) {
        for (int L = bx; L < 128; L += G) {
            int pm, pn; pg8::tile_order(L, 64, 2, pm, pn);
            Gemm gm{(const char*)ws, 512, 512, 512};
            SchedOne S{mk_unit((unsigned)(WS_Z + (size_t)pm * 256 * 512 * 2), (unsigned)(WS_GLU + (size_t)pn * 256 * 512 * 2), pm, pn, 0), 512 * 2};
            EpiGlu E{(const bf16_t*)(ws + WS_Z), (bf16_t*)(ws + WS_YCAT), (float*)(ws + WS_SSSSM), p.in[15]};
            f32x4 acc[2][2][4][2];
            pg8::gemm_phase<EpiGlu, SchedOne, false, true, false>(lds, gm, S, E, acc);
        }
    }
    SEAM(5);
    if (IN(6)) {
        for (int L = bx; L < 256; L += G) {
            int pm, pn; pg8::tile_order(L, 64, 4, pm, pn);
            Gemm gm{(const char*)ws, 1024, 1024, 512};
            const unsigned a0 = (unsigned)(WS_YCAT + (size_t)pm * 256 * 1024 * 2), b0 = (unsigned)(WS_WOUT + (size_t)pn * 256 * 1024 * 2);
            f32x4 acc[2][2][4][2];
            FK_LAS float* xt = (FK_LAS float*)(lds + XTRA_OFF);
            { int t2 = threadIdx.x; asm volatile("" : "+v"(t2));
              if (t2 < 256) { const size_t row = (size_t)pm * 256 + t2; const float ra = rs8((const float*)(ws + WS_SSATT), row, 1.f / 512.f), rs = rs8((const float*)(ws + WS_SSSSM), row, 1.f / 512.f); xt[t2] = ra / rs; xt[256 + t2] = rs; }
              __syncthreads(); }
            { SchedOne S{mk_unit(a0, b0, pm, pn, 0), 2048}; EpiWoutMid E{xt};
              pg8::gemm_phase<EpiWoutMid, SchedOne, false, true, false>(lds, gm, S, E, acc); }
            { SchedOne S{mk_unit(a0 + 1024, b0 + 1024, pm, pn, 0), 2048}; EpiWoutFin E{xt, (const bf16_t*)(ws + WS_XB), (bf16_t*)(ws + WS_X1B), (float*)(ws + WS_SSX1)};
              pg8::gemm_phase<EpiWoutFin, SchedOne, false, true, true>(lds, gm, S, E, acc); }
        }
    }
    SEAM(6);
    if (IN(7)) {
        for (int L = bx; L < 256; L += G) {
            int pm, pn; pg8::tile_order(L, 64, 4, pm, pn);
            const int b = pm >> 3;
            FK_LAS float* xt = (FK_LAS float*)(lds + XTRA_OFF);
            { int t2 = threadIdx.x; asm volatile("" : "+v"(t2));
              if (t2 < 256) { const float* s1 = (const float*)(ws + WS_SSX1) + ((size_t)pm * 256 + t2) * 16; const f32x4 a = *(const f32x4*)s1, b4 = *(const f32x4*)(s1 + 4), c = *(const f32x4*)(s1 + 8), d = *(const f32x4*)(s1 + 12);
                  xt[t2] = rsqrtf((((a[0] + a[1]) + (a[2] + a[3])) + ((b4[0] + b4[1]) + (b4[2] + b4[3])) + ((c[0] + c[1]) + (c[2] + c[3])) + ((d[0] + d[1]) + (d[2] + d[3]))) * (1.f / 1024.f) + EPS); }
              __syncthreads(); }
            const size_t tile = ((size_t)pm * 256 * 1024 + pn * 256) * 2;
            f32x4 acc[2][2][4][2];
            { Gemm gm{(const char*)ws, 1024, 1024, 1024};
              SchedOne S{mk_unit((unsigned)(WS_X1B + (size_t)pm * 256 * 1024 * 2), (unsigned)(WS_WQ + (size_t)pn * 256 * 1024 * 2), pm, pn, 0), 2048};
              EpiScaleBf16 E{(bf16_t*)(ws + WS_QX + tile), 1024, xt, XQSCALE};
              pg8::gemm_phase<EpiScaleBf16, SchedOne, false, true, false>(lds, gm, S, E, acc); }
            __threadfence(); __syncthreads();
            { Gemm gm{(const char*)ws, 1024, 1024, 256};
              SchedOne S{mk_unit((unsigned)(WS_QX + tile), (unsigned)(WS_KM + ((size_t)b * 256 * 1024 + pn * 256) * 2), pm, pn, 0), 2048};
              EpiSoftmax E{(bf16_t*)(ws + WS_PB + tile), 1024};
              pg8::gemm_phase<EpiSoftmax, SchedOne, false, true, false>(lds, gm, S, E, acc); }
            __threadfence(); __syncthreads();
            { Gemm gm{(const char*)ws, 1024, 256, 256};
              SchedOne S{mk_unit((unsigned)(WS_PB + tile), (unsigned)(WS_VT + ((size_t)b * 1024 + pn * 256) * 256 * 2), pm, pn, 0), 2048};
              EpiScaleBf16 E{(bf16_t*)(ws + WS_QX + tile), 1024, nullptr, 1.f};
              pg8::gemm_phase<EpiScaleBf16, SchedOne, false, true, false>(lds, gm, S, E, acc); }
        }
    }
    SEAM(7);
    if (IN(8)) {
        for (int L = bx; L < 256; L += G) {
            int pm, pn; pg8::tile_order(L, 64, 4, pm, pn);
            const size_t tile = ((size_t)pm * 256 * 1024 + pn * 256) * 2;
            Gemm gm{(const char*)ws, 1024, 1024, 1024};
            SchedOne S{mk_unit((unsigned)(WS_QX + (size_t)pm * 256 * 1024 * 2), (unsigned)(WS_WO + (size_t)pn * 256 * 1024 * 2), pm, pn, 0), 2048};
            EpiResid E{(bf16_t*)(ws + WS_X1B + tile), 1024};
            f32x4 acc[2][2][4][2];
            pg8::gemm_phase<EpiResid, SchedOne, false, true, false>(lds, gm, S, E, acc);
        }
    }
    SEAM(8);
    if (IN(9)) { router_phase(p, lds, vcu, G, tid, lane, wave); }
    SEAM(9);
    if (IN(10)) {
        FK_LAS int* tabp = (FK_LAS int*)(lds + XTRA_OFF + 15 * 1024); moe_tab_init(tabp, (const int*)(ws + WS_CTL) + CW_CNT, threadIdx.x); MoeTab tab{tabp};
        FK_LAS unsigned* xo = (FK_LAS unsigned*)(lds + XTRA_OFF);
        FK_LAS float* xf = (FK_LAS float*)(lds + XTRA_OFF + 5 * 1024);
        { int t2 = threadIdx.x; asm volatile("" : "+v"(t2));
          const int nun = tab.total_tiles() * 4; int i = 0;
          for (int L = bx; L < nun && i < 5; L += G, ++i) {
              if (t2 < 256) { int e, mt, ce; tab.decode(L >> 2, e, mt, ce); const int idx = mt * 256 + t2; const bool valid = idx < ce;
                  const int ent = valid ? ((const int*)(ws + WS_LIST))[e * T + idx] : 0; const int tok = ent >> 1;
                  xo[i * 256 + t2] = (unsigned)(WS_X1B + (size_t)tok * 2048);
                  const float r2 = ((const float*)(ws + WS_R2))[tok];
                  xf[i * 512 + t2] = r2; xf[i * 512 + 256 + t2] = valid ? r2 * ((const float*)(ws + WS_WL))[e * T + idx] : 0.f; }
          }
          __syncthreads(); }
        Gemm gm{(const char*)ws, 1024, 1024, 1024};
        SchedMoe1 S{tab, G, bx, xo};
        EpiMoe1 E{(bf16_t*)(ws + WS_ACT), xf};
        f32x4 acc[2][2][4][2];
        pg8::gemm_phase<EpiMoe1, SchedMoe1, true, true, false>(lds, gm, S, E, acc);
    }
    SEAM(10);
    if (IN(11)) {
        FK_LAS int* tabp = (FK_LAS int*)(lds + XTRA_OFF + 15 * 1024); moe_tab_init(tabp, (const int*)(ws + WS_CTL) + CW_CNT, threadIdx.x); MoeTab tab{tabp};
        FK_LAS int* xe = (FK_LAS int*)(lds + XTRA_OFF);
        { int t2 = threadIdx.x; asm volatile("" : "+v"(t2));
          const int nun = tab.total_tiles() * 4; int i = 0;
          for (int L = bx; L < nun && i < 5; L += G, ++i) {
              if (t2 < 256) { int e, mt, ce; tab.decode(L >> 2, e, mt, ce); const int idx = mt * 256 + t2;
                  xe[i * 256 + t2] = idx < ce ? ((const int*)(ws + WS_LIST))[e * T + idx] : -1; }
          }
          __syncthreads(); }
        Gemm gm{(const char*)ws, 512, 512, 512};
        SchedMoe2 S{tab, G, bx};
        EpiMoe2 E{(bf16_t*)p.out, xe};
        f32x4 acc[2][2][4][2];
        pg8::gemm_phase<EpiMoe2, SchedMoe2, true, true, false>(lds, gm, S, E, acc);
    }
    SEAM(11);
    if (IN(12)) { final_phase(p, vcu, G, lane, wave); }
#undef SEAM
#undef IN
}

}
extern "C" void kernel_launch(void* const* d_in, const int* in_sizes, int n_in, void* d_out, int out_size, void* d_ws, size_t ws_size, hipStream_t stream) {
    static int grid = 0;
    if (grid == 0) {
        int dev = 0, cus = 0, per_cu = 0;
        (void)hipGetDevice(&dev);
        (void)hipDeviceGetAttribute(&cus, hipDeviceAttributeMultiprocessorCount, dev);
        (void)hipFuncSetAttribute((const void*)fk::mk, hipFuncAttributeMaxDynamicSharedMemorySize, fk::LDS_BYTES);
        (void)hipOccupancyMaxActiveBlocksPerMultiprocessor(&per_cu, (const void*)fk::mk, fk::NTHREADS, fk::LDS_BYTES);
        if (per_cu < 1 || cus < 1 || ws_size < fk::WS_END) { fprintf(stderr, "kernel_launch: cus %d per_cu %d ws %zu: cannot launch\n", cus, per_cu, ws_size); grid = -1; }
        else grid = cus;
    }
    if (grid < 0) return;
    (void)hipMemsetAsync(d_ws, 0, 1u << 20, stream);
    fk::Params p{};
    for (int i = 0; i < 34; ++i) p.in[i] = (const float*)d_in[i];
    p.out = (float*)d_out; p.ws = (unsigned char*)d_ws; p.ph_lo = 0; p.ph_hi = 13;
    void* args[] = {&p};
    hipError_t e = hipLaunchCooperativeKernel((const void*)fk::mk, dim3(grid), dim3(fk::NTHREADS), args, fk::LDS_BYTES, stream);
    if (e != hipSuccess) fprintf(stderr, "cooperative launch failed: %s (grid %d)\n", hipGetErrorString(e), grid);
}
```

```cpp
#include <hip/hip_runtime.h>
#include <hip/hip_bf16.h>
#include <cmath>
#include <stdint.h>
#include <stdio.h>
#include <hip/hip_cooperative_groups.h>
namespace fk {
namespace cg = cooperative_groups;
#define FK_LAS __attribute__((address_space(3)))
#define FK_GAS __attribute__((address_space(1)))
typedef unsigned short bf16_t;
typedef short bf16x8 __attribute__((ext_vector_type(8)));
typedef float f32x4 __attribute__((ext_vector_type(4)));
typedef float f32x2 __attribute__((ext_vector_type(2)));
typedef unsigned u32x4 __attribute__((ext_vector_type(4)));
typedef unsigned u32x2 __attribute__((ext_vector_type(2)));

constexpr int T = 16384, SEQ = 2048, BATCH = 8, DM = 1024, MEMLEN = 256, MTOK = BATCH * MEMLEN;
constexpr float EPS = 1e-6f;
constexpr float LOG2E = 1.4426950408889634f;
constexpr float QSCALE = 0.125f * LOG2E;
constexpr float XQSCALE = 0.0625f * LOG2E;
constexpr int NWAVES = 8, NTHREADS = 512;
constexpr int SL = 32, NCH = SEQ / SL;
constexpr int SUP = 768;
constexpr int SROWS = BATCH * NCH;

constexpr size_t MiB = 1u << 20;
constexpr size_t WS_CTL = 0;
constexpr size_t WS_WIN = 1 * MiB;
constexpr size_t WS_GLU = 4 * MiB;
constexpr size_t WS_WOUT = 5 * MiB;
constexpr size_t WS_WQ = 7 * MiB, WS_WK = 9 * MiB, WS_WV = 11 * MiB, WS_WO = 13 * MiB;
constexpr size_t WS_W1 = 15 * MiB;
constexpr size_t WS_W2 = 23 * MiB;
constexpr size_t WS_WGU = 47 * MiB;
constexpr size_t WS_WD = 79 * MiB;
constexpr size_t WS_R0 = 95 * MiB;
constexpr size_t WS_ROPE = WS_R0 + 65536;
constexpr size_t WS_R2 = WS_ROPE + 65536;
constexpr size_t WS_SSATT = 95 * MiB + 512 * 1024;
constexpr size_t WS_SSSSM = 96 * MiB;
constexpr size_t WS_SSX1 = 96 * MiB + 512 * 1024;
constexpr size_t WS_LIST = 102 * MiB;
constexpr size_t WS_WL = 103 * MiB;
constexpr size_t WS_XB = 105 * MiB;
constexpr size_t WS_HM = 137 * MiB;
constexpr size_t WS_Q = 141 * MiB;
constexpr size_t WS_K = 157 * MiB;
constexpr size_t WS_V = 161 * MiB;
constexpr size_t WS_SU = 165 * MiB;
constexpr size_t WS_SLOC = 189 * MiB;
constexpr size_t WS_KM = 205 * MiB;
constexpr size_t WS_VT = 209 * MiB;
constexpr size_t WS_YCAT = 213 * MiB;
constexpr size_t WS_END = 245 * MiB;
constexpr size_t WS_Z = WS_Q, WS_X1B = WS_SU, WS_QX = WS_XB, WS_PB = WS_YCAT, WS_ACT = WS_XB;
constexpr int CW_CNT = 64;
constexpr int CW_BAR = 4096;

constexpr int RING_BYTES = 131072, XTRA_OFF = RING_BYTES, LDS_BYTES = 147456;

__device__ __forceinline__ unsigned f2bf(float f) { unsigned u = __builtin_bit_cast(unsigned, f); return (u + 0x7fffu + ((u >> 16) & 1u)) >> 16; }
__device__ __forceinline__ unsigned pk2(float lo, float hi) { return f2bf(lo) | (f2bf(hi) << 16); }
__device__ __forceinline__ float bf2f(unsigned short b) { return __builtin_bit_cast(float, (unsigned)b << 16); }
__device__ __forceinline__ float bflo(unsigned w) { return __builtin_bit_cast(float, w << 16); }
__device__ __forceinline__ float bfhi(unsigned w) { return __builtin_bit_cast(float, w & 0xffff0000u); }
__device__ __forceinline__ float wsum(float v) {
#pragma unroll
    for (int o = 1; o < 64; o <<= 1) v += __shfl_xor(v, o);
    return v;
}

namespace pg8 {
constexpr int BM = 256, BK = 64, HALF = 128, HTB = HALF * BK * 2, STAGE_BYTES = 8 * HTB, NXCD = 8, WGM = 8;
__host__ __device__ __forceinline__ int lds_byte(int r, int c) { const int st = (r >> 4) * 2 + (c >> 5), rr = r & 15, cc = c & 31, ob = rr * 64 + cc * 2; return st * 1024 + (ob ^ (((ob >> 9) & 1) << 5)); }
__host__ __device__ __forceinline__ void stage_rc(int b, int& R, int& C) { const int st = b / 1024, sb = b % 1024, swz = sb ^ (((sb >> 9) & 1) << 5); R = (st >> 1) * 16 + swz / 64; C = (st & 1) * 32 + (swz % 64) / 2; }
__host__ __device__ __forceinline__ int perm32(int rho) { const int n = rho >> 4, i = rho & 15; return 8 * (i >> 2) + 4 * n + (i & 3); }

struct Unit { unsigned a_off, b_off; int pm, pn, kind, aux; };
struct Gemm { const char* base; int lda, ldb, K; };

__device__ __forceinline__ void tile_order(int L, int nM, int nN, int& pm, int& pn) {
    const int nwg = nM * nN; int wgid = L;
    { const int q = nwg / NXCD, r = nwg % NXCD, xcd = wgid % NXCD, off = wgid / NXCD; wgid = (xcd < r ? xcd * (q + 1) : r * (q + 1) + (xcd - r) * q) + off; }
    const int nig = WGM * nN, gid = wgid / nig, fm = gid * WGM, gsz = (nM - fm) < WGM ? (nM - fm) : WGM;
    pm = fm + ((wgid % nig) % gsz); pn = (wgid % nig) / gsz;
}

__device__ __forceinline__ unsigned cvt_pk_bf16(float lo, float hi) { unsigned r; asm volatile("v_cvt_pk_bf16_f32 %0, %1, %2" : "=v"(r) : "v"(lo), "v"(hi)); return r; }

template <class Epi, class Sched, bool ALIGN_EPI, bool SP2, bool KEEP_ACC>
__device__ __forceinline__ void gemm_phase(FK_LAS unsigned char* lds, const Gemm g, const Sched& S, const Epi& E, f32x4 (&acc)[2][2][4][2]) {
    int tid_ = threadIdx.x; asm volatile("" : "+v"(tid_));
    const int tid = tid_, wid = __builtin_amdgcn_readfirstlane(tid >> 6), lane = tid & 63, wr = wid >> 2, wc = wid & 3, fr = lane & 15, fq = lane >> 4;
    const int K = g.K, nt = K / BK;
    int R0, C0; stage_rc(tid * 16, R0, C0);
    unsigned voffB[2];
#pragma unroll
    for (int i = 0; i < 2; ++i) { const int R = R0 + 64 * i; const int Rb = Epi::PERM ? ((R & ~31) + perm32(R & 31)) : R; voffB[i] = (unsigned)(Rb * g.ldb + C0) * 2u; }
    const size_t kstep = (size_t)(BK * 2);
    const size_t hstepB = (size_t)HALF * g.ldb * 2;
    const unsigned ldsw = (unsigned)wid * 1024u;
    const int aoff = lds_byte(wr * 64 + fr, fq * 8), boff = lds_byte(wc * 32 + fr, fq * 8);
#define PG8_SA(b, h) (((b) * 2 + (h)) * HTB)
#define PG8_SB(b, h) ((4 + (b) * 2 + (h)) * HTB)
#define PG8_STAGE(bufoff, gbase, voff) do { _Pragma("unroll") for (int _i = 0; _i < 2; ++_i) \
        __builtin_amdgcn_global_load_lds((const unsigned*)((const char*)(gbase) + (voff)[_i]), (FK_LAS unsigned*)(lds + (bufoff) + ldsw + _i * 8192), 16, 0, 0); } while (0)
#define PG8_STAGEA(bufoff, gbase, h) do { _Pragma("unroll") for (int _i = 0; _i < 2; ++_i) \
        __builtin_amdgcn_global_load_lds((const unsigned*)((const char*)(gbase) + voffA[2 * (h) + _i]), (FK_LAS unsigned*)(lds + (bufoff) + ldsw + _i * 8192), 16, 0, 0); } while (0)
#define PG8_LDA(dst, b, h) do { _Pragma("unroll") for (int m = 0; m < 4; ++m) _Pragma("unroll") for (int k = 0; k < 2; ++k) dst[m][k] = *(const FK_LAS bf16x8*)(lds + PG8_SA(b, h) + aoff + m * 2048 + k * 1024); } while (0)
#define PG8_LDB(dst, b, h) do { _Pragma("unroll") for (int n = 0; n < 2; ++n) _Pragma("unroll") for (int k = 0; k < 2; ++k) dst[n][k] = *(const FK_LAS bf16x8*)(lds + PG8_SB(b, h) + boff + n * 2048 + k * 1024); } while (0)
#define PG8_MMA(ai, bj, At, Bt) do { __builtin_amdgcn_s_setprio(1); _Pragma("unroll") for (int m = 0; m < 4; ++m) _Pragma("unroll") for (int n = 0; n < 2; ++n) _Pragma("unroll") for (int k = 0; k < 2; ++k) \
        acc[ai][bj][m][n] = __builtin_amdgcn_mfma_f32_16x16x32_bf16(Bt[n][k], At[m][k], acc[ai][bj][m][n], 0, 0, 0); __builtin_amdgcn_s_setprio(0); } while (0)
#define PG8_WAIT_V(n) asm volatile("s_waitcnt vmcnt(" #n ")" ::: "memory")
#define PG8_WAIT_L(n) asm volatile("s_waitcnt lgkmcnt(" #n ")" ::: "memory")
#define PG8_BAR __builtin_amdgcn_s_barrier()
#define PG8_SCHED __builtin_amdgcn_sched_barrier(0)
    Unit cur, nxt; int ui = 0;
    if (!S.next(0, cur)) return;
    if constexpr (!KEEP_ACC) {
#pragma unroll
        for (int a = 0; a < 2; ++a)
#pragma unroll
            for (int b = 0; b < 2; ++b)
#pragma unroll
                for (int m = 0; m < 4; ++m)
#pragma unroll
                    for (int n = 0; n < 2; ++n) acc[a][b][m][n] = (f32x4){0.f, 0.f, 0.f, 0.f};
    }
    bf16x8 At[4][2], B0[2][2], B1[2][2];
    unsigned voffA[4];
#pragma unroll
    for (int q = 0; q < 4; ++q) voffA[q] = S.row_off(cur, R0 + 64 * q) + (unsigned)C0 * 2u;
    const char* Ab = g.base;
    const char* cB = g.base + cur.b_off;
    if constexpr (SP2) {
        PG8_STAGE(PG8_SB(0, 0), cB, voffB); PG8_STAGE(PG8_SB(0, 1), cB + hstepB, voffB); PG8_STAGEA(PG8_SA(0, 0), Ab, 0); PG8_STAGEA(PG8_SA(0, 1), Ab, 1);
        if (wr == 1) PG8_BAR;
        PG8_WAIT_V(2); PG8_BAR;
        PG8_STAGE(PG8_SB(1, 0), cB + kstep, voffB); PG8_STAGEA(PG8_SA(1, 0), Ab + kstep, 0); PG8_STAGE(PG8_SB(1, 1), cB + hstepB + kstep, voffB);
        PG8_WAIT_V(6); PG8_BAR;
    } else {
        PG8_STAGE(PG8_SB(0, 0), cB, voffB); PG8_STAGEA(PG8_SA(0, 0), Ab, 0); PG8_STAGE(PG8_SB(0, 1), cB + hstepB, voffB); PG8_STAGEA(PG8_SA(0, 1), Ab, 1);
        if (wr == 1) PG8_BAR;
        PG8_WAIT_V(4); PG8_BAR;
        PG8_STAGE(PG8_SB(1, 0), cB + kstep, voffB); PG8_STAGEA(PG8_SA(1, 0), Ab + kstep, 0); PG8_STAGE(PG8_SB(1, 1), cB + hstepB + kstep, voffB);
        PG8_WAIT_V(6); PG8_BAR;
    }
    for (;;) {
        const bool has_next = S.next(ui + 1, nxt);
        const char* nB = has_next ? g.base + nxt.b_off : cB;
        for (int t = 0; t < nt; t += 2) {
            const bool last = (t == nt - 2);
            const char* a1 = Ab + (size_t)(t + 1) * kstep;
            const char* a2 = last ? Ab : Ab + (size_t)(t + 2) * kstep; const char* b2 = last ? nB : cB + (size_t)(t + 2) * kstep;
            const char* a3 = a2 + kstep; const char* b3 = b2 + kstep;
            if constexpr (SP2) {
            PG8_LDB(B0, 0, 0); PG8_LDB(B1, 0, 1); PG8_SCHED; PG8_LDA(At, 0, 0); PG8_STAGEA(PG8_SA(1, 1), a1, 1);
            if (last && has_next) {
#pragma unroll
                for (int q = 0; q < 4; ++q) voffA[q] = S.row_off(nxt, R0 + 64 * q) + (unsigned)C0 * 2u;
            }
            PG8_WAIT_V(8); PG8_WAIT_L(0); PG8_BAR; PG8_MMA(0, 0, At, B0); PG8_MMA(0, 1, At, B1); PG8_BAR; PG8_SCHED;
            PG8_LDA(At, 0, 1); PG8_STAGE(PG8_SB(0, 0), b2, voffB); PG8_STAGE(PG8_SB(0, 1), b2 + hstepB, voffB); PG8_STAGEA(PG8_SA(0, 0), a2, 0);
            PG8_WAIT_V(8); PG8_WAIT_L(0); PG8_BAR; PG8_MMA(1, 0, At, B0); PG8_MMA(1, 1, At, B1); PG8_BAR; PG8_SCHED;
            PG8_LDB(B0, 1, 0); PG8_LDB(B1, 1, 1); PG8_SCHED; PG8_LDA(At, 1, 0); PG8_STAGEA(PG8_SA(0, 1), a2, 1);
            PG8_WAIT_V(8); PG8_WAIT_L(0); PG8_BAR; PG8_MMA(0, 0, At, B0); PG8_MMA(0, 1, At, B1); PG8_BAR; PG8_SCHED;
            PG8_LDA(At, 1, 1); PG8_STAGE(PG8_SB(1, 0), b3, voffB); PG8_STAGE(PG8_SB(1, 1), b3 + hstepB, voffB); PG8_STAGEA(PG8_SA(1, 0), a3, 0);
            PG8_WAIT_V(8); PG8_WAIT_L(0); PG8_BAR; PG8_MMA(1, 0, At, B0); PG8_MMA(1, 1, At, B1); PG8_BAR; PG8_SCHED;
            } else {
            PG8_LDB(B0, 0, 0); PG8_SCHED; PG8_LDA(At, 0, 0); PG8_STAGEA(PG8_SA(1, 1), a1, 1);
            if (last && has_next) {
#pragma unroll
                for (int q = 0; q < 4; ++q) voffA[q] = S.row_off(nxt, R0 + 64 * q) + (unsigned)C0 * 2u;
            }
            PG8_WAIT_L(8); PG8_BAR; PG8_WAIT_L(0); PG8_MMA(0, 0, At, B0); PG8_BAR; PG8_SCHED;
            PG8_LDB(B1, 0, 1); PG8_STAGE(PG8_SB(0, 0), b2, voffB);
            PG8_BAR; PG8_WAIT_L(0); PG8_MMA(0, 1, At, B1); PG8_BAR;
            PG8_LDA(At, 0, 1); PG8_STAGEA(PG8_SA(0, 0), a2, 0);
            PG8_BAR; PG8_WAIT_L(0); PG8_MMA(1, 0, At, B0); PG8_BAR; PG8_SCHED;
            PG8_STAGE(PG8_SB(0, 1), b2 + hstepB, voffB);
            PG8_WAIT_V(6); PG8_BAR; PG8_MMA(1, 1, At, B1); PG8_BAR;
            PG8_LDB(B0, 1, 0); PG8_SCHED; PG8_LDA(At, 1, 0); PG8_STAGEA(PG8_SA(0, 1), a2, 1);
            PG8_WAIT_L(8); PG8_BAR; PG8_WAIT_L(0); PG8_MMA(0, 0, At, B0); PG8_BAR; PG8_SCHED;
            PG8_LDB(B1, 1, 1); PG8_STAGE(PG8_SB(1, 0), b3, voffB);
            PG8_BAR; PG8_WAIT_L(0); PG8_MMA(0, 1, At, B1); PG8_BAR;
            PG8_LDA(At, 1, 1); PG8_STAGEA(PG8_SA(1, 0), a3, 0);
            PG8_BAR; PG8_WAIT_L(0); PG8_MMA(1, 0, At, B0); PG8_BAR; PG8_SCHED;
            PG8_STAGE(PG8_SB(1, 1), b3 + hstepB, voffB);
            PG8_WAIT_V(6); PG8_BAR; PG8_MMA(1, 1, At, B1); PG8_BAR;
            }
        }
        if constexpr (ALIGN_EPI) { if (wr == 0) PG8_BAR; }
        if constexpr (!Epi::AFTER_DRAIN) { int fr_e = fr, fq_e = fq, lane_e = lane; asm volatile("" : "+v"(fr_e), "+v"(fq_e), "+v"(lane_e)); E(acc, cur, wr, wc, fr_e, fq_e, lds, wid, lane_e); }
        if (!has_next) break;
#pragma unroll
        for (int a = 0; a < 2; ++a)
#pragma unroll
            for (int b = 0; b < 2; ++b)
#pragma unroll
                for (int m = 0; m < 4; ++m)
#pragma unroll
                    for (int n = 0; n < 2; ++n) acc[a][b][m][n] = (f32x4){0.f, 0.f, 0.f, 0.f};
        cur = nxt; cB = nB; ++ui;
        if constexpr (ALIGN_EPI) { if (wr == 1) PG8_BAR; }
    }
    PG8_WAIT_V(0);
    if constexpr (!ALIGN_EPI) { if (wr == 0) PG8_BAR; }
    PG8_BAR;
    if constexpr (Epi::AFTER_DRAIN) { int fr_e = fr, fq_e = fq, lane_e = lane; asm volatile("" : "+v"(fr_e), "+v"(fq_e), "+v"(lane_e)); E(acc, cur, wr, wc, fr_e, fq_e, lds, wid, lane_e); }
#undef PG8_SA
#undef PG8_SB
#undef PG8_STAGE
#undef PG8_STAGEA
#undef PG8_LDA
#undef PG8_LDB
#undef PG8_MMA
#undef PG8_WAIT_V
#undef PG8_WAIT_L
#undef PG8_BAR
#undef PG8_SCHED
}
}
namespace attn_body {
using bf16=__hip_bfloat16;
using bf16x8=__attribute__((ext_vector_type(8)))short;
using s16x4=__attribute__((ext_vector_type(4)))short;
using f32x16=__attribute__((ext_vector_type(16)))float;
using u32x4=__attribute__((ext_vector_type(4)))unsigned;
constexpr int BATCH=8,NHEAD=8,SEQ=2048,D=64,QP=512,KP=128,OP=1024;
constexpr int NW=8,QBLK=32,QB=QBLK*NW,KVBLK=64,NQB=SEQ/QB;
constexpr int ATTN_UNIT_ROWS=QB;
__device__ __forceinline__ int crow(int r,int hi){return (r&3)+8*(r>>2)+4*hi;}
#define SBAR() __builtin_amdgcn_sched_barrier(0)
__device__ __forceinline__ void cmask(f32x16&p0,f32x16&p1,int jb,int qrel,int hi){
  const float NEG=-INFINITY; int kb=64*jb+4*hi;
  #pragma unroll
  for(int r=0;r<16;++r){int kv=kb+(r&3)+8*(r>>2); if(kv>qrel)p0[r]=NEG; if(kv+32>qrel)p1[r]=NEG;}
}

constexpr int NSLOT=3, SLOTB=8192;
constexpr int LDS_K=0, LDS_V=NSLOT*SLOTB, LDS_WS=2*NSLOT*SLOTB, LDS_OST=LDS_WS+NW*64*4, LDS_BYTES=LDS_OST+NW*4096;
constexpr float C2=0.125f*1.4426950408889634f;
__device__ __forceinline__ void glds16(const void*gsrc,unsigned lds_dst){unsigned keep;
  asm volatile("s_mov_b32 %0, m0\n\ts_mov_b32 m0, %2\n\ts_nop 0\n\tglobal_load_lds_dwordx4 %1, off\n\ts_mov_b32 m0, %0":"=&s"(keep):"v"(gsrc),"s"(lds_dst):"memory");}
__device__ __forceinline__ float max3f(float a,float b,float c){float r;asm("v_max3_f32 %0, %1, %2, %3":"=v"(r):"v"(a),"v"(b),"v"(c));return r;}
__device__ __forceinline__ float max2f(float a,float b){float r;asm("v_max_f32_e32 %0, %1, %2":"=v"(r):"v"(a),"v"(b));return r;}
__device__ __forceinline__ float fadd_s(float a,float b){float r;asm("v_add_f32_e32 %0, %1, %2":"=v"(r):"v"(a),"v"(b));return r;}
__device__ __forceinline__ float fsub_s(float a,float b){float r;asm("v_sub_f32_e32 %0, %1, %2":"=v"(r):"v"(a),"v"(b));return r;}
typedef float f32x2_t __attribute__((ext_vector_type(2))); typedef __bf16 bf16x2_t __attribute__((ext_vector_type(2)));
__device__ __forceinline__ unsigned cvtpk_s(float lo,float hi){f32x2_t v={lo,hi};bf16x2_t b=__builtin_convertvector(v,bf16x2_t);return __builtin_bit_cast(unsigned,b);}
#define WAIT_BAR(N) asm volatile("s_waitcnt vmcnt(" #N ") lgkmcnt(0)\n\ts_barrier":::"memory")

__device__ __forceinline__ void qkt(f32x16&p0,f32x16&p1,const char*Kslot,const bf16x8*qr,const f32x16&negm,int r32,int hi){
  const char*kb=Kslot+hi*1024+r32*16;
  #pragma unroll
  for(int d0=0;d0<4;++d0){
    const bf16x8 b0=*reinterpret_cast<const bf16x8*>(kb+d0*2048);
    const bf16x8 b1=*reinterpret_cast<const bf16x8*>(kb+d0*2048+512);
    if(d0==0){p0=__builtin_amdgcn_mfma_f32_32x32x16_bf16(b0,qr[0],negm,0,0,0);p1=__builtin_amdgcn_mfma_f32_32x32x16_bf16(b1,qr[0],negm,0,0,0);}
    else{p0=__builtin_amdgcn_mfma_f32_32x32x16_bf16(b0,qr[d0],p0,0,0,0);p1=__builtin_amdgcn_mfma_f32_32x32x16_bf16(b1,qr[d0],p1,0,0,0);}}
}
typedef __attribute__((address_space(3))) const char* lds_cptr;
typedef short v4i16_t __attribute__((ext_vector_type(4)));
__device__ __forceinline__ void kload8(bf16x8*kf,lds_cptr kp){
  kf[0]=*(const __attribute__((address_space(3))) bf16x8*)(kp);      kf[1]=*(const __attribute__((address_space(3))) bf16x8*)(kp+512);
  kf[2]=*(const __attribute__((address_space(3))) bf16x8*)(kp+2048); kf[3]=*(const __attribute__((address_space(3))) bf16x8*)(kp+2560);
  kf[4]=*(const __attribute__((address_space(3))) bf16x8*)(kp+4096); kf[5]=*(const __attribute__((address_space(3))) bf16x8*)(kp+4608);
  kf[6]=*(const __attribute__((address_space(3))) bf16x8*)(kp+6144); kf[7]=*(const __attribute__((address_space(3))) bf16x8*)(kp+6656);
}
__device__ __forceinline__ void kload2(bf16x8*kf,lds_cptr kp,int j){ kf[2*j]=*(const __attribute__((address_space(3))) bf16x8*)(kp+j*2048); kf[2*j+1]=*(const __attribute__((address_space(3))) bf16x8*)(kp+j*2048+512); }
__device__ __forceinline__ s16x4 vtr(lds_cptr p){ return __builtin_bit_cast(s16x4,__builtin_amdgcn_ds_read_tr16_b64_v4i16((__attribute__((address_space(3))) v4i16_t*)p)); }
__device__ __forceinline__ float rowmax(const f32x16&p0,const f32x16&p1){
  float a=max3f(p0[0],p0[1],p1[0]),b=max3f(p0[2],p0[3],p1[1]);a=max3f(a,p1[2],p1[3]);
  #pragma unroll
  for(int r=4;r<16;r+=4){a=max3f(a,p0[r],p0[r+1]);b=max3f(b,p0[r+2],p0[r+3]);a=max3f(a,p1[r],p1[r+1]);b=max3f(b,p1[r+2],p1[r+3]);}
  const float m=max2f(a,b);
  auto rr=__builtin_amdgcn_permlane32_swap(__float_as_uint(m),__float_as_uint(m),false,false);
  return max2f(__uint_as_float(rr[0]),__uint_as_float(rr[1]));
}
__device__ __forceinline__ void pv(f32x16*o,int vb,bf16x8 pa0,bf16x8 pa1,bf16x8 pa2,bf16x8 pa3){
  #pragma unroll
  for(int d0=0;d0<2;++d0){s16x4 lo[4],hi[4];
    #pragma unroll
    for(int ks=0;ks<4;++ks){
      asm volatile("ds_read_b64_tr_b16 %0,%1 offset:%c2":"=&v"(lo[ks]):"v"(vb),"i"(d0*4096+ks*1024):"memory");
      asm volatile("ds_read_b64_tr_b16 %0,%1 offset:%c2":"=&v"(hi[ks]):"v"(vb),"i"(d0*4096+ks*1024+512):"memory");}
    asm volatile("s_waitcnt lgkmcnt(0)":::"memory");SBAR();
    #define PK(k) (bf16x8){lo[k][0],lo[k][1],lo[k][2],lo[k][3],hi[k][0],hi[k][1],hi[k][2],hi[k][3]}
    o[d0]=__builtin_amdgcn_mfma_f32_32x32x16_bf16(pa0,PK(0),o[d0],0,0,0);
    o[d0]=__builtin_amdgcn_mfma_f32_32x32x16_bf16(pa1,PK(1),o[d0],0,0,0);
    o[d0]=__builtin_amdgcn_mfma_f32_32x32x16_bf16(pa2,PK(2),o[d0],0,0,0);
    o[d0]=__builtin_amdgcn_mfma_f32_32x32x16_bf16(pa3,PK(3),o[d0],0,0,0);
    #undef PK
  }
}

#ifndef ATTN_STORE16
#define ATTN_STORE16(p,v) (*(u32x4*)(p)=(v))
#endif
template<int THRL> __device__ __forceinline__ void attn_unit(int b,int h,int qb,const bf16*Q,const bf16*__restrict__ K,const bf16*__restrict__ V,bf16*O,float*SS,char*shm){
  const int tid=threadIdx.x,lane=tid&63,r32=lane&31,hi=lane>>5; const int wid=__builtin_amdgcn_readfirstlane(tid>>6);
  const long rowbase=(long)b*SEQ; const int q0=qb*QB;
  const bf16*Qw=Q+(rowbase+q0+wid*QBLK)*QP+h*D;
  const bf16*Kh=K+rowbase*KP+(h>>2)*D,*Vh=V+rowbase*KP+(h>>2)*D;
  const unsigned lds0=(unsigned)(uintptr_t)shm;
  float*wsf=(float*)(shm+LDS_WS)+wid*64;
  const bf16*ksrc=Kh+(long)lane*KP+wid*8;
  const bf16*vsrc=Vh+(long)(16*(wid&3)+(lane>>2))*KP+(wid>>2)*32+(lane&3)*8;
  const unsigned kdst=lds0+LDS_K+wid*1024, vdst=lds0+LDS_V+wid*1024;
  #define DMA_K(t,slot) glds16(ksrc+(long)(t)*KVBLK*KP,(unsigned)__builtin_amdgcn_readfirstlane(kdst+(slot)))
  #define DMA_V(t,slot) glds16(vsrc+(long)(t)*KVBLK*KP,(unsigned)__builtin_amdgcn_readfirstlane(vdst+(slot)))
  const int vb0=(int)(lds0+LDS_V)+((lane>>4)&1)*32+(lane&3)*8+(4*hi+((lane&15)>>2))*64;
  const char*Kbase=shm+LDS_K; bf16x8 kf[8];
  const lds_cptr shm3=(lds_cptr)shm; const lds_cptr kp0=shm3+LDS_K+hi*1024+r32*16; const lds_cptr vp0=shm3+LDS_V+((lane>>4)&1)*32+(lane&3)*8+(4*hi+((lane&15)>>2))*64;
  const int NT=SEQ/KVBLK;
  DMA_K(0,0);DMA_V(0,0);DMA_K(1,SLOTB);
  bf16x8 qr[4];
  #pragma unroll
  for(int d0=0;d0<4;++d0)qr[d0]=*reinterpret_cast<const bf16x8*>(&Qw[(long)r32*QP+d0*16+hi*8]);
  float mhat=0.f,l_reg=0.f;f32x16 o[2];o[0]=f32x16{};o[1]=f32x16{};f32x16 negm=f32x16{};asm volatile("":"+v"(negm));
  const int qrel=wid*QBLK+r32;
  #define CMASK(P0,P1,t) do{}while(0)
  bool resc=false;
  #define START(P0,P1) do{ const float rm=rowmax(P0,P1); resc=false; \
    { const float dl=rm; mhat=fadd_s(mhat,dl); \
      _Pragma("unroll") for(int r=0;r<16;++r){P0[r]=fsub_s(P0[r],dl);P1[r]=fsub_s(P1[r],dl);} \
      _Pragma("unroll") for(int r=0;r<16;++r)negm[r]=-mhat; asm volatile("":"+v"(negm)); } \
    _Pragma("unroll") for(int r=0;r<16;++r)P0[r]=__builtin_amdgcn_exp2f(P0[r]); }while(0)
  #define RESC() do{ if(resc){ asm volatile("s_waitcnt lgkmcnt(0)":::"memory"); \
      _Pragma("unroll") for(int d_=0;d_<2;++d_) _Pragma("unroll") for(int r=0;r<16;++r)o[d_][r]*=wsf[crow(r,hi)]; } }while(0)
  f32x16 pA0,pA1,pB0,pB1;
  int sl_prev=0,sl_cur=0,sl_next=SLOTB;
  #define ROT() do{sl_prev=sl_cur;sl_cur=sl_next;sl_next=(sl_next==(NSLOT-1)*SLOTB)?0:sl_next+SLOTB;}while(0)
  DMA_K(2,2*SLOTB);
  WAIT_BAR(3);
  qkt(pA0,pA1,Kbase,qr,negm,r32,hi);asm volatile("s_nop 15\n\ts_nop 7":"+v"(pA0),"+v"(pA1));CMASK(pA0,pA1,0);
  START(pA0,pA1);
  _Pragma("unroll") for(int r=0;r<16;++r)pA1[r]=__builtin_amdgcn_exp2f(pA1[r]);
  WAIT_BAR(0);
  DMA_K(3,0);DMA_V(1,SLOTB);
  ROT();
  kload8(kf,kp0+sl_cur);
  WAIT_BAR(2);
  s16x4 vlo[8],vhi[8]; u32x4 pw0,pw1,pw2,pw3;
  #define PKW(P,B) cvtpk_s(P[B],P[B+1])
  #define PAF(k) __builtin_bit_cast(bf16x8,pw##k)
  #define VFR(i) (bf16x8){vlo[i][0],vlo[i][1],vlo[i][2],vlo[i][3],vhi[i][0],vhi[i][1],vhi[i][2],vhi[i][3]}
  #define PIN(x) asm volatile("":"+v"(x))
  #define MX3(a,b,c) __builtin_fmaxf(__builtin_fmaxf((a),(b)),(c))
  #define GAPA(MF,A0,A1,A2,A3,W0,W1,PW) do{ MF; sacc+=A0; sacc+=A1; sacc+=A2; sacc+=A3; PIN(sacc); W0; W1; PIN(PW); SBAR(); }while(0)
  #define EX(v) __builtin_amdgcn_exp2f(v)
  #define GAPB(MF,X,B) do{ MF; X[B]=EX(X[B]); X[B+1]=EX(X[B+1]); X[B+2]=EX(X[B+2]); X[B+3]=EX(X[B+3]); PIN(X); SBAR(); }while(0)
  #define VRD(i) do{ vlo[i]=vtr(vp_+(((i)>>2)*4096+((i)&3)*1024)); vhi[i]=vtr(vp_+(((i)>>2)*4096+((i)&3)*1024+512)); }while(0)
  #define KRD(G,j) do{ if(G){ kload2(kf,kp0+sl_next,j); SBAR(); } }while(0)
  #define STEP(C0,C1,P0,P1,t,GK,GV,GL) do{ SBAR(); \
    const lds_cptr vp_=vp0+sl_prev; \
    VRD(0); SBAR(); float sacc=(P0[0]+P0[1]); \
    GAPA(C0=__builtin_amdgcn_mfma_f32_32x32x16_bf16(kf[0],qr[0],negm,0,0,0), P0[2],P0[3],P0[4],P0[5],     pw0[0]=PKW(P0,0), pw0[1]=PKW(P0,2), pw0); \
    VRD(4); SBAR(); GAPA(C1=__builtin_amdgcn_mfma_f32_32x32x16_bf16(kf[1],qr[0],negm,0,0,0), P0[6],P0[7],P0[8],P0[9],     pw0[2]=PKW(P0,4), pw0[3]=PKW(P0,6), pw0); \
    VRD(1); SBAR(); GAPA(C0=__builtin_amdgcn_mfma_f32_32x32x16_bf16(kf[2],qr[1],C0,0,0,0),   P0[10],P0[11],P0[12],P0[13], pw1[0]=PKW(P0,8), pw1[1]=PKW(P0,10), pw1); \
    VRD(5); SBAR(); GAPA(C1=__builtin_amdgcn_mfma_f32_32x32x16_bf16(kf[3],qr[1],C1,0,0,0),   P0[14],P0[15],P1[0],P1[1],   pw1[2]=PKW(P0,12),pw1[3]=PKW(P0,14), pw1); \
    VRD(2); SBAR(); GAPA(C0=__builtin_amdgcn_mfma_f32_32x32x16_bf16(kf[4],qr[2],C0,0,0,0),   P1[2],P1[3],P1[4],P1[5],     pw2[0]=PKW(P1,0), pw2[1]=PKW(P1,2), pw2); \
    VRD(6); SBAR(); GAPA(C1=__builtin_amdgcn_mfma_f32_32x32x16_bf16(kf[5],qr[2],C1,0,0,0),   P1[6],P1[7],P1[8],P1[9],     pw2[2]=PKW(P1,4), pw2[3]=PKW(P1,6), pw2); \
    VRD(3); SBAR(); GAPA(C0=__builtin_amdgcn_mfma_f32_32x32x16_bf16(kf[6],qr[3],C0,0,0,0),   P1[10],P1[11],P1[12],P1[13], pw3[0]=PKW(P1,8), pw3[1]=PKW(P1,10), pw3); \
    VRD(7); SBAR(); GAPA(C1=__builtin_amdgcn_mfma_f32_32x32x16_bf16(kf[7],qr[3],C1,0,0,0),   P1[14],P1[15],0.f,0.f,       pw3[2]=PKW(P1,12),pw3[3]=PKW(P1,14), pw3); \
    l_reg+=sacc; \
    if(GK){DMA_K((t)+3,sl_cur);} if(GV){DMA_V((t)+1,sl_next);} \
    CMASK(C0,C1,t); \
    { float a=MX3(C0[0],C0[1],C1[0]),b=MX3(C0[2],C0[3],C1[1]); a=MX3(a,C1[2],C1[3]); \
      _Pragma("unroll") for(int r=4;r<16;r+=4){a=MX3(a,C0[r],C0[r+1]);b=MX3(b,C0[r+2],C0[r+3]);a=MX3(a,C1[r],C1[r+1]);b=MX3(b,C1[r+2],C1[r+3]);} \
      float rm=__builtin_fmaxf(a,b); { auto rr=__builtin_amdgcn_permlane32_swap(__float_as_uint(rm),__float_as_uint(rm),false,false); rm=__builtin_fmaxf(__uint_as_float(rr[0]),__uint_as_float(rr[1])); } \
      resc=false; \
      if(__builtin_expect(__any(rm>(float)THRL),0)){ const float dl=__builtin_fmaxf(rm,0.f); mhat+=dl; \
        _Pragma("unroll") for(int r=0;r<16;++r){C0[r]-=dl;C1[r]-=dl;} \
        _Pragma("unroll") for(int r=0;r<16;++r)negm[r]=-mhat; asm volatile("":"+v"(negm)); \
        const float f=__builtin_amdgcn_exp2f(-dl); l_reg*=f; if(hi==0)wsf[r32]=f; resc=true; } } \
    SBAR(); \
    GAPB(o[0]=__builtin_amdgcn_mfma_f32_32x32x16_bf16(PAF(0),VFR(0),o[0],0,0,0), C0,0); \
    GAPB(o[1]=__builtin_amdgcn_mfma_f32_32x32x16_bf16(PAF(0),VFR(4),o[1],0,0,0), C0,4); \
    KRD(GL,0); GAPB(o[0]=__builtin_amdgcn_mfma_f32_32x32x16_bf16(PAF(1),VFR(1),o[0],0,0,0), C0,8); \
    KRD(GL,1); GAPB(o[1]=__builtin_amdgcn_mfma_f32_32x32x16_bf16(PAF(1),VFR(5),o[1],0,0,0), C0,12); \
    KRD(GL,2); GAPB(o[0]=__builtin_amdgcn_mfma_f32_32x32x16_bf16(PAF(2),VFR(2),o[0],0,0,0), C1,0); \
    KRD(GL,3); GAPB(o[1]=__builtin_amdgcn_mfma_f32_32x32x16_bf16(PAF(2),VFR(6),o[1],0,0,0), C1,4); \
    GAPB(o[0]=__builtin_amdgcn_mfma_f32_32x32x16_bf16(PAF(3),VFR(3),o[0],0,0,0), C1,8); \
    GAPB(o[1]=__builtin_amdgcn_mfma_f32_32x32x16_bf16(PAF(3),VFR(7),o[1],0,0,0), C1,12); \
    }while(0)
  int t=1;
  #undef CMASK
  #define CMASK(P0,P1,t) do{}while(0)
  for(;t+5<NT;t+=2){
    STEP(pB0,pB1,pA0,pA1,t,true,true,true);     WAIT_BAR(2); RESC(); ROT();
    STEP(pA0,pA1,pB0,pB1,t+1,true,true,true);   WAIT_BAR(2); RESC(); ROT();
  }
  #undef CMASK
  #define CMASK(P0,P1,t) do{}while(0)
  #define ENDW(tt) do{ if((tt)+3<NT){WAIT_BAR(2);} else if((tt)+2<NT){WAIT_BAR(1);} else {WAIT_BAR(0);} }while(0)
  for(;t+1<NT;t+=2){
    STEP(pB0,pB1,pA0,pA1,t,(t+3<NT),(t+1<NT),(t+1<NT));       ENDW(t);   RESC(); ROT();
    STEP(pA0,pA1,pB0,pB1,t+1,(t+4<NT),(t+2<NT),(t+2<NT));     ENDW(t+1); RESC(); ROT();
  }
  STEP(pB0,pB1,pA0,pA1,NT-1,false,false,false); RESC();
  { float sacc=pB0[0]+pB0[1]; _Pragma("unroll") for(int r=2;r<16;++r)sacc+=pB0[r]; _Pragma("unroll") for(int r=0;r<16;++r)sacc+=pB1[r]; l_reg+=sacc;
    pw0=(u32x4){PKW(pB0,0),PKW(pB0,2),PKW(pB0,4),PKW(pB0,6)};pw1=(u32x4){PKW(pB0,8),PKW(pB0,10),PKW(pB0,12),PKW(pB0,14)};pw2=(u32x4){PKW(pB1,0),PKW(pB1,2),PKW(pB1,4),PKW(pB1,6)};pw3=(u32x4){PKW(pB1,8),PKW(pB1,10),PKW(pB1,12),PKW(pB1,14)};
    SBAR(); pv(o,vb0+sl_cur,PAF(0),PAF(1),PAF(2),PAF(3)); }
  #undef PKW
  #undef PAF
  #undef VFR
  #undef PIN
  #undef MX3
  #undef GAPA
  #undef GAPB
  #undef EX
  #undef VRD
  #undef KRD
  #undef STEP
  #undef ENDW
  {auto rr=__builtin_amdgcn_permlane32_swap(__float_as_uint(l_reg),__float_as_uint(l_reg),false,false);l_reg=__uint_as_float(rr[0])+__uint_as_float(rr[1]);}
  if(hi==0)wsf[32+r32]=l_reg;asm volatile("s_waitcnt lgkmcnt(0)":::"memory");
  float rli[16];
  #pragma unroll
  for(int r=0;r<16;++r)rli[r]=__builtin_amdgcn_rcpf(wsf[32+crow(r,hi)]);
  bf16*Ow=O+(rowbase+q0+wid*QBLK)*OP+h*D; float*SSw=SS+((rowbase+q0+wid*QBLK)*8+h);
  { bf16*stg=(bf16*)(shm+LDS_OST)+wid*2048;
    #pragma unroll
    for(int r=0;r<16;++r){const int orow=crow(r,hi);
      #pragma unroll
      for(int d0=0;d0<2;++d0)stg[orow*64+d0*32+r32]=__float2bfloat16(o[d0][r]*rli[r]);}
    asm volatile("s_waitcnt lgkmcnt(0)":::"memory");
    #pragma unroll
    for(int i=0;i<4;++i){const int row=i*8+(lane>>3),ch=lane&7; const u32x4 v=*(const u32x4*)(stg+row*64+ch*8); ATTN_STORE16(Ow+(long)row*OP+ch*8,v);
      float ss_=0.f; _Pragma("unroll") for(int e_=0;e_<4;++e_){const unsigned w_=v[e_]; const float a_=__uint_as_float(w_<<16),b_=__uint_as_float(w_&0xffff0000u); ss_+=a_*a_+b_*b_;}
      ss_+=__shfl_xor(ss_,1); ss_+=__shfl_xor(ss_,2); ss_+=__shfl_xor(ss_,4); if(ch==0)SSw[(long)row*8]=ss_;} }
  asm volatile("s_waitcnt lgkmcnt(0)\n\ts_barrier":::"memory");
  #undef DMA_K
  #undef DMA_V
  #undef CMASK
  #undef START
  #undef RESC
  #undef ROT
}
constexpr int ATTN_LDS_BYTES=LDS_BYTES;
template<int THRL=8> __device__ __forceinline__ void attn_phase(char*lds,const bf16*Q,const bf16*K,const bf16*V,bf16*O,float*SS,int G,int vcu){
  for(int uid=vcu;uid<512;uid+=G){ const int pair=uid>>5,b=pair>>1,h=(pair&1)*4+((uid>>3)&3),qb=uid&7; attn_unit<THRL>(b,h,qb,Q,K,V,O,SS,lds); }
}
#undef SBAR
#undef WAIT_BAR
}
typedef FK_GAS unsigned gu32;
#define LAS FK_LAS
#define XB_TMO      128
#define XB_XCNT(j)  (256  + 64 * (j))
#define XB_XSUB(j)  (1280 + 64 * (j))
#define XB_XGEN(j)  (2304 + 64 * (j))
#define XB_TOP      3328
#define XB_TOPGEN   3392
#define XCD_BAR_WORDS 3456
#define XB_SPIN_CAP (1u << 18)

__device__ __forceinline__ unsigned xb_ld(unsigned* p)              { return __hip_atomic_load(p, __ATOMIC_RELAXED, __HIP_MEMORY_SCOPE_AGENT); }
__device__ __forceinline__ unsigned xb_add(unsigned* p, unsigned v) { return __hip_atomic_fetch_add(p, v, __ATOMIC_RELAXED, __HIP_MEMORY_SCOPE_AGENT); }
__device__ __forceinline__ unsigned xb_xcc_id() { return (unsigned)__builtin_amdgcn_s_getreg((3 << 11) | 20) & 0xFu; }
#define XB_SPIN(cond, bar) do { unsigned _sp = 0; while (cond) { __builtin_amdgcn_s_sleep(1); \
    if ((++_sp & 255u) == 0u) { if (xb_ld(&(bar)[XB_TMO])) break; if (_sp > XB_SPIN_CAP) { atomicAdd(&(bar)[XB_TMO], 1u); break; } } } } while (0)

struct XcdBarrier {
    unsigned* bar; unsigned x;
    volatile LAS unsigned* st;
};

__device__ __forceinline__ XcdBarrier xcd_barrier_post(unsigned* bar, volatile LAS unsigned* st) {
    XcdBarrier b; b.bar = bar; b.x = xb_xcc_id(); b.st = st;
    if (threadIdx.x == 0) (void)xb_add(&bar[XB_XCNT(b.x)], 1u);
    return b;
}
__device__ __forceinline__ void xcd_barrier_complete(unsigned* bar, unsigned x, unsigned& nloc, unsigned& nx) {
    const unsigned G = gridDim.x * gridDim.y * gridDim.z;
    unsigned sum, cnt, mine, sp = 0u;
    for (;;) {
        sum = 0u; cnt = 0u; mine = 0u;
#pragma unroll
        for (unsigned j = 0; j < 16; ++j) { const unsigned c = xb_ld(&bar[XB_XCNT(j)]); sum += c; cnt += (c > 0u) ? 1u : 0u; mine = (j == x) ? c : mine; }
        if (sum == G) break;
        __builtin_amdgcn_s_sleep(1);
        if ((++sp & 255u) == 0u) { if (xb_ld(&bar[XB_TMO])) break; if (sp > XB_SPIN_CAP) { atomicAdd(&bar[XB_TMO], 1u); break; } }
    }
    nloc = mine > 0u ? mine : 1u; nx = cnt > 0u ? cnt : 1u;
}

__device__ __forceinline__ void xcd_barrier(const XcdBarrier& b) {
    asm volatile("s_waitcnt vmcnt(0)" ::: "memory");
    __syncthreads();
    if (threadIdx.x == 0) {
        unsigned* bar = b.bar;
        __builtin_amdgcn_s_waitcnt(0);
        unsigned nloc = b.st[0], nx = b.st[1];
        if (nloc == 0u) { xcd_barrier_complete(bar, b.x, nloc, nx); b.st[0] = nloc; b.st[1] = nx; }
        const unsigned old = xb_add(&bar[XB_XSUB(b.x)], 1u);
        const unsigned gen = old / nloc;
        if (old + 1u == (gen + 1u) * nloc) {
            __builtin_amdgcn_fence(__ATOMIC_RELEASE, "agent");
            asm volatile("s_waitcnt vmcnt(0)" ::: "memory");
            const unsigned og = xb_add(&bar[XB_TOP], 1u);
            const unsigned tg = og / nx;
            if (og + 1u == (tg + 1u) * nx) xb_add(&bar[XB_TOPGEN], 1u);
            else XB_SPIN(xb_ld(&bar[XB_TOPGEN]) == tg, bar);
            __builtin_amdgcn_fence(__ATOMIC_ACQUIRE, "agent");
            xb_add(&bar[XB_XGEN(b.x)], 1u);
            asm volatile("s_waitcnt vmcnt(0)" ::: "memory");
        } else {
            XB_SPIN(xb_ld(&bar[XB_XGEN(b.x)]) == gen, bar);
            __builtin_amdgcn_fence(__ATOMIC_ACQUIRE, "agent");
            asm volatile("s_waitcnt vmcnt(0)" ::: "memory");
        }
    }
    __syncthreads();
}
#undef LAS
struct Params {
    const float* in[34];
    float* out;
    unsigned char* ws;
    int ph_lo, ph_hi;
};
using pg8::Unit; using pg8::Gemm;

constexpr int TSCR = 64 * 65 * 4;
template <class RowMap>
__device__ __forceinline__ void transpose_item(const float* W, int K, int N, const float* gain, bf16_t* WT, const RowMap& rm, FK_LAS float* scr, int item, int lane) {
    const int nblk = N / 64, kb = item / nblk, nb = item % nblk, k0 = 64 * kb, n0 = 64 * nb;
    const int nq = (lane & 15) * 4;
#pragma unroll 8
    for (int i = 0; i < 16; ++i) { const int kk = 4 * i + (lane >> 4); const float gv = gain ? gain[k0 + kk] : 1.f;
        const f32x4 v = *(const f32x4*)(W + (size_t)(k0 + kk) * N + n0 + nq) * gv;
        FK_LAS float* d = scr + kk * 65 + nq; d[0] = v[0]; d[1] = v[1]; d[2] = v[2]; d[3] = v[3]; }
    asm volatile("s_waitcnt lgkmcnt(0)" ::: "memory");
    const int c = lane & 7;
#pragma unroll
    for (int j = 0; j < 8; ++j) { const int n = (lane >> 3) + 8 * j; const FK_LAS float* sp = scr + (8 * c) * 65 + n;
        u32x4 o; o.x = pk2(sp[0 * 65], sp[1 * 65]); o.y = pk2(sp[2 * 65], sp[3 * 65]); o.z = pk2(sp[4 * 65], sp[5 * 65]); o.w = pk2(sp[6 * 65], sp[7 * 65]);
        *(u32x4*)(WT + (size_t)rm(n0 + n) * K + k0 + 8 * c) = o; }
    asm volatile("s_waitcnt lgkmcnt(0)" ::: "memory");
}
struct RmId { __device__ __forceinline__ int operator()(int n) const { return n; } };
struct RmWin { __device__ __forceinline__ int operator()(int n) const { if (n >= 768) return n; const int head = n >> 6, dim = n & 63; return 256 * (head >> 2) + 128 * (dim >> 5) + 32 * (head & 3) + (dim & 31); } };
struct RmGU { int up; __device__ __forceinline__ int operator()(int n) const { return (n >> 7) * 256 + up * 128 + (n & 127); } };

__device__ __forceinline__ void row_to_bf16(const float* xrow, bf16_t* orow, float* rout, const float* gain, bool normalise, int lane) {
    const f32x4* xr = (const f32x4*)xrow + lane;
    f32x4 v[4]; float s = 0.f;
#pragma unroll
    for (int j = 0; j < 4; ++j) { v[j] = xr[64 * j]; s += (v[j].x * v[j].x + v[j].y * v[j].y) + (v[j].z * v[j].z + v[j].w * v[j].w); }
    const float r = rsqrtf(wsum(s) * (1.f / 1024.f) + EPS);
    if (rout && lane == 0) *rout = r;
    unsigned long long* o8 = (unsigned long long*)orow + lane;
#pragma unroll
    for (int j = 0; j < 4; ++j) {
        f32x4 w = v[j];
        if (normalise) { const f32x4 gv = ((const f32x4*)gain)[lane + 64 * j]; w = w * r * gv; }
        o8[64 * j] = (unsigned long long)pk2(w.x, w.y) | ((unsigned long long)pk2(w.z, w.w) << 32);
    }
}

__device__ __forceinline__ void s5_prep_part(const Params& p, int g, int q8, FK_LAS float* L, int tid) {
    const float* lam_re = p.in[6]; const float* lam_im = p.in[7]; const float* log_step = p.in[8];
    const float* b_re = p.in[9]; const float* b_im = p.in[10]; const float* c_re = p.in[11]; const float* c_im = p.in[12]; const float* dpar = p.in[13];
    FK_LAS float* LPr = L;
    FK_LAS float* LPi = LPr + 2 * 33 * 64;
    FK_LAS float* BBr = LPi + 2 * 33 * 64;
    FK_LAS float* BBi = BBr + 2 * 1024;
    FK_LAS float* CCr = BBi + 2 * 1024;
    FK_LAS float* CCi = CCr + 2 * 1024;
    FK_LAS float* KT = CCi + 2 * 1024;
    for (int idx = tid; idx < 2 * 33 * 64; idx += NTHREADS) {
        const int dir = idx / (33 * 64), e = (idx / 64) % 33, pp = idx & 63;
        const int gp = (dir * 32 + g) * 64 + pp;
        const float lr = fminf(lam_re[gp], -1e-4f), li = lam_im[gp], dt = expf(log_step[dir * 32 + g]);
        const float mag = expf(lr * dt * (float)e), ang = li * dt * (float)e;
        LPr[idx] = mag * cosf(ang); LPi[idx] = mag * sinf(ang);
    }
    for (int idx = tid; idx < 2 * 1024; idx += NTHREADS) {
        const int dir = idx >> 10, pp = (idx >> 4) & 63, c = idx & 15;
        const int gp = (dir * 32 + g) * 64 + pp;
        const float lr = fminf(lam_re[gp], -1e-4f), li = lam_im[gp], dt = expf(log_step[dir * 32 + g]);
        const float mag = expf(lr * dt), ab_r = mag * cosf(li * dt), ab_i = mag * sinf(li * dt);
        const float den = lr * lr + li * li, nr = ab_r - 1.f;
        const float f_r = (nr * lr + ab_i * li) / den, f_i = (ab_i * lr - nr * li) / den;
        const float br = b_re[(size_t)gp * 16 + c], bi = b_im[(size_t)gp * 16 + c];
        BBr[idx] = f_r * br - f_i * bi; BBi[idx] = f_r * bi + f_i * br;
        const int cc = (idx >> 6) & 15, p2 = idx & 63;
        CCr[idx] = c_re[((size_t)(dir * 32 + g) * 16 + cc) * 64 + p2];
        CCi[idx] = c_im[((size_t)(dir * 32 + g) * 16 + cc) * 64 + p2];
    }
    __syncthreads();
    for (int idx = tid; idx < 2048; idx += NTHREADS) {
        const int dir = idx >> 10, tau = (idx >> 5) & 31, cc = 2 * q8 + ((idx >> 4) & 1), c = idx & 15;
        const FK_LAS float* cr = CCr + dir * 1024 + cc * 64; const FK_LAS float* ci = CCi + dir * 1024 + cc * 64;
        const FK_LAS float* lr = LPr + (dir * 33 + tau) * 64; const FK_LAS float* li = LPi + (dir * 33 + tau) * 64;
        const FK_LAS float* br = BBr + dir * 1024 + c; const FK_LAS float* bi = BBi + dir * 1024 + c;
        float acc = 0.f;
#pragma unroll 8
        for (int pp = 0; pp < 64; ++pp) {
            const float tr = cr[pp] * lr[pp] - ci[pp] * li[pp], ti = cr[pp] * li[pp] + ci[pp] * lr[pp];
            acc += tr * br[pp * 16] - ti * bi[pp * 16];
        }
        KT[idx] = acc;
    }
    __syncthreads();
    bf16_t* W1 = (bf16_t*)(p.ws + WS_W1) + (size_t)g * 256 * 512;
    for (int ch = tid; ch < 32 * 64; ch += NTHREADS) {
        const int n = 32 * q8 + (ch >> 6), kk0 = (ch & 63) * 8, j = kk0 >> 4, c0 = kk0 & 15;
        const int dir = n >> 7, ri = (n >> 6) & 1, pp = n & 63, e = dir ? j : 31 - j;
        const float lr = LPr[(dir * 33 + e) * 64 + pp], li = LPi[(dir * 33 + e) * 64 + pp];
        float v[8];
#pragma unroll
        for (int q = 0; q < 8; ++q) { const float br = BBr[dir * 1024 + pp * 16 + c0 + q], bi = BBi[dir * 1024 + pp * 16 + c0 + q]; v[q] = ri ? (lr * bi + li * br) : (lr * br - li * bi); }
        u32x4 o; o.x = pk2(v[0], v[1]); o.y = pk2(v[2], v[3]); o.z = pk2(v[4], v[5]); o.w = pk2(v[6], v[7]);
        *(u32x4*)(W1 + (size_t)n * 512 + kk0) = o;
    }
    bf16_t* W2 = (bf16_t*)(p.ws + WS_W2) + (size_t)g * 512 * SUP;
    for (int ch = tid; ch < 64 * 96; ch += NTHREADS) {
        const int rowi = ch / 96, kk0 = (ch % 96) * 8, j = rowi >> 1, cl = rowi & 1, cc = 2 * q8 + cl, nn = j * 16 + cc;
        float v[8];
        if (kk0 < 256) {
            const int dir = kk0 >> 7, ri = (kk0 >> 6) & 1, p0 = kk0 & 63, e = dir ? 32 - j : j + 1;
#pragma unroll
            for (int q = 0; q < 8; ++q) {
                const int pp = p0 + q;
                const float cr = CCr[dir * 1024 + cc * 64 + pp], ci = CCi[dir * 1024 + cc * 64 + pp];
                const float lr = LPr[(dir * 33 + e) * 64 + pp], li = LPi[(dir * 33 + e) * 64 + pp];
                v[q] = ri ? -(cr * li + ci * lr) : (cr * lr - ci * li);
            }
        } else {
            const int j2 = (kk0 - 256) >> 4, c0 = kk0 & 15;
#pragma unroll
            for (int q = 0; q < 8; ++q) {
                const int c = c0 + q; float a = 0.f;
                if (j2 <= j) a += KT[((0 * 32 + (j - j2)) * 2 + cl) * 16 + c];
                if (j2 >= j) a += KT[((1 * 32 + (j2 - j)) * 2 + cl) * 16 + c];
                if (j2 == j && c == cc) a += dpar[g * 16 + c];
                v[q] = a;
            }
        }
        u32x4 o; o.x = pk2(v[0], v[1]); o.y = pk2(v[2], v[3]); o.z = pk2(v[4], v[5]); o.w = pk2(v[6], v[7]);
        *(u32x4*)(W2 + (size_t)nn * SUP + kk0) = o;
    }
    __syncthreads();
}

__device__ __forceinline__ void p0_prologue(const Params& p, FK_LAS unsigned char* lds, int vcu, int G, int tid, int lane, int wave) {
    unsigned char* ws = p.ws;
    for (int it = vcu; it < 256; it += G) s5_prep_part(p, it >> 3, it & 7, (FK_LAS float*)lds, tid);
    if (vcu == 0) {
        for (int idx = tid; idx < 1024; idx += NTHREADS) {
            const int pos = idx >> 4, i = idx & 15;
            const float ang = (float)pos * powf(10000.f, -(float)i / 16.f);
            ((f32x2*)(ws + WS_ROPE))[idx] = (f32x2){cosf(ang), sinf(ang)};
        }
    }
    FK_LAS float* scr = (FK_LAS float*)(lds + wave * TSCR);
    const int gw = vcu * NWAVES + wave, NGW = G * NWAVES;
    constexpr int I_WIN = 16 * 20, I_GLU = 8 * 8, I_SQ = 16 * 16, I_GU = 16 * 8, I_DN = 8 * 16;
    constexpr int NITEMS = I_WIN + I_GLU + 5 * I_SQ + 16 * (2 * I_GU + I_DN);
    for (int it = gw; it < NITEMS; it += NGW) {
        int r = it;
        if (r < I_WIN) { transpose_item(p.in[3], 1024, 1280, p.in[2], (bf16_t*)(ws + WS_WIN), RmWin{}, scr, r, lane); continue; } r -= I_WIN;
        if (r < I_GLU) { transpose_item(p.in[14], 512, 512, nullptr, (bf16_t*)(ws + WS_GLU), RmId{}, scr, r, lane); continue; } r -= I_GLU;
        if (r < I_SQ) {
            const int kb = r / 16; const float* gain = kb < 8 ? p.in[16] : p.in[17] - 512;
            transpose_item(p.in[18], 1024, 1024, gain, (bf16_t*)(ws + WS_WOUT), RmId{}, scr, r, lane); continue; } r -= I_SQ;
        if (r < I_SQ) { transpose_item(p.in[21], 1024, 1024, p.in[19], (bf16_t*)(ws + WS_WQ), RmId{}, scr, r, lane); continue; } r -= I_SQ;
        if (r < I_SQ) { transpose_item(p.in[22], 1024, 1024, nullptr, (bf16_t*)(ws + WS_WK), RmId{}, scr, r, lane); continue; } r -= I_SQ;
        if (r < I_SQ) { transpose_item(p.in[23], 1024, 1024, nullptr, (bf16_t*)(ws + WS_WV), RmId{}, scr, r, lane); continue; } r -= I_SQ;
        if (r < I_SQ) { transpose_item(p.in[24], 1024, 1024, nullptr, (bf16_t*)(ws + WS_WO), RmId{}, scr, r, lane); continue; } r -= I_SQ;
        const int e = r / (2 * I_GU + I_DN); r -= e * (2 * I_GU + I_DN);
        bf16_t* wgu = (bf16_t*)(ws + WS_WGU) + (size_t)e * 1024 * 1024;
        if (r < I_GU) { transpose_item(p.in[30] + (size_t)e * 1024 * 512, 1024, 512, p.in[25], wgu, RmGU{0}, scr, r, lane); continue; } r -= I_GU;
        if (r < I_GU) { transpose_item(p.in[31] + (size_t)e * 1024 * 512, 1024, 512, p.in[25], wgu, RmGU{1}, scr, r, lane); continue; } r -= I_GU;
        transpose_item(p.in[32] + (size_t)e * 512 * 1024, 512, 1024, nullptr, (bf16_t*)(ws + WS_WD) + (size_t)e * 1024 * 512, RmId{}, scr, r, lane);
    }
    for (int m = gw; m < T; m += NGW) row_to_bf16(p.in[0] + (size_t)m * 1024, (bf16_t*)(ws + WS_XB) + (size_t)m * 1024, (float*)(ws + WS_R0) + m, nullptr, false, lane);
    for (int m = gw; m < MTOK; m += NGW) row_to_bf16(p.in[1] + (size_t)m * 1024, (bf16_t*)(ws + WS_HM) + (size_t)m * 1024, nullptr, p.in[20], true, lane);
}

struct SchedP1 {
    int G, c;
    __device__ __forceinline__ bool next(int i, Unit& u) const {
        const int L = i * G + c;
        int pm = 0, pn = 0, kind = 0; unsigned a_off = 0, b_off = 0;
        if (L < 320) {
            pg8::tile_order(L, 64, 5, pm, pn);
            a_off = (unsigned)(WS_XB + (size_t)pm * 256 * 1024 * 2); b_off = (unsigned)(WS_WIN + (size_t)pn * 256 * 1024 * 2);
            kind = pn < 3 ? 0 : 1;
        } else if (L < 352) { const int r = L - 320; pm = r >> 2; pn = r & 3; kind = 2;
            a_off = (unsigned)(WS_HM + (size_t)pm * 256 * 1024 * 2); b_off = (unsigned)(WS_WK + (size_t)pn * 256 * 1024 * 2);
        } else { const int q = L - 352; pm = (q >> 3) & 3; pn = q & 7; kind = 3;
            a_off = (unsigned)(WS_WV + (size_t)pm * 256 * 1024 * 2); b_off = (unsigned)(WS_HM + (size_t)pn * 256 * 1024 * 2); }
        u.a_off = a_off; u.b_off = b_off; u.pm = pm; u.pn = pn; u.kind = kind; u.aux = 0;
        return L < 384;
    }
    __device__ __forceinline__ unsigned row_off(const Unit& u, int r) const { return u.a_off + (unsigned)r * 2048u; }
};
struct EpiP1 {
    static constexpr bool PERM = false, AFTER_DRAIN = false;
    unsigned char* ws; const float* qg; const float* kg;
    __device__ __forceinline__ void operator()(f32x4 (&acc)[2][2][4][2], const Unit& u, int wr, int wc, int fr, int fq, FK_LAS unsigned char*, int, int) const {
        if (u.kind == 0) {
            const int head = 4 * u.pn + wc;
            const float* r0 = (const float*)(ws + WS_R0);
            const f32x2* rope = (const f32x2*)(ws + WS_ROPE);
            if (head < 10) {
                const float* gn = head < 8 ? qg : kg;
                f32x4 gv[2][2];
#pragma unroll
                for (int bj = 0; bj < 2; ++bj)
#pragma unroll
                    for (int n = 0; n < 2; ++n) gv[bj][n] = *(const f32x4*)(gn + 32 * bj + 16 * n + 4 * fq);
                const float osc = head < 8 ? QSCALE : 1.f;
#pragma unroll
                for (int ai = 0; ai < 2; ++ai)
#pragma unroll
                    for (int m = 0; m < 4; ++m) {
                        const int row = u.pm * 256 + ai * 128 + wr * 64 + m * 16 + fr;
                        float ss = 0.f;
#pragma unroll
                        for (int bj = 0; bj < 2; ++bj)
#pragma unroll
                            for (int n = 0; n < 2; ++n) { const f32x4 x = acc[ai][bj][m][n]; ss += (x[0] * x[0] + x[1] * x[1]) + (x[2] * x[2] + x[3] * x[3]); }
                        ss += __shfl_xor(ss, 16); ss += __shfl_xor(ss, 32);
                        const float rr = r0[row];
                        const float hs = rr * rsqrtf(rr * rr * ss * (1.f / 64.f) + EPS) * osc;
                        const int s = row & (SEQ - 1);
                        bf16_t* dst = head < 8 ? (bf16_t*)(ws + WS_Q) + (size_t)row * 512 + head * 64 : (bf16_t*)(ws + WS_K) + (size_t)row * 128 + (head - 8) * 64;
#pragma unroll
                        for (int bj = 0; bj < 2; ++bj) {
                            const int pos = bj == 0 ? (s >> 6) : (s & 63);
                            f32x4 x1 = acc[ai][bj][m][0] * hs * gv[bj][0], x2 = acc[ai][bj][m][1] * hs * gv[bj][1], o1, o2;
#pragma unroll
                            for (int j = 0; j < 4; ++j) { const f32x2 cs = rope[pos * 16 + 4 * fq + j]; o1[j] = x1[j] * cs.x - x2[j] * cs.y; o2[j] = x2[j] * cs.x + x1[j] * cs.y; }
                            u32x2 w1, w2; w1.x = pg8::cvt_pk_bf16(o1[0], o1[1]); w1.y = pg8::cvt_pk_bf16(o1[2], o1[3]); w2.x = pg8::cvt_pk_bf16(o2[0], o2[1]); w2.y = pg8::cvt_pk_bf16(o2[2], o2[3]);
                            *(u32x2*)(dst + 32 * bj + 4 * fq) = w1; *(u32x2*)(dst + 32 * bj + 16 + 4 * fq) = w2;
                        }
                    }
            } else {
#pragma unroll
                for (int ai = 0; ai < 2; ++ai)
#pragma unroll
                    for (int m = 0; m < 4; ++m) {
                        const int row = u.pm * 256 + ai * 128 + wr * 64 + m * 16 + fr;
                        const float rr = r0[row];
                        bf16_t* dst = (bf16_t*)(ws + WS_V) + (size_t)row * 128 + (head - 10) * 64;
#pragma unroll
                        for (int bj = 0; bj < 2; ++bj)
#pragma unroll
                            for (int n = 0; n < 2; ++n) { const f32x4 x = acc[ai][bj][m][n] * rr; u32x2 w; w.x = pg8::cvt_pk_bf16(x[0], x[1]); w.y = pg8::cvt_pk_bf16(x[2], x[3]);
                                *(u32x2*)(dst + 32 * bj + 16 * n + 4 * fq) = w; }
                    }
            }
        } else if (u.kind == 1) {
            const float* r0 = (const float*)(ws + WS_R0);
#pragma unroll
            for (int ai = 0; ai < 2; ++ai)
#pragma unroll
                for (int m = 0; m < 4; ++m) {
                    const int row = u.pm * 256 + ai * 128 + wr * 64 + m * 16 + fr;
                    const float rr = r0[row];
                    const int b = row >> 11, s = row & (SEQ - 1), k = s >> 5, jj = s & 31;
#pragma unroll
                    for (int bj = 0; bj < 2; ++bj)
#pragma unroll
                        for (int n = 0; n < 2; ++n) {
                            const int gidx = 16 * (u.pn - 3) + 8 * bj + 2 * wc + n;
                            bf16_t* dst = (bf16_t*)(ws + WS_SU) + ((size_t)gidx * SROWS + b * NCH + k) * SUP + 256 + jj * 16 + 4 * fq;
                            const f32x4 x = acc[ai][bj][m][n] * rr; u32x2 w; w.x = pg8::cvt_pk_bf16(x[0], x[1]); w.y = pg8::cvt_pk_bf16(x[2], x[3]);
                            *(u32x2*)dst = w;
                        }
                }
        } else {
            bf16_t* base = u.kind == 2 ? (bf16_t*)(ws + WS_KM) + (size_t)u.pm * 256 * 1024 + u.pn * 256 : (bf16_t*)(ws + WS_VT) + ((size_t)u.pn * 1024 + u.pm * 256) * 256;
            const int ldc = u.kind == 2 ? 1024 : 256;
#pragma unroll
            for (int ai = 0; ai < 2; ++ai)
#pragma unroll
                for (int m = 0; m < 4; ++m) {
                    bf16_t* rowp = base + (size_t)(ai * 128 + wr * 64 + m * 16 + fr) * ldc + wc * 32 + 4 * fq;
#pragma unroll
                    for (int bj = 0; bj < 2; ++bj)
#pragma unroll
                        for (int n = 0; n < 2; ++n) { const f32x4 x = acc[ai][bj][m][n]; u32x2 w; w.x = pg8::cvt_pk_bf16(x[0], x[1]); w.y = pg8::cvt_pk_bf16(x[2], x[3]);
                            *(u32x2*)(rowp + 128 * bj + 16 * n) = w; }
                }
        }
    }
};
struct SchedOne {
    Unit u; unsigned a_pitch;
    __device__ __forceinline__ bool next(int i, Unit& o) const { o = u; return i == 0; }
    __device__ __forceinline__ unsigned row_off(const Unit& x, int r) const { return x.a_off + (unsigned)r * a_pitch; }
};
__device__ __forceinline__ Unit mk_unit(unsigned a_off, unsigned b_off, int pm, int pn, int kind) { Unit u; u.a_off = a_off; u.b_off = b_off; u.pm = pm; u.pn = pn; u.kind = kind; u.aux = 0; return u; }

struct EpiSloc {
    static constexpr bool PERM = false, AFTER_DRAIN = false;
    float* C;
    __device__ __forceinline__ void operator()(f32x4 (&acc)[2][2][4][2], const Unit& u, int wr, int wc, int fr, int fq, FK_LAS unsigned char*, int, int) const {
#pragma unroll
        for (int ai = 0; ai < 2; ++ai)
#pragma unroll
            for (int m = 0; m < 4; ++m) {
                float* rowp = C + (size_t)(u.pm * 256 + ai * 128 + wr * 64 + m * 16 + fr) * 256 + wc * 32 + 4 * fq;
#pragma unroll
                for (int bj = 0; bj < 2; ++bj)
#pragma unroll
                    for (int n = 0; n < 2; ++n) *(f32x4*)(rowp + 128 * bj + 16 * n) = acc[ai][bj][m][n];
            }
    }
};
__device__ __forceinline__ void s5_scan(const Params& p, int g, int mt, int tid) {
    const int bl = tid >> 7, dir = (tid >> 6) & 1, pp = tid & 63;
    const int gp = (dir * 32 + g) * 64 + pp;
    const float lr = fminf(p.in[6][gp], -1e-4f), li = p.in[7][gp], dt = expf(p.in[8][dir * 32 + g]);
    const float mag = expf(lr * dt * (float)SL), ang = li * dt * (float)SL;
    const float ar = mag * cosf(ang), ai = mag * sinf(ang);
    const float* sl = (const float*)(p.ws + WS_SLOC) + ((size_t)g * SROWS + mt * 256 + bl * 64) * 256 + dir * 128 + pp;
    bf16_t* su = (bf16_t*)(p.ws + WS_SU) + ((size_t)g * SROWS + mt * 256 + bl * 64) * SUP + dir * 128 + pp;
    float sr = 0.f, si = 0.f;
#pragma unroll 8
    for (int s = 0; s < NCH; ++s) {
        const int k = dir ? (NCH - 1 - s) : s;
        su[(size_t)k * SUP] = (bf16_t)f2bf(sr); su[(size_t)k * SUP + 64] = (bf16_t)f2bf(si);
        const float lr_ = sl[(size_t)k * 256], li_ = sl[(size_t)k * 256 + 64];
        const float nr = ar * sr - ai * si + lr_, ni = ar * si + ai * sr + li_;
        sr = nr; si = ni;
    }
}
struct EpiS5Out {
    static constexpr bool PERM = false, AFTER_DRAIN = false;
    bf16_t* Z; int g, mt, ntile;
    __device__ __forceinline__ void operator()(f32x4 (&acc)[2][2][4][2], const Unit& u, int wr, int wc, int fr, int fq, FK_LAS unsigned char*, int, int) const {
#pragma unroll
        for (int ai = 0; ai < 2; ++ai)
#pragma unroll
            for (int m = 0; m < 4; ++m) {
                const int R = mt * 256 + ai * 128 + wr * 64 + m * 16 + fr, b = R >> 6, k = R & 63;
#pragma unroll
                for (int bj = 0; bj < 2; ++bj)
#pragma unroll
                    for (int n = 0; n < 2; ++n) {
                        const int j = 16 * ntile + 8 * bj + 2 * wc + n;
                        const size_t t = (size_t)b * SEQ + k * SL + j;
                        f32x4 y = acc[ai][bj][m][n], z;
#pragma unroll
                        for (int i = 0; i < 4; ++i) { const float a2 = 1.5957691216057308f * (y[i] + 0.044715f * y[i] * y[i] * y[i]); z[i] = y[i] / (1.f + __expf(-a2)); }
                        u32x2 w; w.x = pg8::cvt_pk_bf16(z[0], z[1]); w.y = pg8::cvt_pk_bf16(z[2], z[3]);
                        *(u32x2*)(Z + t * 512 + g * 16 + 4 * fq) = w;
                    }
            }
    }
};
struct EpiGlu {
    static constexpr bool PERM = false, AFTER_DRAIN = false;
    const bf16_t* Z; bf16_t* Y; float* SS; const float* bias;
    __device__ __forceinline__ void operator()(f32x4 (&acc)[2][2][4][2], const Unit& u, int wr, int wc, int fr, int fq, FK_LAS unsigned char*, int, int) const {
        const int col0 = u.pn * 256 + wc * 32 + 4 * fq;
        f32x4 bv[2][2];
#pragma unroll
        for (int bj = 0; bj < 2; ++bj)
#pragma unroll
            for (int n = 0; n < 2; ++n) bv[bj][n] = *(const f32x4*)(bias + col0 + 128 * bj + 16 * n);
#pragma unroll
        for (int ai = 0; ai < 2; ++ai)
#pragma unroll
            for (int m = 0; m < 4; ++m) {
                const size_t row = (size_t)u.pm * 256 + ai * 128 + wr * 64 + m * 16 + fr;
                float ss = 0.f;
#pragma unroll
                for (int bj = 0; bj < 2; ++bj)
#pragma unroll
                    for (int n = 0; n < 2; ++n) {
                        const int col = col0 + 128 * bj + 16 * n;
                        const u32x2 zw = *(const u32x2*)(Z + row * 512 + col);
                        const f32x4 lin = acc[ai][bj][m][n] + bv[bj][n];
                        const float z0 = bflo(zw.x), z1 = bfhi(zw.x), z2 = bflo(zw.y), z3 = bfhi(zw.y);
                        const float y0 = z0 / (1.f + __expf(-lin[0])), y1 = z1 / (1.f + __expf(-lin[1])), y2 = z2 / (1.f + __expf(-lin[2])), y3 = z3 / (1.f + __expf(-lin[3]));
                        u32x2 w; w.x = pg8::cvt_pk_bf16(y0, y1); w.y = pg8::cvt_pk_bf16(y2, y3);
                        *(u32x2*)(Y + row * 1024 + 512 + col) = w;
                        const float r0 = bflo(w.x), r1 = bfhi(w.x), r2 = bflo(w.y), r3 = bfhi(w.y);
                        ss += (r0 * r0 + r1 * r1) + (r2 * r2 + r3 * r3);
                    }
                ss += __shfl_xor(ss, 16); ss += __shfl_xor(ss, 32);
                if (fq == 0) SS[row * 8 + u.pn * 4 + wc] = ss;
                asm volatile("" ::: "memory");
            }
    }
};
__device__ __forceinline__ float rs8(const float* ss, size_t row, float inv_n) {
    const f32x4 a = *(const f32x4*)(ss + row * 8), b = *(const f32x4*)(ss + row * 8 + 4);
    return rsqrtf(((a[0] + a[1]) + (a[2] + a[3]) + (b[0] + b[1]) + (b[2] + b[3])) * inv_n + EPS);
}
struct EpiWoutMid {
    static constexpr bool PERM = false, AFTER_DRAIN = false;
    const FK_LAS float* xt;
    __device__ __forceinline__ void operator()(f32x4 (&acc)[2][2][4][2], const Unit& u, int wr, int wc, int fr, int fq, FK_LAS unsigned char*, int, int) const {
#pragma unroll
        for (int ai = 0; ai < 2; ++ai)
#pragma unroll
            for (int m = 0; m < 4; ++m) {
                const float f = xt[ai * 128 + wr * 64 + m * 16 + fr];
#pragma unroll
                for (int bj = 0; bj < 2; ++bj)
#pragma unroll
                    for (int n = 0; n < 2; ++n) acc[ai][bj][m][n] = acc[ai][bj][m][n] * f;
            }
    }
};
struct EpiWoutFin {
    static constexpr bool PERM = false, AFTER_DRAIN = false;
    const FK_LAS float* xt; const bf16_t* XB; bf16_t* X1; float* SS1;
    __device__ __forceinline__ void operator()(f32x4 (&acc)[2][2][4][2], const Unit& u, int wr, int wc, int fr, int fq, FK_LAS unsigned char*, int, int) const {
        const int col0 = u.pn * 256 + wc * 32 + 4 * fq;
#pragma unroll
        for (int ai = 0; ai < 2; ++ai)
#pragma unroll
            for (int m = 0; m < 4; ++m) {
                const size_t row = (size_t)u.pm * 256 + ai * 128 + wr * 64 + m * 16 + fr;
                const float rs = xt[256 + ai * 128 + wr * 64 + m * 16 + fr];
                float ss = 0.f;
#pragma unroll
                for (int bj = 0; bj < 2; ++bj)
#pragma unroll
                    for (int n = 0; n < 2; ++n) {
                        const int col = col0 + 128 * bj + 16 * n;
                        const u32x2 xw = *(const u32x2*)(XB + row * 1024 + col);
                        const f32x4 a = acc[ai][bj][m][n] * rs;
                        u32x2 w; w.x = pg8::cvt_pk_bf16(bflo(xw.x) + a[0], bfhi(xw.x) + a[1]); w.y = pg8::cvt_pk_bf16(bflo(xw.y) + a[2], bfhi(xw.y) + a[3]);
                        *(u32x2*)(X1 + row * 1024 + col) = w;
                        const float r0 = bflo(w.x), r1 = bfhi(w.x), r2 = bflo(w.y), r3 = bfhi(w.y);
                        ss += (r0 * r0 + r1 * r1) + (r2 * r2 + r3 * r3);
                    }
                ss += __shfl_xor(ss, 16); ss += __shfl_xor(ss, 32);
                if (fq == 0) SS1[row * 16 + u.pn * 4 + wc] = ss;
                asm volatile("" ::: "memory");
            }
    }
};
struct EpiScaleBf16 {
    static constexpr bool PERM = false, AFTER_DRAIN = false;
    bf16_t* O; int ldc; const FK_LAS float* xt; float sc;
    __device__ __forceinline__ void operator()(f32x4 (&acc)[2][2][4][2], const Unit& u, int wr, int wc, int fr, int fq, FK_LAS unsigned char*, int, int) const {
#pragma unroll
        for (int ai = 0; ai < 2; ++ai)
#pragma unroll
            for (int m = 0; m < 4; ++m) {
                const int r = ai * 128 + wr * 64 + m * 16 + fr;
                const float f = xt ? xt[r] * sc : sc;
                bf16_t* rowp = O + (size_t)r * ldc + wc * 32 + 4 * fq;
#pragma unroll
                for (int bj = 0; bj < 2; ++bj)
#pragma unroll
                    for (int n = 0; n < 2; ++n) { const f32x4 x = acc[ai][bj][m][n] * f; u32x2 w; w.x = pg8::cvt_pk_bf16(x[0], x[1]); w.y = pg8::cvt_pk_bf16(x[2], x[3]);
                        *(u32x2*)(rowp + 128 * bj + 16 * n) = w; }
            }
    }
};
struct EpiSoftmax {
    static constexpr bool PERM = false, AFTER_DRAIN = true;
    bf16_t* O; int ldc;
    __device__ __forceinline__ void operator()(f32x4 (&acc)[2][2][4][2], const Unit& u, int wr, int wc, int fr, int fq, FK_LAS unsigned char* lds, int, int) const {
        FK_LAS float* Pm = (FK_LAS float*)lds;
        FK_LAS float* Ps = (FK_LAS float*)(lds + 4096);
#pragma unroll
        for (int ai = 0; ai < 2; ++ai)
#pragma unroll
            for (int m = 0; m < 4; ++m) {
                float mx = -INFINITY;
#pragma unroll
                for (int bj = 0; bj < 2; ++bj)
#pragma unroll
                    for (int n = 0; n < 2; ++n) { const f32x4 x = acc[ai][bj][m][n]; mx = fmaxf(mx, fmaxf(fmaxf(x[0], x[1]), fmaxf(x[2], x[3]))); }
                mx = fmaxf(mx, __shfl_xor(mx, 16)); mx = fmaxf(mx, __shfl_xor(mx, 32));
                if (fq == 0) Pm[(ai * 128 + wr * 64 + m * 16 + fr) * 4 + wc] = mx;
            }
        asm volatile("s_waitcnt lgkmcnt(0)" ::: "memory"); __builtin_amdgcn_s_barrier(); asm volatile("" ::: "memory");
#pragma unroll
        for (int ai = 0; ai < 2; ++ai)
#pragma unroll
            for (int m = 0; m < 4; ++m) {
                const int r = ai * 128 + wr * 64 + m * 16 + fr;
                const f32x4 pm4 = *(const FK_LAS f32x4*)(Pm + r * 4);
                const float M = fmaxf(fmaxf(pm4[0], pm4[1]), fmaxf(pm4[2], pm4[3]));
                float sm = 0.f;
#pragma unroll
                for (int bj = 0; bj < 2; ++bj)
#pragma unroll
                    for (int n = 0; n < 2; ++n) { f32x4 x = acc[ai][bj][m][n];
#pragma unroll
                        for (int i = 0; i < 4; ++i) { x[i] = __builtin_amdgcn_exp2f(x[i] - M); sm += x[i]; }
                        acc[ai][bj][m][n] = x; }
                sm += __shfl_xor(sm, 16); sm += __shfl_xor(sm, 32);
                if (fq == 0) Ps[r * 4 + wc] = sm;
            }
        asm volatile("s_waitcnt lgkmcnt(0)" ::: "memory"); __builtin_amdgcn_s_barrier(); asm volatile("" ::: "memory");
#pragma unroll
        for (int ai = 0; ai < 2; ++ai)
#pragma unroll
            for (int m = 0; m < 4; ++m) {
                const int r = ai * 128 + wr * 64 + m * 16 + fr;
                const f32x4 ps4 = *(const FK_LAS f32x4*)(Ps + r * 4);
                const float inv = 1.f / ((ps4[0] + ps4[1]) + (ps4[2] + ps4[3]));
                bf16_t* rowp = O + (size_t)r * ldc + wc * 32 + 4 * fq;
#pragma unroll
                for (int bj = 0; bj < 2; ++bj)
#pragma unroll
                    for (int n = 0; n < 2; ++n) { const f32x4 x = acc[ai][bj][m][n] * inv; u32x2 w; w.x = pg8::cvt_pk_bf16(x[0], x[1]); w.y = pg8::cvt_pk_bf16(x[2], x[3]);
                        *(u32x2*)(rowp + 128 * bj + 16 * n) = w; }
            }
        asm volatile("s_waitcnt lgkmcnt(0)" ::: "memory"); __builtin_amdgcn_s_barrier(); asm volatile("" ::: "memory");
    }
};
struct EpiResid {
    static constexpr bool PERM = false, AFTER_DRAIN = false;
    bf16_t* X; int ldc;
    __device__ __forceinline__ void operator()(f32x4 (&acc)[2][2][4][2], const Unit& u, int wr, int wc, int fr, int fq, FK_LAS unsigned char*, int, int) const {
#pragma unroll
        for (int ai = 0; ai < 2; ++ai)
#pragma unroll
            for (int m = 0; m < 4; ++m) {
                bf16_t* rowp = X + (size_t)(ai * 128 + wr * 64 + m * 16 + fr) * ldc + wc * 32 + 4 * fq;
#pragma unroll
                for (int bj = 0; bj < 2; ++bj)
#pragma unroll
                    for (int n = 0; n < 2; ++n) { const u32x2 xw = *(const u32x2*)(rowp + 128 * bj + 16 * n); const f32x4 a = acc[ai][bj][m][n];
                        u32x2 w; w.x = pg8::cvt_pk_bf16(bflo(xw.x) + a[0], bfhi(xw.x) + a[1]); w.y = pg8::cvt_pk_bf16(bflo(xw.y) + a[2], bfhi(xw.y) + a[3]);
                        *(u32x2*)(rowp + 128 * bj + 16 * n) = w; }
                asm volatile("" ::: "memory");
            }
    }
};
__device__ __forceinline__ void router_phase(const Params& p, FK_LAS unsigned char* lds, int vcu, int G, int tid, int lane, int wave) {
    unsigned char* ws = p.ws;
    FK_LAS float* RW = (FK_LAS float*)lds;
    FK_LAS int* lcnt = (FK_LAS int*)(lds + XTRA_OFF);
    FK_LAS int* lbase = lcnt + 16;
    FK_LAS int* ee = lbase + 16;
    FK_LAS int* pp = ee + 128;
    FK_LAS float* ww = (FK_LAS float*)(pp + 128);
    const float* gw = p.in[26]; const float* ew = p.in[28]; const float* mg = p.in[25];
    for (int k = tid; k < 1024; k += NTHREADS) {
        const float m = mg[k]; const f32x4 g4 = *(const f32x4*)(gw + k * 4);
        FK_LAS f32x4* dst = (FK_LAS f32x4*)(RW + k * 20);
        dst[0] = g4 * m;
#pragma unroll
        for (int q = 0; q < 4; ++q) dst[1 + q] = *(const f32x4*)(ew + k * 16 + q * 4) * m;
    }
    const bf16_t* X2 = (const bf16_t*)(ws + WS_X1B);
    int* cnt = (int*)(ws + WS_CTL) + CW_CNT; int* list = (int*)(ws + WS_LIST); float* wl = (float*)(ws + WS_WL); float* r2o = (float*)(ws + WS_R2);
    for (int chunk = vcu; chunk < T / 64; chunk += G) {
        if (tid < 16) lcnt[tid] = 0;
        __syncthreads();
        for (int jt = 0; jt < 8; ++jt) {
            const int tl = wave * 8 + jt, t = chunk * 64 + tl;
            float lg[20];
#pragma unroll
            for (int i = 0; i < 20; ++i) lg[i] = 0.f;
            float ss = 0.f;
#pragma unroll
            for (int j = 0; j < 2; ++j) {
                const int k0 = j * 512 + lane * 8;
                const u32x4 xw = *(const u32x4*)(X2 + (size_t)t * 1024 + k0);
#pragma unroll
                for (int e = 0; e < 8; ++e) {
                    const unsigned w = xw[e >> 1]; const float x = (e & 1) ? bfhi(w) : bflo(w);
                    ss += x * x;
                    const FK_LAS f32x4* rw = (const FK_LAS f32x4*)(RW + (k0 + e) * 20);
#pragma unroll
                    for (int q = 0; q < 5; ++q) { const f32x4 wv = rw[q]; lg[4 * q + 0] = fmaf(x, wv[0], lg[4 * q + 0]); lg[4 * q + 1] = fmaf(x, wv[1], lg[4 * q + 1]); lg[4 * q + 2] = fmaf(x, wv[2], lg[4 * q + 2]); lg[4 * q + 3] = fmaf(x, wv[3], lg[4 * q + 3]); }
                    if (e & 1) asm volatile("" ::: "memory");
                }
            }
            ss = wsum(ss);
            const float r2 = rsqrtf(ss * (1.f / 1024.f) + EPS);
#pragma unroll
            for (int i = 0; i < 20; ++i) lg[i] = wsum(lg[i]) * r2 + (i < 4 ? p.in[27][i] : p.in[29][i - 4]);
            if (lane == 0) {
                r2o[t] = r2;
                const float gm = fmaxf(fmaxf(lg[0], lg[1]), fmaxf(lg[2], lg[3]));
                const float e0 = expf(lg[0] - gm), e1 = expf(lg[1] - gm), e2 = expf(lg[2] - gm), e3 = expf(lg[3] - gm);
                const float gs = e0 + e1 + e2 + e3;
                int gsel = 0; float gbest = e0;
                if (e1 > gbest) { gbest = e1; gsel = 1; }
                if (e2 > gbest) { gbest = e2; gsel = 2; }
                if (e3 > gbest) { gbest = e3; gsel = 3; }
                const float gwt = gbest / gs;
                const float v0 = gsel == 0 ? lg[4] : gsel == 1 ? lg[8] : gsel == 2 ? lg[12] : lg[16];
                const float v1 = gsel == 0 ? lg[5] : gsel == 1 ? lg[9] : gsel == 2 ? lg[13] : lg[17];
                const float v2 = gsel == 0 ? lg[6] : gsel == 1 ? lg[10] : gsel == 2 ? lg[14] : lg[18];
                const float v3 = gsel == 0 ? lg[7] : gsel == 1 ? lg[11] : gsel == 2 ? lg[15] : lg[19];
                int i1 = 0; float b1 = v0;
                if (v1 > b1) { b1 = v1; i1 = 1; }
                if (v2 > b1) { b1 = v2; i1 = 2; }
                if (v3 > b1) { b1 = v3; i1 = 3; }
                int i2 = 0; float b2 = -INFINITY;
                if (i1 != 0 && v0 > b2) { b2 = v0; i2 = 0; }
                if (i1 != 1 && v1 > b2) { b2 = v1; i2 = 1; }
                if (i1 != 2 && v2 > b2) { b2 = v2; i2 = 2; }
                if (i1 != 3 && v3 > b2) { b2 = v3; i2 = 3; }
                const float ex2 = expf(b2 - b1);
                const float w1 = gwt / (1.f + ex2), w2 = gwt * ex2 / (1.f + ex2);
                const int ea = gsel * 4 + i1, eb = gsel * 4 + i2;
                ee[tl * 2] = ea; pp[tl * 2] = __hip_atomic_fetch_add(&lcnt[ea], 1, __ATOMIC_RELAXED, __HIP_MEMORY_SCOPE_WORKGROUP); ww[tl * 2] = w1;
                ee[tl * 2 + 1] = eb; pp[tl * 2 + 1] = __hip_atomic_fetch_add(&lcnt[eb], 1, __ATOMIC_RELAXED, __HIP_MEMORY_SCOPE_WORKGROUP); ww[tl * 2 + 1] = w2;
            }
        }
        __syncthreads();
        if (tid < 16) lbase[tid] = atomicAdd(&cnt[tid * 64], lcnt[tid]);
        __syncthreads();
        if (tid < 128) { const int e = ee[tid], pos = lbase[e] + pp[tid]; list[e * T + pos] = (chunk * 64 + (tid >> 1)) * 2 + (tid & 1); wl[e * T + pos] = ww[tid]; }
        __syncthreads();
    }
}
struct MoeTab {
    const FK_LAS int* t;
    __device__ __forceinline__ int total_tiles() const { return __builtin_amdgcn_readfirstlane(t[16]); }
    __device__ __forceinline__ void decode(int mtile, int& e, int& mt, int& ce) const {
        int ee = 0;
#pragma unroll
        for (int j = 1; j < 16; ++j) ee += (mtile >= __builtin_amdgcn_readfirstlane(t[j])) ? 1 : 0;
        e = ee; mt = mtile - __builtin_amdgcn_readfirstlane(t[ee]); ce = __builtin_amdgcn_readfirstlane(t[17 + ee]);
    }
};
__device__ __forceinline__ void moe_tab_init(FK_LAS int* t, const int* cnt, int tid) {
    if (tid == 0) { int acc = 0; t[0] = 0;
        for (int j = 0; j < 16; ++j) { const int c = __hip_atomic_load(cnt + j * 64, __ATOMIC_RELAXED, __HIP_MEMORY_SCOPE_AGENT); t[17 + j] = c; acc += (c + 255) >> 8; t[j + 1] = acc; } }
    __syncthreads();
}
struct SchedMoe1 {
    MoeTab tab; int G, c; const FK_LAS unsigned* xo;
    __device__ __forceinline__ bool next(int i, Unit& u) const {
        const int L = i * G + c; const int nun = tab.total_tiles() * 4;
        int e, mt, ce; tab.decode(L >> 2, e, mt, ce);
        u.a_off = 0; u.b_off = (unsigned)(WS_WGU + ((size_t)e * 1024 + (L & 3) * 256) * 1024 * 2); u.pm = L >> 2; u.pn = L & 3; u.kind = e; u.aux = i;
        return L < nun;
    }
    __device__ __forceinline__ unsigned row_off(const Unit& u, int r) const { return xo[u.aux * 256 + r]; }
};
struct EpiMoe1 {
    static constexpr bool PERM = false, AFTER_DRAIN = false;
    bf16_t* ACT; const FK_LAS float* xf;
    __device__ __forceinline__ void operator()(f32x4 (&acc)[2][2][4][2], const Unit& u, int wr, int wc, int fr, int fq, FK_LAS unsigned char*, int, int) const {
#pragma unroll
        for (int ai = 0; ai < 2; ++ai)
#pragma unroll
            for (int m = 0; m < 4; ++m) {
                const int r = ai * 128 + wr * 64 + m * 16 + fr;
                const float f1 = xf[u.aux * 512 + r], f2 = xf[u.aux * 512 + 256 + r];
                bf16_t* rowp = ACT + ((size_t)u.pm * 256 + r) * 512 + u.pn * 128 + wc * 32 + 4 * fq;
#pragma unroll
                for (int n = 0; n < 2; ++n) {
                    const f32x4 g = acc[ai][0][m][n] * f1, up = acc[ai][1][m][n] * f2; f32x4 a;
#pragma unroll
                    for (int i = 0; i < 4; ++i) a[i] = g[i] / (1.f + __expf(-g[i])) * up[i];
                    u32x2 w; w.x = pg8::cvt_pk_bf16(a[0], a[1]); w.y = pg8::cvt_pk_bf16(a[2], a[3]);
                    *(u32x2*)(rowp + 16 * n) = w;
                }
            }
    }
};
struct SchedMoe2 {
    MoeTab tab; int G, c;
    __device__ __forceinline__ bool next(int i, Unit& u) const {
        const int L = i * G + c; const int nun = tab.total_tiles() * 4;
        int e, mt, ce; tab.decode(L >> 2, e, mt, ce);
        u.a_off = (unsigned)(WS_ACT + (size_t)(L >> 2) * 256 * 512 * 2); u.b_off = (unsigned)(WS_WD + ((size_t)e * 1024 + (L & 3) * 256) * 512 * 2); u.pm = L >> 2; u.pn = L & 3; u.kind = e; u.aux = i;
        return L < nun;
    }
    __device__ __forceinline__ unsigned row_off(const Unit& u, int r) const { return u.a_off + (unsigned)r * 1024u; }
};
struct EpiMoe2 {
    static constexpr bool PERM = false, AFTER_DRAIN = false;
    bf16_t* YM; const FK_LAS int* xe;
    __device__ __forceinline__ void operator()(f32x4 (&acc)[2][2][4][2], const Unit& u, int wr, int wc, int fr, int fq, FK_LAS unsigned char*, int, int) const {
#pragma unroll
        for (int ai = 0; ai < 2; ++ai)
#pragma unroll
            for (int m = 0; m < 4; ++m) {
                const int r = ai * 128 + wr * 64 + m * 16 + fr;
                const int ent = xe[u.aux * 256 + r];
                if (ent >= 0) {
                    bf16_t* rowp = YM + (size_t)ent * 1024 + u.pn * 256 + wc * 32 + 4 * fq;
#pragma unroll
                    for (int bj = 0; bj < 2; ++bj)
#pragma unroll
                        for (int n = 0; n < 2; ++n) { const f32x4 x = acc[ai][bj][m][n]; u32x2 w; w.x = pg8::cvt_pk_bf16(x[0], x[1]); w.y = pg8::cvt_pk_bf16(x[2], x[3]);
                            *(u32x2*)(rowp + 128 * bj + 16 * n) = w; }
                }
            }
    }
};
__device__ __forceinline__ void final_phase(const Params& p, int vcu, int G, int lane, int wave) {
    const bf16_t* X2 = (const bf16_t*)(p.ws + WS_X1B); const bf16_t* YM = (const bf16_t*)p.out; const float* fg = p.in[33];
    const int gwv = vcu * NWAVES + wave, NGW = G * NWAVES;
    for (int t = gwv; t < T; t += NGW) {
        float v[16]; float ss = 0.f;
#pragma unroll
        for (int j = 0; j < 2; ++j) {
            const int k0 = j * 512 + lane * 8;
            const u32x4 a = *(const u32x4*)(X2 + (size_t)t * 1024 + k0), b = *(const u32x4*)(YM + (size_t)t * 2048 + k0), c = *(const u32x4*)(YM + (size_t)t * 2048 + 1024 + k0);
#pragma unroll
            for (int e = 0; e < 4; ++e) { v[j * 8 + 2 * e] = bflo(a[e]) + bflo(b[e]) + bflo(c[e]); v[j * 8 + 2 * e + 1] = bfhi(a[e]) + bfhi(b[e]) + bfhi(c[e]); }
        }
#pragma unroll
        for (int i = 0; i < 16; ++i) ss += v[i] * v[i];
        ss = wsum(ss);
        const float r = rsqrtf(ss * (1.f / 1024.f) + EPS);
        float* orow = p.out + (size_t)t * 1024;
#pragma unroll
        for (int j = 0; j < 2; ++j) {
            const int k0 = j * 512 + lane * 8;
            const f32x4 g0 = *(const f32x4*)(fg + k0), g1 = *(const f32x4*)(fg + k0 + 4);
            f32x4 o0, o1;
#pragma unroll
            for (int e = 0; e < 4; ++e) { o0[e] = v[j * 8 + e] * r * g0[e]; o1[e] = v[j * 8 + 4 + e] * r * g1[e]; }
            *(f32x4*)(orow + k0) = o0; *(f32x4*)(orow + k0 + 4) = o1;
        }
    }
}
__global__ void __launch_bounds__(NTHREADS, 2) mk(Params p) {
    extern __shared__ __attribute__((aligned(16))) unsigned char lds_raw[];
    FK_LAS unsigned char* lds = (FK_LAS unsigned char*)lds_raw;
    const int tid = threadIdx.x, lane = tid & 63, wave = __builtin_amdgcn_readfirstlane(tid >> 6);
    const int G = gridDim.x, bx = blockIdx.x;
    const int vcu = (G % 8 == 0) ? (bx % 8) * (G / 8) + bx / 8 : bx;
    unsigned char* ws = p.ws;
    volatile FK_LAS unsigned* bst = (volatile FK_LAS unsigned*)(lds + LDS_BYTES - 64);
    if (tid < 2) bst[tid] = 0u;
    __syncthreads();
    XcdBarrier bar = xcd_barrier_post((unsigned*)(ws + WS_CTL) + CW_BAR, bst);
#define IN(k) (p.ph_lo <= (k) && (k) < p.ph_hi)
#ifndef PROBE_PHASE
#define PROBE_PHASE -1
#define PROBE_N 1
#endif
#define REP(k) for (int rr_ = 0; rr_ < ((k) == PROBE_PHASE ? PROBE_N : 1); ++rr_)
#define REPBAR() do { if (rr_ > 0) xcd_barrier(bar); } while (0)
#define SEAM(k) do { if (IN(k) && IN((k) + 1)) xcd_barrier(bar); } while (0)
    if (IN(0)) REP(0) { REPBAR(); p0_prologue(p, lds, vcu, G, tid, lane, wave); }
    SEAM(0);
    if (IN(1)) REP(1) { REPBAR();
        Gemm g{(const char*)ws, 1024, 1024, 1024};
        SchedP1 S{G, bx};
        EpiP1 E{ws, p.in[4], p.in[5]};
        f32x4 acc[2][2][4][2];
        pg8::gemm_phase<EpiP1, SchedP1, true, true, false>(lds, g, S, E, acc);
    }
    SEAM(1);
    if (IN(2)) REP(2) { REPBAR();
        attn_body::attn_phase<8>((char*)lds_raw, (const attn_body::bf16*)(ws + WS_Q), (const attn_body::bf16*)(ws + WS_K), (const attn_body::bf16*)(ws + WS_V),
                                 (attn_body::bf16*)(ws + WS_YCAT), (float*)(ws + WS_SSATT), G, vcu);
    }
    SEAM(2);
    if (IN(3)) REP(3) { REPBAR();
        for (int L = bx; L < 64; L += G) {
            const int g = L >> 1, mt = L & 1;
            Gemm gm{(const char*)ws, SUP, 512, 512};
            SchedOne S{mk_unit((unsigned)(WS_SU + (((size_t)g * SROWS + mt * 256) * SUP + 256) * 2), (unsigned)(WS_W1 + (size_t)g * 256 * 512 * 2), mt, 0, 0), SUP * 2};
            EpiSloc E{(float*)(ws + WS_SLOC) + (size_t)g * SROWS * 256};
            f32x4 acc[2][2][4][2];
            pg8::gemm_phase<EpiSloc, SchedOne, false, true, false>(lds, gm, S, E, acc);
        }
    }
    SEAM(3);
    if (IN(4)) REP(4) { REPBAR();
        for (int L = bx; L < 128; L += G) {
            const int g = L >> 2, mt = (L >> 1) & 1, ntile = L & 1;
            s5_scan(p, g, mt, tid);
            asm volatile("s_waitcnt vmcnt(0)" ::: "memory"); __syncthreads();
            Gemm gm{(const char*)ws, SUP, SUP, SUP};
            SchedOne S{mk_unit((unsigned)(WS_SU + ((size_t)g * SROWS + mt * 256) * SUP * 2), (unsigned)(WS_W2 + ((size_t)g * 512 + ntile * 256) * SUP * 2), mt, ntile, 0), SUP * 2};
            EpiS5Out E{(bf16_t*)(ws + WS_Z), g, mt, ntile};
            f32x4 acc[2][2][4][2];
            pg8::gemm_phase<EpiS5Out, SchedOne, false, true, false>(lds, gm, S, E, acc);
        }
    }
    SEAM(4);
    if (IN(5)) REP(5) { REPBAR();
        for (int L = bx; L < 128; L += G) {
            int pm, pn; pg8::tile_order(L, 64, 2, pm, pn);
            Gemm gm{(const char*)ws, 512, 512, 512};
            SchedOne S{mk_unit((unsigned)(WS_Z + (size_t)pm * 256 * 512 * 2), (unsigned)(WS_GLU + (size_t)pn * 256 * 512 * 2), pm, pn, 0), 512 * 2};
            EpiGlu E{(const bf16_t*)(ws + WS_Z), (bf16_t*)(ws + WS_YCAT), (float*)(ws + WS_SSSSM), p.in[15]};
            f32x4 acc[2][2][4][2];
            pg8::gemm_phase<EpiGlu, SchedOne, false, true, false>(lds, gm, S, E, acc);
        }
    }
    SEAM(5);
    if (IN(6)) REP(6) { REPBAR();
        for (int L = bx; L < 256; L += G) {
            int pm, pn; pg8::tile_order(L, 64, 4, pm, pn);
            Gemm gm{(const char*)ws, 1024, 1024, 512};
            const unsigned a0 = (unsigned)(WS_YCAT + (size_t)pm * 256 * 1024 * 2), b0 = (unsigned)(WS_WOUT + (size_t)pn * 256 * 1024 * 2);
            f32x4 acc[2][2][4][2];
            FK_LAS float* xt = (FK_LAS float*)(lds + XTRA_OFF);
            { int t2 = threadIdx.x; asm volatile("" : "+v"(t2));
              if (t2 < 256) { const size_t row = (size_t)pm * 256 + t2; const float ra = rs8((const float*)(ws + WS_SSATT), row, 1.f / 512.f), rs = rs8((const float*)(ws + WS_SSSSM), row, 1.f / 512.f); xt[t2] = ra / rs; xt[256 + t2] = rs; }
              __syncthreads(); }
            { SchedOne S{mk_unit(a0, b0, pm, pn, 0), 2048}; EpiWoutMid E{xt};
              pg8::gemm_phase<EpiWoutMid, SchedOne, false, true, false>(lds, gm, S, E, acc); }
            { SchedOne S{mk_unit(a0 + 1024, b0 + 1024, pm, pn, 0), 2048}; EpiWoutFin E{xt, (const bf16_t*)(ws + WS_XB), (bf16_t*)(ws + WS_X1B), (float*)(ws + WS_SSX1)};
              pg8::gemm_phase<EpiWoutFin, SchedOne, false, true, true>(lds, gm, S, E, acc); }
        }
    }
    SEAM(6);
    if (IN(7)) REP(7) { REPBAR();
        for (int L = bx; L < 256; L += G) {
            int pm, pn; pg8::tile_order(L, 64, 4, pm, pn);
            const int b = pm >> 3;
            FK_LAS float* xt = (FK_LAS float*)(lds + XTRA_OFF);
            { int t2 = threadIdx.x; asm volatile("" : "+v"(t2));
              if (t2 < 256) { const float* s1 = (const float*)(ws + WS_SSX1) + ((size_t)pm * 256 + t2) * 16; const f32x4 a = *(const f32x4*)s1, b4 = *(const f32x4*)(s1 + 4), c = *(const f32x4*)(s1 + 8), d = *(const f32x4*)(s1 + 12);
                  xt[t2] = rsqrtf((((a[0] + a[1]) + (a[2] + a[3])) + ((b4[0] + b4[1]) + (b4[2] + b4[3])) + ((c[0] + c[1]) + (c[2] + c[3])) + ((d[0] + d[1]) + (d[2] + d[3]))) * (1.f / 1024.f) + EPS); }
              __syncthreads(); }
            const size_t tile = ((size_t)pm * 256 * 1024 + pn * 256) * 2;
            f32x4 acc[2][2][4][2];
            { Gemm gm{(const char*)ws, 1024, 1024, 1024};
              SchedOne S{mk_unit((unsigned)(WS_X1B + (size_t)pm * 256 * 1024 * 2), (unsigned)(WS_WQ + (size_t)pn * 256 * 1024 * 2), pm, pn, 0), 2048};
              EpiScaleBf16 E{(bf16_t*)(ws + WS_QX + tile), 1024, xt, XQSCALE};
              pg8::gemm_phase<EpiScaleBf16, SchedOne, false, true, false>(lds, gm, S, E, acc); }
            asm volatile("s_waitcnt vmcnt(0)" ::: "memory"); __syncthreads();
            { Gemm gm{(const char*)ws, 1024, 1024, 256};
              SchedOne S{mk_unit((unsigned)(WS_QX + tile), (unsigned)(WS_KM + ((size_t)b * 256 * 1024 + pn * 256) * 2), pm, pn, 0), 2048};
              EpiSoftmax E{(bf16_t*)(ws + WS_PB + tile), 1024};
              pg8::gemm_phase<EpiSoftmax, SchedOne, false, true, false>(lds, gm, S, E, acc); }
            asm volatile("s_waitcnt vmcnt(0)" ::: "memory"); __syncthreads();
            { Gemm gm{(const char*)ws, 1024, 256, 256};
              SchedOne S{mk_unit((unsigned)(WS_PB + tile), (unsigned)(WS_VT + ((size_t)b * 1024 + pn * 256) * 256 * 2), pm, pn, 0), 2048};
              EpiScaleBf16 E{(bf16_t*)(ws + WS_QX + tile), 1024, nullptr, 1.f};
              pg8::gemm_phase<EpiScaleBf16, SchedOne, false, true, false>(lds, gm, S, E, acc); }
        }
    }
    SEAM(7);
    if (IN(8)) REP(8) { REPBAR();
        for (int L = bx; L < 256; L += G) {
            int pm, pn; pg8::tile_order(L, 64, 4, pm, pn);
            const size_t tile = ((size_t)pm * 256 * 1024 + pn * 256) * 2;
            Gemm gm{(const char*)ws, 1024, 1024, 1024};
            SchedOne S{mk_unit((unsigned)(WS_QX + (size_t)pm * 256 * 1024 * 2), (unsigned)(WS_WO + (size_t)pn * 256 * 1024 * 2), pm, pn, 0), 2048};
            EpiResid E{(bf16_t*)(ws + WS_X1B + tile), 1024};
            f32x4 acc[2][2][4][2];
            pg8::gemm_phase<EpiResid, SchedOne, false, true, false>(lds, gm, S, E, acc);
        }
    }
    SEAM(8);
    if (IN(9)) REP(9) { REPBAR(); router_phase(p, lds, vcu, G, tid, lane, wave); }
    SEAM(9);
    if (IN(10)) REP(10) { REPBAR();
        FK_LAS int* tabp = (FK_LAS int*)(lds + XTRA_OFF + 15 * 1024); moe_tab_init(tabp, (const int*)(ws + WS_CTL) + CW_CNT, threadIdx.x); MoeTab tab{tabp};
        FK_LAS unsigned* xo = (FK_LAS unsigned*)(lds + XTRA_OFF);
        FK_LAS float* xf = (FK_LAS float*)(lds + XTRA_OFF + 5 * 1024);
        { int t2 = threadIdx.x; asm volatile("" : "+v"(t2));
          const int nun = tab.total_tiles() * 4; int i = 0;
          for (int L = bx; L < nun && i < 5; L += G, ++i) {
              if (t2 < 256) { int e, mt, ce; tab.decode(L >> 2, e, mt, ce); const int idx = mt * 256 + t2; const bool valid = idx < ce;
                  const int ent = valid ? ((const int*)(ws + WS_LIST))[e * T + idx] : 0; const int tok = ent >> 1;
                  xo[i * 256 + t2] = (unsigned)(WS_X1B + (size_t)tok * 2048);
                  const float r2 = ((const float*)(ws + WS_R2))[tok];
                  xf[i * 512 + t2] = r2; xf[i * 512 + 256 + t2] = valid ? r2 * ((const float*)(ws + WS_WL))[e * T + idx] : 0.f; }
          }
          __syncthreads(); }
        Gemm gm{(const char*)ws, 1024, 1024, 1024};
        SchedMoe1 S{tab, G, bx, xo};
        EpiMoe1 E{(bf16_t*)(ws + WS_ACT), xf};
        f32x4 acc[2][2][4][2];
        pg8::gemm_phase<EpiMoe1, SchedMoe1, true, true, false>(lds, gm, S, E, acc);
    }
    SEAM(10);
    if (IN(11)) REP(11) { REPBAR();
        FK_LAS int* tabp = (FK_LAS int*)(lds + XTRA_OFF + 15 * 1024); moe_tab_init(tabp, (const int*)(ws + WS_CTL) + CW_CNT, threadIdx.x); MoeTab tab{tabp};
        FK_LAS int* xe = (FK_LAS int*)(lds + XTRA_OFF);
        { int t2 = threadIdx.x; asm volatile("" : "+v"(t2));
          const int nun = tab.total_tiles() * 4; int i = 0;
          for (int L = bx; L < nun && i < 5; L += G, ++i) {
              if (t2 < 256) { int e, mt, ce; tab.decode(L >> 2, e, mt, ce); const int idx = mt * 256 + t2;
                  xe[i * 256 + t2] = idx < ce ? ((const int*)(ws + WS_LIST))[e * T + idx] : -1; }
          }
          __syncthreads(); }
        Gemm gm{(const char*)ws, 512, 512, 512};
        SchedMoe2 S{tab, G, bx};
        EpiMoe2 E{(bf16_t*)p.out, xe};
        f32x4 acc[2][2][4][2];
        pg8::gemm_phase<EpiMoe2, SchedMoe2, true, true, false>(lds, gm, S, E, acc);
    }
    SEAM(11);
    if (IN(12)) REP(12) { REPBAR(); final_phase(p, vcu, G, lane, wave); }
#undef SEAM
#undef IN
}

}
extern "C" void kernel_launch(void* const* d_in, const int* in_sizes, int n_in, void* d_out, int out_size, void* d_ws, size_t ws_size, hipStream_t stream) {
    static int grid = 0;
    if (grid == 0) {
        int dev = 0, cus = 0, per_cu = 0;
        (void)hipGetDevice(&dev);
        (void)hipDeviceGetAttribute(&cus, hipDeviceAttributeMultiprocessorCount, dev);
        (void)hipFuncSetAttribute((const void*)fk::mk, hipFuncAttributeMaxDynamicSharedMemorySize, fk::LDS_BYTES);
        (void)hipOccupancyMaxActiveBlocksPerMultiprocessor(&per_cu, (const void*)fk::mk, fk::NTHREADS, fk::LDS_BYTES);
        if (per_cu < 1 || cus < 1 || ws_size < fk::WS_END) { fprintf(stderr, "kernel_launch: cus %d per_cu %d ws %zu: cannot launch\n", cus, per_cu, ws_size); grid = -1; }
        else grid = cus;
    }
    if (grid < 0) return;
    (void)hipMemsetAsync(d_ws, 0, 1u << 20, stream);
    fk::Params p{};
    for (int i = 0; i < 34; ++i) p.in[i] = (const float*)d_in[i];
    p.out = (float*)d_out; p.ws = (unsigned char*)d_ws; p.ph_lo = 0; p.ph_hi = 13;
    void* args[] = {&p};
    hipError_t e = hipLaunchCooperativeKernel((const void*)fk::mk, dim3(grid), dim3(fk::NTHREADS), args, fk::LDS_BYTES, stream);
    if (e != hipSuccess) fprintf(stderr, "cooperative launch failed: %s (grid %d)\n", hipGetErrorString(e), grid);
}
```

```cpp
#include <hip/hip_runtime.h>
#include <hip/hip_bf16.h>
#include <cmath>
#include <stdint.h>
#include <stdio.h>
#include <hip/hip_cooperative_groups.h>
namespace fk {
namespace cg = cooperative_groups;
#define FK_LAS __attribute__((address_space(3)))
#define FK_GAS __attribute__((address_space(1)))
typedef unsigned short bf16_t;
typedef short bf16x8 __attribute__((ext_vector_type(8)));
typedef float f32x4 __attribute__((ext_vector_type(4)));
typedef float f32x2 __attribute__((ext_vector_type(2)));
typedef unsigned u32x4 __attribute__((ext_vector_type(4)));
typedef unsigned u32x2 __attribute__((ext_vector_type(2)));

constexpr int T = 16384, SEQ = 2048, BATCH = 8, DM = 1024, MEMLEN = 256, MTOK = BATCH * MEMLEN;
constexpr float EPS = 1e-6f;
constexpr float LOG2E = 1.4426950408889634f;
constexpr float QSCALE = 0.125f * LOG2E;
constexpr float XQSCALE = 0.0625f * LOG2E;
constexpr int NWAVES = 8, NTHREADS = 512;
constexpr int SL = 32, NCH = SEQ / SL;
constexpr int SUP = 768;
constexpr int SROWS = BATCH * NCH;

constexpr size_t MiB = 1u << 20;
constexpr size_t WS_CTL = 0;
constexpr size_t WS_WIN = 1 * MiB;
constexpr size_t WS_GLU = 4 * MiB;
constexpr size_t WS_WOUT = 5 * MiB;
constexpr size_t WS_WQ = 7 * MiB, WS_WK = 9 * MiB, WS_WV = 11 * MiB, WS_WO = 13 * MiB;
constexpr size_t WS_W1 = 15 * MiB;
constexpr size_t WS_W2 = 23 * MiB;
constexpr size_t WS_WGU = 47 * MiB;
constexpr size_t WS_WD = 79 * MiB;
constexpr size_t WS_R0 = 95 * MiB;
constexpr size_t WS_ROPE = WS_R0 + 65536;
constexpr size_t WS_R2 = WS_ROPE + 65536;
constexpr size_t WS_RWT = 95 * MiB + 256 * 1024;
constexpr size_t WS_SSATT = 95 * MiB + 512 * 1024;
constexpr size_t WS_SSSSM = 96 * MiB;
constexpr size_t WS_SSX1 = 96 * MiB + 512 * 1024;
constexpr size_t WS_LIST = 102 * MiB;
constexpr size_t WS_WL = 103 * MiB;
constexpr size_t WS_XB = 105 * MiB;
constexpr size_t WS_HM = 137 * MiB;
constexpr size_t WS_Q = 141 * MiB;
constexpr size_t WS_K = 157 * MiB;
constexpr size_t WS_V = 161 * MiB;
constexpr size_t WS_SU = 165 * MiB;
constexpr size_t WS_SLOC = 189 * MiB;
constexpr size_t WS_KM = 205 * MiB;
constexpr size_t WS_VT = 209 * MiB;
constexpr size_t WS_YCAT = 213 * MiB;
constexpr size_t WS_END = 245 * MiB;
constexpr size_t WS_Z = WS_Q, WS_X1B = WS_SU, WS_QX = WS_XB, WS_PB = WS_YCAT, WS_ACT = WS_XB;
constexpr int CW_CNT = 64;
constexpr int CW_BAR = 4096;

constexpr int RING_BYTES = 131072, XTRA_OFF = RING_BYTES, LDS_BYTES = 147456;

__device__ __forceinline__ unsigned f2bf(float f) { unsigned u = __builtin_bit_cast(unsigned, f); return (u + 0x7fffu + ((u >> 16) & 1u)) >> 16; }
__device__ __forceinline__ unsigned pk2(float lo, float hi) { return f2bf(lo) | (f2bf(hi) << 16); }
__device__ __forceinline__ float bf2f(unsigned short b) { return __builtin_bit_cast(float, (unsigned)b << 16); }
__device__ __forceinline__ float bflo(unsigned w) { return __builtin_bit_cast(float, w << 16); }
__device__ __forceinline__ float bfhi(unsigned w) { return __builtin_bit_cast(float, w & 0xffff0000u); }
__device__ __forceinline__ float wsum(float v) {
#pragma unroll
    for (int o = 1; o < 64; o <<= 1) v += __shfl_xor(v, o);
    return v;
}

namespace pg8 {
constexpr int BM = 256, BK = 64, HALF = 128, HTB = HALF * BK * 2, STAGE_BYTES = 8 * HTB, NXCD = 8, WGM = 8;
__host__ __device__ __forceinline__ int lds_byte(int r, int c) { const int st = (r >> 4) * 2 + (c >> 5), rr = r & 15, cc = c & 31, ob = rr * 64 + cc * 2; return st * 1024 + (ob ^ (((ob >> 9) & 1) << 5)); }
__host__ __device__ __forceinline__ void stage_rc(int b, int& R, int& C) { const int st = b / 1024, sb = b % 1024, swz = sb ^ (((sb >> 9) & 1) << 5); R = (st >> 1) * 16 + swz / 64; C = (st & 1) * 32 + (swz % 64) / 2; }
__host__ __device__ __forceinline__ int perm32(int rho) { const int n = rho >> 4, i = rho & 15; return 8 * (i >> 2) + 4 * n + (i & 3); }

struct Unit { unsigned a_off, b_off; int pm, pn, kind, aux; };
struct Gemm { const char* base; int lda, ldb, K; };

__device__ __forceinline__ void tile_order(int L, int nM, int nN, int& pm, int& pn) {
    const int nwg = nM * nN; int wgid = L;
    { const int q = nwg / NXCD, r = nwg % NXCD, xcd = wgid % NXCD, off = wgid / NXCD; wgid = (xcd < r ? xcd * (q + 1) : r * (q + 1) + (xcd - r) * q) + off; }
    const int nig = WGM * nN, gid = wgid / nig, fm = gid * WGM, gsz = (nM - fm) < WGM ? (nM - fm) : WGM;
    pm = fm + ((wgid % nig) % gsz); pn = (wgid % nig) / gsz;
}

__device__ __forceinline__ unsigned cvt_pk_bf16(float lo, float hi) { unsigned r; asm volatile("v_cvt_pk_bf16_f32 %0, %1, %2" : "=v"(r) : "v"(lo), "v"(hi)); return r; }

template <class Epi, class Sched, bool ALIGN_EPI, bool SP2, bool KEEP_ACC>
__device__ __forceinline__ void gemm_phase(FK_LAS unsigned char* lds, const Gemm g, const Sched& S, const Epi& E, f32x4 (&acc)[2][2][4][2]) {
    int tid_ = threadIdx.x; asm volatile("" : "+v"(tid_));
    const int tid = tid_, wid = __builtin_amdgcn_readfirstlane(tid >> 6), lane = tid & 63, wr = wid >> 2, wc = wid & 3, fr = lane & 15, fq = lane >> 4;
    const int K = g.K, nt = K / BK;
    int R0, C0; stage_rc(tid * 16, R0, C0);
    unsigned voffB[2];
#pragma unroll
    for (int i = 0; i < 2; ++i) { const int R = R0 + 64 * i; const int Rb = Epi::PERM ? ((R & ~31) + perm32(R & 31)) : R; voffB[i] = (unsigned)(Rb * g.ldb + C0) * 2u; }
    const size_t kstep = (size_t)(BK * 2);
    const size_t hstepB = (size_t)HALF * g.ldb * 2;
    const unsigned ldsw = (unsigned)wid * 1024u;
    const int aoff = lds_byte(wr * 64 + fr, fq * 8), boff = lds_byte(wc * 32 + fr, fq * 8);
#define PG8_SA(b, h) (((b) * 2 + (h)) * HTB)
#define PG8_SB(b, h) ((4 + (b) * 2 + (h)) * HTB)
#define PG8_STAGE(bufoff, gbase, voff) do { _Pragma("unroll") for (int _i = 0; _i < 2; ++_i) \
        __builtin_amdgcn_global_load_lds((const unsigned*)((const char*)(gbase) + (voff)[_i]), (FK_LAS unsigned*)(lds + (bufoff) + ldsw + _i * 8192), 16, 0, 0); } while (0)
#define PG8_STAGEA(bufoff, gbase, h) do { _Pragma("unroll") for (int _i = 0; _i < 2; ++_i) \
        __builtin_amdgcn_global_load_lds((const unsigned*)((const char*)(gbase) + voffA[2 * (h) + _i]), (FK_LAS unsigned*)(lds + (bufoff) + ldsw + _i * 8192), 16, 0, 0); } while (0)
#define PG8_LDA(dst, b, h) do { _Pragma("unroll") for (int m = 0; m < 4; ++m) _Pragma("unroll") for (int k = 0; k < 2; ++k) dst[m][k] = *(const FK_LAS bf16x8*)(lds + PG8_SA(b, h) + aoff + m * 2048 + k * 1024); } while (0)
#define PG8_LDB(dst, b, h) do { _Pragma("unroll") for (int n = 0; n < 2; ++n) _Pragma("unroll") for (int k = 0; k < 2; ++k) dst[n][k] = *(const FK_LAS bf16x8*)(lds + PG8_SB(b, h) + boff + n * 2048 + k * 1024); } while (0)
#define PG8_MMA(ai, bj, At, Bt) do { __builtin_amdgcn_s_setprio(1); _Pragma("unroll") for (int m = 0; m < 4; ++m) _Pragma("unroll") for (int n = 0; n < 2; ++n) _Pragma("unroll") for (int k = 0; k < 2; ++k) \
        acc[ai][bj][m][n] = __builtin_amdgcn_mfma_f32_16x16x32_bf16(Bt[n][k], At[m][k], acc[ai][bj][m][n], 0, 0, 0); __builtin_amdgcn_s_setprio(0); } while (0)
#define PG8_WAIT_V(n) asm volatile("s_waitcnt vmcnt(" #n ")" ::: "memory")
#define PG8_WAIT_L(n) asm volatile("s_waitcnt lgkmcnt(" #n ")" ::: "memory")
#define PG8_BAR __builtin_amdgcn_s_barrier()
#define PG8_SCHED __builtin_amdgcn_sched_barrier(0)
    Unit cur, nxt; int ui = 0;
    if (!S.next(0, cur)) return;
    if constexpr (!KEEP_ACC) {
#pragma unroll
        for (int a = 0; a < 2; ++a)
#pragma unroll
            for (int b = 0; b < 2; ++b)
#pragma unroll
                for (int m = 0; m < 4; ++m)
#pragma unroll
                    for (int n = 0; n < 2; ++n) acc[a][b][m][n] = (f32x4){0.f, 0.f, 0.f, 0.f};
    }
    bf16x8 At[4][2], B0[2][2], B1[2][2];
    unsigned voffA[4];
#pragma unroll
    for (int q = 0; q < 4; ++q) voffA[q] = S.row_off(cur, R0 + 64 * q) + (unsigned)C0 * 2u;
    const char* Ab = g.base;
    const char* cB = g.base + cur.b_off;
    if constexpr (SP2) {
        PG8_STAGE(PG8_SB(0, 0), cB, voffB); PG8_STAGE(PG8_SB(0, 1), cB + hstepB, voffB); PG8_STAGEA(PG8_SA(0, 0), Ab, 0); PG8_STAGEA(PG8_SA(0, 1), Ab, 1);
        if (wr == 1) PG8_BAR;
        PG8_WAIT_V(2); PG8_BAR;
        PG8_STAGE(PG8_SB(1, 0), cB + kstep, voffB); PG8_STAGEA(PG8_SA(1, 0), Ab + kstep, 0); PG8_STAGE(PG8_SB(1, 1), cB + hstepB + kstep, voffB);
        PG8_WAIT_V(6); PG8_BAR;
    } else {
        PG8_STAGE(PG8_SB(0, 0), cB, voffB); PG8_STAGEA(PG8_SA(0, 0), Ab, 0); PG8_STAGE(PG8_SB(0, 1), cB + hstepB, voffB); PG8_STAGEA(PG8_SA(0, 1), Ab, 1);
        if (wr == 1) PG8_BAR;
        PG8_WAIT_V(4); PG8_BAR;
        PG8_STAGE(PG8_SB(1, 0), cB + kstep, voffB); PG8_STAGEA(PG8_SA(1, 0), Ab + kstep, 0); PG8_STAGE(PG8_SB(1, 1), cB + hstepB + kstep, voffB);
        PG8_WAIT_V(6); PG8_BAR;
    }
    for (;;) {
        const bool has_next = S.next(ui + 1, nxt);
        const char* nB = has_next ? g.base + nxt.b_off : cB;
        for (int t = 0; t < nt; t += 2) {
            const bool last = (t == nt - 2);
            const char* a1 = Ab + (size_t)(t + 1) * kstep;
            const char* a2 = last ? Ab : Ab + (size_t)(t + 2) * kstep; const char* b2 = last ? nB : cB + (size_t)(t + 2) * kstep;
            const char* a3 = a2 + kstep; const char* b3 = b2 + kstep;
            if constexpr (SP2) {
            PG8_LDB(B0, 0, 0); PG8_LDB(B1, 0, 1); PG8_SCHED; PG8_LDA(At, 0, 0); PG8_STAGEA(PG8_SA(1, 1), a1, 1);
            if (last && has_next) {
#pragma unroll
                for (int q = 0; q < 4; ++q) voffA[q] = S.row_off(nxt, R0 + 64 * q) + (unsigned)C0 * 2u;
            }
            PG8_WAIT_V(8); PG8_WAIT_L(0); PG8_BAR; PG8_MMA(0, 0, At, B0); PG8_MMA(0, 1, At, B1); PG8_BAR; PG8_SCHED;
            PG8_LDA(At, 0, 1); PG8_STAGE(PG8_SB(0, 0), b2, voffB); PG8_STAGE(PG8_SB(0, 1), b2 + hstepB, voffB); PG8_STAGEA(PG8_SA(0, 0), a2, 0);
            PG8_WAIT_V(8); PG8_WAIT_L(0); PG8_BAR; PG8_MMA(1, 0, At, B0); PG8_MMA(1, 1, At, B1); PG8_BAR; PG8_SCHED;
            PG8_LDB(B0, 1, 0); PG8_LDB(B1, 1, 1); PG8_SCHED; PG8_LDA(At, 1, 0); PG8_STAGEA(PG8_SA(0, 1), a2, 1);
            PG8_WAIT_V(8); PG8_WAIT_L(0); PG8_BAR; PG8_MMA(0, 0, At, B0); PG8_MMA(0, 1, At, B1); PG8_BAR; PG8_SCHED;
            PG8_LDA(At, 1, 1); PG8_STAGE(PG8_SB(1, 0), b3, voffB); PG8_STAGE(PG8_SB(1, 1), b3 + hstepB, voffB); PG8_STAGEA(PG8_SA(1, 0), a3, 0);
            PG8_WAIT_V(8); PG8_WAIT_L(0); PG8_BAR; PG8_MMA(1, 0, At, B0); PG8_MMA(1, 1, At, B1); PG8_BAR; PG8_SCHED;
            } else {
            PG8_LDB(B0, 0, 0); PG8_SCHED; PG8_LDA(At, 0, 0); PG8_STAGEA(PG8_SA(1, 1), a1, 1);
            if (last && has_next) {
#pragma unroll
                for (int q = 0; q < 4; ++q) voffA[q] = S.row_off(nxt, R0 + 64 * q) + (unsigned)C0 * 2u;
            }
            PG8_WAIT_L(8); PG8_BAR; PG8_WAIT_L(0); PG8_MMA(0, 0, At, B0); PG8_BAR; PG8_SCHED;
            PG8_LDB(B1, 0, 1); PG8_STAGE(PG8_SB(0, 0), b2, voffB);
            PG8_BAR; PG8_WAIT_L(0); PG8_MMA(0, 1, At, B1); PG8_BAR;
            PG8_LDA(At, 0, 1); PG8_STAGEA(PG8_SA(0, 0), a2, 0);
            PG8_BAR; PG8_WAIT_L(0); PG8_MMA(1, 0, At, B0); PG8_BAR; PG8_SCHED;
            PG8_STAGE(PG8_SB(0, 1), b2 + hstepB, voffB);
            PG8_WAIT_V(6); PG8_BAR; PG8_MMA(1, 1, At, B1); PG8_BAR;
            PG8_LDB(B0, 1, 0); PG8_SCHED; PG8_LDA(At, 1, 0); PG8_STAGEA(PG8_SA(0, 1), a2, 1);
            PG8_WAIT_L(8); PG8_BAR; PG8_WAIT_L(0); PG8_MMA(0, 0, At, B0); PG8_BAR; PG8_SCHED;
            PG8_LDB(B1, 1, 1); PG8_STAGE(PG8_SB(1, 0), b3, voffB);
            PG8_BAR; PG8_WAIT_L(0); PG8_MMA(0, 1, At, B1); PG8_BAR;
            PG8_LDA(At, 1, 1); PG8_STAGEA(PG8_SA(1, 0), a3, 0);
            PG8_BAR; PG8_WAIT_L(0); PG8_MMA(1, 0, At, B0); PG8_BAR; PG8_SCHED;
            PG8_STAGE(PG8_SB(1, 1), b3 + hstepB, voffB);
            PG8_WAIT_V(6); PG8_BAR; PG8_MMA(1, 1, At, B1); PG8_BAR;
            }
        }
        if constexpr (ALIGN_EPI) { if (wr == 0) PG8_BAR; }
        if constexpr (!Epi::AFTER_DRAIN) { int fr_e = fr, fq_e = fq, lane_e = lane; asm volatile("" : "+v"(fr_e), "+v"(fq_e), "+v"(lane_e)); E(acc, cur, wr, wc, fr_e, fq_e, lds, wid, lane_e); }
        if (!has_next) break;
#pragma unroll
        for (int a = 0; a < 2; ++a)
#pragma unroll
            for (int b = 0; b < 2; ++b)
#pragma unroll
                for (int m = 0; m < 4; ++m)
#pragma unroll
                    for (int n = 0; n < 2; ++n) acc[a][b][m][n] = (f32x4){0.f, 0.f, 0.f, 0.f};
        cur = nxt; cB = nB; ++ui;
        if constexpr (ALIGN_EPI) { if (wr == 1) PG8_BAR; }
    }
    PG8_WAIT_V(0);
    if constexpr (!ALIGN_EPI) { if (wr == 0) PG8_BAR; }
    PG8_BAR;
    if constexpr (Epi::AFTER_DRAIN) { int fr_e = fr, fq_e = fq, lane_e = lane; asm volatile("" : "+v"(fr_e), "+v"(fq_e), "+v"(lane_e)); E(acc, cur, wr, wc, fr_e, fq_e, lds, wid, lane_e); }
#undef PG8_SA
#undef PG8_SB
#undef PG8_STAGE
#undef PG8_STAGEA
#undef PG8_LDA
#undef PG8_LDB
#undef PG8_MMA
#undef PG8_WAIT_V
#undef PG8_WAIT_L
#undef PG8_BAR
#undef PG8_SCHED
}
}
namespace attn_body {
using bf16=__hip_bfloat16;
using bf16x8=__attribute__((ext_vector_type(8)))short;
using s16x4=__attribute__((ext_vector_type(4)))short;
using f32x16=__attribute__((ext_vector_type(16)))float;
using u32x4=__attribute__((ext_vector_type(4)))unsigned;
constexpr int BATCH=8,NHEAD=8,SEQ=2048,D=64,QP=512,KP=128,OP=1024;
constexpr int NW=8,QBLK=32,QB=QBLK*NW,KVBLK=64,NQB=SEQ/QB;
constexpr int ATTN_UNIT_ROWS=QB;
__device__ __forceinline__ int crow(int r,int hi){return (r&3)+8*(r>>2)+4*hi;}
#define SBAR() __builtin_amdgcn_sched_barrier(0)
__device__ __forceinline__ void cmask(f32x16&p0,f32x16&p1,int jb,int qrel,int hi){
  const float NEG=-INFINITY; int kb=64*jb+4*hi;
  #pragma unroll
  for(int r=0;r<16;++r){int kv=kb+(r&3)+8*(r>>2); if(kv>qrel)p0[r]=NEG; if(kv+32>qrel)p1[r]=NEG;}
}

constexpr int NSLOT=3, SLOTB=8192;
constexpr int LDS_K=0, LDS_V=NSLOT*SLOTB, LDS_WS=2*NSLOT*SLOTB, LDS_OST=LDS_WS+NW*64*4, LDS_BYTES=LDS_OST+NW*4096;
constexpr float C2=0.125f*1.4426950408889634f;
__device__ __forceinline__ void glds16(const void*gsrc,unsigned lds_dst){unsigned keep;
  asm volatile("s_mov_b32 %0, m0\n\ts_mov_b32 m0, %2\n\ts_nop 0\n\tglobal_load_lds_dwordx4 %1, off\n\ts_mov_b32 m0, %0":"=&s"(keep):"v"(gsrc),"s"(lds_dst):"memory");}
__device__ __forceinline__ float max3f(float a,float b,float c){float r;asm("v_max3_f32 %0, %1, %2, %3":"=v"(r):"v"(a),"v"(b),"v"(c));return r;}
__device__ __forceinline__ float max2f(float a,float b){float r;asm("v_max_f32_e32 %0, %1, %2":"=v"(r):"v"(a),"v"(b));return r;}
__device__ __forceinline__ float fadd_s(float a,float b){float r;asm("v_add_f32_e32 %0, %1, %2":"=v"(r):"v"(a),"v"(b));return r;}
__device__ __forceinline__ float fsub_s(float a,float b){float r;asm("v_sub_f32_e32 %0, %1, %2":"=v"(r):"v"(a),"v"(b));return r;}
typedef float f32x2_t __attribute__((ext_vector_type(2))); typedef __bf16 bf16x2_t __attribute__((ext_vector_type(2)));
__device__ __forceinline__ unsigned cvtpk_s(float lo,float hi){f32x2_t v={lo,hi};bf16x2_t b=__builtin_convertvector(v,bf16x2_t);return __builtin_bit_cast(unsigned,b);}
#define WAIT_BAR(N) asm volatile("s_waitcnt vmcnt(" #N ") lgkmcnt(0)\n\ts_barrier":::"memory")

__device__ __forceinline__ void qkt(f32x16&p0,f32x16&p1,const char*Kslot,const bf16x8*qr,const f32x16&negm,int r32,int hi){
  const char*kb=Kslot+hi*1024+r32*16;
  #pragma unroll
  for(int d0=0;d0<4;++d0){
    const bf16x8 b0=*reinterpret_cast<const bf16x8*>(kb+d0*2048);
    const bf16x8 b1=*reinterpret_cast<const bf16x8*>(kb+d0*2048+512);
    if(d0==0){p0=__builtin_amdgcn_mfma_f32_32x32x16_bf16(b0,qr[0],negm,0,0,0);p1=__builtin_amdgcn_mfma_f32_32x32x16_bf16(b1,qr[0],negm,0,0,0);}
    else{p0=__builtin_amdgcn_mfma_f32_32x32x16_bf16(b0,qr[d0],p0,0,0,0);p1=__builtin_amdgcn_mfma_f32_32x32x16_bf16(b1,qr[d0],p1,0,0,0);}}
}
typedef __attribute__((address_space(3))) const char* lds_cptr;
typedef short v4i16_t __attribute__((ext_vector_type(4)));
__device__ __forceinline__ void kload8(bf16x8*kf,lds_cptr kp){
  kf[0]=*(const __attribute__((address_space(3))) bf16x8*)(kp);      kf[1]=*(const __attribute__((address_space(3))) bf16x8*)(kp+512);
  kf[2]=*(const __attribute__((address_space(3))) bf16x8*)(kp+2048); kf[3]=*(const __attribute__((address_space(3))) bf16x8*)(kp+2560);
  kf[4]=*(const __attribute__((address_space(3))) bf16x8*)(kp+4096); kf[5]=*(const __attribute__((address_space(3))) bf16x8*)(kp+4608);
  kf[6]=*(const __attribute__((address_space(3))) bf16x8*)(kp+6144); kf[7]=*(const __attribute__((address_space(3))) bf16x8*)(kp+6656);
}
__device__ __forceinline__ void kload2(bf16x8*kf,lds_cptr kp,int j){ kf[2*j]=*(const __attribute__((address_space(3))) bf16x8*)(kp+j*2048); kf[2*j+1]=*(const __attribute__((address_space(3))) bf16x8*)(kp+j*2048+512); }
__device__ __forceinline__ s16x4 vtr(lds_cptr p){ return __builtin_bit_cast(s16x4,__builtin_amdgcn_ds_read_tr16_b64_v4i16((__attribute__((address_space(3))) v4i16_t*)p)); }
__device__ __forceinline__ float rowmax(const f32x16&p0,const f32x16&p1){
  float a=max3f(p0[0],p0[1],p1[0]),b=max3f(p0[2],p0[3],p1[1]);a=max3f(a,p1[2],p1[3]);
  #pragma unroll
  for(int r=4;r<16;r+=4){a=max3f(a,p0[r],p0[r+1]);b=max3f(b,p0[r+2],p0[r+3]);a=max3f(a,p1[r],p1[r+1]);b=max3f(b,p1[r+2],p1[r+3]);}
  const float m=max2f(a,b);
  auto rr=__builtin_amdgcn_permlane32_swap(__float_as_uint(m),__float_as_uint(m),false,false);
  return max2f(__uint_as_float(rr[0]),__uint_as_float(rr[1]));
}
__device__ __forceinline__ void pv(f32x16*o,int vb,bf16x8 pa0,bf16x8 pa1,bf16x8 pa2,bf16x8 pa3){
  #pragma unroll
  for(int d0=0;d0<2;++d0){s16x4 lo[4],hi[4];
    #pragma unroll
    for(int ks=0;ks<4;++ks){
      asm volatile("ds_read_b64_tr_b16 %0,%1 offset:%c2":"=&v"(lo[ks]):"v"(vb),"i"(d0*4096+ks*1024):"memory");
      asm volatile("ds_read_b64_tr_b16 %0,%1 offset:%c2":"=&v"(hi[ks]):"v"(vb),"i"(d0*4096+ks*1024+512):"memory");}
    asm volatile("s_waitcnt lgkmcnt(0)":::"memory");SBAR();
    #define PK(k) (bf16x8){lo[k][0],lo[k][1],lo[k][2],lo[k][3],hi[k][0],hi[k][1],hi[k][2],hi[k][3]}
    o[d0]=__builtin_amdgcn_mfma_f32_32x32x16_bf16(pa0,PK(0),o[d0],0,0,0);
    o[d0]=__builtin_amdgcn_mfma_f32_32x32x16_bf16(pa1,PK(1),o[d0],0,0,0);
    o[d0]=__builtin_amdgcn_mfma_f32_32x32x16_bf16(pa2,PK(2),o[d0],0,0,0);
    o[d0]=__builtin_amdgcn_mfma_f32_32x32x16_bf16(pa3,PK(3),o[d0],0,0,0);
    #undef PK
  }
}

#ifndef ATTN_STORE16
#define ATTN_STORE16(p,v) (*(u32x4*)(p)=(v))
#endif
template<int THRL> __device__ __forceinline__ void attn_unit(int b,int h,int qb,const bf16*Q,const bf16*__restrict__ K,const bf16*__restrict__ V,bf16*O,float*SS,char*shm){
  const int tid=threadIdx.x,lane=tid&63,r32=lane&31,hi=lane>>5; const int wid=__builtin_amdgcn_readfirstlane(tid>>6);
  const long rowbase=(long)b*SEQ; const int q0=qb*QB;
  const bf16*Qw=Q+(rowbase+q0+wid*QBLK)*QP+h*D;
  const bf16*Kh=K+rowbase*KP+(h>>2)*D,*Vh=V+rowbase*KP+(h>>2)*D;
  const unsigned lds0=(unsigned)(uintptr_t)shm;
  float*wsf=(float*)(shm+LDS_WS)+wid*64;
  const bf16*ksrc=Kh+(long)lane*KP+wid*8;
  const bf16*vsrc=Vh+(long)(16*(wid&3)+(lane>>2))*KP+(wid>>2)*32+(lane&3)*8;
  const unsigned kdst=lds0+LDS_K+wid*1024, vdst=lds0+LDS_V+wid*1024;
  #define DMA_K(t,slot) glds16(ksrc+(long)(t)*KVBLK*KP,(unsigned)__builtin_amdgcn_readfirstlane(kdst+(slot)))
  #define DMA_V(t,slot) glds16(vsrc+(long)(t)*KVBLK*KP,(unsigned)__builtin_amdgcn_readfirstlane(vdst+(slot)))
  const int vb0=(int)(lds0+LDS_V)+((lane>>4)&1)*32+(lane&3)*8+(4*hi+((lane&15)>>2))*64;
  const char*Kbase=shm+LDS_K; bf16x8 kf[8];
  const lds_cptr shm3=(lds_cptr)shm; const lds_cptr kp0=shm3+LDS_K+hi*1024+r32*16; const lds_cptr vp0=shm3+LDS_V+((lane>>4)&1)*32+(lane&3)*8+(4*hi+((lane&15)>>2))*64;
  const int NT=SEQ/KVBLK;
  DMA_K(0,0);DMA_V(0,0);DMA_K(1,SLOTB);
  bf16x8 qr[4];
  #pragma unroll
  for(int d0=0;d0<4;++d0)qr[d0]=*reinterpret_cast<const bf16x8*>(&Qw[(long)r32*QP+d0*16+hi*8]);
  float mhat=0.f,l_reg=0.f;f32x16 o[2];o[0]=f32x16{};o[1]=f32x16{};f32x16 negm=f32x16{};asm volatile("":"+v"(negm));
  const int qrel=wid*QBLK+r32;
  #define CMASK(P0,P1,t) do{}while(0)
  bool resc=false;
  #define START(P0,P1) do{ const float rm=rowmax(P0,P1); resc=false; \
    { const float dl=rm; mhat=fadd_s(mhat,dl); \
      _Pragma("unroll") for(int r=0;r<16;++r){P0[r]=fsub_s(P0[r],dl);P1[r]=fsub_s(P1[r],dl);} \
      _Pragma("unroll") for(int r=0;r<16;++r)negm[r]=-mhat; asm volatile("":"+v"(negm)); } \
    _Pragma("unroll") for(int r=0;r<16;++r)P0[r]=__builtin_amdgcn_exp2f(P0[r]); }while(0)
  #define RESC() do{ if(resc){ asm volatile("s_waitcnt lgkmcnt(0)":::"memory"); \
      _Pragma("unroll") for(int d_=0;d_<2;++d_) _Pragma("unroll") for(int r=0;r<16;++r)o[d_][r]*=wsf[crow(r,hi)]; } }while(0)
  f32x16 pA0,pA1,pB0,pB1;
  int sl_prev=0,sl_cur=0,sl_next=SLOTB;
  #define ROT() do{sl_prev=sl_cur;sl_cur=sl_next;sl_next=(sl_next==(NSLOT-1)*SLOTB)?0:sl_next+SLOTB;}while(0)
  DMA_K(2,2*SLOTB);
  WAIT_BAR(3);
  qkt(pA0,pA1,Kbase,qr,negm,r32,hi);asm volatile("s_nop 15\n\ts_nop 7":"+v"(pA0),"+v"(pA1));CMASK(pA0,pA1,0);
  START(pA0,pA1);
  _Pragma("unroll") for(int r=0;r<16;++r)pA1[r]=__builtin_amdgcn_exp2f(pA1[r]);
  WAIT_BAR(0);
  DMA_K(3,0);DMA_V(1,SLOTB);
  ROT();
  kload8(kf,kp0+sl_cur);
  WAIT_BAR(2);
  s16x4 vlo[8],vhi[8]; u32x4 pw0,pw1,pw2,pw3;
  #define PKW(P,B) cvtpk_s(P[B],P[B+1])
  #define PAF(k) __builtin_bit_cast(bf16x8,pw##k)
  #define VFR(i) (bf16x8){vlo[i][0],vlo[i][1],vlo[i][2],vlo[i][3],vhi[i][0],vhi[i][1],vhi[i][2],vhi[i][3]}
  #define PIN(x) asm volatile("":"+v"(x))
  #define MX3(a,b,c) __builtin_fmaxf(__builtin_fmaxf((a),(b)),(c))
  #define GAPA(MF,A0,A1,A2,A3,W0,W1,PW) do{ MF; sacc+=A0; sacc+=A1; sacc+=A2; sacc+=A3; PIN(sacc); W0; W1; PIN(PW); SBAR(); }while(0)
  #define EX(v) __builtin_amdgcn_exp2f(v)
  #define GAPB(MF,X,B) do{ MF; X[B]=EX(X[B]); X[B+1]=EX(X[B+1]); X[B+2]=EX(X[B+2]); X[B+3]=EX(X[B+3]); PIN(X); SBAR(); }while(0)
  #define VRD(i) do{ vlo[i]=vtr(vp_+(((i)>>2)*4096+((i)&3)*1024)); vhi[i]=vtr(vp_+(((i)>>2)*4096+((i)&3)*1024+512)); }while(0)
  #define KRD(G,j) do{ if(G){ kload2(kf,kp0+sl_next,j); SBAR(); } }while(0)
  #define STEP(C0,C1,P0,P1,t,GK,GV,GL) do{ SBAR(); \
    const lds_cptr vp_=vp0+sl_prev; \
    VRD(0); SBAR(); float sacc=(P0[0]+P0[1]); \
    GAPA(C0=__builtin_amdgcn_mfma_f32_32x32x16_bf16(kf[0],qr[0],negm,0,0,0), P0[2],P0[3],P0[4],P0[5],     pw0[0]=PKW(P0,0), pw0[1]=PKW(P0,2), pw0); \
    VRD(4); SBAR(); GAPA(C1=__builtin_amdgcn_mfma_f32_32x32x16_bf16(kf[1],qr[0],negm,0,0,0), P0[6],P0[7],P0[8],P0[9],     pw0[2]=PKW(P0,4), pw0[3]=PKW(P0,6), pw0); \
    VRD(1); SBAR(); GAPA(C0=__builtin_amdgcn_mfma_f32_32x32x16_bf16(kf[2],qr[1],C0,0,0,0),   P0[10],P0[11],P0[12],P0[13], pw1[0]=PKW(P0,8), pw1[1]=PKW(P0,10), pw1); \
    VRD(5); SBAR(); GAPA(C1=__builtin_amdgcn_mfma_f32_32x32x16_bf16(kf[3],qr[1],C1,0,0,0),   P0[14],P0[15],P1[0],P1[1],   pw1[2]=PKW(P0,12),pw1[3]=PKW(P0,14), pw1); \
    VRD(2); SBAR(); GAPA(C0=__builtin_amdgcn_mfma_f32_32x32x16_bf16(kf[4],qr[2],C0,0,0,0),   P1[2],P1[3],P1[4],P1[5],     pw2[0]=PKW(P1,0), pw2[1]=PKW(P1,2), pw2); \
    VRD(6); SBAR(); GAPA(C1=__builtin_amdgcn_mfma_f32_32x32x16_bf16(kf[5],qr[2],C1,0,0,0),   P1[6],P1[7],P1[8],P1[9],     pw2[2]=PKW(P1,4), pw2[3]=PKW(P1,6), pw2); \
    VRD(3); SBAR(); GAPA(C0=__builtin_amdgcn_mfma_f32_32x32x16_bf16(kf[6],qr[3],C0,0,0,0),   P1[10],P1[11],P1[12],P1[13], pw3[0]=PKW(P1,8), pw3[1]=PKW(P1,10), pw3); \
    VRD(7); SBAR(); GAPA(C1=__builtin_amdgcn_mfma_f32_32x32x16_bf16(kf[7],qr[3],C1,0,0,0),   P1[14],P1[15],0.f,0.f,       pw3[2]=PKW(P1,12),pw3[3]=PKW(P1,14), pw3); \
    l_reg+=sacc; \
    if(GK){DMA_K((t)+3,sl_cur);} if(GV){DMA_V((t)+1,sl_next);} \
    CMASK(C0,C1,t); \
    { float a=MX3(C0[0],C0[1],C1[0]),b=MX3(C0[2],C0[3],C1[1]); a=MX3(a,C1[2],C1[3]); \
      _Pragma("unroll") for(int r=4;r<16;r+=4){a=MX3(a,C0[r],C0[r+1]);b=MX3(b,C0[r+2],C0[r+3]);a=MX3(a,C1[r],C1[r+1]);b=MX3(b,C1[r+2],C1[r+3]);} \
      float rm=__builtin_fmaxf(a,b); { auto rr=__builtin_amdgcn_permlane32_swap(__float_as_uint(rm),__float_as_uint(rm),false,false); rm=__builtin_fmaxf(__uint_as_float(rr[0]),__uint_as_float(rr[1])); } \
      resc=false; \
      if(__builtin_expect(__any(rm>(float)THRL),0)){ const float dl=__builtin_fmaxf(rm,0.f); mhat+=dl; \
        _Pragma("unroll") for(int r=0;r<16;++r){C0[r]-=dl;C1[r]-=dl;} \
        _Pragma("unroll") for(int r=0;r<16;++r)negm[r]=-mhat; asm volatile("":"+v"(negm)); \
        const float f=__builtin_amdgcn_exp2f(-dl); l_reg*=f; if(hi==0)wsf[r32]=f; resc=true; } } \
    SBAR(); \
    GAPB(o[0]=__builtin_amdgcn_mfma_f32_32x32x16_bf16(PAF(0),VFR(0),o[0],0,0,0), C0,0); \
    GAPB(o[1]=__builtin_amdgcn_mfma_f32_32x32x16_bf16(PAF(0),VFR(4),o[1],0,0,0), C0,4); \
    KRD(GL,0); GAPB(o[0]=__builtin_amdgcn_mfma_f32_32x32x16_bf16(PAF(1),VFR(1),o[0],0,0,0), C0,8); \
    KRD(GL,1); GAPB(o[1]=__builtin_amdgcn_mfma_f32_32x32x16_bf16(PAF(1),VFR(5),o[1],0,0,0), C0,12); \
    KRD(GL,2); GAPB(o[0]=__builtin_amdgcn_mfma_f32_32x32x16_bf16(PAF(2),VFR(2),o[0],0,0,0), C1,0); \
    KRD(GL,3); GAPB(o[1]=__builtin_amdgcn_mfma_f32_32x32x16_bf16(PAF(2),VFR(6),o[1],0,0,0), C1,4); \
    GAPB(o[0]=__builtin_amdgcn_mfma_f32_32x32x16_bf16(PAF(3),VFR(3),o[0],0,0,0), C1,8); \
    GAPB(o[1]=__builtin_amdgcn_mfma_f32_32x32x16_bf16(PAF(3),VFR(7),o[1],0,0,0), C1,12); \
    }while(0)
  int t=1;
  #undef CMASK
  #define CMASK(P0,P1,t) do{}while(0)
  for(;t+5<NT;t+=2){
    STEP(pB0,pB1,pA0,pA1,t,true,true,true);     WAIT_BAR(2); RESC(); ROT();
    STEP(pA0,pA1,pB0,pB1,t+1,true,true,true);   WAIT_BAR(2); RESC(); ROT();
  }
  #undef CMASK
  #define CMASK(P0,P1,t) do{}while(0)
  #define ENDW(tt) do{ if((tt)+3<NT){WAIT_BAR(2);} else if((tt)+2<NT){WAIT_BAR(1);} else {WAIT_BAR(0);} }while(0)
  for(;t+1<NT;t+=2){
    STEP(pB0,pB1,pA0,pA1,t,(t+3<NT),(t+1<NT),(t+1<NT));       ENDW(t);   RESC(); ROT();
    STEP(pA0,pA1,pB0,pB1,t+1,(t+4<NT),(t+2<NT),(t+2<NT));     ENDW(t+1); RESC(); ROT();
  }
  STEP(pB0,pB1,pA0,pA1,NT-1,false,false,false); RESC();
  { float sacc=pB0[0]+pB0[1]; _Pragma("unroll") for(int r=2;r<16;++r)sacc+=pB0[r]; _Pragma("unroll") for(int r=0;r<16;++r)sacc+=pB1[r]; l_reg+=sacc;
    pw0=(u32x4){PKW(pB0,0),PKW(pB0,2),PKW(pB0,4),PKW(pB0,6)};pw1=(u32x4){PKW(pB0,8),PKW(pB0,10),PKW(pB0,12),PKW(pB0,14)};pw2=(u32x4){PKW(pB1,0),PKW(pB1,2),PKW(pB1,4),PKW(pB1,6)};pw3=(u32x4){PKW(pB1,8),PKW(pB1,10),PKW(pB1,12),PKW(pB1,14)};
    SBAR(); pv(o,vb0+sl_cur,PAF(0),PAF(1),PAF(2),PAF(3)); }
  #undef PKW
  #undef PAF
  #undef VFR
  #undef PIN
  #undef MX3
  #undef GAPA
  #undef GAPB
  #undef EX
  #undef VRD
  #undef KRD
  #undef STEP
  #undef ENDW
  {auto rr=__builtin_amdgcn_permlane32_swap(__float_as_uint(l_reg),__float_as_uint(l_reg),false,false);l_reg=__uint_as_float(rr[0])+__uint_as_float(rr[1]);}
  if(hi==0)wsf[32+r32]=l_reg;asm volatile("s_waitcnt lgkmcnt(0)":::"memory");
  float rli[16];
  #pragma unroll
  for(int r=0;r<16;++r)rli[r]=__builtin_amdgcn_rcpf(wsf[32+crow(r,hi)]);
  bf16*Ow=O+(rowbase+q0+wid*QBLK)*OP+h*D; float*SSw=SS+((rowbase+q0+wid*QBLK)*8+h);
  { bf16*stg=(bf16*)(shm+LDS_OST)+wid*2048;
    #pragma unroll
    for(int r=0;r<16;++r){const int orow=crow(r,hi);
      #pragma unroll
      for(int d0=0;d0<2;++d0)stg[orow*64+d0*32+r32]=__float2bfloat16(o[d0][r]*rli[r]);}
    asm volatile("s_waitcnt lgkmcnt(0)":::"memory");
    #pragma unroll
    for(int i=0;i<4;++i){const int row=i*8+(lane>>3),ch=lane&7; const u32x4 v=*(const u32x4*)(stg+row*64+ch*8); ATTN_STORE16(Ow+(long)row*OP+ch*8,v);
      float ss_=0.f; _Pragma("unroll") for(int e_=0;e_<4;++e_){const unsigned w_=v[e_]; const float a_=__uint_as_float(w_<<16),b_=__uint_as_float(w_&0xffff0000u); ss_+=a_*a_+b_*b_;}
      ss_+=__shfl_xor(ss_,1); ss_+=__shfl_xor(ss_,2); ss_+=__shfl_xor(ss_,4); if(ch==0)SSw[(long)row*8]=ss_;} }
  asm volatile("s_waitcnt lgkmcnt(0)\n\ts_barrier":::"memory");
  #undef DMA_K
  #undef DMA_V
  #undef CMASK
  #undef START
  #undef RESC
  #undef ROT
}
constexpr int ATTN_LDS_BYTES=LDS_BYTES;
template<int THRL=8> __device__ __forceinline__ void attn_phase(char*lds,const bf16*Q,const bf16*K,const bf16*V,bf16*O,float*SS,int G,int vcu){
  for(int uid=vcu;uid<512;uid+=G){ const int pair=uid>>5,b=pair>>1,h=(pair&1)*4+((uid>>3)&3),qb=uid&7; attn_unit<THRL>(b,h,qb,Q,K,V,O,SS,lds); }
}
#undef SBAR
#undef WAIT_BAR
}
typedef FK_GAS unsigned gu32;
#define LAS FK_LAS
#define XB_TMO      128
#define XB_XCNT(j)  (256  + 64 * (j))
#define XB_XSUB(j)  (1280 + 64 * (j))
#define XB_XGEN(j)  (2304 + 64 * (j))
#define XB_TOP      3328
#define XB_TOPGEN   3392
#define XCD_BAR_WORDS 3456
#define XB_SPIN_CAP (1u << 18)

__device__ __forceinline__ unsigned xb_ld(unsigned* p)              { return __hip_atomic_load(p, __ATOMIC_RELAXED, __HIP_MEMORY_SCOPE_AGENT); }
__device__ __forceinline__ unsigned xb_add(unsigned* p, unsigned v) { return __hip_atomic_fetch_add(p, v, __ATOMIC_RELAXED, __HIP_MEMORY_SCOPE_AGENT); }
__device__ __forceinline__ unsigned xb_xcc_id() { return (unsigned)__builtin_amdgcn_s_getreg((3 << 11) | 20) & 0xFu; }
#define XB_SPIN(cond, bar) do { unsigned _sp = 0; while (cond) { __builtin_amdgcn_s_sleep(1); \
    if ((++_sp & 255u) == 0u) { if (xb_ld(&(bar)[XB_TMO])) break; if (_sp > XB_SPIN_CAP) { atomicAdd(&(bar)[XB_TMO], 1u); break; } } } } while (0)

struct XcdBarrier {
    unsigned* bar; unsigned x;
    volatile LAS unsigned* st;
};

__device__ __forceinline__ XcdBarrier xcd_barrier_post(unsigned* bar, volatile LAS unsigned* st) {
    XcdBarrier b; b.bar = bar; b.x = xb_xcc_id(); b.st = st;
    if (threadIdx.x == 0) (void)xb_add(&bar[XB_XCNT(b.x)], 1u);
    return b;
}
__device__ __forceinline__ void xcd_barrier_complete(unsigned* bar, unsigned x, unsigned& nloc, unsigned& nx) {
    const unsigned G = gridDim.x * gridDim.y * gridDim.z;
    unsigned sum, cnt, mine, sp = 0u;
    for (;;) {
        sum = 0u; cnt = 0u; mine = 0u;
#pragma unroll
        for (unsigned j = 0; j < 16; ++j) { const unsigned c = xb_ld(&bar[XB_XCNT(j)]); sum += c; cnt += (c > 0u) ? 1u : 0u; mine = (j == x) ? c : mine; }
        if (sum == G) break;
        __builtin_amdgcn_s_sleep(1);
        if ((++sp & 255u) == 0u) { if (xb_ld(&bar[XB_TMO])) break; if (sp > XB_SPIN_CAP) { atomicAdd(&bar[XB_TMO], 1u); break; } }
    }
    nloc = mine > 0u ? mine : 1u; nx = cnt > 0u ? cnt : 1u;
}

__device__ __forceinline__ void xcd_barrier(const XcdBarrier& b) {
    asm volatile("s_waitcnt vmcnt(0)" ::: "memory");
    __syncthreads();
    if (threadIdx.x == 0) {
        unsigned* bar = b.bar;
        __builtin_amdgcn_s_waitcnt(0);
        unsigned nloc = b.st[0], nx = b.st[1];
        if (nloc == 0u) { xcd_barrier_complete(bar, b.x, nloc, nx); b.st[0] = nloc; b.st[1] = nx; }
        const unsigned old = xb_add(&bar[XB_XSUB(b.x)], 1u);
        const unsigned gen = old / nloc;
        if (old + 1u == (gen + 1u) * nloc) {
            __builtin_amdgcn_fence(__ATOMIC_RELEASE, "agent");
            asm volatile("s_waitcnt vmcnt(0)" ::: "memory");
            const unsigned og = xb_add(&bar[XB_TOP], 1u);
            const unsigned tg = og / nx;
            if (og + 1u == (tg + 1u) * nx) xb_add(&bar[XB_TOPGEN], 1u);
            else XB_SPIN(xb_ld(&bar[XB_TOPGEN]) == tg, bar);
            __builtin_amdgcn_fence(__ATOMIC_ACQUIRE, "agent");
            xb_add(&bar[XB_XGEN(b.x)], 1u);
            asm volatile("s_waitcnt vmcnt(0)" ::: "memory");
        } else {
            XB_SPIN(xb_ld(&bar[XB_XGEN(b.x)]) == gen, bar);
            __builtin_amdgcn_fence(__ATOMIC_ACQUIRE, "agent");
            asm volatile("s_waitcnt vmcnt(0)" ::: "memory");
        }
    }
    __syncthreads();
}
#undef LAS
struct Params {
    const float* in[34];
    float* out;
    unsigned char* ws;
    int ph_lo, ph_hi;
};
using pg8::Unit; using pg8::Gemm;

constexpr int TSCR = 64 * 65 * 4;
template <class RowMap>
__device__ __forceinline__ void transpose_item(const float* W, int K, int N, const float* gain, bf16_t* WT, const RowMap& rm, FK_LAS float* scr, int item, int lane) {
    const int nblk = N / 64, kb = item / nblk, nb = item % nblk, k0 = 64 * kb, n0 = 64 * nb;
    const int nq = (lane & 15) * 4;
#pragma unroll 8
    for (int i = 0; i < 16; ++i) { const int kk = 4 * i + (lane >> 4); const float gv = gain ? gain[k0 + kk] : 1.f;
        const f32x4 v = *(const f32x4*)(W + (size_t)(k0 + kk) * N + n0 + nq) * gv;
        FK_LAS float* d = scr + kk * 65 + nq; d[0] = v[0]; d[1] = v[1]; d[2] = v[2]; d[3] = v[3]; }
    asm volatile("s_waitcnt lgkmcnt(0)" ::: "memory");
    const int c = lane & 7;
#pragma unroll
    for (int j = 0; j < 8; ++j) { const int n = (lane >> 3) + 8 * j; const FK_LAS float* sp = scr + (8 * c) * 65 + n;
        u32x4 o; o.x = pk2(sp[0 * 65], sp[1 * 65]); o.y = pk2(sp[2 * 65], sp[3 * 65]); o.z = pk2(sp[4 * 65], sp[5 * 65]); o.w = pk2(sp[6 * 65], sp[7 * 65]);
        *(u32x4*)(WT + (size_t)rm(n0 + n) * K + k0 + 8 * c) = o; }
    asm volatile("s_waitcnt lgkmcnt(0)" ::: "memory");
}
struct RmId { __device__ __forceinline__ int operator()(int n) const { return n; } };
struct RmWin { __device__ __forceinline__ int operator()(int n) const { if (n >= 768) return n; const int head = n >> 6, dim = n & 63; return 256 * (head >> 2) + 128 * (dim >> 5) + 32 * (head & 3) + (dim & 31); } };
struct RmGU { int up; __device__ __forceinline__ int operator()(int n) const { return (n >> 7) * 256 + up * 128 + (n & 127); } };

__device__ __forceinline__ void row_to_bf16(const float* xrow, bf16_t* orow, float* rout, const float* gain, bool normalise, int lane) {
    const f32x4* xr = (const f32x4*)xrow + lane;
    f32x4 v[4]; float s = 0.f;
#pragma unroll
    for (int j = 0; j < 4; ++j) { v[j] = xr[64 * j]; s += (v[j].x * v[j].x + v[j].y * v[j].y) + (v[j].z * v[j].z + v[j].w * v[j].w); }
    const float r = rsqrtf(wsum(s) * (1.f / 1024.f) + EPS);
    if (rout && lane == 0) *rout = r;
    unsigned long long* o8 = (unsigned long long*)orow + lane;
#pragma unroll
    for (int j = 0; j < 4; ++j) {
        f32x4 w = v[j];
        if (normalise) { const f32x4 gv = ((const f32x4*)gain)[lane + 64 * j]; w = w * r * gv; }
        o8[64 * j] = (unsigned long long)pk2(w.x, w.y) | ((unsigned long long)pk2(w.z, w.w) << 32);
    }
}

__device__ __forceinline__ void s5_prep_part(const Params& p, int g, int q8, FK_LAS float* L, int tid) {
    const float* lam_re = p.in[6]; const float* lam_im = p.in[7]; const float* log_step = p.in[8];
    const float* b_re = p.in[9]; const float* b_im = p.in[10]; const float* c_re = p.in[11]; const float* c_im = p.in[12]; const float* dpar = p.in[13];
    FK_LAS float* LPr = L;
    FK_LAS float* LPi = LPr + 2 * 33 * 64;
    FK_LAS float* BBr = LPi + 2 * 33 * 64;
    FK_LAS float* BBi = BBr + 2 * 1024;
    FK_LAS float* CCr = BBi + 2 * 1024;
    FK_LAS float* CCi = CCr + 2 * 1024;
    FK_LAS float* KT = CCi + 2 * 1024;
    for (int idx = tid; idx < 2 * 33 * 64; idx += NTHREADS) {
        const int dir = idx / (33 * 64), e = (idx / 64) % 33, pp = idx & 63;
        const int gp = (dir * 32 + g) * 64 + pp;
        const float lr = fminf(lam_re[gp], -1e-4f), li = lam_im[gp], dt = expf(log_step[dir * 32 + g]);
        const float mag = expf(lr * dt * (float)e), ang = li * dt * (float)e;
        LPr[idx] = mag * cosf(ang); LPi[idx] = mag * sinf(ang);
    }
    for (int idx = tid; idx < 2 * 1024; idx += NTHREADS) {
        const int dir = idx >> 10, pp = (idx >> 4) & 63, c = idx & 15;
        const int gp = (dir * 32 + g) * 64 + pp;
        const float lr = fminf(lam_re[gp], -1e-4f), li = lam_im[gp], dt = expf(log_step[dir * 32 + g]);
        const float mag = expf(lr * dt), ab_r = mag * cosf(li * dt), ab_i = mag * sinf(li * dt);
        const float den = lr * lr + li * li, nr = ab_r - 1.f;
        const float f_r = (nr * lr + ab_i * li) / den, f_i = (ab_i * lr - nr * li) / den;
        const float br = b_re[(size_t)gp * 16 + c], bi = b_im[(size_t)gp * 16 + c];
        BBr[idx] = f_r * br - f_i * bi; BBi[idx] = f_r * bi + f_i * br;
        const int cc = (idx >> 6) & 15, p2 = idx & 63;
        CCr[idx] = c_re[((size_t)(dir * 32 + g) * 16 + cc) * 64 + p2];
        CCi[idx] = c_im[((size_t)(dir * 32 + g) * 16 + cc) * 64 + p2];
    }
    __syncthreads();
    for (int idx = tid; idx < 2048; idx += NTHREADS) {
        const int dir = idx >> 10, tau = (idx >> 5) & 31, cc = 2 * q8 + ((idx >> 4) & 1), c = idx & 15;
        const FK_LAS float* cr = CCr + dir * 1024 + cc * 64; const FK_LAS float* ci = CCi + dir * 1024 + cc * 64;
        const FK_LAS float* lr = LPr + (dir * 33 + tau) * 64; const FK_LAS float* li = LPi + (dir * 33 + tau) * 64;
        const FK_LAS float* br = BBr + dir * 1024 + c; const FK_LAS float* bi = BBi + dir * 1024 + c;
        float acc = 0.f;
#pragma unroll 8
        for (int pp = 0; pp < 64; ++pp) {
            const float tr = cr[pp] * lr[pp] - ci[pp] * li[pp], ti = cr[pp] * li[pp] + ci[pp] * lr[pp];
            acc += tr * br[pp * 16] - ti * bi[pp * 16];
        }
        KT[idx] = acc;
    }
    __syncthreads();
    bf16_t* W1 = (bf16_t*)(p.ws + WS_W1) + (size_t)g * 256 * 512;
    for (int ch = tid; ch < 32 * 64; ch += NTHREADS) {
        const int n = 32 * q8 + (ch >> 6), kk0 = (ch & 63) * 8, j = kk0 >> 4, c0 = kk0 & 15;
        const int dir = n >> 7, ri = (n >> 6) & 1, pp = n & 63, e = dir ? j : 31 - j;
        const float lr = LPr[(dir * 33 + e) * 64 + pp], li = LPi[(dir * 33 + e) * 64 + pp];
        float v[8];
#pragma unroll
        for (int q = 0; q < 8; ++q) { const float br = BBr[dir * 1024 + pp * 16 + c0 + q], bi = BBi[dir * 1024 + pp * 16 + c0 + q]; v[q] = ri ? (lr * bi + li * br) : (lr * br - li * bi); }
        u32x4 o; o.x = pk2(v[0], v[1]); o.y = pk2(v[2], v[3]); o.z = pk2(v[4], v[5]); o.w = pk2(v[6], v[7]);
        *(u32x4*)(W1 + (size_t)n * 512 + kk0) = o;
    }
    bf16_t* W2 = (bf16_t*)(p.ws + WS_W2) + (size_t)g * 512 * SUP;
    for (int ch = tid; ch < 64 * 96; ch += NTHREADS) {
        const int rowi = ch / 96, kk0 = (ch % 96) * 8, j = rowi >> 1, cl = rowi & 1, cc = 2 * q8 + cl, nn = j * 16 + cc;
        float v[8];
        if (kk0 < 256) {
            const int dir = kk0 >> 7, ri = (kk0 >> 6) & 1, p0 = kk0 & 63, e = dir ? 32 - j : j + 1;
#pragma unroll
            for (int q = 0; q < 8; ++q) {
                const int pp = p0 + q;
                const float cr = CCr[dir * 1024 + cc * 64 + pp], ci = CCi[dir * 1024 + cc * 64 + pp];
                const float lr = LPr[(dir * 33 + e) * 64 + pp], li = LPi[(dir * 33 + e) * 64 + pp];
                v[q] = ri ? -(cr * li + ci * lr) : (cr * lr - ci * li);
            }
        } else {
            const int j2 = (kk0 - 256) >> 4, c0 = kk0 & 15;
#pragma unroll
            for (int q = 0; q < 8; ++q) {
                const int c = c0 + q; float a = 0.f;
                if (j2 <= j) a += KT[((0 * 32 + (j - j2)) * 2 + cl) * 16 + c];
                if (j2 >= j) a += KT[((1 * 32 + (j2 - j)) * 2 + cl) * 16 + c];
                if (j2 == j && c == cc) a += dpar[g * 16 + c];
                v[q] = a;
            }
        }
        u32x4 o; o.x = pk2(v[0], v[1]); o.y = pk2(v[2], v[3]); o.z = pk2(v[4], v[5]); o.w = pk2(v[6], v[7]);
        *(u32x4*)(W2 + (size_t)nn * SUP + kk0) = o;
    }
    __syncthreads();
}

__device__ __forceinline__ void p0_prologue(const Params& p, FK_LAS unsigned char* lds, int vcu, int G, int tid, int lane, int wave) {
    unsigned char* ws = p.ws;
    for (int it = vcu; it < 256; it += G) s5_prep_part(p, it >> 3, it & 7, (FK_LAS float*)lds, tid);
    if (vcu == (G > 1 ? 1 : 0)) {
        bf16_t* rwt = (bf16_t*)(ws + WS_RWT);
        for (int idx = tid; idx < 32 * 1024; idx += NTHREADS) {
            const int n = idx >> 10, k = idx & 1023;
            const float v = n < 4 ? p.in[25][k] * p.in[26][k * 4 + n] : n < 20 ? p.in[25][k] * p.in[28][k * 16 + (n - 4)] : 0.f;
            const unsigned h = f2bf(v); const float lo = v - bf2f((unsigned short)h);
            rwt[idx] = (bf16_t)h; rwt[32 * 1024 + idx] = (bf16_t)f2bf(lo);
        }
    }
    if (vcu == 0) {
        for (int idx = tid; idx < 1024; idx += NTHREADS) {
            const int pos = idx >> 4, i = idx & 15;
            const float ang = (float)pos * powf(10000.f, -(float)i / 16.f);
            ((f32x2*)(ws + WS_ROPE))[idx] = (f32x2){cosf(ang), sinf(ang)};
        }
    }
    FK_LAS float* scr = (FK_LAS float*)(lds + wave * TSCR);
    const int gw = vcu * NWAVES + wave, NGW = G * NWAVES;
    constexpr int I_WIN = 16 * 20, I_GLU = 8 * 8, I_SQ = 16 * 16, I_GU = 16 * 8, I_DN = 8 * 16;
    constexpr int NITEMS = I_WIN + I_GLU + 5 * I_SQ + 16 * (2 * I_GU + I_DN);
    for (int it = gw; it < NITEMS; it += NGW) {
        int r = it;
        if (r < I_WIN) { transpose_item(p.in[3], 1024, 1280, p.in[2], (bf16_t*)(ws + WS_WIN), RmWin{}, scr, r, lane); continue; } r -= I_WIN;
        if (r < I_GLU) { transpose_item(p.in[14], 512, 512, nullptr, (bf16_t*)(ws + WS_GLU), RmId{}, scr, r, lane); continue; } r -= I_GLU;
        if (r < I_SQ) {
            const int kb = r / 16; const float* gain = kb < 8 ? p.in[16] : p.in[17] - 512;
            transpose_item(p.in[18], 1024, 1024, gain, (bf16_t*)(ws + WS_WOUT), RmId{}, scr, r, lane); continue; } r -= I_SQ;
        if (r < I_SQ) { transpose_item(p.in[21], 1024, 1024, p.in[19], (bf16_t*)(ws + WS_WQ), RmId{}, scr, r, lane); continue; } r -= I_SQ;
        if (r < I_SQ) { transpose_item(p.in[22], 1024, 1024, nullptr, (bf16_t*)(ws + WS_WK), RmId{}, scr, r, lane); continue; } r -= I_SQ;
        if (r < I_SQ) { transpose_item(p.in[23], 1024, 1024, nullptr, (bf16_t*)(ws + WS_WV), RmId{}, scr, r, lane); continue; } r -= I_SQ;
        if (r < I_SQ) { transpose_item(p.in[24], 1024, 1024, nullptr, (bf16_t*)(ws + WS_WO), RmId{}, scr, r, lane); continue; } r -= I_SQ;
        const int e = r / (2 * I_GU + I_DN); r -= e * (2 * I_GU + I_DN);
        bf16_t* wgu = (bf16_t*)(ws + WS_WGU) + (size_t)e * 1024 * 1024;
        if (r < I_GU) { transpose_item(p.in[30] + (size_t)e * 1024 * 512, 1024, 512, p.in[25], wgu, RmGU{0}, scr, r, lane); continue; } r -= I_GU;
        if (r < I_GU) { transpose_item(p.in[31] + (size_t)e * 1024 * 512, 1024, 512, p.in[25], wgu, RmGU{1}, scr, r, lane); continue; } r -= I_GU;
        transpose_item(p.in[32] + (size_t)e * 512 * 1024, 512, 1024, nullptr, (bf16_t*)(ws + WS_WD) + (size_t)e * 1024 * 512, RmId{}, scr, r, lane);
    }
    for (int m = gw; m < T; m += NGW) row_to_bf16(p.in[0] + (size_t)m * 1024, (bf16_t*)(ws + WS_XB) + (size_t)m * 1024, (float*)(ws + WS_R0) + m, nullptr, false, lane);
    for (int m = gw; m < MTOK; m += NGW) row_to_bf16(p.in[1] + (size_t)m * 1024, (bf16_t*)(ws + WS_HM) + (size_t)m * 1024, nullptr, p.in[20], true, lane);
}

struct SchedP1 {
    int G, c;
    __device__ __forceinline__ bool next(int i, Unit& u) const {
        const int L = i * G + c;
        int pm = 0, pn = 0, kind = 0; unsigned a_off = 0, b_off = 0;
        if (L < 320) {
            pg8::tile_order(L, 64, 5, pm, pn);
            a_off = (unsigned)(WS_XB + (size_t)pm * 256 * 1024 * 2); b_off = (unsigned)(WS_WIN + (size_t)pn * 256 * 1024 * 2);
            kind = pn < 3 ? 0 : 1;
        } else if (L < 352) { const int r = L - 320; pm = r >> 2; pn = r & 3; kind = 2;
            a_off = (unsigned)(WS_HM + (size_t)pm * 256 * 1024 * 2); b_off = (unsigned)(WS_WK + (size_t)pn * 256 * 1024 * 2);
        } else { const int q = L - 352; pm = (q >> 3) & 3; pn = q & 7; kind = 3;
            a_off = (unsigned)(WS_WV + (size_t)pm * 256 * 1024 * 2); b_off = (unsigned)(WS_HM + (size_t)pn * 256 * 1024 * 2); }
        u.a_off = a_off; u.b_off = b_off; u.pm = pm; u.pn = pn; u.kind = kind; u.aux = 0;
        return L < 384;
    }
    __device__ __forceinline__ unsigned row_off(const Unit& u, int r) const { return u.a_off + (unsigned)r * 2048u; }
};
struct EpiP1 {
    static constexpr bool PERM = false, AFTER_DRAIN = false;
    unsigned char* ws; const float* qg; const float* kg;
    __device__ __forceinline__ void operator()(f32x4 (&acc)[2][2][4][2], const Unit& u, int wr, int wc, int fr, int fq, FK_LAS unsigned char*, int, int) const {
        if (u.kind == 0) {
            const int head = 4 * u.pn + wc;
            const float* r0 = (const float*)(ws + WS_R0);
            const f32x2* rope = (const f32x2*)(ws + WS_ROPE);
            if (head < 10) {
                const float* gn = head < 8 ? qg : kg;
                f32x4 gv[2][2];
#pragma unroll
                for (int bj = 0; bj < 2; ++bj)
#pragma unroll
                    for (int n = 0; n < 2; ++n) gv[bj][n] = *(const f32x4*)(gn + 32 * bj + 16 * n + 4 * fq);
                const float osc = head < 8 ? QSCALE : 1.f;
#pragma unroll
                for (int ai = 0; ai < 2; ++ai)
#pragma unroll
                    for (int m = 0; m < 4; ++m) {
                        const int row = u.pm * 256 + ai * 128 + wr * 64 + m * 16 + fr;
                        float ss = 0.f;
#pragma unroll
                        for (int bj = 0; bj < 2; ++bj)
#pragma unroll
                            for (int n = 0; n < 2; ++n) { const f32x4 x = acc[ai][bj][m][n]; ss += (x[0] * x[0] + x[1] * x[1]) + (x[2] * x[2] + x[3] * x[3]); }
                        ss += __shfl_xor(ss, 16); ss += __shfl_xor(ss, 32);
                        const float rr = r0[row];
                        const float hs = rr * rsqrtf(rr * rr * ss * (1.f / 64.f) + EPS) * osc;
                        const int s = row & (SEQ - 1);
                        bf16_t* dst = head < 8 ? (bf16_t*)(ws + WS_Q) + (size_t)row * 512 + head * 64 : (bf16_t*)(ws + WS_K) + (size_t)row * 128 + (head - 8) * 64;
#pragma unroll
                        for (int bj = 0; bj < 2; ++bj) {
                            const int pos = bj == 0 ? (s >> 6) : (s & 63);
                            f32x4 x1 = acc[ai][bj][m][0] * hs * gv[bj][0], x2 = acc[ai][bj][m][1] * hs * gv[bj][1], o1, o2;
#pragma unroll
                            for (int j = 0; j < 4; ++j) { const f32x2 cs = rope[pos * 16 + 4 * fq + j]; o1[j] = x1[j] * cs.x - x2[j] * cs.y; o2[j] = x2[j] * cs.x + x1[j] * cs.y; }
                            u32x2 w1, w2; w1.x = pg8::cvt_pk_bf16(o1[0], o1[1]); w1.y = pg8::cvt_pk_bf16(o1[2], o1[3]); w2.x = pg8::cvt_pk_bf16(o2[0], o2[1]); w2.y = pg8::cvt_pk_bf16(o2[2], o2[3]);
                            *(u32x2*)(dst + 32 * bj + 4 * fq) = w1; *(u32x2*)(dst + 32 * bj + 16 + 4 * fq) = w2;
                        }
                    }
            } else {
#pragma unroll
                for (int ai = 0; ai < 2; ++ai)
#pragma unroll
                    for (int m = 0; m < 4; ++m) {
                        const int row = u.pm * 256 + ai * 128 + wr * 64 + m * 16 + fr;
                        const float rr = r0[row];
                        bf16_t* dst = (bf16_t*)(ws + WS_V) + (size_t)row * 128 + (head - 10) * 64;
#pragma unroll
                        for (int bj = 0; bj < 2; ++bj)
#pragma unroll
                            for (int n = 0; n < 2; ++n) { const f32x4 x = acc[ai][bj][m][n] * rr; u32x2 w; w.x = pg8::cvt_pk_bf16(x[0], x[1]); w.y = pg8::cvt_pk_bf16(x[2], x[3]);
                                *(u32x2*)(dst + 32 * bj + 16 * n + 4 * fq) = w; }
                    }
            }
        } else if (u.kind == 1) {
            const float* r0 = (const float*)(ws + WS_R0);
#pragma unroll
            for (int ai = 0; ai < 2; ++ai)
#pragma unroll
                for (int m = 0; m < 4; ++m) {
                    const int row = u.pm * 256 + ai * 128 + wr * 64 + m * 16 + fr;
                    const float rr = r0[row];
                    const int b = row >> 11, s = row & (SEQ - 1), k = s >> 5, jj = s & 31;
#pragma unroll
                    for (int bj = 0; bj < 2; ++bj)
#pragma unroll
                        for (int n = 0; n < 2; ++n) {
                            const int gidx = 16 * (u.pn - 3) + 8 * bj + 2 * wc + n;
                            bf16_t* dst = (bf16_t*)(ws + WS_SU) + ((size_t)gidx * SROWS + b * NCH + k) * SUP + 256 + jj * 16 + 4 * fq;
                            const f32x4 x = acc[ai][bj][m][n] * rr; u32x2 w; w.x = pg8::cvt_pk_bf16(x[0], x[1]); w.y = pg8::cvt_pk_bf16(x[2], x[3]);
                            *(u32x2*)dst = w;
                        }
                }
        } else {
            bf16_t* base = u.kind == 2 ? (bf16_t*)(ws + WS_KM) + (size_t)u.pm * 256 * 1024 + u.pn * 256 : (bf16_t*)(ws + WS_VT) + ((size_t)u.pn * 1024 + u.pm * 256) * 256;
            const int ldc = u.kind == 2 ? 1024 : 256;
#pragma unroll
            for (int ai = 0; ai < 2; ++ai)
#pragma unroll
                for (int m = 0; m < 4; ++m) {
                    bf16_t* rowp = base + (size_t)(ai * 128 + wr * 64 + m * 16 + fr) * ldc + wc * 32 + 4 * fq;
#pragma unroll
                    for (int bj = 0; bj < 2; ++bj)
#pragma unroll
                        for (int n = 0; n < 2; ++n) { const f32x4 x = acc[ai][bj][m][n]; u32x2 w; w.x = pg8::cvt_pk_bf16(x[0], x[1]); w.y = pg8::cvt_pk_bf16(x[2], x[3]);
                            *(u32x2*)(rowp + 128 * bj + 16 * n) = w; }
                }
        }
    }
};
struct SchedOne {
    Unit u; unsigned a_pitch;
    __device__ __forceinline__ bool next(int i, Unit& o) const { o = u; return i == 0; }
    __device__ __forceinline__ unsigned row_off(const Unit& x, int r) const { return x.a_off + (unsigned)r * a_pitch; }
};
__device__ __forceinline__ Unit mk_unit(unsigned a_off, unsigned b_off, int pm, int pn, int kind) { Unit u; u.a_off = a_off; u.b_off = b_off; u.pm = pm; u.pn = pn; u.kind = kind; u.aux = 0; return u; }

struct EpiSloc {
    static constexpr bool PERM = false, AFTER_DRAIN = false;
    float* C;
    __device__ __forceinline__ void operator()(f32x4 (&acc)[2][2][4][2], const Unit& u, int wr, int wc, int fr, int fq, FK_LAS unsigned char*, int, int) const {
#pragma unroll
        for (int ai = 0; ai < 2; ++ai)
#pragma unroll
            for (int m = 0; m < 4; ++m) {
                float* rowp = C + (size_t)(u.pm * 256 + ai * 128 + wr * 64 + m * 16 + fr) * 256 + wc * 32 + 4 * fq;
#pragma unroll
                for (int bj = 0; bj < 2; ++bj)
#pragma unroll
                    for (int n = 0; n < 2; ++n) *(f32x4*)(rowp + 128 * bj + 16 * n) = acc[ai][bj][m][n];
            }
    }
};
__device__ __forceinline__ void s5_scan(const Params& p, int g, int mt, int tid) {
    const int bl = tid >> 7, dir = (tid >> 6) & 1, pp = tid & 63;
    const int gp = (dir * 32 + g) * 64 + pp;
    const float lr = fminf(p.in[6][gp], -1e-4f), li = p.in[7][gp], dt = expf(p.in[8][dir * 32 + g]);
    const float mag = expf(lr * dt * (float)SL), ang = li * dt * (float)SL;
    const float ar = mag * cosf(ang), ai = mag * sinf(ang);
    const float* sl = (const float*)(p.ws + WS_SLOC) + ((size_t)g * SROWS + mt * 256 + bl * 64) * 256 + dir * 128 + pp;
    bf16_t* su = (bf16_t*)(p.ws + WS_SU) + ((size_t)g * SROWS + mt * 256 + bl * 64) * SUP + dir * 128 + pp;
    float sr = 0.f, si = 0.f;
    for (int h2 = 0; h2 < 2; ++h2) {
        float lr_[32], li_[32];
#pragma unroll
        for (int i = 0; i < 32; ++i) { const int s = h2 * 32 + i, k = dir ? (NCH - 1 - s) : s; lr_[i] = sl[(size_t)k * 256]; li_[i] = sl[(size_t)k * 256 + 64]; }
#pragma unroll
        for (int i = 0; i < 32; ++i) {
            const int s = h2 * 32 + i, k = dir ? (NCH - 1 - s) : s;
            su[(size_t)k * SUP] = (bf16_t)f2bf(sr); su[(size_t)k * SUP + 64] = (bf16_t)f2bf(si);
            const float nr = ar * sr - ai * si + lr_[i], ni = ar * si + ai * sr + li_[i];
            sr = nr; si = ni;
        }
    }
}
struct EpiS5Out {
    static constexpr bool PERM = false, AFTER_DRAIN = false;
    bf16_t* Z; int g, mt, ntile;
    __device__ __forceinline__ void operator()(f32x4 (&acc)[2][2][4][2], const Unit& u, int wr, int wc, int fr, int fq, FK_LAS unsigned char*, int, int) const {
#pragma unroll
        for (int ai = 0; ai < 2; ++ai)
#pragma unroll
            for (int m = 0; m < 4; ++m) {
                const int R = mt * 256 + ai * 128 + wr * 64 + m * 16 + fr, b = R >> 6, k = R & 63;
#pragma unroll
                for (int bj = 0; bj < 2; ++bj)
#pragma unroll
                    for (int n = 0; n < 2; ++n) {
                        const int j = 16 * ntile + 8 * bj + 2 * wc + n;
                        const size_t t = (size_t)b * SEQ + k * SL + j;
                        f32x4 y = acc[ai][bj][m][n], z;
#pragma unroll
                        for (int i = 0; i < 4; ++i) { const float a2 = 1.5957691216057308f * (y[i] + 0.044715f * y[i] * y[i] * y[i]); z[i] = y[i] / (1.f + __expf(-a2)); }
                        u32x2 w; w.x = pg8::cvt_pk_bf16(z[0], z[1]); w.y = pg8::cvt_pk_bf16(z[2], z[3]);
                        *(u32x2*)(Z + t * 512 + g * 16 + 4 * fq) = w;
                    }
            }
    }
};
struct EpiGlu {
    static constexpr bool PERM = false, AFTER_DRAIN = false;
    const bf16_t* Z; bf16_t* Y; float* SS; const float* bias;
    __device__ __forceinline__ void operator()(f32x4 (&acc)[2][2][4][2], const Unit& u, int wr, int wc, int fr, int fq, FK_LAS unsigned char*, int, int) const {
        const int col0 = u.pn * 256 + wc * 32 + 4 * fq;
        f32x4 bv[2][2];
#pragma unroll
        for (int bj = 0; bj < 2; ++bj)
#pragma unroll
            for (int n = 0; n < 2; ++n) bv[bj][n] = *(const f32x4*)(bias + col0 + 128 * bj + 16 * n);
#pragma unroll
        for (int ai = 0; ai < 2; ++ai) {
            u32x2 zw[4][2][2];
#pragma unroll
            for (int m = 0; m < 4; ++m) { const size_t row = (size_t)u.pm * 256 + ai * 128 + wr * 64 + m * 16 + fr;
#pragma unroll
                for (int bj = 0; bj < 2; ++bj)
#pragma unroll
                    for (int n = 0; n < 2; ++n) zw[m][bj][n] = *(const u32x2*)(Z + row * 512 + col0 + 128 * bj + 16 * n); }
#pragma unroll
            for (int m = 0; m < 4; ++m) {
                const size_t row = (size_t)u.pm * 256 + ai * 128 + wr * 64 + m * 16 + fr;
                float ss = 0.f;
#pragma unroll
                for (int bj = 0; bj < 2; ++bj)
#pragma unroll
                    for (int n = 0; n < 2; ++n) {
                        const int col = col0 + 128 * bj + 16 * n;
                        const f32x4 lin = acc[ai][bj][m][n] + bv[bj][n];
                        const float z0 = bflo(zw[m][bj][n].x), z1 = bfhi(zw[m][bj][n].x), z2 = bflo(zw[m][bj][n].y), z3 = bfhi(zw[m][bj][n].y);
                        const float y0 = z0 / (1.f + __expf(-lin[0])), y1 = z1 / (1.f + __expf(-lin[1])), y2 = z2 / (1.f + __expf(-lin[2])), y3 = z3 / (1.f + __expf(-lin[3]));
                        u32x2 w; w.x = pg8::cvt_pk_bf16(y0, y1); w.y = pg8::cvt_pk_bf16(y2, y3);
                        *(u32x2*)(Y + row * 1024 + 512 + col) = w;
                        const float r0 = bflo(w.x), r1 = bfhi(w.x), r2 = bflo(w.y), r3 = bfhi(w.y);
                        ss += (r0 * r0 + r1 * r1) + (r2 * r2 + r3 * r3);
                    }
                ss += __shfl_xor(ss, 16); ss += __shfl_xor(ss, 32);
                if (fq == 0) SS[row * 8 + u.pn * 4 + wc] = ss;
            }
            asm volatile("" ::: "memory");
        }
    }
};
__device__ __forceinline__ float rs8(const float* ss, size_t row, float inv_n) {
    const f32x4 a = *(const f32x4*)(ss + row * 8), b = *(const f32x4*)(ss + row * 8 + 4);
    return rsqrtf(((a[0] + a[1]) + (a[2] + a[3]) + (b[0] + b[1]) + (b[2] + b[3])) * inv_n + EPS);
}
struct EpiWoutMid {
    static constexpr bool PERM = false, AFTER_DRAIN = false;
    const FK_LAS float* xt;
    __device__ __forceinline__ void operator()(f32x4 (&acc)[2][2][4][2], const Unit& u, int wr, int wc, int fr, int fq, FK_LAS unsigned char*, int, int) const {
#pragma unroll
        for (int ai = 0; ai < 2; ++ai)
#pragma unroll
            for (int m = 0; m < 4; ++m) {
                const float f = xt[ai * 128 + wr * 64 + m * 16 + fr];
#pragma unroll
                for (int bj = 0; bj < 2; ++bj)
#pragma unroll
                    for (int n = 0; n < 2; ++n) acc[ai][bj][m][n] = acc[ai][bj][m][n] * f;
            }
    }
};
struct EpiWoutFin {
    static constexpr bool PERM = false, AFTER_DRAIN = false;
    const FK_LAS float* xt; const bf16_t* XB; bf16_t* X1; float* SS1;
    __device__ __forceinline__ void operator()(f32x4 (&acc)[2][2][4][2], const Unit& u, int wr, int wc, int fr, int fq, FK_LAS unsigned char*, int, int) const {
        const int col0 = u.pn * 256 + wc * 32 + 4 * fq;
#pragma unroll
        for (int ai = 0; ai < 2; ++ai) {
            u32x2 xw[4][2][2];
#pragma unroll
            for (int m = 0; m < 4; ++m) { const size_t row = (size_t)u.pm * 256 + ai * 128 + wr * 64 + m * 16 + fr;
#pragma unroll
                for (int bj = 0; bj < 2; ++bj)
#pragma unroll
                    for (int n = 0; n < 2; ++n) xw[m][bj][n] = *(const u32x2*)(XB + row * 1024 + col0 + 128 * bj + 16 * n); }
#pragma unroll
            for (int m = 0; m < 4; ++m) {
                const size_t row = (size_t)u.pm * 256 + ai * 128 + wr * 64 + m * 16 + fr;
                const float rs = xt[256 + ai * 128 + wr * 64 + m * 16 + fr];
                float ss = 0.f;
#pragma unroll
                for (int bj = 0; bj < 2; ++bj)
#pragma unroll
                    for (int n = 0; n < 2; ++n) {
                        const int col = col0 + 128 * bj + 16 * n;
                        const f32x4 a = acc[ai][bj][m][n] * rs;
                        u32x2 w; w.x = pg8::cvt_pk_bf16(bflo(xw[m][bj][n].x) + a[0], bfhi(xw[m][bj][n].x) + a[1]); w.y = pg8::cvt_pk_bf16(bflo(xw[m][bj][n].y) + a[2], bfhi(xw[m][bj][n].y) + a[3]);
                        *(u32x2*)(X1 + row * 1024 + col) = w;
                        const float r0 = bflo(w.x), r1 = bfhi(w.x), r2 = bflo(w.y), r3 = bfhi(w.y);
                        ss += (r0 * r0 + r1 * r1) + (r2 * r2 + r3 * r3);
                    }
                ss += __shfl_xor(ss, 16); ss += __shfl_xor(ss, 32);
                if (fq == 0) SS1[row * 16 + u.pn * 4 + wc] = ss;
            }
            asm volatile("" ::: "memory");
        }
    }
};
struct EpiScaleBf16 {
    static constexpr bool PERM = false, AFTER_DRAIN = false;
    bf16_t* O; int ldc; const FK_LAS float* xt; float sc;
    __device__ __forceinline__ void operator()(f32x4 (&acc)[2][2][4][2], const Unit& u, int wr, int wc, int fr, int fq, FK_LAS unsigned char*, int, int) const {
#pragma unroll
        for (int ai = 0; ai < 2; ++ai)
#pragma unroll
            for (int m = 0; m < 4; ++m) {
                const int r = ai * 128 + wr * 64 + m * 16 + fr;
                const float f = xt ? xt[r] * sc : sc;
                bf16_t* rowp = O + (size_t)r * ldc + wc * 32 + 4 * fq;
#pragma unroll
                for (int bj = 0; bj < 2; ++bj)
#pragma unroll
                    for (int n = 0; n < 2; ++n) { const f32x4 x = acc[ai][bj][m][n] * f; u32x2 w; w.x = pg8::cvt_pk_bf16(x[0], x[1]); w.y = pg8::cvt_pk_bf16(x[2], x[3]);
                        *(u32x2*)(rowp + 128 * bj + 16 * n) = w; }
            }
    }
};
struct EpiSoftmax {
    static constexpr bool PERM = false, AFTER_DRAIN = true;
    bf16_t* O; int ldc;
    __device__ __forceinline__ void operator()(f32x4 (&acc)[2][2][4][2], const Unit& u, int wr, int wc, int fr, int fq, FK_LAS unsigned char* lds, int, int) const {
        FK_LAS float* Pm = (FK_LAS float*)lds;
        FK_LAS float* Ps = (FK_LAS float*)(lds + 4096);
#pragma unroll
        for (int ai = 0; ai < 2; ++ai)
#pragma unroll
            for (int m = 0; m < 4; ++m) {
                float mx = -INFINITY;
#pragma unroll
                for (int bj = 0; bj < 2; ++bj)
#pragma unroll
                    for (int n = 0; n < 2; ++n) { const f32x4 x = acc[ai][bj][m][n]; mx = fmaxf(mx, fmaxf(fmaxf(x[0], x[1]), fmaxf(x[2], x[3]))); }
                mx = fmaxf(mx, __shfl_xor(mx, 16)); mx = fmaxf(mx, __shfl_xor(mx, 32));
                if (fq == 0) Pm[(ai * 128 + wr * 64 + m * 16 + fr) * 4 + wc] = mx;
            }
        asm volatile("s_waitcnt lgkmcnt(0)" ::: "memory"); __builtin_amdgcn_s_barrier(); asm volatile("" ::: "memory");
#pragma unroll
        for (int ai = 0; ai < 2; ++ai)
#pragma unroll
            for (int m = 0; m < 4; ++m) {
                const int r = ai * 128 + wr * 64 + m * 16 + fr;
                const f32x4 pm4 = *(const FK_LAS f32x4*)(Pm + r * 4);
                const float M = fmaxf(fmaxf(pm4[0], pm4[1]), fmaxf(pm4[2], pm4[3]));
                float sm = 0.f;
#pragma unroll
                for (int bj = 0; bj < 2; ++bj)
#pragma unroll
                    for (int n = 0; n < 2; ++n) { f32x4 x = acc[ai][bj][m][n];
#pragma unroll
                        for (int i = 0; i < 4; ++i) { x[i] = __builtin_amdgcn_exp2f(x[i] - M); sm += x[i]; }
                        acc[ai][bj][m][n] = x; }
                sm += __shfl_xor(sm, 16); sm += __shfl_xor(sm, 32);
                if (fq == 0) Ps[r * 4 + wc] = sm;
            }
        asm volatile("s_waitcnt lgkmcnt(0)" ::: "memory"); __builtin_amdgcn_s_barrier(); asm volatile("" ::: "memory");
#pragma unroll
        for (int ai = 0; ai < 2; ++ai)
#pragma unroll
            for (int m = 0; m < 4; ++m) {
                const int r = ai * 128 + wr * 64 + m * 16 + fr;
                const f32x4 ps4 = *(const FK_LAS f32x4*)(Ps + r * 4);
                const float inv = 1.f / ((ps4[0] + ps4[1]) + (ps4[2] + ps4[3]));
                bf16_t* rowp = O + (size_t)r * ldc + wc * 32 + 4 * fq;
#pragma unroll
                for (int bj = 0; bj < 2; ++bj)
#pragma unroll
                    for (int n = 0; n < 2; ++n) { const f32x4 x = acc[ai][bj][m][n] * inv; u32x2 w; w.x = pg8::cvt_pk_bf16(x[0], x[1]); w.y = pg8::cvt_pk_bf16(x[2], x[3]);
                        *(u32x2*)(rowp + 128 * bj + 16 * n) = w; }
            }
        asm volatile("s_waitcnt lgkmcnt(0)" ::: "memory"); __builtin_amdgcn_s_barrier(); asm volatile("" ::: "memory");
    }
};
struct EpiResid {
    static constexpr bool PERM = false, AFTER_DRAIN = false;
    bf16_t* X; int ldc;
    __device__ __forceinline__ void operator()(f32x4 (&acc)[2][2][4][2], const Unit& u, int wr, int wc, int fr, int fq, FK_LAS unsigned char*, int, int) const {
#pragma unroll
        for (int ai = 0; ai < 2; ++ai) {
            u32x2 xw[4][2][2];
#pragma unroll
            for (int m = 0; m < 4; ++m) { const bf16_t* rowp = X + (size_t)(ai * 128 + wr * 64 + m * 16 + fr) * ldc + wc * 32 + 4 * fq;
#pragma unroll
                for (int bj = 0; bj < 2; ++bj)
#pragma unroll
                    for (int n = 0; n < 2; ++n) xw[m][bj][n] = *(const u32x2*)(rowp + 128 * bj + 16 * n); }
#pragma unroll
            for (int m = 0; m < 4; ++m) {
                bf16_t* rowp = X + (size_t)(ai * 128 + wr * 64 + m * 16 + fr) * ldc + wc * 32 + 4 * fq;
#pragma unroll
                for (int bj = 0; bj < 2; ++bj)
#pragma unroll
                    for (int n = 0; n < 2; ++n) { const f32x4 a = acc[ai][bj][m][n];
                        u32x2 w; w.x = pg8::cvt_pk_bf16(bflo(xw[m][bj][n].x) + a[0], bfhi(xw[m][bj][n].x) + a[1]); w.y = pg8::cvt_pk_bf16(bflo(xw[m][bj][n].y) + a[2], bfhi(xw[m][bj][n].y) + a[3]);
                        *(u32x2*)(rowp + 128 * bj + 16 * n) = w; }
            }
            asm volatile("" ::: "memory");
        }
    }
};
typedef float f32x16 __attribute__((ext_vector_type(16)));
__device__ __forceinline__ void router_phase(const Params& p, FK_LAS unsigned char* lds, int vcu, int G, int tid, int lane, int wave) {
    unsigned char* ws = p.ws;
    FK_LAS float* PL = (FK_LAS float*)lds;
    FK_LAS float* SSP = PL + 8 * 64 * 33;
    FK_LAS int* lcnt = (FK_LAS int*)(lds + XTRA_OFF);
    FK_LAS int* lbase = lcnt + 16;
    FK_LAS int* ee = lbase + 16;
    FK_LAS int* pp = ee + 128;
    FK_LAS float* ww = (FK_LAS float*)(pp + 128);
    const bf16_t* X2 = (const bf16_t*)(ws + WS_X1B);
    const bf16_t* RWT = (const bf16_t*)(ws + WS_RWT);
    int* cnt = (int*)(ws + WS_CTL) + CW_CNT; int* list = (int*)(ws + WS_LIST); float* wl = (float*)(ws + WS_WL); float* r2o = (float*)(ws + WS_R2);
    const int r32 = lane & 31, hi = lane >> 5;
    for (int chunk = vcu; chunk < T / 64; chunk += G) {
        if (tid < 16) lcnt[tid] = 0;
        const int t0 = chunk * 64;
        bf16x8 a[2][8], bh[8], bl[8];
#pragma unroll
        for (int ks = 0; ks < 8; ++ks) {
            const int k = 128 * wave + 16 * ks + 8 * hi;
            a[0][ks] = *(const bf16x8*)(X2 + (size_t)(t0 + r32) * 1024 + k);
            a[1][ks] = *(const bf16x8*)(X2 + (size_t)(t0 + 32 + r32) * 1024 + k);
            bh[ks] = *(const bf16x8*)(RWT + (size_t)r32 * 1024 + k);
            bl[ks] = *(const bf16x8*)(RWT + (size_t)(32 + r32) * 1024 + k);
        }
        f32x16 acc0 = {}, acc1 = {};
        float ss0 = 0.f, ss1 = 0.f;
#pragma unroll
        for (int ks = 0; ks < 8; ++ks) {
            acc0 = __builtin_amdgcn_mfma_f32_32x32x16_bf16(a[0][ks], bh[ks], acc0, 0, 0, 0);
            acc1 = __builtin_amdgcn_mfma_f32_32x32x16_bf16(a[1][ks], bh[ks], acc1, 0, 0, 0);
            acc0 = __builtin_amdgcn_mfma_f32_32x32x16_bf16(a[0][ks], bl[ks], acc0, 0, 0, 0);
            acc1 = __builtin_amdgcn_mfma_f32_32x32x16_bf16(a[1][ks], bl[ks], acc1, 0, 0, 0);
#pragma unroll
            for (int e = 0; e < 8; ++e) { const float x0 = bf2f((unsigned short)a[0][ks][e]), x1 = bf2f((unsigned short)a[1][ks][e]); ss0 = fmaf(x0, x0, ss0); ss1 = fmaf(x1, x1, ss1); }
        }
        ss0 += __shfl_xor(ss0, 32); ss1 += __shfl_xor(ss1, 32);
        if (hi == 0) { SSP[wave * 64 + r32] = ss0; SSP[wave * 64 + 32 + r32] = ss1; }
#pragma unroll
        for (int r = 0; r < 16; ++r) {
            const int row = (r & 3) + 8 * (r >> 2) + 4 * hi;
            PL[(wave * 64 + row) * 33 + r32] = acc0[r];
            PL[(wave * 64 + 32 + row) * 33 + r32] = acc1[r];
        }
        __syncthreads();
        if (wave == 0) {
            const int tl = lane, t = t0 + tl;
            float lg[20];
#pragma unroll
            for (int i = 0; i < 20; ++i) { float s_ = 0.f;
#pragma unroll
                for (int w8 = 0; w8 < 8; ++w8) s_ += PL[(w8 * 64 + tl) * 33 + i];
                lg[i] = s_; }
            float ss = 0.f;
#pragma unroll
            for (int w8 = 0; w8 < 8; ++w8) ss += SSP[w8 * 64 + tl];
            const float r2 = rsqrtf(ss * (1.f / 1024.f) + EPS);
#pragma unroll
            for (int i = 0; i < 20; ++i) lg[i] = lg[i] * r2 + (i < 4 ? p.in[27][i] : p.in[29][i - 4]);
            r2o[t] = r2;
            const float gm = fmaxf(fmaxf(lg[0], lg[1]), fmaxf(lg[2], lg[3]));
            const float e0 = expf(lg[0] - gm), e1 = expf(lg[1] - gm), e2 = expf(lg[2] - gm), e3 = expf(lg[3] - gm);
            const float gs = e0 + e1 + e2 + e3;
            int gsel = 0; float gbest = e0;
            if (e1 > gbest) { gbest = e1; gsel = 1; }
            if (e2 > gbest) { gbest = e2; gsel = 2; }
            if (e3 > gbest) { gbest = e3; gsel = 3; }
            const float gwt = gbest / gs;
            const float v0 = gsel == 0 ? lg[4] : gsel == 1 ? lg[8] : gsel == 2 ? lg[12] : lg[16];
            const float v1 = gsel == 0 ? lg[5] : gsel == 1 ? lg[9] : gsel == 2 ? lg[13] : lg[17];
            const float v2 = gsel == 0 ? lg[6] : gsel == 1 ? lg[10] : gsel == 2 ? lg[14] : lg[18];
            const float v3 = gsel == 0 ? lg[7] : gsel == 1 ? lg[11] : gsel == 2 ? lg[15] : lg[19];
            int i1 = 0; float b1 = v0;
            if (v1 > b1) { b1 = v1; i1 = 1; }
            if (v2 > b1) { b1 = v2; i1 = 2; }
            if (v3 > b1) { b1 = v3; i1 = 3; }
            int i2 = 0; float b2 = -INFINITY;
            if (i1 != 0 && v0 > b2) { b2 = v0; i2 = 0; }
            if (i1 != 1 && v1 > b2) { b2 = v1; i2 = 1; }
            if (i1 != 2 && v2 > b2) { b2 = v2; i2 = 2; }
            if (i1 != 3 && v3 > b2) { b2 = v3; i2 = 3; }
            const float ex2 = expf(b2 - b1);
            const float w1 = gwt / (1.f + ex2), w2 = gwt * ex2 / (1.f + ex2);
            const int ea = gsel * 4 + i1, eb = gsel * 4 + i2;
            ee[tl * 2] = ea; pp[tl * 2] = __hip_atomic_fetch_add(&lcnt[ea], 1, __ATOMIC_RELAXED, __HIP_MEMORY_SCOPE_WORKGROUP); ww[tl * 2] = w1;
            ee[tl * 2 + 1] = eb; pp[tl * 2 + 1] = __hip_atomic_fetch_add(&lcnt[eb], 1, __ATOMIC_RELAXED, __HIP_MEMORY_SCOPE_WORKGROUP); ww[tl * 2 + 1] = w2;
        }
        __syncthreads();
        if (tid < 16) lbase[tid] = atomicAdd(&cnt[tid * 64], lcnt[tid]);
        __syncthreads();
        if (tid < 128) { const int e = ee[tid], pos = lbase[e] + pp[tid]; list[e * T + pos] = (t0 + (tid >> 1)) * 2 + (tid & 1); wl[e * T + pos] = ww[tid]; }
        __syncthreads();
    }
}
struct MoeTab {
    const FK_LAS int* t;
    __device__ __forceinline__ int total_tiles() const { return __builtin_amdgcn_readfirstlane(t[16]); }
    __device__ __forceinline__ void decode(int mtile, int& e, int& mt, int& ce) const {
        int ee = 0;
#pragma unroll
        for (int j = 1; j < 16; ++j) ee += (mtile >= __builtin_amdgcn_readfirstlane(t[j])) ? 1 : 0;
        e = ee; mt = mtile - __builtin_amdgcn_readfirstlane(t[ee]); ce = __builtin_amdgcn_readfirstlane(t[17 + ee]);
    }
};
__device__ __forceinline__ void moe_tab_init(FK_LAS int* t, const int* cnt, int tid) {
    if (tid == 0) { int acc = 0; t[0] = 0;
        for (int j = 0; j < 16; ++j) { const int c = __hip_atomic_load(cnt + j * 64, __ATOMIC_RELAXED, __HIP_MEMORY_SCOPE_AGENT); t[17 + j] = c; acc += (c + 255) >> 8; t[j + 1] = acc; } }
    __syncthreads();
}
struct SchedMoe1 {
    MoeTab tab; int G, c; const FK_LAS unsigned* xo;
    __device__ __forceinline__ bool next(int i, Unit& u) const {
        const int L = i * G + c; const int nun = tab.total_tiles() * 4;
        int e, mt, ce; tab.decode(L >> 2, e, mt, ce);
        u.a_off = 0; u.b_off = (unsigned)(WS_WGU + ((size_t)e * 1024 + (L & 3) * 256) * 1024 * 2); u.pm = L >> 2; u.pn = L & 3; u.kind = e; u.aux = i;
        return L < nun;
    }
    __device__ __forceinline__ unsigned row_off(const Unit& u, int r) const { return xo[u.aux * 256 + r]; }
};
struct EpiMoe1 {
    static constexpr bool PERM = false, AFTER_DRAIN = false;
    bf16_t* ACT; const FK_LAS float* xf;
    __device__ __forceinline__ void operator()(f32x4 (&acc)[2][2][4][2], const Unit& u, int wr, int wc, int fr, int fq, FK_LAS unsigned char*, int, int) const {
#pragma unroll
        for (int ai = 0; ai < 2; ++ai)
#pragma unroll
            for (int m = 0; m < 4; ++m) {
                const int r = ai * 128 + wr * 64 + m * 16 + fr;
                const float f1 = xf[u.aux * 512 + r], f2 = xf[u.aux * 512 + 256 + r];
                bf16_t* rowp = ACT + ((size_t)u.pm * 256 + r) * 512 + u.pn * 128 + wc * 32 + 4 * fq;
#pragma unroll
                for (int n = 0; n < 2; ++n) {
                    const f32x4 g = acc[ai][0][m][n] * f1, up = acc[ai][1][m][n] * f2; f32x4 a;
#pragma unroll
                    for (int i = 0; i < 4; ++i) a[i] = g[i] / (1.f + __expf(-g[i])) * up[i];
                    u32x2 w; w.x = pg8::cvt_pk_bf16(a[0], a[1]); w.y = pg8::cvt_pk_bf16(a[2], a[3]);
                    *(u32x2*)(rowp + 16 * n) = w;
                }
            }
    }
};
struct SchedMoe2 {
    MoeTab tab; int G, c;
    __device__ __forceinline__ bool next(int i, Unit& u) const {
        const int L = i * G + c; const int nun = tab.total_tiles() * 4;
        int e, mt, ce; tab.decode(L >> 2, e, mt, ce);
        u.a_off = (unsigned)(WS_ACT + (size_t)(L >> 2) * 256 * 512 * 2); u.b_off = (unsigned)(WS_WD + ((size_t)e * 1024 + (L & 3) * 256) * 512 * 2); u.pm = L >> 2; u.pn = L & 3; u.kind = e; u.aux = i;
        return L < nun;
    }
    __device__ __forceinline__ unsigned row_off(const Unit& u, int r) const { return u.a_off + (unsigned)r * 1024u; }
};
struct EpiMoe2 {
    static constexpr bool PERM = false, AFTER_DRAIN = false;
    bf16_t* YM; const FK_LAS int* xe;
    __device__ __forceinline__ void operator()(f32x4 (&acc)[2][2][4][2], const Unit& u, int wr, int wc, int fr, int fq, FK_LAS unsigned char*, int, int) const {
#pragma unroll
        for (int ai = 0; ai < 2; ++ai)
#pragma unroll
            for (int m = 0; m < 4; ++m) {
                const int r = ai * 128 + wr * 64 + m * 16 + fr;
                const int ent = xe[u.aux * 256 + r];
                if (ent >= 0) {
                    bf16_t* rowp = YM + (size_t)ent * 1024 + u.pn * 256 + wc * 32 + 4 * fq;
#pragma unroll
                    for (int bj = 0; bj < 2; ++bj)
#pragma unroll
                        for (int n = 0; n < 2; ++n) { const f32x4 x = acc[ai][bj][m][n]; u32x2 w; w.x = pg8::cvt_pk_bf16(x[0], x[1]); w.y = pg8::cvt_pk_bf16(x[2], x[3]);
                            *(u32x2*)(rowp + 128 * bj + 16 * n) = w; }
                }
            }
    }
};
__device__ __forceinline__ void final_phase(const Params& p, int vcu, int G, int lane, int wave) {
    const bf16_t* X2 = (const bf16_t*)(p.ws + WS_X1B); const bf16_t* YM = (const bf16_t*)p.out; const float* fg = p.in[33];
    const int gwv = vcu * NWAVES + wave, NGW = G * NWAVES;
    for (int t = gwv; t < T; t += NGW) {
        float v[16]; float ss = 0.f;
#pragma unroll
        for (int j = 0; j < 2; ++j) {
            const int k0 = j * 512 + lane * 8;
            const u32x4 a = *(const u32x4*)(X2 + (size_t)t * 1024 + k0), b = *(const u32x4*)(YM + (size_t)t * 2048 + k0), c = *(const u32x4*)(YM + (size_t)t * 2048 + 1024 + k0);
#pragma unroll
            for (int e = 0; e < 4; ++e) { v[j * 8 + 2 * e] = bflo(a[e]) + bflo(b[e]) + bflo(c[e]); v[j * 8 + 2 * e + 1] = bfhi(a[e]) + bfhi(b[e]) + bfhi(c[e]); }
        }
#pragma unroll
        for (int i = 0; i < 16; ++i) ss += v[i] * v[i];
        ss = wsum(ss);
        const float r = rsqrtf(ss * (1.f / 1024.f) + EPS);
        float* orow = p.out + (size_t)t * 1024;
#pragma unroll
        for (int j = 0; j < 2; ++j) {
            const int k0 = j * 512 + lane * 8;
            const f32x4 g0 = *(const f32x4*)(fg + k0), g1 = *(const f32x4*)(fg + k0 + 4);
            f32x4 o0, o1;
#pragma unroll
            for (int e = 0; e < 4; ++e) { o0[e] = v[j * 8 + e] * r * g0[e]; o1[e] = v[j * 8 + 4 + e] * r * g1[e]; }
            *(f32x4*)(orow + k0) = o0; *(f32x4*)(orow + k0 + 4) = o1;
        }
    }
}
__global__ void __launch_bounds__(NTHREADS, 2) mk(Params p) {
    extern __shared__ __attribute__((aligned(16))) unsigned char lds_raw[];
    FK_LAS unsigned char* lds = (FK_LAS unsigned char*)lds_raw;
    const int tid = threadIdx.x, lane = tid & 63, wave = __builtin_amdgcn_readfirstlane(tid >> 6);
    const int G = gridDim.x, bx = blockIdx.x;
    const int vcu = (G % 8 == 0) ? (bx % 8) * (G / 8) + bx / 8 : bx;
    unsigned char* ws = p.ws;
    volatile FK_LAS unsigned* bst = (volatile FK_LAS unsigned*)(lds + LDS_BYTES - 64);
    if (tid < 2) bst[tid] = 0u;
    __syncthreads();
    XcdBarrier bar = xcd_barrier_post((unsigned*)(ws + WS_CTL) + CW_BAR, bst);
#define IN(k) (p.ph_lo <= (k) && (k) < p.ph_hi)
#ifndef PROBE_PHASE
#define PROBE_PHASE -1
#define PROBE_N 1
#endif
#define REP(k) for (int rr_ = 0; rr_ < ((k) == PROBE_PHASE ? PROBE_N : 1); ++rr_)
#define REPBAR() do { if (rr_ > 0) xcd_barrier(bar); } while (0)
#define SEAM(k) do { if (IN(k) && IN((k) + 1)) xcd_barrier(bar); } while (0)
    if (IN(0)) { p0_prologue(p, lds, vcu, G, tid, lane, wave);
#if PROBE_PHASE == 0
        xcd_barrier(bar); p0_prologue(p, lds, vcu, G, tid, lane, wave); xcd_barrier(bar); p0_prologue(p, lds, vcu, G, tid, lane, wave);
#endif
    }
    SEAM(0);
    if (IN(1)) REP(1) { REPBAR();
        Gemm g{(const char*)ws, 1024, 1024, 1024};
        SchedP1 S{G, bx};
        EpiP1 E{ws, p.in[4], p.in[5]};
        f32x4 acc[2][2][4][2];
        pg8::gemm_phase<EpiP1, SchedP1, true, true, false>(lds, g, S, E, acc);
    }
    SEAM(1);
    if (IN(2)) REP(2) { REPBAR();
        attn_body::attn_phase<8>((char*)lds_raw, (const attn_body::bf16*)(ws + WS_Q), (const attn_body::bf16*)(ws + WS_K), (const attn_body::bf16*)(ws + WS_V),
                                 (attn_body::bf16*)(ws + WS_YCAT), (float*)(ws + WS_SSATT), G, vcu);
    }
    SEAM(2);
    if (IN(3)) REP(3) { REPBAR();
        for (int L = bx; L < 64; L += G) {
            const int g = L >> 1, mt = L & 1;
            Gemm gm{(const char*)ws, SUP, 512, 512};
            SchedOne S{mk_unit((unsigned)(WS_SU + (((size_t)g * SROWS + mt * 256) * SUP + 256) * 2), (unsigned)(WS_W1 + (size_t)g * 256 * 512 * 2), mt, 0, 0), SUP * 2};
            EpiSloc E{(float*)(ws + WS_SLOC) + (size_t)g * SROWS * 256};
            f32x4 acc[2][2][4][2];
            pg8::gemm_phase<EpiSloc, SchedOne, false, true, false>(lds, gm, S, E, acc);
            asm volatile("s_waitcnt vmcnt(0)" ::: "memory"); __syncthreads();
            { int t2 = threadIdx.x; asm volatile("" : "+v"(t2)); s5_scan(p, g, mt, t2); }
        }
    }
    SEAM(3);
    if (IN(4)) REP(4) { REPBAR();
        for (int L = bx; L < 128; L += G) {
            const int g = L >> 2, mt = (L >> 1) & 1, ntile = L & 1;
            Gemm gm{(const char*)ws, SUP, SUP, SUP};
            SchedOne S{mk_unit((unsigned)(WS_SU + ((size_t)g * SROWS + mt * 256) * SUP * 2), (unsigned)(WS_W2 + ((size_t)g * 512 + ntile * 256) * SUP * 2), mt, ntile, 0), SUP * 2};
            EpiS5Out E{(bf16_t*)(ws + WS_Z), g, mt, ntile};
            f32x4 acc[2][2][4][2];
            pg8::gemm_phase<EpiS5Out, SchedOne, false, true, false>(lds, gm, S, E, acc);
        }
    }
    SEAM(4);
    if (IN(5)) REP(5) { REPBAR();
        for (int L = bx; L < 128; L += G) {
            int pm, pn; pg8::tile_order(L, 64, 2, pm, pn);
            Gemm gm{(const char*)ws, 512, 512, 512};
            SchedOne S{mk_unit((unsigned)(WS_Z + (size_t)pm * 256 * 512 * 2), (unsigned)(WS_GLU + (size_t)pn * 256 * 512 * 2), pm, pn, 0), 512 * 2};
            EpiGlu E{(const bf16_t*)(ws + WS_Z), (bf16_t*)(ws + WS_YCAT), (float*)(ws + WS_SSSSM), p.in[15]};
            f32x4 acc[2][2][4][2];
            pg8::gemm_phase<EpiGlu, SchedOne, false, true, false>(lds, gm, S, E, acc);
        }
    }
    SEAM(5);
    if (IN(6)) REP(6) { REPBAR();
        for (int L = bx; L < 256; L += G) {
            int pm, pn; pg8::tile_order(L, 64, 4, pm, pn);
            Gemm gm{(const char*)ws, 1024, 1024, 512};
            const unsigned a0 = (unsigned)(WS_YCAT + (size_t)pm * 256 * 1024 * 2), b0 = (unsigned)(WS_WOUT + (size_t)pn * 256 * 1024 * 2);
            f32x4 acc[2][2][4][2];
            FK_LAS float* xt = (FK_LAS float*)(lds + XTRA_OFF);
            { int t2 = threadIdx.x; asm volatile("" : "+v"(t2));
              if (t2 < 256) { const size_t row = (size_t)pm * 256 + t2; const float ra = rs8((const float*)(ws + WS_SSATT), row, 1.f / 512.f), rs = rs8((const float*)(ws + WS_SSSSM), row, 1.f / 512.f); xt[t2] = ra / rs; xt[256 + t2] = rs; }
              __syncthreads(); }
            { SchedOne S{mk_unit(a0, b0, pm, pn, 0), 2048}; EpiWoutMid E{xt};
              pg8::gemm_phase<EpiWoutMid, SchedOne, false, true, false>(lds, gm, S, E, acc); }
            { SchedOne S{mk_unit(a0 + 1024, b0 + 1024, pm, pn, 0), 2048}; EpiWoutFin E{xt, (const bf16_t*)(ws + WS_XB), (bf16_t*)(ws + WS_X1B), (float*)(ws + WS_SSX1)};
              pg8::gemm_phase<EpiWoutFin, SchedOne, false, true, true>(lds, gm, S, E, acc); }
        }
    }
    SEAM(6);
    if (IN(7)) REP(7) { REPBAR();
        for (int L = bx; L < 256; L += G) {
            int pm, pn; pg8::tile_order(L, 64, 4, pm, pn);
            const int b = pm >> 3;
            FK_LAS float* xt = (FK_LAS float*)(lds + XTRA_OFF);
            { int t2 = threadIdx.x; asm volatile("" : "+v"(t2));
              if (t2 < 256) { const float* s1 = (const float*)(ws + WS_SSX1) + ((size_t)pm * 256 + t2) * 16; const f32x4 a = *(const f32x4*)s1, b4 = *(const f32x4*)(s1 + 4), c = *(const f32x4*)(s1 + 8), d = *(const f32x4*)(s1 + 12);
                  xt[t2] = rsqrtf((((a[0] + a[1]) + (a[2] + a[3])) + ((b4[0] + b4[1]) + (b4[2] + b4[3])) + ((c[0] + c[1]) + (c[2] + c[3])) + ((d[0] + d[1]) + (d[2] + d[3]))) * (1.f / 1024.f) + EPS); }
              __syncthreads(); }
            const size_t tile = ((size_t)pm * 256 * 1024 + pn * 256) * 2;
            f32x4 acc[2][2][4][2];
            { Gemm gm{(const char*)ws, 1024, 1024, 1024};
              SchedOne S{mk_unit((unsigned)(WS_X1B + (size_t)pm * 256 * 1024 * 2), (unsigned)(WS_WQ + (size_t)pn * 256 * 1024 * 2), pm, pn, 0), 2048};
              EpiScaleBf16 E{(bf16_t*)(ws + WS_QX + tile), 1024, xt, XQSCALE};
              pg8::gemm_phase<EpiScaleBf16, SchedOne, false, true, false>(lds, gm, S, E, acc); }
            asm volatile("s_waitcnt vmcnt(0)" ::: "memory"); __syncthreads();
            { Gemm gm{(const char*)ws, 1024, 1024, 256};
              SchedOne S{mk_unit((unsigned)(WS_QX + tile), (unsigned)(WS_KM + ((size_t)b * 256 * 1024 + pn * 256) * 2), pm, pn, 0), 2048};
              EpiSoftmax E{(bf16_t*)(ws + WS_PB + tile), 1024};
              pg8::gemm_phase<EpiSoftmax, SchedOne, false, true, false>(lds, gm, S, E, acc); }
            asm volatile("s_waitcnt vmcnt(0)" ::: "memory"); __syncthreads();
            { Gemm gm{(const char*)ws, 1024, 256, 256};
              SchedOne S{mk_unit((unsigned)(WS_PB + tile), (unsigned)(WS_VT + ((size_t)b * 1024 + pn * 256) * 256 * 2), pm, pn, 0), 2048};
              EpiScaleBf16 E{(bf16_t*)(ws + WS_QX + tile), 1024, nullptr, 1.f};
              pg8::gemm_phase<EpiScaleBf16, SchedOne, false, true, false>(lds, gm, S, E, acc); }
        }
    }
    SEAM(7);
    if (IN(8)) REP(8) { REPBAR();
        for (int L = bx; L < 256; L += G) {
            int pm, pn; pg8::tile_order(L, 64, 4, pm, pn);
            const size_t tile = ((size_t)pm * 256 * 1024 + pn * 256) * 2;
            Gemm gm{(const char*)ws, 1024, 1024, 1024};
            SchedOne S{mk_unit((unsigned)(WS_QX + (size_t)pm * 256 * 1024 * 2), (unsigned)(WS_WO + (size_t)pn * 256 * 1024 * 2), pm, pn, 0), 2048};
            EpiResid E{(bf16_t*)(ws + WS_X1B + tile), 1024};
            f32x4 acc[2][2][4][2];
            pg8::gemm_phase<EpiResid, SchedOne, false, true, false>(lds, gm, S, E, acc);
        }
    }
    SEAM(8);
    if (IN(9)) REP(9) { REPBAR(); if (rr_ > 0) { if (bx == 0 && tid < 16) __hip_atomic_store((int*)(ws + WS_CTL) + CW_CNT + tid * 64, 0, __ATOMIC_RELAXED, __HIP_MEMORY_SCOPE_AGENT); xcd_barrier(bar); } router_phase(p, lds, vcu, G, tid, lane, wave); }
    SEAM(9);
    if (IN(10)) REP(10) { REPBAR();
        FK_LAS int* tabp = (FK_LAS int*)(lds + XTRA_OFF + 15 * 1024); moe_tab_init(tabp, (const int*)(ws + WS_CTL) + CW_CNT, threadIdx.x); MoeTab tab{tabp};
        FK_LAS unsigned* xo = (FK_LAS unsigned*)(lds + XTRA_OFF);
        FK_LAS float* xf = (FK_LAS float*)(lds + XTRA_OFF + 5 * 1024);
        { int t2 = threadIdx.x; asm volatile("" : "+v"(t2));
          const int nun = tab.total_tiles() * 4; int i = 0;
          for (int L = bx; L < nun && i < 5; L += G, ++i) {
              if (t2 < 256) { int e, mt, ce; tab.decode(L >> 2, e, mt, ce); const int idx = mt * 256 + t2; const bool valid = idx < ce;
                  const int ent = valid ? ((const int*)(ws + WS_LIST))[e * T + idx] : 0; const int tok = ent >> 1;
                  xo[i * 256 + t2] = (unsigned)(WS_X1B + (size_t)tok * 2048);
                  const float r2 = ((const float*)(ws + WS_R2))[tok];
                  xf[i * 512 + t2] = r2; xf[i * 512 + 256 + t2] = valid ? r2 * ((const float*)(ws + WS_WL))[e * T + idx] : 0.f; }
          }
          __syncthreads(); }
        Gemm gm{(const char*)ws, 1024, 1024, 1024};
        SchedMoe1 S{tab, G, bx, xo};
        EpiMoe1 E{(bf16_t*)(ws + WS_ACT), xf};
        f32x4 acc[2][2][4][2];
        pg8::gemm_phase<EpiMoe1, SchedMoe1, true, true, false>(lds, gm, S, E, acc);
    }
    SEAM(10);
    if (IN(11)) REP(11) { REPBAR();
        FK_LAS int* tabp = (FK_LAS int*)(lds + XTRA_OFF + 15 * 1024); moe_tab_init(tabp, (const int*)(ws + WS_CTL) + CW_CNT, threadIdx.x); MoeTab tab{tabp};
        FK_LAS int* xe = (FK_LAS int*)(lds + XTRA_OFF);
        { int t2 = threadIdx.x; asm volatile("" : "+v"(t2));
          const int nun = tab.total_tiles() * 4; int i = 0;
          for (int L = bx; L < nun && i < 5; L += G, ++i) {
              if (t2 < 256) { int e, mt, ce; tab.decode(L >> 2, e, mt, ce); const int idx = mt * 256 + t2;
                  xe[i * 256 + t2] = idx < ce ? ((const int*)(ws + WS_LIST))[e * T + idx] : -1; }
          }
          __syncthreads(); }
        Gemm gm{(const char*)ws, 512, 512, 512};
        SchedMoe2 S{tab, G, bx};
        EpiMoe2 E{(bf16_t*)p.out, xe};
        f32x4 acc[2][2][4][2];
        pg8::gemm_phase<EpiMoe2, SchedMoe2, true, true, false>(lds, gm, S, E, acc);
    }
    SEAM(11);
    if (IN(12)) REP(12) { REPBAR(); final_phase(p, vcu, G, lane, wave); }
#undef SEAM
#undef IN
}

}
extern "C" void kernel_launch(void* const* d_in, const int* in_sizes, int n_in, void* d_out, int out_size, void* d_ws, size_t ws_size, hipStream_t stream) {
    static int grid = 0;
    if (grid == 0) {
        int dev = 0, cus = 0, per_cu = 0;
        (void)hipGetDevice(&dev);
        (void)hipDeviceGetAttribute(&cus, hipDeviceAttributeMultiprocessorCount, dev);
        (void)hipFuncSetAttribute((const void*)fk::mk, hipFuncAttributeMaxDynamicSharedMemorySize, fk::LDS_BYTES);
        (void)hipOccupancyMaxActiveBlocksPerMultiprocessor(&per_cu, (const void*)fk::mk, fk::NTHREADS, fk::LDS_BYTES);
        if (per_cu < 1 || cus < 1 || ws_size < fk::WS_END) { fprintf(stderr, "kernel_launch: cus %d per_cu %d ws %zu: cannot launch\n", cus, per_cu, ws_size); grid = -1; }
        else grid = cus;
    }
    if (grid < 0) return;
    (void)hipMemsetAsync(d_ws, 0, 1u << 20, stream);
    fk::Params p{};
    for (int i = 0; i < 34; ++i) p.in[i] = (const float*)d_in[i];
    p.out = (float*)d_out; p.ws = (unsigned char*)d_ws; p.ph_lo = 0; p.ph_hi = 13;
    void* args[] = {&p};
    hipError_t e = hipLaunchCooperativeKernel((const void*)fk::mk, dim3(grid), dim3(fk::NTHREADS), args, fk::LDS_BYTES, stream);
    if (e != hipSuccess) fprintf(stderr, "cooperative launch failed: %s (grid %d)\n", hipGetErrorString(e), grid);
}
```

```cpp
#include <hip/hip_runtime.h>
#include <hip/hip_bf16.h>
#include <cmath>
#include <stdint.h>
#include <stdio.h>
#include <hip/hip_cooperative_groups.h>
namespace fk {
namespace cg = cooperative_groups;
#define FK_LAS __attribute__((address_space(3)))
#define FK_GAS __attribute__((address_space(1)))
typedef unsigned short bf16_t;
typedef short bf16x8 __attribute__((ext_vector_type(8)));
typedef float f32x4 __attribute__((ext_vector_type(4)));
typedef float f32x2 __attribute__((ext_vector_type(2)));
typedef unsigned u32x4 __attribute__((ext_vector_type(4)));
typedef unsigned u32x2 __attribute__((ext_vector_type(2)));

constexpr int T = 16384, SEQ = 2048, BATCH = 8, DM = 1024, MEMLEN = 256, MTOK = BATCH * MEMLEN;
constexpr float EPS = 1e-6f;
constexpr float LOG2E = 1.4426950408889634f;
constexpr float QSCALE = 0.125f * LOG2E;
constexpr float XQSCALE = 0.0625f * LOG2E;
constexpr int NWAVES = 8, NTHREADS = 512;
constexpr int SL = 32, NCH = SEQ / SL;
constexpr int SUP = 768;
constexpr int SROWS = BATCH * NCH;

constexpr size_t MiB = 1u << 20;
constexpr size_t WS_CTL = 0;
constexpr size_t WS_WIN = 1 * MiB;
constexpr size_t WS_GLU = 4 * MiB;
constexpr size_t WS_WOUT = 5 * MiB;
constexpr size_t WS_WQ = 7 * MiB, WS_WK = 9 * MiB, WS_WV = 11 * MiB, WS_WO = 13 * MiB;
constexpr size_t WS_W1 = 15 * MiB;
constexpr size_t WS_W2 = 23 * MiB;
constexpr size_t WS_WGU = 47 * MiB;
constexpr size_t WS_WD = 79 * MiB;
constexpr size_t WS_R0 = 95 * MiB;
constexpr size_t WS_ROPE = WS_R0 + 65536;
constexpr size_t WS_R2 = WS_ROPE + 65536;
constexpr size_t WS_RWT = 95 * MiB + 256 * 1024;
constexpr size_t WS_SSATT = 95 * MiB + 512 * 1024;
constexpr size_t WS_SSSSM = 96 * MiB;
constexpr size_t WS_SSX1 = 96 * MiB + 512 * 1024;
constexpr size_t WS_LIST = 102 * MiB;
constexpr size_t WS_WL = 103 * MiB;
constexpr size_t WS_XB = 105 * MiB;
constexpr size_t WS_HM = 137 * MiB;
constexpr size_t WS_Q = 141 * MiB;
constexpr size_t WS_K = 157 * MiB;
constexpr size_t WS_V = 161 * MiB;
constexpr size_t WS_SU = 165 * MiB;
constexpr size_t WS_SLOC = 189 * MiB;
constexpr size_t WS_KM = 205 * MiB;
constexpr size_t WS_VT = 209 * MiB;
constexpr size_t WS_YCAT = 213 * MiB;
constexpr size_t WS_END = 245 * MiB;
constexpr size_t WS_Z = WS_Q, WS_X1B = WS_SU, WS_QX = WS_XB, WS_PB = WS_YCAT, WS_ACT = WS_XB;
constexpr int CW_CNT = 64;
constexpr int CW_BAR = 4096;

constexpr int RING_BYTES = 131072, XTRA_OFF = RING_BYTES, LDS_BYTES = 147456;

__device__ __forceinline__ unsigned f2bf(float f) { unsigned u = __builtin_bit_cast(unsigned, f); return (u + 0x7fffu + ((u >> 16) & 1u)) >> 16; }
__device__ __forceinline__ unsigned pk2(float lo, float hi) { return f2bf(lo) | (f2bf(hi) << 16); }
__device__ __forceinline__ float bf2f(unsigned short b) { return __builtin_bit_cast(float, (unsigned)b << 16); }
__device__ __forceinline__ float bflo(unsigned w) { return __builtin_bit_cast(float, w << 16); }
__device__ __forceinline__ float bfhi(unsigned w) { return __builtin_bit_cast(float, w & 0xffff0000u); }
__device__ __forceinline__ float wsum(float v) {
#pragma unroll
    for (int o = 1; o < 64; o <<= 1) v += __shfl_xor(v, o);
    return v;
}

namespace pg8 {
constexpr int BM = 256, BK = 64, HALF = 128, HTB = HALF * BK * 2, STAGE_BYTES = 8 * HTB, NXCD = 8, WGM = 8;
__host__ __device__ __forceinline__ int lds_byte(int r, int c) { const int st = (r >> 4) * 2 + (c >> 5), rr = r & 15, cc = c & 31, ob = rr * 64 + cc * 2; return st * 1024 + (ob ^ (((ob >> 9) & 1) << 5)); }
__host__ __device__ __forceinline__ void stage_rc(int b, int& R, int& C) { const int st = b / 1024, sb = b % 1024, swz = sb ^ (((sb >> 9) & 1) << 5); R = (st >> 1) * 16 + swz / 64; C = (st & 1) * 32 + (swz % 64) / 2; }
__host__ __device__ __forceinline__ int perm32(int rho) { const int n = rho >> 4, i = rho & 15; return 8 * (i >> 2) + 4 * n + (i & 3); }

struct Unit { unsigned a_off, b_off; int pm, pn, kind, aux; };
struct Gemm { const char* base; int lda, ldb, K; };

__device__ __forceinline__ void tile_order(int L, int nM, int nN, int& pm, int& pn) {
    const int nwg = nM * nN; int wgid = L;
    { const int q = nwg / NXCD, r = nwg % NXCD, xcd = wgid % NXCD, off = wgid / NXCD; wgid = (xcd < r ? xcd * (q + 1) : r * (q + 1) + (xcd - r) * q) + off; }
    const int nig = WGM * nN, gid = wgid / nig, fm = gid * WGM, gsz = (nM - fm) < WGM ? (nM - fm) : WGM;
    pm = fm + ((wgid % nig) % gsz); pn = (wgid % nig) / gsz;
}

__device__ __forceinline__ unsigned cvt_pk_bf16(float lo, float hi) { unsigned r; asm volatile("v_cvt_pk_bf16_f32 %0, %1, %2" : "=v"(r) : "v"(lo), "v"(hi)); return r; }

template <class Epi, class Sched, bool ALIGN_EPI, bool SP2, bool KEEP_ACC>
__device__ __forceinline__ void gemm_phase(FK_LAS unsigned char* lds, const Gemm g, const Sched& S, const Epi& E, f32x4 (&acc)[2][2][4][2]) {
    int tid_ = threadIdx.x; asm volatile("" : "+v"(tid_));
    const int tid = tid_, wid = __builtin_amdgcn_readfirstlane(tid >> 6), lane = tid & 63, wr = wid >> 2, wc = wid & 3, fr = lane & 15, fq = lane >> 4;
    const int K = g.K, nt = K / BK;
    int R0, C0; stage_rc(tid * 16, R0, C0);
    unsigned voffB[2];
#pragma unroll
    for (int i = 0; i < 2; ++i) { const int R = R0 + 64 * i; const int Rb = Epi::PERM ? ((R & ~31) + perm32(R & 31)) : R; voffB[i] = (unsigned)(Rb * g.ldb + C0) * 2u; }
    const size_t kstep = (size_t)(BK * 2);
    const size_t hstepB = (size_t)HALF * g.ldb * 2;
    const unsigned ldsw = (unsigned)wid * 1024u;
    const int aoff = lds_byte(wr * 64 + fr, fq * 8), boff = lds_byte(wc * 32 + fr, fq * 8);
#define PG8_SA(b, h) (((b) * 2 + (h)) * HTB)
#define PG8_SB(b, h) ((4 + (b) * 2 + (h)) * HTB)
#define PG8_STAGE(bufoff, gbase, voff) do { _Pragma("unroll") for (int _i = 0; _i < 2; ++_i) \
        __builtin_amdgcn_global_load_lds((const unsigned*)((const char*)(gbase) + (voff)[_i]), (FK_LAS unsigned*)(lds + (bufoff) + ldsw + _i * 8192), 16, 0, 0); } while (0)
#define PG8_STAGEA(bufoff, gbase, h) do { _Pragma("unroll") for (int _i = 0; _i < 2; ++_i) \
        __builtin_amdgcn_global_load_lds((const unsigned*)((const char*)(gbase) + voffA[2 * (h) + _i]), (FK_LAS unsigned*)(lds + (bufoff) + ldsw + _i * 8192), 16, 0, 0); } while (0)
#define PG8_LDA(dst, b, h) do { _Pragma("unroll") for (int m = 0; m < 4; ++m) _Pragma("unroll") for (int k = 0; k < 2; ++k) dst[m][k] = *(const FK_LAS bf16x8*)(lds + PG8_SA(b, h) + aoff + m * 2048 + k * 1024); } while (0)
#define PG8_LDB(dst, b, h) do { _Pragma("unroll") for (int n = 0; n < 2; ++n) _Pragma("unroll") for (int k = 0; k < 2; ++k) dst[n][k] = *(const FK_LAS bf16x8*)(lds + PG8_SB(b, h) + boff + n * 2048 + k * 1024); } while (0)
#define PG8_MMA(ai, bj, At, Bt) do { __builtin_amdgcn_s_setprio(1); _Pragma("unroll") for (int m = 0; m < 4; ++m) _Pragma("unroll") for (int n = 0; n < 2; ++n) _Pragma("unroll") for (int k = 0; k < 2; ++k) \
        acc[ai][bj][m][n] = __builtin_amdgcn_mfma_f32_16x16x32_bf16(Bt[n][k], At[m][k], acc[ai][bj][m][n], 0, 0, 0); __builtin_amdgcn_s_setprio(0); } while (0)
#define PG8_WAIT_V(n) asm volatile("s_waitcnt vmcnt(" #n ")" ::: "memory")
#define PG8_WAIT_L(n) asm volatile("s_waitcnt lgkmcnt(" #n ")" ::: "memory")
#define PG8_BAR __builtin_amdgcn_s_barrier()
#define PG8_SCHED __builtin_amdgcn_sched_barrier(0)
    Unit cur, nxt; int ui = 0;
    if (!S.next(0, cur)) return;
    if constexpr (!KEEP_ACC) {
#pragma unroll
        for (int a = 0; a < 2; ++a)
#pragma unroll
            for (int b = 0; b < 2; ++b)
#pragma unroll
                for (int m = 0; m < 4; ++m)
#pragma unroll
                    for (int n = 0; n < 2; ++n) acc[a][b][m][n] = (f32x4){0.f, 0.f, 0.f, 0.f};
    }
    bf16x8 At[4][2], B0[2][2], B1[2][2];
    unsigned voffA[4];
#pragma unroll
    for (int q = 0; q < 4; ++q) voffA[q] = S.row_off(cur, R0 + 64 * q) + (unsigned)C0 * 2u;
    const char* Ab = g.base;
    const char* cB = g.base + cur.b_off;
    if constexpr (SP2) {
        PG8_STAGE(PG8_SB(0, 0), cB, voffB); PG8_STAGE(PG8_SB(0, 1), cB + hstepB, voffB); PG8_STAGEA(PG8_SA(0, 0), Ab, 0); PG8_STAGEA(PG8_SA(0, 1), Ab, 1);
        if (wr == 1) PG8_BAR;
        PG8_WAIT_V(2); PG8_BAR;
        PG8_STAGE(PG8_SB(1, 0), cB + kstep, voffB); PG8_STAGEA(PG8_SA(1, 0), Ab + kstep, 0); PG8_STAGE(PG8_SB(1, 1), cB + hstepB + kstep, voffB);
        PG8_WAIT_V(6); PG8_BAR;
    } else {
        PG8_STAGE(PG8_SB(0, 0), cB, voffB); PG8_STAGEA(PG8_SA(0, 0), Ab, 0); PG8_STAGE(PG8_SB(0, 1), cB + hstepB, voffB); PG8_STAGEA(PG8_SA(0, 1), Ab, 1);
        if (wr == 1) PG8_BAR;
        PG8_WAIT_V(4); PG8_BAR;
        PG8_STAGE(PG8_SB(1, 0), cB + kstep, voffB); PG8_STAGEA(PG8_SA(1, 0), Ab + kstep, 0); PG8_STAGE(PG8_SB(1, 1), cB + hstepB + kstep, voffB);
        PG8_WAIT_V(6); PG8_BAR;
    }
    for (;;) {
        const bool has_next = S.next(ui + 1, nxt);
        const char* nB = has_next ? g.base + nxt.b_off : cB;
        for (int t = 0; t < nt; t += 2) {
            const bool last = (t == nt - 2);
            const char* a1 = Ab + (size_t)(t + 1) * kstep;
            const char* a2 = last ? Ab : Ab + (size_t)(t + 2) * kstep; const char* b2 = last ? nB : cB + (size_t)(t + 2) * kstep;
            const char* a3 = a2 + kstep; const char* b3 = b2 + kstep;
            if constexpr (SP2) {
            PG8_LDB(B0, 0, 0); PG8_LDB(B1, 0, 1); PG8_SCHED; PG8_LDA(At, 0, 0); PG8_STAGEA(PG8_SA(1, 1), a1, 1);
            if (last && has_next) {
#pragma unroll
                for (int q = 0; q < 4; ++q) voffA[q] = S.row_off(nxt, R0 + 64 * q) + (unsigned)C0 * 2u;
            }
            PG8_WAIT_V(8); PG8_WAIT_L(0); PG8_BAR; PG8_MMA(0, 0, At, B0); PG8_MMA(0, 1, At, B1); PG8_BAR; PG8_SCHED;
            PG8_LDA(At, 0, 1); PG8_STAGE(PG8_SB(0, 0), b2, voffB); PG8_STAGE(PG8_SB(0, 1), b2 + hstepB, voffB); PG8_STAGEA(PG8_SA(0, 0), a2, 0);
            PG8_WAIT_V(8); PG8_WAIT_L(0); PG8_BAR; PG8_MMA(1, 0, At, B0); PG8_MMA(1, 1, At, B1); PG8_BAR; PG8_SCHED;
            PG8_LDB(B0, 1, 0); PG8_LDB(B1, 1, 1); PG8_SCHED; PG8_LDA(At, 1, 0); PG8_STAGEA(PG8_SA(0, 1), a2, 1);
            PG8_WAIT_V(8); PG8_WAIT_L(0); PG8_BAR; PG8_MMA(0, 0, At, B0); PG8_MMA(0, 1, At, B1); PG8_BAR; PG8_SCHED;
            PG8_LDA(At, 1, 1); PG8_STAGE(PG8_SB(1, 0), b3, voffB); PG8_STAGE(PG8_SB(1, 1), b3 + hstepB, voffB); PG8_STAGEA(PG8_SA(1, 0), a3, 0);
            PG8_WAIT_V(8); PG8_WAIT_L(0); PG8_BAR; PG8_MMA(1, 0, At, B0); PG8_MMA(1, 1, At, B1); PG8_BAR; PG8_SCHED;
            } else {
            PG8_LDB(B0, 0, 0); PG8_SCHED; PG8_LDA(At, 0, 0); PG8_STAGEA(PG8_SA(1, 1), a1, 1);
            if (last && has_next) {
#pragma unroll
                for (int q = 0; q < 4; ++q) voffA[q] = S.row_off(nxt, R0 + 64 * q) + (unsigned)C0 * 2u;
            }
            PG8_WAIT_L(8); PG8_BAR; PG8_WAIT_L(0); PG8_MMA(0, 0, At, B0); PG8_BAR; PG8_SCHED;
            PG8_LDB(B1, 0, 1); PG8_STAGE(PG8_SB(0, 0), b2, voffB);
            PG8_BAR; PG8_WAIT_L(0); PG8_MMA(0, 1, At, B1); PG8_BAR;
            PG8_LDA(At, 0, 1); PG8_STAGEA(PG8_SA(0, 0), a2, 0);
            PG8_BAR; PG8_WAIT_L(0); PG8_MMA(1, 0, At, B0); PG8_BAR; PG8_SCHED;
            PG8_STAGE(PG8_SB(0, 1), b2 + hstepB, voffB);
            PG8_WAIT_V(6); PG8_BAR; PG8_MMA(1, 1, At, B1); PG8_BAR;
            PG8_LDB(B0, 1, 0); PG8_SCHED; PG8_LDA(At, 1, 0); PG8_STAGEA(PG8_SA(0, 1), a2, 1);
            PG8_WAIT_L(8); PG8_BAR; PG8_WAIT_L(0); PG8_MMA(0, 0, At, B0); PG8_BAR; PG8_SCHED;
            PG8_LDB(B1, 1, 1); PG8_STAGE(PG8_SB(1, 0), b3, voffB);
            PG8_BAR; PG8_WAIT_L(0); PG8_MMA(0, 1, At, B1); PG8_BAR;
            PG8_LDA(At, 1, 1); PG8_STAGEA(PG8_SA(1, 0), a3, 0);
            PG8_BAR; PG8_WAIT_L(0); PG8_MMA(1, 0, At, B0); PG8_BAR; PG8_SCHED;
            PG8_STAGE(PG8_SB(1, 1), b3 + hstepB, voffB);
            PG8_WAIT_V(6); PG8_BAR; PG8_MMA(1, 1, At, B1); PG8_BAR;
            }
        }
        if constexpr (ALIGN_EPI) { if (wr == 0) PG8_BAR; }
        if constexpr (!Epi::AFTER_DRAIN) { int fr_e = fr, fq_e = fq, lane_e = lane; asm volatile("" : "+v"(fr_e), "+v"(fq_e), "+v"(lane_e)); E(acc, cur, wr, wc, fr_e, fq_e, lds, wid, lane_e); }
        if (!has_next) break;
#pragma unroll
        for (int a = 0; a < 2; ++a)
#pragma unroll
            for (int b = 0; b < 2; ++b)
#pragma unroll
                for (int m = 0; m < 4; ++m)
#pragma unroll
                    for (int n = 0; n < 2; ++n) acc[a][b][m][n] = (f32x4){0.f, 0.f, 0.f, 0.f};
        cur = nxt; cB = nB; ++ui;
        if constexpr (ALIGN_EPI) { if (wr == 1) PG8_BAR; }
    }
    PG8_WAIT_V(0);
    if constexpr (!ALIGN_EPI) { if (wr == 0) PG8_BAR; }
    PG8_BAR;
    if constexpr (Epi::AFTER_DRAIN) { int fr_e = fr, fq_e = fq, lane_e = lane; asm volatile("" : "+v"(fr_e), "+v"(fq_e), "+v"(lane_e)); E(acc, cur, wr, wc, fr_e, fq_e, lds, wid, lane_e); }
#undef PG8_SA
#undef PG8_SB
#undef PG8_STAGE
#undef PG8_STAGEA
#undef PG8_LDA
#undef PG8_LDB
#undef PG8_MMA
#undef PG8_WAIT_V
#undef PG8_WAIT_L
#undef PG8_BAR
#undef PG8_SCHED
}
}
namespace attn_body {
using bf16=__hip_bfloat16;
using bf16x8=__attribute__((ext_vector_type(8)))short;
using s16x4=__attribute__((ext_vector_type(4)))short;
using f32x16=__attribute__((ext_vector_type(16)))float;
using u32x4=__attribute__((ext_vector_type(4)))unsigned;
constexpr int BATCH=8,NHEAD=8,SEQ=2048,D=64,QP=512,KP=128,OP=1024;
constexpr int NW=8,QBLK=32,QB=QBLK*NW,KVBLK=64,NQB=SEQ/QB;
constexpr int ATTN_UNIT_ROWS=QB;
__device__ __forceinline__ int crow(int r,int hi){return (r&3)+8*(r>>2)+4*hi;}
#define SBAR() __builtin_amdgcn_sched_barrier(0)
__device__ __forceinline__ void cmask(f32x16&p0,f32x16&p1,int jb,int qrel,int hi){
  const float NEG=-INFINITY; int kb=64*jb+4*hi;
  #pragma unroll
  for(int r=0;r<16;++r){int kv=kb+(r&3)+8*(r>>2); if(kv>qrel)p0[r]=NEG; if(kv+32>qrel)p1[r]=NEG;}
}

constexpr int NSLOT=3, SLOTB=8192;
constexpr int LDS_K=0, LDS_V=NSLOT*SLOTB, LDS_WS=2*NSLOT*SLOTB, LDS_OST=LDS_WS+NW*64*4, LDS_BYTES=LDS_OST+NW*4096;
constexpr float C2=0.125f*1.4426950408889634f;
__device__ __forceinline__ void glds16(const void*gsrc,unsigned lds_dst){unsigned keep;
  asm volatile("s_mov_b32 %0, m0\n\ts_mov_b32 m0, %2\n\ts_nop 0\n\tglobal_load_lds_dwordx4 %1, off\n\ts_mov_b32 m0, %0":"=&s"(keep):"v"(gsrc),"s"(lds_dst):"memory");}
__device__ __forceinline__ float max3f(float a,float b,float c){float r;asm("v_max3_f32 %0, %1, %2, %3":"=v"(r):"v"(a),"v"(b),"v"(c));return r;}
__device__ __forceinline__ float max2f(float a,float b){float r;asm("v_max_f32_e32 %0, %1, %2":"=v"(r):"v"(a),"v"(b));return r;}
__device__ __forceinline__ float fadd_s(float a,float b){float r;asm("v_add_f32_e32 %0, %1, %2":"=v"(r):"v"(a),"v"(b));return r;}
__device__ __forceinline__ float fsub_s(float a,float b){float r;asm("v_sub_f32_e32 %0, %1, %2":"=v"(r):"v"(a),"v"(b));return r;}
typedef float f32x2_t __attribute__((ext_vector_type(2))); typedef __bf16 bf16x2_t __attribute__((ext_vector_type(2)));
__device__ __forceinline__ unsigned cvtpk_s(float lo,float hi){f32x2_t v={lo,hi};bf16x2_t b=__builtin_convertvector(v,bf16x2_t);return __builtin_bit_cast(unsigned,b);}
#define WAIT_BAR(N) asm volatile("s_waitcnt vmcnt(" #N ") lgkmcnt(0)\n\ts_barrier":::"memory")

__device__ __forceinline__ void qkt(f32x16&p0,f32x16&p1,const char*Kslot,const bf16x8*qr,const f32x16&negm,int r32,int hi){
  const char*kb=Kslot+hi*1024+r32*16;
  #pragma unroll
  for(int d0=0;d0<4;++d0){
    const bf16x8 b0=*reinterpret_cast<const bf16x8*>(kb+d0*2048);
    const bf16x8 b1=*reinterpret_cast<const bf16x8*>(kb+d0*2048+512);
    if(d0==0){p0=__builtin_amdgcn_mfma_f32_32x32x16_bf16(b0,qr[0],negm,0,0,0);p1=__builtin_amdgcn_mfma_f32_32x32x16_bf16(b1,qr[0],negm,0,0,0);}
    else{p0=__builtin_amdgcn_mfma_f32_32x32x16_bf16(b0,qr[d0],p0,0,0,0);p1=__builtin_amdgcn_mfma_f32_32x32x16_bf16(b1,qr[d0],p1,0,0,0);}}
}
typedef __attribute__((address_space(3))) const char* lds_cptr;
typedef short v4i16_t __attribute__((ext_vector_type(4)));
__device__ __forceinline__ void kload8(bf16x8*kf,lds_cptr kp){
  kf[0]=*(const __attribute__((address_space(3))) bf16x8*)(kp);      kf[1]=*(const __attribute__((address_space(3))) bf16x8*)(kp+512);
  kf[2]=*(const __attribute__((address_space(3))) bf16x8*)(kp+2048); kf[3]=*(const __attribute__((address_space(3))) bf16x8*)(kp+2560);
  kf[4]=*(const __attribute__((address_space(3))) bf16x8*)(kp+4096); kf[5]=*(const __attribute__((address_space(3))) bf16x8*)(kp+4608);
  kf[6]=*(const __attribute__((address_space(3))) bf16x8*)(kp+6144); kf[7]=*(const __attribute__((address_space(3))) bf16x8*)(kp+6656);
}
__device__ __forceinline__ void kload2(bf16x8*kf,lds_cptr kp,int j){ kf[2*j]=*(const __attribute__((address_space(3))) bf16x8*)(kp+j*2048); kf[2*j+1]=*(const __attribute__((address_space(3))) bf16x8*)(kp+j*2048+512); }
__device__ __forceinline__ s16x4 vtr(lds_cptr p){ return __builtin_bit_cast(s16x4,__builtin_amdgcn_ds_read_tr16_b64_v4i16((__attribute__((address_space(3))) v4i16_t*)p)); }
__device__ __forceinline__ float rowmax(const f32x16&p0,const f32x16&p1){
  float a=max3f(p0[0],p0[1],p1[0]),b=max3f(p0[2],p0[3],p1[1]);a=max3f(a,p1[2],p1[3]);
  #pragma unroll
  for(int r=4;r<16;r+=4){a=max3f(a,p0[r],p0[r+1]);b=max3f(b,p0[r+2],p0[r+3]);a=max3f(a,p1[r],p1[r+1]);b=max3f(b,p1[r+2],p1[r+3]);}
  const float m=max2f(a,b);
  auto rr=__builtin_amdgcn_permlane32_swap(__float_as_uint(m),__float_as_uint(m),false,false);
  return max2f(__uint_as_float(rr[0]),__uint_as_float(rr[1]));
}
__device__ __forceinline__ void pv(f32x16*o,int vb,bf16x8 pa0,bf16x8 pa1,bf16x8 pa2,bf16x8 pa3){
  #pragma unroll
  for(int d0=0;d0<2;++d0){s16x4 lo[4],hi[4];
    #pragma unroll
    for(int ks=0;ks<4;++ks){
      asm volatile("ds_read_b64_tr_b16 %0,%1 offset:%c2":"=&v"(lo[ks]):"v"(vb),"i"(d0*4096+ks*1024):"memory");
      asm volatile("ds_read_b64_tr_b16 %0,%1 offset:%c2":"=&v"(hi[ks]):"v"(vb),"i"(d0*4096+ks*1024+512):"memory");}
    asm volatile("s_waitcnt lgkmcnt(0)":::"memory");SBAR();
    #define PK(k) (bf16x8){lo[k][0],lo[k][1],lo[k][2],lo[k][3],hi[k][0],hi[k][1],hi[k][2],hi[k][3]}
    o[d0]=__builtin_amdgcn_mfma_f32_32x32x16_bf16(pa0,PK(0),o[d0],0,0,0);
    o[d0]=__builtin_amdgcn_mfma_f32_32x32x16_bf16(pa1,PK(1),o[d0],0,0,0);
    o[d0]=__builtin_amdgcn_mfma_f32_32x32x16_bf16(pa2,PK(2),o[d0],0,0,0);
    o[d0]=__builtin_amdgcn_mfma_f32_32x32x16_bf16(pa3,PK(3),o[d0],0,0,0);
    #undef PK
  }
}

#ifndef ATTN_STORE16
#define ATTN_STORE16(p,v) (*(u32x4*)(p)=(v))
#endif
template<int THRL> __device__ __forceinline__ void attn_unit(int b,int h,int qb,const bf16*Q,const bf16*__restrict__ K,const bf16*__restrict__ V,bf16*O,float*SS,char*shm){
  const int tid=threadIdx.x,lane=tid&63,r32=lane&31,hi=lane>>5; const int wid=__builtin_amdgcn_readfirstlane(tid>>6);
  const long rowbase=(long)b*SEQ; const int q0=qb*QB;
  const bf16*Qw=Q+(rowbase+q0+wid*QBLK)*QP+h*D;
  const bf16*Kh=K+rowbase*KP+(h>>2)*D,*Vh=V+rowbase*KP+(h>>2)*D;
  const unsigned lds0=(unsigned)(uintptr_t)shm;
  float*wsf=(float*)(shm+LDS_WS)+wid*64;
  const bf16*ksrc=Kh+(long)lane*KP+wid*8;
  const bf16*vsrc=Vh+(long)(16*(wid&3)+(lane>>2))*KP+(wid>>2)*32+(lane&3)*8;
  const unsigned kdst=lds0+LDS_K+wid*1024, vdst=lds0+LDS_V+wid*1024;
  #define DMA_K(t,slot) glds16(ksrc+(long)(t)*KVBLK*KP,(unsigned)__builtin_amdgcn_readfirstlane(kdst+(slot)))
  #define DMA_V(t,slot) glds16(vsrc+(long)(t)*KVBLK*KP,(unsigned)__builtin_amdgcn_readfirstlane(vdst+(slot)))
  const int vb0=(int)(lds0+LDS_V)+((lane>>4)&1)*32+(lane&3)*8+(4*hi+((lane&15)>>2))*64;
  const char*Kbase=shm+LDS_K; bf16x8 kf[8];
  const lds_cptr shm3=(lds_cptr)shm; const lds_cptr kp0=shm3+LDS_K+hi*1024+r32*16; const lds_cptr vp0=shm3+LDS_V+((lane>>4)&1)*32+(lane&3)*8+(4*hi+((lane&15)>>2))*64;
  const int NT=SEQ/KVBLK;
  DMA_K(0,0);DMA_V(0,0);DMA_K(1,SLOTB);
  bf16x8 qr[4];
  #pragma unroll
  for(int d0=0;d0<4;++d0)qr[d0]=*reinterpret_cast<const bf16x8*>(&Qw[(long)r32*QP+d0*16+hi*8]);
  float mhat=0.f,l_reg=0.f;f32x16 o[2];o[0]=f32x16{};o[1]=f32x16{};f32x16 negm=f32x16{};asm volatile("":"+v"(negm));
  const int qrel=wid*QBLK+r32;
  #define CMASK(P0,P1,t) do{}while(0)
  bool resc=false;
  #define START(P0,P1) do{ const float rm=rowmax(P0,P1); resc=false; \
    { const float dl=rm; mhat=fadd_s(mhat,dl); \
      _Pragma("unroll") for(int r=0;r<16;++r){P0[r]=fsub_s(P0[r],dl);P1[r]=fsub_s(P1[r],dl);} \
      _Pragma("unroll") for(int r=0;r<16;++r)negm[r]=-mhat; asm volatile("":"+v"(negm)); } \
    _Pragma("unroll") for(int r=0;r<16;++r)P0[r]=__builtin_amdgcn_exp2f(P0[r]); }while(0)
  #define RESC() do{ if(resc){ asm volatile("s_waitcnt lgkmcnt(0)":::"memory"); \
      _Pragma("unroll") for(int d_=0;d_<2;++d_) _Pragma("unroll") for(int r=0;r<16;++r)o[d_][r]*=wsf[crow(r,hi)]; } }while(0)
  f32x16 pA0,pA1,pB0,pB1;
  int sl_prev=0,sl_cur=0,sl_next=SLOTB;
  #define ROT() do{sl_prev=sl_cur;sl_cur=sl_next;sl_next=(sl_next==(NSLOT-1)*SLOTB)?0:sl_next+SLOTB;}while(0)
  DMA_K(2,2*SLOTB);
  WAIT_BAR(3);
  qkt(pA0,pA1,Kbase,qr,negm,r32,hi);asm volatile("s_nop 15\n\ts_nop 7":"+v"(pA0),"+v"(pA1));CMASK(pA0,pA1,0);
  START(pA0,pA1);
  _Pragma("unroll") for(int r=0;r<16;++r)pA1[r]=__builtin_amdgcn_exp2f(pA1[r]);
  WAIT_BAR(0);
  DMA_K(3,0);DMA_V(1,SLOTB);
  ROT();
  kload8(kf,kp0+sl_cur);
  WAIT_BAR(2);
  s16x4 vlo[8],vhi[8]; u32x4 pw0,pw1,pw2,pw3;
  #define PKW(P,B) cvtpk_s(P[B],P[B+1])
  #define PAF(k) __builtin_bit_cast(bf16x8,pw##k)
  #define VFR(i) (bf16x8){vlo[i][0],vlo[i][1],vlo[i][2],vlo[i][3],vhi[i][0],vhi[i][1],vhi[i][2],vhi[i][3]}
  #define PIN(x) asm volatile("":"+v"(x))
  #define MX3(a,b,c) __builtin_fmaxf(__builtin_fmaxf((a),(b)),(c))
  #define GAPA(MF,A0,A1,A2,A3,W0,W1,PW) do{ MF; sacc+=A0; sacc+=A1; sacc+=A2; sacc+=A3; PIN(sacc); W0; W1; PIN(PW); SBAR(); }while(0)
  #define EX(v) __builtin_amdgcn_exp2f(v)
  #define GAPB(MF,X,B) do{ MF; X[B]=EX(X[B]); X[B+1]=EX(X[B+1]); X[B+2]=EX(X[B+2]); X[B+3]=EX(X[B+3]); PIN(X); SBAR(); }while(0)
  #define VRD(i) do{ vlo[i]=vtr(vp_+(((i)>>2)*4096+((i)&3)*1024)); vhi[i]=vtr(vp_+(((i)>>2)*4096+((i)&3)*1024+512)); }while(0)
  #define KRD(G,j) do{ if(G){ kload2(kf,kp0+sl_next,j); SBAR(); } }while(0)
  #define STEP(C0,C1,P0,P1,t,GK,GV,GL) do{ SBAR(); \
    const lds_cptr vp_=vp0+sl_prev; \
    VRD(0); SBAR(); float sacc=(P0[0]+P0[1]); \
    GAPA(C0=__builtin_amdgcn_mfma_f32_32x32x16_bf16(kf[0],qr[0],negm,0,0,0), P0[2],P0[3],P0[4],P0[5],     pw0[0]=PKW(P0,0), pw0[1]=PKW(P0,2), pw0); \
    VRD(4); SBAR(); GAPA(C1=__builtin_amdgcn_mfma_f32_32x32x16_bf16(kf[1],qr[0],negm,0,0,0), P0[6],P0[7],P0[8],P0[9],     pw0[2]=PKW(P0,4), pw0[3]=PKW(P0,6), pw0); \
    VRD(1); SBAR(); GAPA(C0=__builtin_amdgcn_mfma_f32_32x32x16_bf16(kf[2],qr[1],C0,0,0,0),   P0[10],P0[11],P0[12],P0[13], pw1[0]=PKW(P0,8), pw1[1]=PKW(P0,10), pw1); \
    VRD(5); SBAR(); GAPA(C1=__builtin_amdgcn_mfma_f32_32x32x16_bf16(kf[3],qr[1],C1,0,0,0),   P0[14],P0[15],P1[0],P1[1],   pw1[2]=PKW(P0,12),pw1[3]=PKW(P0,14), pw1); \
    VRD(2); SBAR(); GAPA(C0=__builtin_amdgcn_mfma_f32_32x32x16_bf16(kf[4],qr[2],C0,0,0,0),   P1[2],P1[3],P1[4],P1[5],     pw2[0]=PKW(P1,0), pw2[1]=PKW(P1,2), pw2); \
    VRD(6); SBAR(); GAPA(C1=__builtin_amdgcn_mfma_f32_32x32x16_bf16(kf[5],qr[2],C1,0,0,0),   P1[6],P1[7],P1[8],P1[9],     pw2[2]=PKW(P1,4), pw2[3]=PKW(P1,6), pw2); \
    VRD(3); SBAR(); GAPA(C0=__builtin_amdgcn_mfma_f32_32x32x16_bf16(kf[6],qr[3],C0,0,0,0),   P1[10],P1[11],P1[12],P1[13], pw3[0]=PKW(P1,8), pw3[1]=PKW(P1,10), pw3); \
    VRD(7); SBAR(); GAPA(C1=__builtin_amdgcn_mfma_f32_32x32x16_bf16(kf[7],qr[3],C1,0,0,0),   P1[14],P1[15],0.f,0.f,       pw3[2]=PKW(P1,12),pw3[3]=PKW(P1,14), pw3); \
    l_reg+=sacc; \
    if(GK){DMA_K((t)+3,sl_cur);} if(GV){DMA_V((t)+1,sl_next);} \
    CMASK(C0,C1,t); \
    { float a=MX3(C0[0],C0[1],C1[0]),b=MX3(C0[2],C0[3],C1[1]); a=MX3(a,C1[2],C1[3]); \
      _Pragma("unroll") for(int r=4;r<16;r+=4){a=MX3(a,C0[r],C0[r+1]);b=MX3(b,C0[r+2],C0[r+3]);a=MX3(a,C1[r],C1[r+1]);b=MX3(b,C1[r+2],C1[r+3]);} \
      float rm=__builtin_fmaxf(a,b); { auto rr=__builtin_amdgcn_permlane32_swap(__float_as_uint(rm),__float_as_uint(rm),false,false); rm=__builtin_fmaxf(__uint_as_float(rr[0]),__uint_as_float(rr[1])); } \
      resc=false; \
      if(__builtin_expect(__any(rm>(float)THRL),0)){ const float dl=__builtin_fmaxf(rm,0.f); mhat+=dl; \
        _Pragma("unroll") for(int r=0;r<16;++r){C0[r]-=dl;C1[r]-=dl;} \
        _Pragma("unroll") for(int r=0;r<16;++r)negm[r]=-mhat; asm volatile("":"+v"(negm)); \
        const float f=__builtin_amdgcn_exp2f(-dl); l_reg*=f; if(hi==0)wsf[r32]=f; resc=true; } } \
    SBAR(); \
    GAPB(o[0]=__builtin_amdgcn_mfma_f32_32x32x16_bf16(PAF(0),VFR(0),o[0],0,0,0), C0,0); \
    GAPB(o[1]=__builtin_amdgcn_mfma_f32_32x32x16_bf16(PAF(0),VFR(4),o[1],0,0,0), C0,4); \
    KRD(GL,0); GAPB(o[0]=__builtin_amdgcn_mfma_f32_32x32x16_bf16(PAF(1),VFR(1),o[0],0,0,0), C0,8); \
    KRD(GL,1); GAPB(o[1]=__builtin_amdgcn_mfma_f32_32x32x16_bf16(PAF(1),VFR(5),o[1],0,0,0), C0,12); \
    KRD(GL,2); GAPB(o[0]=__builtin_amdgcn_mfma_f32_32x32x16_bf16(PAF(2),VFR(2),o[0],0,0,0), C1,0); \
    KRD(GL,3); GAPB(o[1]=__builtin_amdgcn_mfma_f32_32x32x16_bf16(PAF(2),VFR(6),o[1],0,0,0), C1,4); \
    GAPB(o[0]=__builtin_amdgcn_mfma_f32_32x32x16_bf16(PAF(3),VFR(3),o[0],0,0,0), C1,8); \
    GAPB(o[1]=__builtin_amdgcn_mfma_f32_32x32x16_bf16(PAF(3),VFR(7),o[1],0,0,0), C1,12); \
    }while(0)
  int t=1;
  #undef CMASK
  #define CMASK(P0,P1,t) do{}while(0)
  for(;t+5<NT;t+=2){
    STEP(pB0,pB1,pA0,pA1,t,true,true,true);     WAIT_BAR(2); RESC(); ROT();
    STEP(pA0,pA1,pB0,pB1,t+1,true,true,true);   WAIT_BAR(2); RESC(); ROT();
  }
  #undef CMASK
  #define CMASK(P0,P1,t) do{}while(0)
  #define ENDW(tt) do{ if((tt)+3<NT){WAIT_BAR(2);} else if((tt)+2<NT){WAIT_BAR(1);} else {WAIT_BAR(0);} }while(0)
  for(;t+1<NT;t+=2){
    STEP(pB0,pB1,pA0,pA1,t,(t+3<NT),(t+1<NT),(t+1<NT));       ENDW(t);   RESC(); ROT();
    STEP(pA0,pA1,pB0,pB1,t+1,(t+4<NT),(t+2<NT),(t+2<NT));     ENDW(t+1); RESC(); ROT();
  }
  STEP(pB0,pB1,pA0,pA1,NT-1,false,false,false); RESC();
  { float sacc=pB0[0]+pB0[1]; _Pragma("unroll") for(int r=2;r<16;++r)sacc+=pB0[r]; _Pragma("unroll") for(int r=0;r<16;++r)sacc+=pB1[r]; l_reg+=sacc;
    pw0=(u32x4){PKW(pB0,0),PKW(pB0,2),PKW(pB0,4),PKW(pB0,6)};pw1=(u32x4){PKW(pB0,8),PKW(pB0,10),PKW(pB0,12),PKW(pB0,14)};pw2=(u32x4){PKW(pB1,0),PKW(pB1,2),PKW(pB1,4),PKW(pB1,6)};pw3=(u32x4){PKW(pB1,8),PKW(pB1,10),PKW(pB1,12),PKW(pB1,14)};
    SBAR(); pv(o,vb0+sl_cur,PAF(0),PAF(1),PAF(2),PAF(3)); }
  #undef PKW
  #undef PAF
  #undef VFR
  #undef PIN
  #undef MX3
  #undef GAPA
  #undef GAPB
  #undef EX
  #undef VRD
  #undef KRD
  #undef STEP
  #undef ENDW
  {auto rr=__builtin_amdgcn_permlane32_swap(__float_as_uint(l_reg),__float_as_uint(l_reg),false,false);l_reg=__uint_as_float(rr[0])+__uint_as_float(rr[1]);}
  if(hi==0)wsf[32+r32]=l_reg;asm volatile("s_waitcnt lgkmcnt(0)":::"memory");
  float rli[16];
  #pragma unroll
  for(int r=0;r<16;++r)rli[r]=__builtin_amdgcn_rcpf(wsf[32+crow(r,hi)]);
  bf16*Ow=O+(rowbase+q0+wid*QBLK)*OP+h*D; float*SSw=SS+((rowbase+q0+wid*QBLK)*8+h);
  { bf16*stg=(bf16*)(shm+LDS_OST)+wid*2048;
    #pragma unroll
    for(int r=0;r<16;++r){const int orow=crow(r,hi);
      #pragma unroll
      for(int d0=0;d0<2;++d0)stg[orow*64+d0*32+r32]=__float2bfloat16(o[d0][r]*rli[r]);}
    asm volatile("s_waitcnt lgkmcnt(0)":::"memory");
    #pragma unroll
    for(int i=0;i<4;++i){const int row=i*8+(lane>>3),ch=lane&7; const u32x4 v=*(const u32x4*)(stg+row*64+ch*8); ATTN_STORE16(Ow+(long)row*OP+ch*8,v);
      float ss_=0.f; _Pragma("unroll") for(int e_=0;e_<4;++e_){const unsigned w_=v[e_]; const float a_=__uint_as_float(w_<<16),b_=__uint_as_float(w_&0xffff0000u); ss_+=a_*a_+b_*b_;}
      ss_+=__shfl_xor(ss_,1); ss_+=__shfl_xor(ss_,2); ss_+=__shfl_xor(ss_,4); if(ch==0)SSw[(long)row*8]=ss_;} }
  asm volatile("s_waitcnt lgkmcnt(0)\n\ts_barrier":::"memory");
  #undef DMA_K
  #undef DMA_V
  #undef CMASK
  #undef START
  #undef RESC
  #undef ROT
}
constexpr int ATTN_LDS_BYTES=LDS_BYTES;
template<int THRL=8> __device__ __forceinline__ void attn_phase(char*lds,const bf16*Q,const bf16*K,const bf16*V,bf16*O,float*SS,int G,int vcu){
  for(int uid=vcu;uid<512;uid+=G){ const int pair=uid>>5,b=pair>>1,h=(pair&1)*4+((uid>>3)&3),qb=uid&7; attn_unit<THRL>(b,h,qb,Q,K,V,O,SS,lds); }
}
#undef SBAR
#undef WAIT_BAR
}
typedef FK_GAS unsigned gu32;
#define LAS FK_LAS
#define XB_TMO      128
#define XB_XCNT(j)  (256  + 64 * (j))
#define XB_XSUB(j)  (1280 + 64 * (j))
#define XB_XGEN(j)  (2304 + 64 * (j))
#define XB_TOP      3328
#define XB_TOPGEN   3392
#define XCD_BAR_WORDS 3456
#define XB_SPIN_CAP (1u << 18)

__device__ __forceinline__ unsigned xb_ld(unsigned* p)              { return __hip_atomic_load(p, __ATOMIC_RELAXED, __HIP_MEMORY_SCOPE_AGENT); }
__device__ __forceinline__ unsigned xb_add(unsigned* p, unsigned v) { return __hip_atomic_fetch_add(p, v, __ATOMIC_RELAXED, __HIP_MEMORY_SCOPE_AGENT); }
__device__ __forceinline__ unsigned xb_xcc_id() { return (unsigned)__builtin_amdgcn_s_getreg((3 << 11) | 20) & 0xFu; }
#define XB_SPIN(cond, bar) do { unsigned _sp = 0; while (cond) { __builtin_amdgcn_s_sleep(1); \
    if ((++_sp & 255u) == 0u) { if (xb_ld(&(bar)[XB_TMO])) break; if (_sp > XB_SPIN_CAP) { atomicAdd(&(bar)[XB_TMO], 1u); break; } } } } while (0)

struct XcdBarrier {
    unsigned* bar; unsigned x;
    volatile LAS unsigned* st;
};

__device__ __forceinline__ XcdBarrier xcd_barrier_post(unsigned* bar, volatile LAS unsigned* st) {
    XcdBarrier b; b.bar = bar; b.x = xb_xcc_id(); b.st = st;
    if (threadIdx.x == 0) (void)xb_add(&bar[XB_XCNT(b.x)], 1u);
    return b;
}
__device__ __forceinline__ void xcd_barrier_complete(unsigned* bar, unsigned x, unsigned& nloc, unsigned& nx) {
    const unsigned G = gridDim.x * gridDim.y * gridDim.z;
    unsigned sum, cnt, mine, sp = 0u;
    for (;;) {
        sum = 0u; cnt = 0u; mine = 0u;
#pragma unroll
        for (unsigned j = 0; j < 16; ++j) { const unsigned c = xb_ld(&bar[XB_XCNT(j)]); sum += c; cnt += (c > 0u) ? 1u : 0u; mine = (j == x) ? c : mine; }
        if (sum == G) break;
        __builtin_amdgcn_s_sleep(1);
        if ((++sp & 255u) == 0u) { if (xb_ld(&bar[XB_TMO])) break; if (sp > XB_SPIN_CAP) { atomicAdd(&bar[XB_TMO], 1u); break; } }
    }
    nloc = mine > 0u ? mine : 1u; nx = cnt > 0u ? cnt : 1u;
}

__device__ __forceinline__ void xcd_barrier(const XcdBarrier& b) {
    asm volatile("s_waitcnt vmcnt(0)" ::: "memory");
    __syncthreads();
    if (threadIdx.x == 0) {
        unsigned* bar = b.bar;
        __builtin_amdgcn_s_waitcnt(0);
        unsigned nloc = b.st[0], nx = b.st[1];
        if (nloc == 0u) { xcd_barrier_complete(bar, b.x, nloc, nx); b.st[0] = nloc; b.st[1] = nx; }
        const unsigned old = xb_add(&bar[XB_XSUB(b.x)], 1u);
        const unsigned gen = old / nloc;
        if (old + 1u == (gen + 1u) * nloc) {
            __builtin_amdgcn_fence(__ATOMIC_RELEASE, "agent");
            asm volatile("s_waitcnt vmcnt(0)" ::: "memory");
            const unsigned og = xb_add(&bar[XB_TOP], 1u);
            const unsigned tg = og / nx;
            if (og + 1u == (tg + 1u) * nx) xb_add(&bar[XB_TOPGEN], 1u);
            else XB_SPIN(xb_ld(&bar[XB_TOPGEN]) == tg, bar);
            __builtin_amdgcn_fence(__ATOMIC_ACQUIRE, "agent");
            xb_add(&bar[XB_XGEN(b.x)], 1u);
            asm volatile("s_waitcnt vmcnt(0)" ::: "memory");
        } else {
            XB_SPIN(xb_ld(&bar[XB_XGEN(b.x)]) == gen, bar);
            __builtin_amdgcn_fence(__ATOMIC_ACQUIRE, "agent");
            asm volatile("s_waitcnt vmcnt(0)" ::: "memory");
        }
    }
    __syncthreads();
}
#undef LAS
struct Params {
    const float* in[34];
    float* out;
    unsigned char* ws;
    int ph_lo, ph_hi;
};
using pg8::Unit; using pg8::Gemm;

constexpr int TSCR = 64 * 65 * 4;
template <class RowMap>
__device__ __forceinline__ void transpose_item(const float* W, int K, int N, const float* gain, bf16_t* WT, const RowMap& rm, FK_LAS float* scr, int item, int lane) {
    const int nblk = N / 64, kb = item / nblk, nb = item % nblk, k0 = 64 * kb, n0 = 64 * nb;
    const int nq = (lane & 15) * 4;
#pragma unroll 8
    for (int i = 0; i < 16; ++i) { const int kk = 4 * i + (lane >> 4); const float gv = gain ? gain[k0 + kk] : 1.f;
        const f32x4 v = *(const f32x4*)(W + (size_t)(k0 + kk) * N + n0 + nq) * gv;
        FK_LAS float* d = scr + kk * 65 + nq; d[0] = v[0]; d[1] = v[1]; d[2] = v[2]; d[3] = v[3]; }
    asm volatile("s_waitcnt lgkmcnt(0)" ::: "memory");
    const int c = lane & 7;
#pragma unroll
    for (int j = 0; j < 8; ++j) { const int n = (lane >> 3) + 8 * j; const FK_LAS float* sp = scr + (8 * c) * 65 + n;
        u32x4 o; o.x = pk2(sp[0 * 65], sp[1 * 65]); o.y = pk2(sp[2 * 65], sp[3 * 65]); o.z = pk2(sp[4 * 65], sp[5 * 65]); o.w = pk2(sp[6 * 65], sp[7 * 65]);
        *(u32x4*)(WT + (size_t)rm(n0 + n) * K + k0 + 8 * c) = o; }
    asm volatile("s_waitcnt lgkmcnt(0)" ::: "memory");
}
struct RmId { __device__ __forceinline__ int operator()(int n) const { return n; } };
struct RmWin { __device__ __forceinline__ int operator()(int n) const { if (n >= 768) return n; const int head = n >> 6, dim = n & 63; return 256 * (head >> 2) + 128 * (dim >> 5) + 32 * (head & 3) + (dim & 31); } };
struct RmGU { int up; __device__ __forceinline__ int operator()(int n) const { return (n >> 7) * 256 + up * 128 + (n & 127); } };

__device__ __forceinline__ void row_to_bf16(const float* xrow, bf16_t* orow, float* rout, const float* gain, bool normalise, int lane) {
    const f32x4* xr = (const f32x4*)xrow + lane;
    f32x4 v[4]; float s = 0.f;
#pragma unroll
    for (int j = 0; j < 4; ++j) { v[j] = xr[64 * j]; s += (v[j].x * v[j].x + v[j].y * v[j].y) + (v[j].z * v[j].z + v[j].w * v[j].w); }
    const float r = rsqrtf(wsum(s) * (1.f / 1024.f) + EPS);
    if (rout && lane == 0) *rout = r;
    unsigned long long* o8 = (unsigned long long*)orow + lane;
#pragma unroll
    for (int j = 0; j < 4; ++j) {
        f32x4 w = v[j];
        if (normalise) { const f32x4 gv = ((const f32x4*)gain)[lane + 64 * j]; w = w * r * gv; }
        o8[64 * j] = (unsigned long long)pk2(w.x, w.y) | ((unsigned long long)pk2(w.z, w.w) << 32);
    }
}

__device__ __forceinline__ void s5_prep_part(const Params& p, int g, int q8, FK_LAS float* L, int tid) {
    const float* lam_re = p.in[6]; const float* lam_im = p.in[7]; const float* log_step = p.in[8];
    const float* b_re = p.in[9]; const float* b_im = p.in[10]; const float* c_re = p.in[11]; const float* c_im = p.in[12]; const float* dpar = p.in[13];
    FK_LAS float* LPr = L;
    FK_LAS float* LPi = LPr + 2 * 33 * 64;
    FK_LAS float* BBr = LPi + 2 * 33 * 64;
    FK_LAS float* BBi = BBr + 2 * 1024;
    FK_LAS float* CCr = BBi + 2 * 1024;
    FK_LAS float* CCi = CCr + 2 * 1024;
    FK_LAS float* KT = CCi + 2 * 1024;
    float gbr[4], gbi[4], gcr[4], gci[4];
#pragma unroll
    for (int u = 0; u < 4; ++u) { const int idx = tid + u * NTHREADS; const int dir = idx >> 10, pp = (idx >> 4) & 63, c = idx & 15, gp = (dir * 32 + g) * 64 + pp, cc = (idx >> 6) & 15, p2 = idx & 63;
        gbr[u] = b_re[(size_t)gp * 16 + c]; gbi[u] = b_im[(size_t)gp * 16 + c];
        gcr[u] = c_re[((size_t)(dir * 32 + g) * 16 + cc) * 64 + p2]; gci[u] = c_im[((size_t)(dir * 32 + g) * 16 + cc) * 64 + p2]; }
    float f_r, f_i;
    {
        const int qd = tid >> 2, r4 = tid & 3, dir = qd >> 6, pp = qd & 63, gp = (dir * 32 + g) * 64 + pp;
        const float lr = fminf(lam_re[gp], -1e-4f), li = lam_im[gp], dt = expf(log_step[dir * 32 + g]);
        const float mag = expf(lr * dt), ab_r = mag * cosf(li * dt), ab_i = mag * sinf(li * dt);
        const float den = lr * lr + li * li, nr = ab_r - 1.f;
        f_r = (nr * lr + ab_i * li) / den; f_i = (ab_i * lr - nr * li) / den;
        const float a2r = ab_r * ab_r - ab_i * ab_i, a2i = 2.f * ab_r * ab_i;
        const float a4r = a2r * a2r - a2i * a2i, a4i = 2.f * a2r * a2i;
        const float a3r = a2r * ab_r - a2i * ab_i, a3i = a2r * ab_i + a2i * ab_r;
        float pr = r4 == 0 ? 1.f : r4 == 1 ? ab_r : r4 == 2 ? a2r : a3r, pi = r4 == 0 ? 0.f : r4 == 1 ? ab_i : r4 == 2 ? a2i : a3i;
#pragma unroll
        for (int s8 = 0; s8 < 9; ++s8) { const int e = r4 + 4 * s8;
            if (e <= 32) { LPr[(dir * 33 + e) * 64 + pp] = pr; LPi[(dir * 33 + e) * 64 + pp] = pi; }
            const float nr2 = pr * a4r - pi * a4i, ni2 = pr * a4i + pi * a4r; pr = nr2; pi = ni2; }
        FK_LAS float* FF = KT + 2048;
        if (r4 == 0) { FF[qd * 2] = f_r; FF[qd * 2 + 1] = f_i; }
    }
    __syncthreads();
    {
        const FK_LAS float* FF = KT + 2048;
#pragma unroll
        for (int u = 0; u < 4; ++u) { const int idx = tid + u * NTHREADS; const int dir = idx >> 10, pp = (idx >> 4) & 63;
            const float fr = FF[(dir * 64 + pp) * 2], fi = FF[(dir * 64 + pp) * 2 + 1];
            BBr[idx] = fr * gbr[u] - fi * gbi[u]; BBi[idx] = fr * gbi[u] + fi * gbr[u]; CCr[idx] = gcr[u]; CCi[idx] = gci[u]; }
    }
    __syncthreads();
    {
        const int dir = tid >> 8, tau = (tid >> 3) & 31, cl = (tid >> 2) & 1, c4 = (tid & 3) * 4, cc = 2 * q8 + cl;
        const FK_LAS float* cr = CCr + dir * 1024 + cc * 64; const FK_LAS float* ci = CCi + dir * 1024 + cc * 64;
        const FK_LAS float* lr = LPr + (dir * 33 + tau) * 64; const FK_LAS float* li = LPi + (dir * 33 + tau) * 64;
        const FK_LAS float* br = BBr + dir * 1024 + c4; const FK_LAS float* bi = BBi + dir * 1024 + c4;
        f32x4 acc = {0.f, 0.f, 0.f, 0.f};
#pragma unroll 4
        for (int pp = 0; pp < 64; pp += 4) {
            const f32x4 c4r = *(const FK_LAS f32x4*)(cr + pp), c4i = *(const FK_LAS f32x4*)(ci + pp), l4r = *(const FK_LAS f32x4*)(lr + pp), l4i = *(const FK_LAS f32x4*)(li + pp);
            const f32x4 tr = c4r * l4r - c4i * l4i, ti = c4r * l4i + c4i * l4r;
#pragma unroll
            for (int u = 0; u < 4; ++u) { const f32x4 b4r = *(const FK_LAS f32x4*)(br + (pp + u) * 16), b4i = *(const FK_LAS f32x4*)(bi + (pp + u) * 16); acc = acc + b4r * tr[u] - b4i * ti[u]; }
        }
        *(FK_LAS f32x4*)(KT + ((dir * 32 + tau) * 2 + cl) * 16 + c4) = acc;
    }
    __syncthreads();
    bf16_t* W1 = (bf16_t*)(p.ws + WS_W1) + (size_t)g * 256 * 512;
#pragma unroll
    for (int u = 0; u < 4; ++u) {
        const int ch = tid + u * NTHREADS;
        const int n = 32 * q8 + (ch >> 6), kk0 = (ch & 63) * 8, j = kk0 >> 4, c0 = kk0 & 15;
        const int dir = n >> 7, ri = (n >> 6) & 1, pp = n & 63, e = dir ? j : 31 - j;
        const float lr = LPr[(dir * 33 + e) * 64 + pp], li = LPi[(dir * 33 + e) * 64 + pp];
        const f32x4 br0 = *(const FK_LAS f32x4*)(BBr + dir * 1024 + pp * 16 + c0), br1 = *(const FK_LAS f32x4*)(BBr + dir * 1024 + pp * 16 + c0 + 4);
        const f32x4 bi0 = *(const FK_LAS f32x4*)(BBi + dir * 1024 + pp * 16 + c0), bi1 = *(const FK_LAS f32x4*)(BBi + dir * 1024 + pp * 16 + c0 + 4);
        const f32x4 v0 = ri ? (bi0 * lr + br0 * li) : (br0 * lr - bi0 * li), v1 = ri ? (bi1 * lr + br1 * li) : (br1 * lr - bi1 * li);
        u32x4 o; o.x = pk2(v0[0], v0[1]); o.y = pk2(v0[2], v0[3]); o.z = pk2(v1[0], v1[1]); o.w = pk2(v1[2], v1[3]);
        *(u32x4*)(W1 + (size_t)n * 512 + kk0) = o;
    }
    bf16_t* W2 = (bf16_t*)(p.ws + WS_W2) + (size_t)g * 512 * SUP;
#pragma unroll 2
    for (int u = 0; u < 12; ++u) {
        const int ch = tid + u * NTHREADS;
        const int rowi = (int)(((unsigned)ch * 43691u) >> 22), kk0 = (ch - rowi * 96) * 8, j = rowi >> 1, cl = rowi & 1, cc = 2 * q8 + cl, nn = j * 16 + cc;
        f32x4 v0, v1;
        if (kk0 < 256) {
            const int dir = kk0 >> 7, ri = (kk0 >> 6) & 1, p0 = kk0 & 63, e = dir ? 32 - j : j + 1;
            const FK_LAS float* cr = CCr + dir * 1024 + cc * 64 + p0; const FK_LAS float* ci = CCi + dir * 1024 + cc * 64 + p0;
            const FK_LAS float* lr = LPr + (dir * 33 + e) * 64 + p0; const FK_LAS float* li = LPi + (dir * 33 + e) * 64 + p0;
            const f32x4 cr0 = *(const FK_LAS f32x4*)cr, cr1 = *(const FK_LAS f32x4*)(cr + 4), ci0 = *(const FK_LAS f32x4*)ci, ci1 = *(const FK_LAS f32x4*)(ci + 4);
            const f32x4 lr0 = *(const FK_LAS f32x4*)lr, lr1 = *(const FK_LAS f32x4*)(lr + 4), li0 = *(const FK_LAS f32x4*)li, li1 = *(const FK_LAS f32x4*)(li + 4);
            v0 = ri ? -(cr0 * li0 + ci0 * lr0) : (cr0 * lr0 - ci0 * li0); v1 = ri ? -(cr1 * li1 + ci1 * lr1) : (cr1 * lr1 - ci1 * li1);
        } else {
            const int j2 = (kk0 - 256) >> 4, c0 = kk0 & 15;
            v0 = (f32x4){0.f, 0.f, 0.f, 0.f}; v1 = v0;
            if (j2 <= j) { const FK_LAS float* kp = KT + ((0 * 32 + (j - j2)) * 2 + cl) * 16 + c0; v0 = v0 + *(const FK_LAS f32x4*)kp; v1 = v1 + *(const FK_LAS f32x4*)(kp + 4); }
            if (j2 >= j) { const FK_LAS float* kp = KT + ((1 * 32 + (j2 - j)) * 2 + cl) * 16 + c0; v0 = v0 + *(const FK_LAS f32x4*)kp; v1 = v1 + *(const FK_LAS f32x4*)(kp + 4); }
            if (j2 == j && (cc >> 3) == (c0 >> 3)) { const float dv = dpar[g * 16 + cc]; const int q = cc & 7;
                v0[0] += q == 0 ? dv : 0.f; v0[1] += q == 1 ? dv : 0.f; v0[2] += q == 2 ? dv : 0.f; v0[3] += q == 3 ? dv : 0.f; v1[0] += q == 4 ? dv : 0.f; v1[1] += q == 5 ? dv : 0.f; v1[2] += q == 6 ? dv : 0.f; v1[3] += q == 7 ? dv : 0.f; }
        }
        u32x4 o; o.x = pk2(v0[0], v0[1]); o.y = pk2(v0[2], v0[3]); o.z = pk2(v1[0], v1[1]); o.w = pk2(v1[2], v1[3]);
        *(u32x4*)(W2 + (size_t)nn * SUP + kk0) = o;
    }
    __syncthreads();
}

constexpr int I_WIN = 16 * 20, I_GLU = 8 * 8, I_SQ = 16 * 16, I_GU = 16 * 8, I_DN = 8 * 16;
constexpr int NIT_A = I_WIN + 2 * I_SQ;
constexpr int NIT_B = I_GLU + 3 * I_SQ;
constexpr int NIT_C = 16 * (2 * I_GU + I_DN);
__device__ __forceinline__ void convert_A(const Params& p, FK_LAS float* scr, int lane, int w, int nw, int lo, int hi) {
    unsigned char* ws = p.ws;
    for (int it = lo + w; it < hi; it += nw) {
        int r = it;
        if (r < I_WIN) { transpose_item(p.in[3], 1024, 1280, p.in[2], (bf16_t*)(ws + WS_WIN), RmWin{}, scr, r, lane); continue; } r -= I_WIN;
        if (r < I_SQ) { transpose_item(p.in[22], 1024, 1024, nullptr, (bf16_t*)(ws + WS_WK), RmId{}, scr, r, lane); continue; } r -= I_SQ;
        transpose_item(p.in[23], 1024, 1024, nullptr, (bf16_t*)(ws + WS_WV), RmId{}, scr, r, lane);
    }
}
__device__ __forceinline__ void convert_B(const Params& p, FK_LAS float* scr, int lane, int w, int nw, int lo, int hi) {
    unsigned char* ws = p.ws;
    for (int it = lo + w; it < hi; it += nw) {
        int r = it;
        if (r < I_GLU) { transpose_item(p.in[14], 512, 512, nullptr, (bf16_t*)(ws + WS_GLU), RmId{}, scr, r, lane); continue; } r -= I_GLU;
        if (r < I_SQ) {
            const int kb = r / 16; const float* gain = kb < 8 ? p.in[16] : p.in[17] - 512;
            transpose_item(p.in[18], 1024, 1024, gain, (bf16_t*)(ws + WS_WOUT), RmId{}, scr, r, lane); continue; } r -= I_SQ;
        if (r < I_SQ) { transpose_item(p.in[21], 1024, 1024, p.in[19], (bf16_t*)(ws + WS_WQ), RmId{}, scr, r, lane); continue; } r -= I_SQ;
        transpose_item(p.in[24], 1024, 1024, nullptr, (bf16_t*)(ws + WS_WO), RmId{}, scr, r, lane);
    }
}
__device__ __forceinline__ void convert_C(const Params& p, FK_LAS float* scr, int lane, int w, int nw, int lo, int hi) {
    unsigned char* ws = p.ws;
    for (int it = lo + w; it < hi; it += nw) {
        int r = it;
        const int e = r / (2 * I_GU + I_DN); r -= e * (2 * I_GU + I_DN);
        bf16_t* wgu = (bf16_t*)(ws + WS_WGU) + (size_t)e * 1024 * 1024;
        if (r < I_GU) { transpose_item(p.in[30] + (size_t)e * 1024 * 512, 1024, 512, p.in[25], wgu, RmGU{0}, scr, r, lane); continue; } r -= I_GU;
        if (r < I_GU) { transpose_item(p.in[31] + (size_t)e * 1024 * 512, 1024, 512, p.in[25], wgu, RmGU{1}, scr, r, lane); continue; } r -= I_GU;
        transpose_item(p.in[32] + (size_t)e * 512 * 1024, 512, 1024, nullptr, (bf16_t*)(ws + WS_WD) + (size_t)e * 1024 * 512, RmId{}, scr, r, lane);
    }
}
#define SIDE_WAVES(first_idle) const int sw_ = (bx - (first_idle)) * NWAVES + wave, snw_ = (G - (first_idle)) * NWAVES; FK_LAS float* sscr_ = (FK_LAS float*)(lds + wave * TSCR)

__device__ __forceinline__ void p0_prologue(const Params& p, FK_LAS unsigned char* lds, int vcu, int G, int tid, int lane, int wave, bool defer) {
    unsigned char* ws = p.ws;
    if (!defer) for (int it = vcu; it < 256; it += G) s5_prep_part(p, it >> 3, it & 7, (FK_LAS float*)lds, tid);
    if (vcu == (G > 1 ? 1 : 0)) {
        bf16_t* rwt = (bf16_t*)(ws + WS_RWT);
        for (int idx = tid; idx < 32 * 1024; idx += NTHREADS) {
            const int n = idx >> 10, k = idx & 1023;
            const float v = n < 4 ? p.in[25][k] * p.in[26][k * 4 + n] : n < 20 ? p.in[25][k] * p.in[28][k * 16 + (n - 4)] : 0.f;
            const unsigned h = f2bf(v); const float lo = v - bf2f((unsigned short)h);
            rwt[idx] = (bf16_t)h; rwt[32 * 1024 + idx] = (bf16_t)f2bf(lo);
        }
    }
    if (vcu == 0) {
        for (int idx = tid; idx < 1024; idx += NTHREADS) {
            const int pos = idx >> 4, i = idx & 15;
            const float ang = (float)pos * powf(10000.f, -(float)i / 16.f);
            ((f32x2*)(ws + WS_ROPE))[idx] = (f32x2){cosf(ang), sinf(ang)};
        }
    }
    FK_LAS float* scr = (FK_LAS float*)(lds + wave * TSCR);
    const int gw = vcu * NWAVES + wave, NGW = G * NWAVES;
    convert_A(p, scr, lane, gw, NGW, 0, NIT_A);
    if (!defer) { convert_B(p, scr, lane, gw, NGW, 0, NIT_B); convert_C(p, scr, lane, gw, NGW, 0, NIT_C); }
    for (int m = gw; m < T; m += NGW) row_to_bf16(p.in[0] + (size_t)m * 1024, (bf16_t*)(ws + WS_XB) + (size_t)m * 1024, (float*)(ws + WS_R0) + m, nullptr, false, lane);
    for (int m = gw; m < MTOK; m += NGW) row_to_bf16(p.in[1] + (size_t)m * 1024, (bf16_t*)(ws + WS_HM) + (size_t)m * 1024, nullptr, p.in[20], true, lane);
}

struct SchedP1 {
    int G, c;
    __device__ __forceinline__ bool next(int i, Unit& u) const {
        const int L = i * G + c;
        int pm = 0, pn = 0, kind = 0; unsigned a_off = 0, b_off = 0;
        if (L < 320) {
            pg8::tile_order(L, 64, 5, pm, pn);
            a_off = (unsigned)(WS_XB + (size_t)pm * 256 * 1024 * 2); b_off = (unsigned)(WS_WIN + (size_t)pn * 256 * 1024 * 2);
            kind = pn < 3 ? 0 : 1;
        } else if (L < 352) { const int r = L - 320; pm = r >> 2; pn = r & 3; kind = 2;
            a_off = (unsigned)(WS_HM + (size_t)pm * 256 * 1024 * 2); b_off = (unsigned)(WS_WK + (size_t)pn * 256 * 1024 * 2);
        } else { const int q = L - 352; pm = (q >> 3) & 3; pn = q & 7; kind = 3;
            a_off = (unsigned)(WS_WV + (size_t)pm * 256 * 1024 * 2); b_off = (unsigned)(WS_HM + (size_t)pn * 256 * 1024 * 2); }
        u.a_off = a_off; u.b_off = b_off; u.pm = pm; u.pn = pn; u.kind = kind; u.aux = 0;
        return L < 384;
    }
    __device__ __forceinline__ unsigned row_off(const Unit& u, int r) const { return u.a_off + (unsigned)r * 2048u; }
};
struct EpiP1 {
    static constexpr bool PERM = false, AFTER_DRAIN = false;
    unsigned char* ws; const float* qg; const float* kg;
    __device__ __forceinline__ void operator()(f32x4 (&acc)[2][2][4][2], const Unit& u, int wr, int wc, int fr, int fq, FK_LAS unsigned char*, int, int) const {
        if (u.kind == 0) {
            const int head = 4 * u.pn + wc;
            const float* r0 = (const float*)(ws + WS_R0);
            const f32x2* rope = (const f32x2*)(ws + WS_ROPE);
            if (head < 10) {
                const float* gn = head < 8 ? qg : kg;
                f32x4 gv[2][2];
#pragma unroll
                for (int bj = 0; bj < 2; ++bj)
#pragma unroll
                    for (int n = 0; n < 2; ++n) gv[bj][n] = *(const f32x4*)(gn + 32 * bj + 16 * n + 4 * fq);
                const float osc = head < 8 ? QSCALE : 1.f;
#pragma unroll
                for (int ai = 0; ai < 2; ++ai)
#pragma unroll
                    for (int m = 0; m < 4; ++m) {
                        const int row = u.pm * 256 + ai * 128 + wr * 64 + m * 16 + fr;
                        float ss = 0.f;
#pragma unroll
                        for (int bj = 0; bj < 2; ++bj)
#pragma unroll
                            for (int n = 0; n < 2; ++n) { const f32x4 x = acc[ai][bj][m][n]; ss += (x[0] * x[0] + x[1] * x[1]) + (x[2] * x[2] + x[3] * x[3]); }
                        ss += __shfl_xor(ss, 16); ss += __shfl_xor(ss, 32);
                        const float rr = r0[row];
                        const float hs = rr * rsqrtf(rr * rr * ss * (1.f / 64.f) + EPS) * osc;
                        const int s = row & (SEQ - 1);
                        bf16_t* dst = head < 8 ? (bf16_t*)(ws + WS_Q) + (size_t)row * 512 + head * 64 : (bf16_t*)(ws + WS_K) + (size_t)row * 128 + (head - 8) * 64;
#pragma unroll
                        for (int bj = 0; bj < 2; ++bj) {
                            const int pos = bj == 0 ? (s >> 6) : (s & 63);
                            f32x4 x1 = acc[ai][bj][m][0] * hs * gv[bj][0], x2 = acc[ai][bj][m][1] * hs * gv[bj][1], o1, o2;
#pragma unroll
                            for (int j = 0; j < 4; ++j) { const f32x2 cs = rope[pos * 16 + 4 * fq + j]; o1[j] = x1[j] * cs.x - x2[j] * cs.y; o2[j] = x2[j] * cs.x + x1[j] * cs.y; }
                            u32x2 w1, w2; w1.x = pg8::cvt_pk_bf16(o1[0], o1[1]); w1.y = pg8::cvt_pk_bf16(o1[2], o1[3]); w2.x = pg8::cvt_pk_bf16(o2[0], o2[1]); w2.y = pg8::cvt_pk_bf16(o2[2], o2[3]);
                            *(u32x2*)(dst + 32 * bj + 4 * fq) = w1; *(u32x2*)(dst + 32 * bj + 16 + 4 * fq) = w2;
                        }
                    }
            } else {
#pragma unroll
                for (int ai = 0; ai < 2; ++ai)
#pragma unroll
                    for (int m = 0; m < 4; ++m) {
                        const int row = u.pm * 256 + ai * 128 + wr * 64 + m * 16 + fr;
                        const float rr = r0[row];
                        bf16_t* dst = (bf16_t*)(ws + WS_V) + (size_t)row * 128 + (head - 10) * 64;
#pragma unroll
                        for (int bj = 0; bj < 2; ++bj)
#pragma unroll
                            for (int n = 0; n < 2; ++n) { const f32x4 x = acc[ai][bj][m][n] * rr; u32x2 w; w.x = pg8::cvt_pk_bf16(x[0], x[1]); w.y = pg8::cvt_pk_bf16(x[2], x[3]);
                                *(u32x2*)(dst + 32 * bj + 16 * n + 4 * fq) = w; }
                    }
            }
        } else if (u.kind == 1) {
            const float* r0 = (const float*)(ws + WS_R0);
#pragma unroll
            for (int ai = 0; ai < 2; ++ai)
#pragma unroll
                for (int m = 0; m < 4; ++m) {
                    const int row = u.pm * 256 + ai * 128 + wr * 64 + m * 16 + fr;
                    const float rr = r0[row];
                    const int b = row >> 11, s = row & (SEQ - 1), k = s >> 5, jj = s & 31;
#pragma unroll
                    for (int bj = 0; bj < 2; ++bj)
#pragma unroll
                        for (int n = 0; n < 2; ++n) {
                            const int gidx = 16 * (u.pn - 3) + 8 * bj + 2 * wc + n;
                            bf16_t* dst = (bf16_t*)(ws + WS_SU) + ((size_t)gidx * SROWS + b * NCH + k) * SUP + 256 + jj * 16 + 4 * fq;
                            const f32x4 x = acc[ai][bj][m][n] * rr; u32x2 w; w.x = pg8::cvt_pk_bf16(x[0], x[1]); w.y = pg8::cvt_pk_bf16(x[2], x[3]);
                            *(u32x2*)dst = w;
                        }
                }
        } else {
            bf16_t* base = u.kind == 2 ? (bf16_t*)(ws + WS_KM) + (size_t)u.pm * 256 * 1024 + u.pn * 256 : (bf16_t*)(ws + WS_VT) + ((size_t)u.pn * 1024 + u.pm * 256) * 256;
            const int ldc = u.kind == 2 ? 1024 : 256;
#pragma unroll
            for (int ai = 0; ai < 2; ++ai)
#pragma unroll
                for (int m = 0; m < 4; ++m) {
                    bf16_t* rowp = base + (size_t)(ai * 128 + wr * 64 + m * 16 + fr) * ldc + wc * 32 + 4 * fq;
#pragma unroll
                    for (int bj = 0; bj < 2; ++bj)
#pragma unroll
                        for (int n = 0; n < 2; ++n) { const f32x4 x = acc[ai][bj][m][n]; u32x2 w; w.x = pg8::cvt_pk_bf16(x[0], x[1]); w.y = pg8::cvt_pk_bf16(x[2], x[3]);
                            *(u32x2*)(rowp + 128 * bj + 16 * n) = w; }
                }
        }
    }
};
struct SchedOne {
    Unit u; unsigned a_pitch;
    __device__ __forceinline__ bool next(int i, Unit& o) const { o = u; return i == 0; }
    __device__ __forceinline__ unsigned row_off(const Unit& x, int r) const { return x.a_off + (unsigned)r * a_pitch; }
};
__device__ __forceinline__ Unit mk_unit(unsigned a_off, unsigned b_off, int pm, int pn, int kind) { Unit u; u.a_off = a_off; u.b_off = b_off; u.pm = pm; u.pn = pn; u.kind = kind; u.aux = 0; return u; }

struct EpiSloc {
    static constexpr bool PERM = false, AFTER_DRAIN = false;
    float* C;
    __device__ __forceinline__ void operator()(f32x4 (&acc)[2][2][4][2], const Unit& u, int wr, int wc, int fr, int fq, FK_LAS unsigned char*, int, int) const {
#pragma unroll
        for (int ai = 0; ai < 2; ++ai)
#pragma unroll
            for (int m = 0; m < 4; ++m) {
                float* rowp = C + (size_t)(u.pm * 256 + ai * 128 + wr * 64 + m * 16 + fr) * 256 + wc * 32 + 4 * fq;
#pragma unroll
                for (int bj = 0; bj < 2; ++bj)
#pragma unroll
                    for (int n = 0; n < 2; ++n) *(f32x4*)(rowp + 128 * bj + 16 * n) = acc[ai][bj][m][n];
            }
    }
};
__device__ __forceinline__ void s5_scan(const Params& p, int g, int mt, int tid) {
    const int bl = tid >> 7, dir = (tid >> 6) & 1, pp = tid & 63;
    const int gp = (dir * 32 + g) * 64 + pp;
    const float lr = fminf(p.in[6][gp], -1e-4f), li = p.in[7][gp], dt = expf(p.in[8][dir * 32 + g]);
    const float mag = expf(lr * dt * (float)SL), ang = li * dt * (float)SL;
    const float ar = mag * cosf(ang), ai = mag * sinf(ang);
    const float* sl = (const float*)(p.ws + WS_SLOC) + ((size_t)g * SROWS + mt * 256 + bl * 64) * 256 + dir * 128 + pp;
    bf16_t* su = (bf16_t*)(p.ws + WS_SU) + ((size_t)g * SROWS + mt * 256 + bl * 64) * SUP + dir * 128 + pp;
    float sr = 0.f, si = 0.f;
    for (int h2 = 0; h2 < 2; ++h2) {
        float lr_[32], li_[32];
#pragma unroll
        for (int i = 0; i < 32; ++i) { const int s = h2 * 32 + i, k = dir ? (NCH - 1 - s) : s; lr_[i] = sl[(size_t)k * 256]; li_[i] = sl[(size_t)k * 256 + 64]; }
#pragma unroll
        for (int i = 0; i < 32; ++i) {
            const int s = h2 * 32 + i, k = dir ? (NCH - 1 - s) : s;
            su[(size_t)k * SUP] = (bf16_t)f2bf(sr); su[(size_t)k * SUP + 64] = (bf16_t)f2bf(si);
            const float nr = ar * sr - ai * si + lr_[i], ni = ar * si + ai * sr + li_[i];
            sr = nr; si = ni;
        }
    }
}
struct EpiS5Out {
    static constexpr bool PERM = false, AFTER_DRAIN = false;
    bf16_t* Z; int g, mt, ntile;
    __device__ __forceinline__ void operator()(f32x4 (&acc)[2][2][4][2], const Unit& u, int wr, int wc, int fr, int fq, FK_LAS unsigned char*, int, int) const {
#pragma unroll
        for (int ai = 0; ai < 2; ++ai)
#pragma unroll
            for (int m = 0; m < 4; ++m) {
                const int R = mt * 256 + ai * 128 + wr * 64 + m * 16 + fr, b = R >> 6, k = R & 63;
#pragma unroll
                for (int bj = 0; bj < 2; ++bj)
#pragma unroll
                    for (int n = 0; n < 2; ++n) {
                        const int j = 16 * ntile + 8 * bj + 2 * wc + n;
                        const size_t t = (size_t)b * SEQ + k * SL + j;
                        f32x4 y = acc[ai][bj][m][n], z;
#pragma unroll
                        for (int i = 0; i < 4; ++i) { const float a2 = 1.5957691216057308f * (y[i] + 0.044715f * y[i] * y[i] * y[i]); z[i] = y[i] / (1.f + __expf(-a2)); }
                        u32x2 w; w.x = pg8::cvt_pk_bf16(z[0], z[1]); w.y = pg8::cvt_pk_bf16(z[2], z[3]);
                        *(u32x2*)(Z + t * 512 + g * 16 + 4 * fq) = w;
                    }
            }
    }
};
struct EpiGlu {
    static constexpr bool PERM = false, AFTER_DRAIN = false;
    const bf16_t* Z; bf16_t* Y; float* SS; const float* bias;
    __device__ __forceinline__ void operator()(f32x4 (&acc)[2][2][4][2], const Unit& u, int wr, int wc, int fr, int fq, FK_LAS unsigned char*, int, int) const {
        const int col0 = u.pn * 256 + wc * 32 + 4 * fq;
        f32x4 bv[2][2];
#pragma unroll
        for (int bj = 0; bj < 2; ++bj)
#pragma unroll
            for (int n = 0; n < 2; ++n) bv[bj][n] = *(const f32x4*)(bias + col0 + 128 * bj + 16 * n);
#pragma unroll
        for (int ai = 0; ai < 2; ++ai) {
            u32x2 zw[4][2][2];
#pragma unroll
            for (int m = 0; m < 4; ++m) { const size_t row = (size_t)u.pm * 256 + ai * 128 + wr * 64 + m * 16 + fr;
#pragma unroll
                for (int bj = 0; bj < 2; ++bj)
#pragma unroll
                    for (int n = 0; n < 2; ++n) zw[m][bj][n] = *(const u32x2*)(Z + row * 512 + col0 + 128 * bj + 16 * n); }
#pragma unroll
            for (int m = 0; m < 4; ++m) {
                const size_t row = (size_t)u.pm * 256 + ai * 128 + wr * 64 + m * 16 + fr;
                float ss = 0.f;
#pragma unroll
                for (int bj = 0; bj < 2; ++bj)
#pragma unroll
                    for (int n = 0; n < 2; ++n) {
                        const int col = col0 + 128 * bj + 16 * n;
                        const f32x4 lin = acc[ai][bj][m][n] + bv[bj][n];
                        const float z0 = bflo(zw[m][bj][n].x), z1 = bfhi(zw[m][bj][n].x), z2 = bflo(zw[m][bj][n].y), z3 = bfhi(zw[m][bj][n].y);
                        const float y0 = z0 / (1.f + __expf(-lin[0])), y1 = z1 / (1.f + __expf(-lin[1])), y2 = z2 / (1.f + __expf(-lin[2])), y3 = z3 / (1.f + __expf(-lin[3]));
                        u32x2 w; w.x = pg8::cvt_pk_bf16(y0, y1); w.y = pg8::cvt_pk_bf16(y2, y3);
                        *(u32x2*)(Y + row * 1024 + 512 + col) = w;
                        const float r0 = bflo(w.x), r1 = bfhi(w.x), r2 = bflo(w.y), r3 = bfhi(w.y);
                        ss += (r0 * r0 + r1 * r1) + (r2 * r2 + r3 * r3);
                    }
                ss += __shfl_xor(ss, 16); ss += __shfl_xor(ss, 32);
                if (fq == 0) SS[row * 8 + u.pn * 4 + wc] = ss;
            }
            asm volatile("" ::: "memory");
        }
    }
};
__device__ __forceinline__ float rs8(const float* ss, size_t row, float inv_n) {
    const f32x4 a = *(const f32x4*)(ss + row * 8), b = *(const f32x4*)(ss + row * 8 + 4);
    return rsqrtf(((a[0] + a[1]) + (a[2] + a[3]) + (b[0] + b[1]) + (b[2] + b[3])) * inv_n + EPS);
}
struct EpiWoutMid {
    static constexpr bool PERM = false, AFTER_DRAIN = false;
    const FK_LAS float* xt;
    __device__ __forceinline__ void operator()(f32x4 (&acc)[2][2][4][2], const Unit& u, int wr, int wc, int fr, int fq, FK_LAS unsigned char*, int, int) const {
#pragma unroll
        for (int ai = 0; ai < 2; ++ai)
#pragma unroll
            for (int m = 0; m < 4; ++m) {
                const float f = xt[ai * 128 + wr * 64 + m * 16 + fr];
#pragma unroll
                for (int bj = 0; bj < 2; ++bj)
#pragma unroll
                    for (int n = 0; n < 2; ++n) acc[ai][bj][m][n] = acc[ai][bj][m][n] * f;
            }
    }
};
struct EpiWoutFin {
    static constexpr bool PERM = false, AFTER_DRAIN = false;
    const FK_LAS float* xt; const bf16_t* XB; bf16_t* X1; float* SS1;
    __device__ __forceinline__ void operator()(f32x4 (&acc)[2][2][4][2], const Unit& u, int wr, int wc, int fr, int fq, FK_LAS unsigned char*, int, int) const {
        const int col0 = u.pn * 256 + wc * 32 + 4 * fq;
#pragma unroll
        for (int ai = 0; ai < 2; ++ai) {
            u32x2 xw[4][2][2];
#pragma unroll
            for (int m = 0; m < 4; ++m) { const size_t row = (size_t)u.pm * 256 + ai * 128 + wr * 64 + m * 16 + fr;
#pragma unroll
                for (int bj = 0; bj < 2; ++bj)
#pragma unroll
                    for (int n = 0; n < 2; ++n) xw[m][bj][n] = *(const u32x2*)(XB + row * 1024 + col0 + 128 * bj + 16 * n); }
#pragma unroll
            for (int m = 0; m < 4; ++m) {
                const size_t row = (size_t)u.pm * 256 + ai * 128 + wr * 64 + m * 16 + fr;
                const float rs = xt[256 + ai * 128 + wr * 64 + m * 16 + fr];
                float ss = 0.f;
#pragma unroll
                for (int bj = 0; bj < 2; ++bj)
#pragma unroll
                    for (int n = 0; n < 2; ++n) {
                        const int col = col0 + 128 * bj + 16 * n;
                        const f32x4 a = acc[ai][bj][m][n] * rs;
                        u32x2 w; w.x = pg8::cvt_pk_bf16(bflo(xw[m][bj][n].x) + a[0], bfhi(xw[m][bj][n].x) + a[1]); w.y = pg8::cvt_pk_bf16(bflo(xw[m][bj][n].y) + a[2], bfhi(xw[m][bj][n].y) + a[3]);
                        *(u32x2*)(X1 + row * 1024 + col) = w;
                        const float r0 = bflo(w.x), r1 = bfhi(w.x), r2 = bflo(w.y), r3 = bfhi(w.y);
                        ss += (r0 * r0 + r1 * r1) + (r2 * r2 + r3 * r3);
                    }
                ss += __shfl_xor(ss, 16); ss += __shfl_xor(ss, 32);
                if (fq == 0) SS1[row * 16 + u.pn * 4 + wc] = ss;
            }
            asm volatile("" ::: "memory");
        }
    }
};
struct EpiScaleBf16 {
    static constexpr bool PERM = false, AFTER_DRAIN = false;
    bf16_t* O; int ldc; const FK_LAS float* xt; float sc;
    __device__ __forceinline__ void operator()(f32x4 (&acc)[2][2][4][2], const Unit& u, int wr, int wc, int fr, int fq, FK_LAS unsigned char*, int, int) const {
#pragma unroll
        for (int ai = 0; ai < 2; ++ai)
#pragma unroll
            for (int m = 0; m < 4; ++m) {
                const int r = ai * 128 + wr * 64 + m * 16 + fr;
                const float f = xt ? xt[r] * sc : sc;
                bf16_t* rowp = O + (size_t)r * ldc + wc * 32 + 4 * fq;
#pragma unroll
                for (int bj = 0; bj < 2; ++bj)
#pragma unroll
                    for (int n = 0; n < 2; ++n) { const f32x4 x = acc[ai][bj][m][n] * f; u32x2 w; w.x = pg8::cvt_pk_bf16(x[0], x[1]); w.y = pg8::cvt_pk_bf16(x[2], x[3]);
                        *(u32x2*)(rowp + 128 * bj + 16 * n) = w; }
            }
    }
};
struct EpiSoftmax {
    static constexpr bool PERM = false, AFTER_DRAIN = true;
    bf16_t* O; int ldc;
    __device__ __forceinline__ void operator()(f32x4 (&acc)[2][2][4][2], const Unit& u, int wr, int wc, int fr, int fq, FK_LAS unsigned char* lds, int, int) const {
        FK_LAS float* Pm = (FK_LAS float*)lds;
        FK_LAS float* Ps = (FK_LAS float*)(lds + 4096);
#pragma unroll
        for (int ai = 0; ai < 2; ++ai)
#pragma unroll
            for (int m = 0; m < 4; ++m) {
                float mx = -INFINITY;
#pragma unroll
                for (int bj = 0; bj < 2; ++bj)
#pragma unroll
                    for (int n = 0; n < 2; ++n) { const f32x4 x = acc[ai][bj][m][n]; mx = fmaxf(mx, fmaxf(fmaxf(x[0], x[1]), fmaxf(x[2], x[3]))); }
                mx = fmaxf(mx, __shfl_xor(mx, 16)); mx = fmaxf(mx, __shfl_xor(mx, 32));
                if (fq == 0) Pm[(ai * 128 + wr * 64 + m * 16 + fr) * 4 + wc] = mx;
            }
        asm volatile("s_waitcnt lgkmcnt(0)" ::: "memory"); __builtin_amdgcn_s_barrier(); asm volatile("" ::: "memory");
#pragma unroll
        for (int ai = 0; ai < 2; ++ai)
#pragma unroll
            for (int m = 0; m < 4; ++m) {
                const int r = ai * 128 + wr * 64 + m * 16 + fr;
                const f32x4 pm4 = *(const FK_LAS f32x4*)(Pm + r * 4);
                const float M = fmaxf(fmaxf(pm4[0], pm4[1]), fmaxf(pm4[2], pm4[3]));
                float sm = 0.f;
#pragma unroll
                for (int bj = 0; bj < 2; ++bj)
#pragma unroll
                    for (int n = 0; n < 2; ++n) { f32x4 x = acc[ai][bj][m][n];
#pragma unroll
                        for (int i = 0; i < 4; ++i) { x[i] = __builtin_amdgcn_exp2f(x[i] - M); sm += x[i]; }
                        acc[ai][bj][m][n] = x; }
                sm += __shfl_xor(sm, 16); sm += __shfl_xor(sm, 32);
                if (fq == 0) Ps[r * 4 + wc] = sm;
            }
        asm volatile("s_waitcnt lgkmcnt(0)" ::: "memory"); __builtin_amdgcn_s_barrier(); asm volatile("" ::: "memory");
#pragma unroll
        for (int ai = 0; ai < 2; ++ai)
#pragma unroll
            for (int m = 0; m < 4; ++m) {
                const int r = ai * 128 + wr * 64 + m * 16 + fr;
                const f32x4 ps4 = *(const FK_LAS f32x4*)(Ps + r * 4);
                const float inv = 1.f / ((ps4[0] + ps4[1]) + (ps4[2] + ps4[3]));
                bf16_t* rowp = O + (size_t)r * ldc + wc * 32 + 4 * fq;
#pragma unroll
                for (int bj = 0; bj < 2; ++bj)
#pragma unroll
                    for (int n = 0; n < 2; ++n) { const f32x4 x = acc[ai][bj][m][n] * inv; u32x2 w; w.x = pg8::cvt_pk_bf16(x[0], x[1]); w.y = pg8::cvt_pk_bf16(x[2], x[3]);
                        *(u32x2*)(rowp + 128 * bj + 16 * n) = w; }
            }
        asm volatile("s_waitcnt lgkmcnt(0)" ::: "memory"); __builtin_amdgcn_s_barrier(); asm volatile("" ::: "memory");
    }
};
struct EpiResid {
    static constexpr bool PERM = false, AFTER_DRAIN = false;
    bf16_t* X; int ldc;
    __device__ __forceinline__ void operator()(f32x4 (&acc)[2][2][4][2], const Unit& u, int wr, int wc, int fr, int fq, FK_LAS unsigned char*, int, int) const {
#pragma unroll
        for (int ai = 0; ai < 2; ++ai) {
            u32x2 xw[4][2][2];
#pragma unroll
            for (int m = 0; m < 4; ++m) { const bf16_t* rowp = X + (size_t)(ai * 128 + wr * 64 + m * 16 + fr) * ldc + wc * 32 + 4 * fq;
#pragma unroll
                for (int bj = 0; bj < 2; ++bj)
#pragma unroll
                    for (int n = 0; n < 2; ++n) xw[m][bj][n] = *(const u32x2*)(rowp + 128 * bj + 16 * n); }
#pragma unroll
            for (int m = 0; m < 4; ++m) {
                bf16_t* rowp = X + (size_t)(ai * 128 + wr * 64 + m * 16 + fr) * ldc + wc * 32 + 4 * fq;
#pragma unroll
                for (int bj = 0; bj < 2; ++bj)
#pragma unroll
                    for (int n = 0; n < 2; ++n) { const f32x4 a = acc[ai][bj][m][n];
                        u32x2 w; w.x = pg8::cvt_pk_bf16(bflo(xw[m][bj][n].x) + a[0], bfhi(xw[m][bj][n].x) + a[1]); w.y = pg8::cvt_pk_bf16(bflo(xw[m][bj][n].y) + a[2], bfhi(xw[m][bj][n].y) + a[3]);
                        *(u32x2*)(rowp + 128 * bj + 16 * n) = w; }
            }
            asm volatile("" ::: "memory");
        }
    }
};
typedef float f32x16 __attribute__((ext_vector_type(16)));
__device__ __forceinline__ void router_phase(const Params& p, FK_LAS unsigned char* lds, int vcu, int G, int tid, int lane, int wave) {
    unsigned char* ws = p.ws;
    FK_LAS float* PL = (FK_LAS float*)lds;
    FK_LAS float* SSP = PL + 8 * 64 * 33;
    FK_LAS int* lcnt = (FK_LAS int*)(lds + XTRA_OFF);
    FK_LAS int* lbase = lcnt + 16;
    FK_LAS int* ee = lbase + 16;
    FK_LAS int* pp = ee + 128;
    FK_LAS float* ww = (FK_LAS float*)(pp + 128);
    const bf16_t* X2 = (const bf16_t*)(ws + WS_X1B);
    const bf16_t* RWT = (const bf16_t*)(ws + WS_RWT);
    int* cnt = (int*)(ws + WS_CTL) + CW_CNT; int* list = (int*)(ws + WS_LIST); float* wl = (float*)(ws + WS_WL); float* r2o = (float*)(ws + WS_R2);
    const int r32 = lane & 31, hi = lane >> 5;
    for (int chunk = vcu; chunk < T / 64; chunk += G) {
        if (tid < 16) lcnt[tid] = 0;
        const int t0 = chunk * 64;
        bf16x8 a[2][8], bh[8], bl[8];
#pragma unroll
        for (int ks = 0; ks < 8; ++ks) {
            const int k = 128 * wave + 16 * ks + 8 * hi;
            a[0][ks] = *(const bf16x8*)(X2 + (size_t)(t0 + r32) * 1024 + k);
            a[1][ks] = *(const bf16x8*)(X2 + (size_t)(t0 + 32 + r32) * 1024 + k);
            bh[ks] = *(const bf16x8*)(RWT + (size_t)r32 * 1024 + k);
            bl[ks] = *(const bf16x8*)(RWT + (size_t)(32 + r32) * 1024 + k);
        }
        f32x16 acc0 = {}, acc1 = {};
        float ss0 = 0.f, ss1 = 0.f;
#pragma unroll
        for (int ks = 0; ks < 8; ++ks) {
            acc0 = __builtin_amdgcn_mfma_f32_32x32x16_bf16(a[0][ks], bh[ks], acc0, 0, 0, 0);
            acc1 = __builtin_amdgcn_mfma_f32_32x32x16_bf16(a[1][ks], bh[ks], acc1, 0, 0, 0);
            acc0 = __builtin_amdgcn_mfma_f32_32x32x16_bf16(a[0][ks], bl[ks], acc0, 0, 0, 0);
            acc1 = __builtin_amdgcn_mfma_f32_32x32x16_bf16(a[1][ks], bl[ks], acc1, 0, 0, 0);
#pragma unroll
            for (int e = 0; e < 8; ++e) { const float x0 = bf2f((unsigned short)a[0][ks][e]), x1 = bf2f((unsigned short)a[1][ks][e]); ss0 = fmaf(x0, x0, ss0); ss1 = fmaf(x1, x1, ss1); }
        }
        ss0 += __shfl_xor(ss0, 32); ss1 += __shfl_xor(ss1, 32);
        if (hi == 0) { SSP[wave * 64 + r32] = ss0; SSP[wave * 64 + 32 + r32] = ss1; }
#pragma unroll
        for (int r = 0; r < 16; ++r) {
            const int row = (r & 3) + 8 * (r >> 2) + 4 * hi;
            PL[(wave * 64 + row) * 33 + r32] = acc0[r];
            PL[(wave * 64 + 32 + row) * 33 + r32] = acc1[r];
        }
        __syncthreads();
        if (wave == 0) {
            const int tl = lane, t = t0 + tl;
            float lg[20];
#pragma unroll
            for (int i = 0; i < 20; ++i) { float s_ = 0.f;
#pragma unroll
                for (int w8 = 0; w8 < 8; ++w8) s_ += PL[(w8 * 64 + tl) * 33 + i];
                lg[i] = s_; }
            float ss = 0.f;
#pragma unroll
            for (int w8 = 0; w8 < 8; ++w8) ss += SSP[w8 * 64 + tl];
            const float r2 = rsqrtf(ss * (1.f / 1024.f) + EPS);
#pragma unroll
            for (int i = 0; i < 20; ++i) lg[i] = lg[i] * r2 + (i < 4 ? p.in[27][i] : p.in[29][i - 4]);
            r2o[t] = r2;
            const float gm = fmaxf(fmaxf(lg[0], lg[1]), fmaxf(lg[2], lg[3]));
            const float e0 = expf(lg[0] - gm), e1 = expf(lg[1] - gm), e2 = expf(lg[2] - gm), e3 = expf(lg[3] - gm);
            const float gs = e0 + e1 + e2 + e3;
            int gsel = 0; float gbest = e0;
            if (e1 > gbest) { gbest = e1; gsel = 1; }
            if (e2 > gbest) { gbest = e2; gsel = 2; }
            if (e3 > gbest) { gbest = e3; gsel = 3; }
            const float gwt = gbest / gs;
            const float v0 = gsel == 0 ? lg[4] : gsel == 1 ? lg[8] : gsel == 2 ? lg[12] : lg[16];
            const float v1 = gsel == 0 ? lg[5] : gsel == 1 ? lg[9] : gsel == 2 ? lg[13] : lg[17];
            const float v2 = gsel == 0 ? lg[6] : gsel == 1 ? lg[10] : gsel == 2 ? lg[14] : lg[18];
            const float v3 = gsel == 0 ? lg[7] : gsel == 1 ? lg[11] : gsel == 2 ? lg[15] : lg[19];
            int i1 = 0; float b1 = v0;
            if (v1 > b1) { b1 = v1; i1 = 1; }
            if (v2 > b1) { b1 = v2; i1 = 2; }
            if (v3 > b1) { b1 = v3; i1 = 3; }
            int i2 = 0; float b2 = -INFINITY;
            if (i1 != 0 && v0 > b2) { b2 = v0; i2 = 0; }
            if (i1 != 1 && v1 > b2) { b2 = v1; i2 = 1; }
            if (i1 != 2 && v2 > b2) { b2 = v2; i2 = 2; }
            if (i1 != 3 && v3 > b2) { b2 = v3; i2 = 3; }
            const float ex2 = expf(b2 - b1);
            const float w1 = gwt / (1.f + ex2), w2 = gwt * ex2 / (1.f + ex2);
            const int ea = gsel * 4 + i1, eb = gsel * 4 + i2;
            ee[tl * 2] = ea; pp[tl * 2] = __hip_atomic_fetch_add(&lcnt[ea], 1, __ATOMIC_RELAXED, __HIP_MEMORY_SCOPE_WORKGROUP); ww[tl * 2] = w1;
            ee[tl * 2 + 1] = eb; pp[tl * 2 + 1] = __hip_atomic_fetch_add(&lcnt[eb], 1, __ATOMIC_RELAXED, __HIP_MEMORY_SCOPE_WORKGROUP); ww[tl * 2 + 1] = w2;
        }
        __syncthreads();
        if (tid < 16) lbase[tid] = atomicAdd(&cnt[tid * 64], lcnt[tid]);
        __syncthreads();
        if (tid < 128) { const int e = ee[tid], pos = lbase[e] + pp[tid]; list[e * T + pos] = (t0 + (tid >> 1)) * 2 + (tid & 1); wl[e * T + pos] = ww[tid]; }
        __syncthreads();
    }
}
struct MoeTab {
    const FK_LAS int* t;
    __device__ __forceinline__ int total_tiles() const { return __builtin_amdgcn_readfirstlane(t[16]); }
    __device__ __forceinline__ void decode(int mtile, int& e, int& mt, int& ce) const {
        int ee = 0;
#pragma unroll
        for (int j = 1; j < 16; ++j) ee += (mtile >= __builtin_amdgcn_readfirstlane(t[j])) ? 1 : 0;
        e = ee; mt = mtile - __builtin_amdgcn_readfirstlane(t[ee]); ce = __builtin_amdgcn_readfirstlane(t[17 + ee]);
    }
};
__device__ __forceinline__ void moe_tab_init(FK_LAS int* t, const int* cnt, int tid) {
    if (tid == 0) { int acc = 0; t[0] = 0;
        for (int j = 0; j < 16; ++j) { const int c = __hip_atomic_load(cnt + j * 64, __ATOMIC_RELAXED, __HIP_MEMORY_SCOPE_AGENT); t[17 + j] = c; acc += (c + 255) >> 8; t[j + 1] = acc; } }
    __syncthreads();
}
struct SchedMoe1 {
    MoeTab tab; int G, c; const FK_LAS unsigned* xo;
    __device__ __forceinline__ bool next(int i, Unit& u) const {
        const int L = i * G + c; const int nun = tab.total_tiles() * 4;
        int e, mt, ce; tab.decode(L >> 2, e, mt, ce);
        u.a_off = 0; u.b_off = (unsigned)(WS_WGU + ((size_t)e * 1024 + (L & 3) * 256) * 1024 * 2); u.pm = L >> 2; u.pn = L & 3; u.kind = e; u.aux = i;
        return L < nun;
    }
    __device__ __forceinline__ unsigned row_off(const Unit& u, int r) const { return xo[u.aux * 256 + r]; }
};
struct EpiMoe1 {
    static constexpr bool PERM = false, AFTER_DRAIN = false;
    bf16_t* ACT; const FK_LAS float* xf;
    __device__ __forceinline__ void operator()(f32x4 (&acc)[2][2][4][2], const Unit& u, int wr, int wc, int fr, int fq, FK_LAS unsigned char*, int, int) const {
#pragma unroll
        for (int ai = 0; ai < 2; ++ai)
#pragma unroll
            for (int m = 0; m < 4; ++m) {
                const int r = ai * 128 + wr * 64 + m * 16 + fr;
                const float f1 = xf[u.aux * 512 + r], f2 = xf[u.aux * 512 + 256 + r];
                bf16_t* rowp = ACT + ((size_t)u.pm * 256 + r) * 512 + u.pn * 128 + wc * 32 + 4 * fq;
#pragma unroll
                for (int n = 0; n < 2; ++n) {
                    const f32x4 g = acc[ai][0][m][n] * f1, up = acc[ai][1][m][n] * f2; f32x4 a;
#pragma unroll
                    for (int i = 0; i < 4; ++i) a[i] = g[i] / (1.f + __expf(-g[i])) * up[i];
                    u32x2 w; w.x = pg8::cvt_pk_bf16(a[0], a[1]); w.y = pg8::cvt_pk_bf16(a[2], a[3]);
                    *(u32x2*)(rowp + 16 * n) = w;
                }
            }
    }
};
struct SchedMoe2 {
    MoeTab tab; int G, c;
    __device__ __forceinline__ bool next(int i, Unit& u) const {
        const int L = i * G + c; const int nun = tab.total_tiles() * 4;
        int e, mt, ce; tab.decode(L >> 2, e, mt, ce);
        u.a_off = (unsigned)(WS_ACT + (size_t)(L >> 2) * 256 * 512 * 2); u.b_off = (unsigned)(WS_WD + ((size_t)e * 1024 + (L & 3) * 256) * 512 * 2); u.pm = L >> 2; u.pn = L & 3; u.kind = e; u.aux = i;
        return L < nun;
    }
    __device__ __forceinline__ unsigned row_off(const Unit& u, int r) const { return u.a_off + (unsigned)r * 1024u; }
};
struct EpiMoe2 {
    static constexpr bool PERM = false, AFTER_DRAIN = false;
    bf16_t* YM; const FK_LAS int* xe;
    __device__ __forceinline__ void operator()(f32x4 (&acc)[2][2][4][2], const Unit& u, int wr, int wc, int fr, int fq, FK_LAS unsigned char*, int, int) const {
#pragma unroll
        for (int ai = 0; ai < 2; ++ai)
#pragma unroll
            for (int m = 0; m < 4; ++m) {
                const int r = ai * 128 + wr * 64 + m * 16 + fr;
                const int ent = xe[u.aux * 256 + r];
                if (ent >= 0) {
                    bf16_t* rowp = YM + (size_t)ent * 1024 + u.pn * 256 + wc * 32 + 4 * fq;
#pragma unroll
                    for (int bj = 0; bj < 2; ++bj)
#pragma unroll
                        for (int n = 0; n < 2; ++n) { const f32x4 x = acc[ai][bj][m][n]; u32x2 w; w.x = pg8::cvt_pk_bf16(x[0], x[1]); w.y = pg8::cvt_pk_bf16(x[2], x[3]);
                            *(u32x2*)(rowp + 128 * bj + 16 * n) = w; }
                }
            }
    }
};
__device__ __forceinline__ void final_phase(const Params& p, int vcu, int G, int lane, int wave) {
    const bf16_t* X2 = (const bf16_t*)(p.ws + WS_X1B); const bf16_t* YM = (const bf16_t*)p.out; const float* fg = p.in[33];
    const int gwv = vcu * NWAVES + wave, NGW = G * NWAVES;
    for (int t = gwv; t < T; t += NGW) {
        float v[16]; float ss = 0.f;
#pragma unroll
        for (int j = 0; j < 2; ++j) {
            const int k0 = j * 512 + lane * 8;
            const u32x4 a = *(const u32x4*)(X2 + (size_t)t * 1024 + k0), b = *(const u32x4*)(YM + (size_t)t * 2048 + k0), c = *(const u32x4*)(YM + (size_t)t * 2048 + 1024 + k0);
#pragma unroll
            for (int e = 0; e < 4; ++e) { v[j * 8 + 2 * e] = bflo(a[e]) + bflo(b[e]) + bflo(c[e]); v[j * 8 + 2 * e + 1] = bfhi(a[e]) + bfhi(b[e]) + bfhi(c[e]); }
        }
#pragma unroll
        for (int i = 0; i < 16; ++i) ss += v[i] * v[i];
        ss = wsum(ss);
        const float r = rsqrtf(ss * (1.f / 1024.f) + EPS);
        float* orow = p.out + (size_t)t * 1024;
#pragma unroll
        for (int j = 0; j < 2; ++j) {
            const int k0 = j * 512 + lane * 8;
            const f32x4 g0 = *(const f32x4*)(fg + k0), g1 = *(const f32x4*)(fg + k0 + 4);
            f32x4 o0, o1;
#pragma unroll
            for (int e = 0; e < 4; ++e) { o0[e] = v[j * 8 + e] * r * g0[e]; o1[e] = v[j * 8 + 4 + e] * r * g1[e]; }
            *(f32x4*)(orow + k0) = o0; *(f32x4*)(orow + k0 + 4) = o1;
        }
    }
}
__global__ void __launch_bounds__(NTHREADS, 2) mk(Params p) {
    extern __shared__ __attribute__((aligned(16))) unsigned char lds_raw[];
    FK_LAS unsigned char* lds = (FK_LAS unsigned char*)lds_raw;
    const int tid0 = threadIdx.x;
    const int G = gridDim.x, bx = blockIdx.x;
    const int vcu = (G % 8 == 0) ? (bx % 8) * (G / 8) + bx / 8 : bx;
    unsigned char* ws = p.ws;
    volatile FK_LAS unsigned* bst = (volatile FK_LAS unsigned*)(lds + LDS_BYTES - 64);
    if (tid0 < 2) bst[tid0] = 0u;
    __syncthreads();
    XcdBarrier bar = xcd_barrier_post((unsigned*)(ws + WS_CTL) + CW_BAR, bst);
#define IN(k) (p.ph_lo <= (k) && (k) < p.ph_hi)
#define FRESH_IDS() int tid_f = threadIdx.x; asm volatile("" : "+v"(tid_f)); const int tid = tid_f, lane = tid_f & 63, wave = __builtin_amdgcn_readfirstlane(tid_f >> 6); (void)tid; (void)lane; (void)wave
    const bool defer = (G == 256) && p.ph_lo == 0 && p.ph_hi == 13;
#ifndef PROBE_PHASE
#define PROBE_PHASE -1
#define PROBE_N 1
#endif
#define REP(k) for (int rr_ = 0; rr_ < ((k) == PROBE_PHASE ? PROBE_N : 1); ++rr_)
#define REPBAR() do { if (rr_ > 0) xcd_barrier(bar); } while (0)
#define SEAM(k) do { if (IN(k) && IN((k) + 1)) xcd_barrier(bar); } while (0)
    if (IN(0)) { FRESH_IDS(); p0_prologue(p, lds, vcu, G, tid, lane, wave, defer);
#if PROBE_PHASE == 0
        xcd_barrier(bar); p0_prologue(p, lds, vcu, G, tid, lane, wave, defer); xcd_barrier(bar); p0_prologue(p, lds, vcu, G, tid, lane, wave, defer);
#endif
    }
    SEAM(0);
    if (IN(1)) REP(1) { REPBAR(); FRESH_IDS();
        Gemm g{(const char*)ws, 1024, 1024, 1024};
        SchedP1 S{G, bx};
        EpiP1 E{ws, p.in[4], p.in[5]};
        f32x4 acc[2][2][4][2];
        pg8::gemm_phase<EpiP1, SchedP1, true, true, false>(lds, g, S, E, acc);
        if (defer && bx >= 128) { int t2 = threadIdx.x; asm volatile("" : "+v"(t2)); for (int it = bx - 128; it < 256; it += 128) s5_prep_part(p, it >> 3, it & 7, (FK_LAS float*)lds, t2); }
    }
    SEAM(1);
    if (IN(2)) REP(2) { REPBAR(); FRESH_IDS();
        attn_body::attn_phase<8>((char*)lds_raw, (const attn_body::bf16*)(ws + WS_Q), (const attn_body::bf16*)(ws + WS_K), (const attn_body::bf16*)(ws + WS_V),
                                 (attn_body::bf16*)(ws + WS_YCAT), (float*)(ws + WS_SSATT), G, vcu);
    }
    SEAM(2);
    if (IN(3)) REP(3) { REPBAR(); FRESH_IDS();
        for (int L = bx; L < 64; L += G) {
            const int g = L >> 1, mt = L & 1;
            Gemm gm{(const char*)ws, SUP, 512, 512};
            SchedOne S{mk_unit((unsigned)(WS_SU + (((size_t)g * SROWS + mt * 256) * SUP + 256) * 2), (unsigned)(WS_W1 + (size_t)g * 256 * 512 * 2), mt, 0, 0), SUP * 2};
            EpiSloc E{(float*)(ws + WS_SLOC) + (size_t)g * SROWS * 256};
            f32x4 acc[2][2][4][2];
            pg8::gemm_phase<EpiSloc, SchedOne, false, true, false>(lds, gm, S, E, acc);
            asm volatile("s_waitcnt vmcnt(0)" ::: "memory"); __syncthreads();
            { int t2 = threadIdx.x; asm volatile("" : "+v"(t2)); s5_scan(p, g, mt, t2); }
        }
        if (defer && bx >= 64) { SIDE_WAVES(64); convert_B(p, sscr_, lane, sw_, snw_, 0, NIT_B); convert_C(p, sscr_, lane, sw_, snw_, 0, NIT_C / 3); }
    }
    SEAM(3);
    if (IN(4)) REP(4) { REPBAR(); FRESH_IDS();
        for (int L = bx; L < 128; L += G) {
            const int g = L >> 2, mt = (L >> 1) & 1, ntile = L & 1;
            Gemm gm{(const char*)ws, SUP, SUP, SUP};
            SchedOne S{mk_unit((unsigned)(WS_SU + ((size_t)g * SROWS + mt * 256) * SUP * 2), (unsigned)(WS_W2 + ((size_t)g * 512 + ntile * 256) * SUP * 2), mt, ntile, 0), SUP * 2};
            EpiS5Out E{(bf16_t*)(ws + WS_Z), g, mt, ntile};
            f32x4 acc[2][2][4][2];
            pg8::gemm_phase<EpiS5Out, SchedOne, false, true, false>(lds, gm, S, E, acc);
        }
        if (defer && bx >= 128) { SIDE_WAVES(128); convert_C(p, sscr_, lane, sw_, snw_, NIT_C / 3, 2 * (NIT_C / 3)); }
    }
    SEAM(4);
    if (IN(5)) REP(5) { REPBAR(); FRESH_IDS();
        for (int L = bx; L < 128; L += G) {
            int pm, pn; pg8::tile_order(L, 64, 2, pm, pn);
            Gemm gm{(const char*)ws, 512, 512, 512};
            SchedOne S{mk_unit((unsigned)(WS_Z + (size_t)pm * 256 * 512 * 2), (unsigned)(WS_GLU + (size_t)pn * 256 * 512 * 2), pm, pn, 0), 512 * 2};
            EpiGlu E{(const bf16_t*)(ws + WS_Z), (bf16_t*)(ws + WS_YCAT), (float*)(ws + WS_SSSSM), p.in[15]};
            f32x4 acc[2][2][4][2];
            pg8::gemm_phase<EpiGlu, SchedOne, false, true, false>(lds, gm, S, E, acc);
        }
        if (defer && bx >= 128) { SIDE_WAVES(128); convert_C(p, sscr_, lane, sw_, snw_, 2 * (NIT_C / 3), NIT_C); }
    }
    SEAM(5);
    if (IN(6)) REP(6) { REPBAR(); FRESH_IDS();
        for (int L = bx; L < 256; L += G) {
            int pm, pn; pg8::tile_order(L, 64, 4, pm, pn);
            Gemm gm{(const char*)ws, 1024, 1024, 512};
            const unsigned a0 = (unsigned)(WS_YCAT + (size_t)pm * 256 * 1024 * 2), b0 = (unsigned)(WS_WOUT + (size_t)pn * 256 * 1024 * 2);
            f32x4 acc[2][2][4][2];
            FK_LAS float* xt = (FK_LAS float*)(lds + XTRA_OFF);
            { int t2 = threadIdx.x; asm volatile("" : "+v"(t2));
              if (t2 < 256) { const size_t row = (size_t)pm * 256 + t2; const float ra = rs8((const float*)(ws + WS_SSATT), row, 1.f / 512.f), rs = rs8((const float*)(ws + WS_SSSSM), row, 1.f / 512.f); xt[t2] = ra / rs; xt[256 + t2] = rs; }
              __syncthreads(); }
            { SchedOne S{mk_unit(a0, b0, pm, pn, 0), 2048}; EpiWoutMid E{xt};
              pg8::gemm_phase<EpiWoutMid, SchedOne, false, true, false>(lds, gm, S, E, acc); }
            { SchedOne S{mk_unit(a0 + 1024, b0 + 1024, pm, pn, 0), 2048}; EpiWoutFin E{xt, (const bf16_t*)(ws + WS_XB), (bf16_t*)(ws + WS_X1B), (float*)(ws + WS_SSX1)};
              pg8::gemm_phase<EpiWoutFin, SchedOne, false, true, true>(lds, gm, S, E, acc); }
        }
    }
    SEAM(6);
    if (IN(7)) REP(7) { REPBAR(); FRESH_IDS();
        for (int L = bx; L < 256; L += G) {
            int pm, pn; pg8::tile_order(L, 64, 4, pm, pn);
            const int b = pm >> 3;
            FK_LAS float* xt = (FK_LAS float*)(lds + XTRA_OFF);
            { int t2 = threadIdx.x; asm volatile("" : "+v"(t2));
              if (t2 < 256) { const float* s1 = (const float*)(ws + WS_SSX1) + ((size_t)pm * 256 + t2) * 16; const f32x4 a = *(const f32x4*)s1, b4 = *(const f32x4*)(s1 + 4), c = *(const f32x4*)(s1 + 8), d = *(const f32x4*)(s1 + 12);
                  xt[t2] = rsqrtf((((a[0] + a[1]) + (a[2] + a[3])) + ((b4[0] + b4[1]) + (b4[2] + b4[3])) + ((c[0] + c[1]) + (c[2] + c[3])) + ((d[0] + d[1]) + (d[2] + d[3]))) * (1.f / 1024.f) + EPS); }
              __syncthreads(); }
            const size_t tile = ((size_t)pm * 256 * 1024 + pn * 256) * 2;
            f32x4 acc[2][2][4][2];
            { Gemm gm{(const char*)ws, 1024, 1024, 1024};
              SchedOne S{mk_unit((unsigned)(WS_X1B + (size_t)pm * 256 * 1024 * 2), (unsigned)(WS_WQ + (size_t)pn * 256 * 1024 * 2), pm, pn, 0), 2048};
              EpiScaleBf16 E{(bf16_t*)(ws + WS_QX + tile), 1024, xt, XQSCALE};
              pg8::gemm_phase<EpiScaleBf16, SchedOne, false, true, false>(lds, gm, S, E, acc); }
            asm volatile("s_waitcnt vmcnt(0)" ::: "memory"); __syncthreads();
            { Gemm gm{(const char*)ws, 1024, 1024, 256};
              SchedOne S{mk_unit((unsigned)(WS_QX + tile), (unsigned)(WS_KM + ((size_t)b * 256 * 1024 + pn * 256) * 2), pm, pn, 0), 2048};
              EpiSoftmax E{(bf16_t*)(ws + WS_PB + tile), 1024};
              pg8::gemm_phase<EpiSoftmax, SchedOne, false, true, false>(lds, gm, S, E, acc); }
            asm volatile("s_waitcnt vmcnt(0)" ::: "memory"); __syncthreads();
            { Gemm gm{(const char*)ws, 1024, 256, 256};
              SchedOne S{mk_unit((unsigned)(WS_PB + tile), (unsigned)(WS_VT + ((size_t)b * 1024 + pn * 256) * 256 * 2), pm, pn, 0), 2048};
              EpiScaleBf16 E{(bf16_t*)(ws + WS_QX + tile), 1024, nullptr, 1.f};
              pg8::gemm_phase<EpiScaleBf16, SchedOne, false, true, false>(lds, gm, S, E, acc); }
        }
    }
    SEAM(7);
    if (IN(8)) REP(8) { REPBAR(); FRESH_IDS();
        for (int L = bx; L < 256; L += G) {
            int pm, pn; pg8::tile_order(L, 64, 4, pm, pn);
            const size_t tile = ((size_t)pm * 256 * 1024 + pn * 256) * 2;
            Gemm gm{(const char*)ws, 1024, 1024, 1024};
            SchedOne S{mk_unit((unsigned)(WS_QX + (size_t)pm * 256 * 1024 * 2), (unsigned)(WS_WO + (size_t)pn * 256 * 1024 * 2), pm, pn, 0), 2048};
            EpiResid E{(bf16_t*)(ws + WS_X1B + tile), 1024};
            f32x4 acc[2][2][4][2];
            pg8::gemm_phase<EpiResid, SchedOne, false, true, false>(lds, gm, S, E, acc);
        }
    }
    SEAM(8);
    if (IN(9)) REP(9) { REPBAR(); FRESH_IDS(); if (rr_ > 0) { if (bx == 0 && tid < 16) __hip_atomic_store((int*)(ws + WS_CTL) + CW_CNT + tid * 64, 0, __ATOMIC_RELAXED, __HIP_MEMORY_SCOPE_AGENT); xcd_barrier(bar); } router_phase(p, lds, vcu, G, tid, lane, wave); }
    SEAM(9);
    if (IN(10)) REP(10) { REPBAR(); FRESH_IDS();
        FK_LAS int* tabp = (FK_LAS int*)(lds + XTRA_OFF + 15 * 1024); moe_tab_init(tabp, (const int*)(ws + WS_CTL) + CW_CNT, threadIdx.x); MoeTab tab{tabp};
        FK_LAS unsigned* xo = (FK_LAS unsigned*)(lds + XTRA_OFF);
        FK_LAS float* xf = (FK_LAS float*)(lds + XTRA_OFF + 5 * 1024);
        { int t2 = threadIdx.x; asm volatile("" : "+v"(t2));
          const int nun = tab.total_tiles() * 4; int i = 0;
          for (int L = bx; L < nun && i < 5; L += G, ++i) {
              if (t2 < 256) { int e, mt, ce; tab.decode(L >> 2, e, mt, ce); const int idx = mt * 256 + t2; const bool valid = idx < ce;
                  const int ent = valid ? ((const int*)(ws + WS_LIST))[e * T + idx] : 0; const int tok = ent >> 1;
                  xo[i * 256 + t2] = (unsigned)(WS_X1B + (size_t)tok * 2048);
                  const float r2 = ((const float*)(ws + WS_R2))[tok];
                  xf[i * 512 + t2] = r2; xf[i * 512 + 256 + t2] = valid ? r2 * ((const float*)(ws + WS_WL))[e * T + idx] : 0.f; }
          }
          __syncthreads(); }
        Gemm gm{(const char*)ws, 1024, 1024, 1024};
        SchedMoe1 S{tab, G, bx, xo};
        EpiMoe1 E{(bf16_t*)(ws + WS_ACT), xf};
        f32x4 acc[2][2][4][2];
        pg8::gemm_phase<EpiMoe1, SchedMoe1, true, true, false>(lds, gm, S, E, acc);
    }
    SEAM(10);
    if (IN(11)) REP(11) { REPBAR(); FRESH_IDS();
        FK_LAS int* tabp = (FK_LAS int*)(lds + XTRA_OFF + 15 * 1024); moe_tab_init(tabp, (const int*)(ws + WS_CTL) + CW_CNT, threadIdx.x); MoeTab tab{tabp};
        FK_LAS int* xe = (FK_LAS int*)(lds + XTRA_OFF);
        { int t2 = threadIdx.x; asm volatile("" : "+v"(t2));
          const int nun = tab.total_tiles() * 4; int i = 0;
          for (int L = bx; L < nun && i < 5; L += G, ++i) {
              if (t2 < 256) { int e, mt, ce; tab.decode(L >> 2, e, mt, ce); const int idx = mt * 256 + t2;
                  xe[i * 256 + t2] = idx < ce ? ((const int*)(ws + WS_LIST))[e * T + idx] : -1; }
          }
          __syncthreads(); }
        Gemm gm{(const char*)ws, 512, 512, 512};
        SchedMoe2 S{tab, G, bx};
        EpiMoe2 E{(bf16_t*)p.out, xe};
        f32x4 acc[2][2][4][2];
        pg8::gemm_phase<EpiMoe2, SchedMoe2, true, true, false>(lds, gm, S, E, acc);
    }
    SEAM(11);
    if (IN(12)) REP(12) { REPBAR(); FRESH_IDS(); final_phase(p, vcu, G, lane, wave); }
#undef SEAM
#undef IN
}

}
extern "C" void kernel_launch(void* const* d_in, const int* in_sizes, int n_in, void* d_out, int out_size, void* d_ws, size_t ws_size, hipStream_t stream) {
    static int grid = 0;
    if (grid == 0) {
        int dev = 0, cus = 0, per_cu = 0;
        (void)hipGetDevice(&dev);
        (void)hipDeviceGetAttribute(&cus, hipDeviceAttributeMultiprocessorCount, dev);
        (void)hipFuncSetAttribute((const void*)fk::mk, hipFuncAttributeMaxDynamicSharedMemorySize, fk::LDS_BYTES);
        (void)hipOccupancyMaxActiveBlocksPerMultiprocessor(&per_cu, (const void*)fk::mk, fk::NTHREADS, fk::LDS_BYTES);
        if (per_cu < 1 || cus < 1 || ws_size < fk::WS_END) { fprintf(stderr, "kernel_launch: cus %d per_cu %d ws %zu: cannot launch\n", cus, per_cu, ws_size); grid = -1; }
        else grid = cus;
    }
    if (grid < 0) return;
    (void)hipMemsetAsync(d_ws, 0, 1u << 20, stream);
    fk::Params p{};
    for (int i = 0; i < 34; ++i) p.in[i] = (const float*)d_in[i];
    p.out = (float*)d_out; p.ws = (unsigned char*)d_ws; p.ph_lo = 0; p.ph_hi = 13;
    void* args[] = {&p};
    hipError_t e = hipLaunchCooperativeKernel((const void*)fk::mk, dim3(grid), dim3(fk::NTHREADS), args, fk::LDS_BYTES, stream);
    if (e != hipSuccess) fprintf(stderr, "cooperative launch failed: %s (grid %d)\n", hipGetErrorString(e), grid);
}
```

```cpp
#include <hip/hip_runtime.h>
#include <hip/hip_bf16.h>
#include <cmath>
#include <stdint.h>
#include <stdio.h>
#include <hip/hip_cooperative_groups.h>
namespace fk {
namespace cg = cooperative_groups;
#define FK_LAS __attribute__((address_space(3)))
#define FK_GAS __attribute__((address_space(1)))
typedef unsigned short bf16_t;
typedef short bf16x8 __attribute__((ext_vector_type(8)));
typedef float f32x4 __attribute__((ext_vector_type(4)));
typedef float f32x2 __attribute__((ext_vector_type(2)));
typedef unsigned u32x4 __attribute__((ext_vector_type(4)));
typedef unsigned u32x2 __attribute__((ext_vector_type(2)));

constexpr int T = 16384, SEQ = 2048, BATCH = 8, DM = 1024, MEMLEN = 256, MTOK = BATCH * MEMLEN;
constexpr float EPS = 1e-6f;
constexpr float LOG2E = 1.4426950408889634f;
constexpr float QSCALE = 0.125f * LOG2E;
constexpr float XQSCALE = 0.0625f * LOG2E;
constexpr int NWAVES = 8, NTHREADS = 512;
constexpr int SL = 32, NCH = SEQ / SL;
constexpr int SUP = 768;
constexpr int SROWS = BATCH * NCH;

constexpr size_t MiB = 1u << 20;
constexpr size_t WS_CTL = 0;
constexpr size_t WS_WIN = 1 * MiB;
constexpr size_t WS_GLU = 4 * MiB;
constexpr size_t WS_WOUT = 5 * MiB;
constexpr size_t WS_WQ = 7 * MiB  , WS_WK = 9 * MiB, WS_WV = 11 * MiB, WS_WO = 13 * MiB;
constexpr size_t OUT_MT = 0, OUT_NT = 16 * MiB;
constexpr size_t WS_W1 = 15 * MiB;
constexpr size_t WS_W2 = 23 * MiB;
constexpr size_t WS_WGU = 47 * MiB;
constexpr size_t WS_WD = 79 * MiB;
constexpr size_t WS_R0 = 95 * MiB;
constexpr size_t WS_ROPE = WS_R0 + 65536;
constexpr size_t WS_R2 = WS_ROPE + 65536;
constexpr size_t WS_RWT = 95 * MiB + 256 * 1024;
constexpr size_t WS_SSATT = 95 * MiB + 512 * 1024;
constexpr size_t WS_SSSSM = 96 * MiB;
constexpr size_t WS_SSX1 = 96 * MiB + 512 * 1024;
constexpr size_t WS_LIST = 102 * MiB;
constexpr size_t WS_WL = 103 * MiB;
constexpr size_t WS_XB = 105 * MiB;
constexpr size_t WS_HM = 137 * MiB;
constexpr size_t WS_Q = 141 * MiB;
constexpr size_t WS_K = 157 * MiB;
constexpr size_t WS_V = 161 * MiB;
constexpr size_t WS_SU = 165 * MiB;
constexpr size_t WS_SLOC = 189 * MiB;
constexpr size_t WS_KM = 205 * MiB;
constexpr size_t WS_VM = 209 * MiB;
constexpr size_t WS_YCAT = 213 * MiB;
constexpr size_t WS_END = 245 * MiB;
constexpr size_t WS_Z = WS_Q, WS_X1B = WS_SU, WS_QX = WS_XB, WS_PB = WS_YCAT, WS_ACT = WS_XB;
constexpr int CW_CNT = 64;
constexpr int CW_BAR = 4096;

constexpr int RING_BYTES = 131072, XTRA_OFF = RING_BYTES, LDS_BYTES = 147456;

__device__ __forceinline__ unsigned f2bf(float f) { unsigned u = __builtin_bit_cast(unsigned, f); return (u + 0x7fffu + ((u >> 16) & 1u)) >> 16; }
__device__ __forceinline__ unsigned pk2(float lo, float hi) { return f2bf(lo) | (f2bf(hi) << 16); }
__device__ __forceinline__ float bf2f(unsigned short b) { return __builtin_bit_cast(float, (unsigned)b << 16); }
__device__ __forceinline__ float bflo(unsigned w) { return __builtin_bit_cast(float, w << 16); }
__device__ __forceinline__ float bfhi(unsigned w) { return __builtin_bit_cast(float, w & 0xffff0000u); }
__device__ __forceinline__ float wsum(float v) {
#pragma unroll
    for (int o = 1; o < 64; o <<= 1) v += __shfl_xor(v, o);
    return v;
}

namespace pg8 {
constexpr int BM = 256, BK = 64, HALF = 128, HTB = HALF * BK * 2, STAGE_BYTES = 8 * HTB, NXCD = 8, WGM = 8;
__host__ __device__ __forceinline__ int lds_byte(int r, int c) { const int st = (r >> 4) * 2 + (c >> 5), rr = r & 15, cc = c & 31, ob = rr * 64 + cc * 2; return st * 1024 + (ob ^ (((ob >> 9) & 1) << 5)); }
__host__ __device__ __forceinline__ void stage_rc(int b, int& R, int& C) { const int st = b / 1024, sb = b % 1024, swz = sb ^ (((sb >> 9) & 1) << 5); R = (st >> 1) * 16 + swz / 64; C = (st & 1) * 32 + (swz % 64) / 2; }
__host__ __device__ __forceinline__ int perm32(int rho) { const int n = rho >> 4, i = rho & 15; return 8 * (i >> 2) + 4 * n + (i & 3); }

struct Unit { unsigned a_off, b_off; int pm, pn, kind, aux; };
struct Gemm { const char* baseA; const char* baseB; int lda, ldb, K; };

__device__ __forceinline__ void tile_order(int L, int nM, int nN, int& pm, int& pn) {
    const int nwg = nM * nN; int wgid = L;
    { const int q = nwg / NXCD, r = nwg % NXCD, xcd = wgid % NXCD, off = wgid / NXCD; wgid = (xcd < r ? xcd * (q + 1) : r * (q + 1) + (xcd - r) * q) + off; }
    const int nig = WGM * nN, gid = wgid / nig, fm = gid * WGM, gsz = (nM - fm) < WGM ? (nM - fm) : WGM;
    pm = fm + ((wgid % nig) % gsz); pn = (wgid % nig) / gsz;
}

__device__ __forceinline__ unsigned cvt_pk_bf16(float lo, float hi) { unsigned r; asm volatile("v_cvt_pk_bf16_f32 %0, %1, %2" : "=v"(r) : "v"(lo), "v"(hi)); return r; }

template <class Epi, class Sched, bool ALIGN_EPI, bool SP2, bool KEEP_ACC>
__device__ __forceinline__ void gemm_phase(FK_LAS unsigned char* lds, const Gemm g, const Sched& S, const Epi& E, f32x4 (&acc)[2][2][4][2]) {
    int tid_ = threadIdx.x; asm volatile("" : "+v"(tid_));
    const int tid = tid_, wid = __builtin_amdgcn_readfirstlane(tid >> 6), lane = tid & 63, wr = wid >> 2, wc = wid & 3, fr = lane & 15, fq = lane >> 4;
    const int K = g.K, nt = K / BK;
    int R0, C0; stage_rc(tid * 16, R0, C0);
    unsigned voffB[2];
#pragma unroll
    for (int i = 0; i < 2; ++i) { const int R = R0 + 64 * i; const int Rb = Epi::PERM ? ((R & ~31) + perm32(R & 31)) : R; voffB[i] = (unsigned)(Rb * g.ldb + C0) * 2u; }
    const size_t kstep = (size_t)(BK * 2);
    const size_t hstepB = (size_t)HALF * g.ldb * 2;
    const unsigned ldsw = (unsigned)wid * 1024u;
    const int aoff = lds_byte(wr * 64 + fr, fq * 8), boff = lds_byte(wc * 32 + fr, fq * 8);
#define PG8_SA(b, h) (((b) * 2 + (h)) * HTB)
#define PG8_SB(b, h) ((4 + (b) * 2 + (h)) * HTB)
#define PG8_STAGE(bufoff, gbase, voff) do { _Pragma("unroll") for (int _i = 0; _i < 2; ++_i) \
        __builtin_amdgcn_global_load_lds((const unsigned*)((const char*)(gbase) + (voff)[_i]), (FK_LAS unsigned*)(lds + (bufoff) + ldsw + _i * 8192), 16, 0, 0); } while (0)
#define PG8_STAGEA(bufoff, gbase, h) do { _Pragma("unroll") for (int _i = 0; _i < 2; ++_i) \
        __builtin_amdgcn_global_load_lds((const unsigned*)((const char*)(gbase) + voffA[2 * (h) + _i]), (FK_LAS unsigned*)(lds + (bufoff) + ldsw + _i * 8192), 16, 0, 0); } while (0)
#define PG8_LDA(dst, b, h) do { _Pragma("unroll") for (int m = 0; m < 4; ++m) _Pragma("unroll") for (int k = 0; k < 2; ++k) dst[m][k] = *(const FK_LAS bf16x8*)(lds + PG8_SA(b, h) + aoff + m * 2048 + k * 1024); } while (0)
#define PG8_LDB(dst, b, h) do { _Pragma("unroll") for (int n = 0; n < 2; ++n) _Pragma("unroll") for (int k = 0; k < 2; ++k) dst[n][k] = *(const FK_LAS bf16x8*)(lds + PG8_SB(b, h) + boff + n * 2048 + k * 1024); } while (0)
#define PG8_MMA(ai, bj, At, Bt) do { __builtin_amdgcn_s_setprio(1); _Pragma("unroll") for (int m = 0; m < 4; ++m) _Pragma("unroll") for (int n = 0; n < 2; ++n) _Pragma("unroll") for (int k = 0; k < 2; ++k) \
        acc[ai][bj][m][n] = __builtin_amdgcn_mfma_f32_16x16x32_bf16(Bt[n][k], At[m][k], acc[ai][bj][m][n], 0, 0, 0); __builtin_amdgcn_s_setprio(0); } while (0)
#define PG8_WAIT_V(n) asm volatile("s_waitcnt vmcnt(" #n ")" ::: "memory")
#define PG8_WAIT_L(n) asm volatile("s_waitcnt lgkmcnt(" #n ")" ::: "memory")
#define PG8_BAR __builtin_amdgcn_s_barrier()
#define PG8_SCHED __builtin_amdgcn_sched_barrier(0)
    Unit cur, nxt; int ui = 0;
    if (!S.next(0, cur)) return;
    if constexpr (!KEEP_ACC) {
#pragma unroll
        for (int a = 0; a < 2; ++a)
#pragma unroll
            for (int b = 0; b < 2; ++b)
#pragma unroll
                for (int m = 0; m < 4; ++m)
#pragma unroll
                    for (int n = 0; n < 2; ++n) acc[a][b][m][n] = (f32x4){0.f, 0.f, 0.f, 0.f};
    }
    bf16x8 At[4][2], B0[2][2], B1[2][2];
    unsigned voffA[4];
#pragma unroll
    for (int q = 0; q < 4; ++q) voffA[q] = S.row_off(cur, R0 + 64 * q) + (unsigned)C0 * 2u;
    const char* Ab = g.baseA;
    const char* cB = g.baseB + cur.b_off;
    if constexpr (SP2) {
        PG8_STAGE(PG8_SB(0, 0), cB, voffB); PG8_STAGE(PG8_SB(0, 1), cB + hstepB, voffB); PG8_STAGEA(PG8_SA(0, 0), Ab, 0); PG8_STAGEA(PG8_SA(0, 1), Ab, 1);
        if (wr == 1) PG8_BAR;
        PG8_WAIT_V(2); PG8_BAR;
        PG8_STAGE(PG8_SB(1, 0), cB + kstep, voffB); PG8_STAGEA(PG8_SA(1, 0), Ab + kstep, 0); PG8_STAGE(PG8_SB(1, 1), cB + hstepB + kstep, voffB);
        PG8_WAIT_V(6); PG8_BAR;
    } else {
        PG8_STAGE(PG8_SB(0, 0), cB, voffB); PG8_STAGEA(PG8_SA(0, 0), Ab, 0); PG8_STAGE(PG8_SB(0, 1), cB + hstepB, voffB); PG8_STAGEA(PG8_SA(0, 1), Ab, 1);
        if (wr == 1) PG8_BAR;
        PG8_WAIT_V(4); PG8_BAR;
        PG8_STAGE(PG8_SB(1, 0), cB + kstep, voffB); PG8_STAGEA(PG8_SA(1, 0), Ab + kstep, 0); PG8_STAGE(PG8_SB(1, 1), cB + hstepB + kstep, voffB);
        PG8_WAIT_V(6); PG8_BAR;
    }
    for (;;) {
        const bool has_next = S.next(ui + 1, nxt);
        const char* nB = has_next ? g.baseB + nxt.b_off : cB;
        for (int t = 0; t < nt; t += 2) {
            const bool last = (t == nt - 2);
            const char* a1 = Ab + (size_t)(t + 1) * kstep;
            const char* a2 = last ? Ab : Ab + (size_t)(t + 2) * kstep; const char* b2 = last ? nB : cB + (size_t)(t + 2) * kstep;
            const char* a3 = a2 + kstep; const char* b3 = b2 + kstep;
            if constexpr (SP2) {
            PG8_LDB(B0, 0, 0); PG8_LDB(B1, 0, 1); PG8_SCHED; PG8_LDA(At, 0, 0); PG8_STAGEA(PG8_SA(1, 1), a1, 1);
            if (last && has_next) {
#pragma unroll
                for (int q = 0; q < 4; ++q) voffA[q] = S.row_off(nxt, R0 + 64 * q) + (unsigned)C0 * 2u;
            }
            PG8_WAIT_V(8); PG8_WAIT_L(0); PG8_BAR; PG8_MMA(0, 0, At, B0); PG8_MMA(0, 1, At, B1); PG8_BAR; PG8_SCHED;
            PG8_LDA(At, 0, 1); PG8_STAGE(PG8_SB(0, 0), b2, voffB); PG8_STAGE(PG8_SB(0, 1), b2 + hstepB, voffB); PG8_STAGEA(PG8_SA(0, 0), a2, 0);
            PG8_WAIT_V(8); PG8_WAIT_L(0); PG8_BAR; PG8_MMA(1, 0, At, B0); PG8_MMA(1, 1, At, B1); PG8_BAR; PG8_SCHED;
            PG8_LDB(B0, 1, 0); PG8_LDB(B1, 1, 1); PG8_SCHED; PG8_LDA(At, 1, 0); PG8_STAGEA(PG8_SA(0, 1), a2, 1);
            PG8_WAIT_V(8); PG8_WAIT_L(0); PG8_BAR; PG8_MMA(0, 0, At, B0); PG8_MMA(0, 1, At, B1); PG8_BAR; PG8_SCHED;
            PG8_LDA(At, 1, 1); PG8_STAGE(PG8_SB(1, 0), b3, voffB); PG8_STAGE(PG8_SB(1, 1), b3 + hstepB, voffB); PG8_STAGEA(PG8_SA(1, 0), a3, 0);
            PG8_WAIT_V(8); PG8_WAIT_L(0); PG8_BAR; PG8_MMA(1, 0, At, B0); PG8_MMA(1, 1, At, B1); PG8_BAR; PG8_SCHED;
            } else {
            PG8_LDB(B0, 0, 0); PG8_SCHED; PG8_LDA(At, 0, 0); PG8_STAGEA(PG8_SA(1, 1), a1, 1);
            if (last && has_next) {
#pragma unroll
                for (int q = 0; q < 4; ++q) voffA[q] = S.row_off(nxt, R0 + 64 * q) + (unsigned)C0 * 2u;
            }
            PG8_WAIT_L(8); PG8_BAR; PG8_WAIT_L(0); PG8_MMA(0, 0, At, B0); PG8_BAR; PG8_SCHED;
            PG8_LDB(B1, 0, 1); PG8_STAGE(PG8_SB(0, 0), b2, voffB);
            PG8_BAR; PG8_WAIT_L(0); PG8_MMA(0, 1, At, B1); PG8_BAR;
            PG8_LDA(At, 0, 1); PG8_STAGEA(PG8_SA(0, 0), a2, 0);
            PG8_BAR; PG8_WAIT_L(0); PG8_MMA(1, 0, At, B0); PG8_BAR; PG8_SCHED;
            PG8_STAGE(PG8_SB(0, 1), b2 + hstepB, voffB);
            PG8_WAIT_V(6); PG8_BAR; PG8_MMA(1, 1, At, B1); PG8_BAR;
            PG8_LDB(B0, 1, 0); PG8_SCHED; PG8_LDA(At, 1, 0); PG8_STAGEA(PG8_SA(0, 1), a2, 1);
            PG8_WAIT_L(8); PG8_BAR; PG8_WAIT_L(0); PG8_MMA(0, 0, At, B0); PG8_BAR; PG8_SCHED;
            PG8_LDB(B1, 1, 1); PG8_STAGE(PG8_SB(1, 0), b3, voffB);
            PG8_BAR; PG8_WAIT_L(0); PG8_MMA(0, 1, At, B1); PG8_BAR;
            PG8_LDA(At, 1, 1); PG8_STAGEA(PG8_SA(1, 0), a3, 0);
            PG8_BAR; PG8_WAIT_L(0); PG8_MMA(1, 0, At, B0); PG8_BAR; PG8_SCHED;
            PG8_STAGE(PG8_SB(1, 1), b3 + hstepB, voffB);
            PG8_WAIT_V(6); PG8_BAR; PG8_MMA(1, 1, At, B1); PG8_BAR;
            }
        }
        if constexpr (ALIGN_EPI) { if (wr == 0) PG8_BAR; }
        if constexpr (!Epi::AFTER_DRAIN) { int fr_e = fr, fq_e = fq, lane_e = lane; asm volatile("" : "+v"(fr_e), "+v"(fq_e), "+v"(lane_e)); E(acc, cur, wr, wc, fr_e, fq_e, lds, wid, lane_e); }
        if (!has_next) break;
#pragma unroll
        for (int a = 0; a < 2; ++a)
#pragma unroll
            for (int b = 0; b < 2; ++b)
#pragma unroll
                for (int m = 0; m < 4; ++m)
#pragma unroll
                    for (int n = 0; n < 2; ++n) acc[a][b][m][n] = (f32x4){0.f, 0.f, 0.f, 0.f};
        cur = nxt; cB = nB; ++ui;
        if constexpr (ALIGN_EPI) { if (wr == 1) PG8_BAR; }
    }
    PG8_WAIT_V(0);
    if constexpr (!ALIGN_EPI) { if (wr == 0) PG8_BAR; }
    PG8_BAR;
    if constexpr (Epi::AFTER_DRAIN) { int fr_e = fr, fq_e = fq, lane_e = lane; asm volatile("" : "+v"(fr_e), "+v"(fq_e), "+v"(lane_e)); E(acc, cur, wr, wc, fr_e, fq_e, lds, wid, lane_e); }
#undef PG8_SA
#undef PG8_SB
#undef PG8_STAGE
#undef PG8_STAGEA
#undef PG8_LDA
#undef PG8_LDB
#undef PG8_MMA
#undef PG8_WAIT_V
#undef PG8_WAIT_L
#undef PG8_BAR
#undef PG8_SCHED
}
}
namespace attn_body {
using bf16=__hip_bfloat16;
using bf16x8=__attribute__((ext_vector_type(8)))short;
using s16x4=__attribute__((ext_vector_type(4)))short;
using f32x16=__attribute__((ext_vector_type(16)))float;
using u32x4=__attribute__((ext_vector_type(4)))unsigned;
constexpr int BATCH=8,NHEAD=8,SEQ=2048,D=64,QP=512,KP=128,OP=1024;
constexpr int NW=8,QBLK=32,QB=QBLK*NW,KVBLK=64,NQB=SEQ/QB;
constexpr int ATTN_UNIT_ROWS=QB;
__device__ __forceinline__ int crow(int r,int hi){return (r&3)+8*(r>>2)+4*hi;}
#define SBAR() __builtin_amdgcn_sched_barrier(0)
__device__ __forceinline__ void cmask(f32x16&p0,f32x16&p1,int jb,int qrel,int hi){
  const float NEG=-INFINITY; int kb=64*jb+4*hi;
  #pragma unroll
  for(int r=0;r<16;++r){int kv=kb+(r&3)+8*(r>>2); if(kv>qrel)p0[r]=NEG; if(kv+32>qrel)p1[r]=NEG;}
}

constexpr int NSLOT=3, SLOTB=8192;
constexpr int LDS_K=0, LDS_V=NSLOT*SLOTB, LDS_WS=2*NSLOT*SLOTB, LDS_OST=LDS_WS+NW*64*4, LDS_BYTES=LDS_OST+NW*4096;
constexpr float C2=0.125f*1.4426950408889634f;
__device__ __forceinline__ void glds16(const void*gsrc,unsigned lds_dst){unsigned keep;
  asm volatile("s_mov_b32 %0, m0\n\ts_mov_b32 m0, %2\n\ts_nop 0\n\tglobal_load_lds_dwordx4 %1, off\n\ts_mov_b32 m0, %0":"=&s"(keep):"v"(gsrc),"s"(lds_dst):"memory");}
__device__ __forceinline__ float max3f(float a,float b,float c){float r;asm("v_max3_f32 %0, %1, %2, %3":"=v"(r):"v"(a),"v"(b),"v"(c));return r;}
__device__ __forceinline__ float max2f(float a,float b){float r;asm("v_max_f32_e32 %0, %1, %2":"=v"(r):"v"(a),"v"(b));return r;}
__device__ __forceinline__ float fadd_s(float a,float b){float r;asm("v_add_f32_e32 %0, %1, %2":"=v"(r):"v"(a),"v"(b));return r;}
__device__ __forceinline__ float fsub_s(float a,float b){float r;asm("v_sub_f32_e32 %0, %1, %2":"=v"(r):"v"(a),"v"(b));return r;}
typedef float f32x2_t __attribute__((ext_vector_type(2))); typedef __bf16 bf16x2_t __attribute__((ext_vector_type(2)));
__device__ __forceinline__ unsigned cvtpk_s(float lo,float hi){f32x2_t v={lo,hi};bf16x2_t b=__builtin_convertvector(v,bf16x2_t);return __builtin_bit_cast(unsigned,b);}
#define WAIT_BAR(N) asm volatile("s_waitcnt vmcnt(" #N ") lgkmcnt(0)\n\ts_barrier":::"memory")

__device__ __forceinline__ void qkt(f32x16&p0,f32x16&p1,const char*Kslot,const bf16x8*qr,const f32x16&negm,int r32,int hi){
  const char*kb=Kslot+hi*1024+r32*16;
  #pragma unroll
  for(int d0=0;d0<4;++d0){
    const bf16x8 b0=*reinterpret_cast<const bf16x8*>(kb+d0*2048);
    const bf16x8 b1=*reinterpret_cast<const bf16x8*>(kb+d0*2048+512);
    if(d0==0){p0=__builtin_amdgcn_mfma_f32_32x32x16_bf16(b0,qr[0],negm,0,0,0);p1=__builtin_amdgcn_mfma_f32_32x32x16_bf16(b1,qr[0],negm,0,0,0);}
    else{p0=__builtin_amdgcn_mfma_f32_32x32x16_bf16(b0,qr[d0],p0,0,0,0);p1=__builtin_amdgcn_mfma_f32_32x32x16_bf16(b1,qr[d0],p1,0,0,0);}}
}
typedef __attribute__((address_space(3))) const char* lds_cptr;
typedef short v4i16_t __attribute__((ext_vector_type(4)));
__device__ __forceinline__ void kload8(bf16x8*kf,lds_cptr kp){
  kf[0]=*(const __attribute__((address_space(3))) bf16x8*)(kp);      kf[1]=*(const __attribute__((address_space(3))) bf16x8*)(kp+512);
  kf[2]=*(const __attribute__((address_space(3))) bf16x8*)(kp+2048); kf[3]=*(const __attribute__((address_space(3))) bf16x8*)(kp+2560);
  kf[4]=*(const __attribute__((address_space(3))) bf16x8*)(kp+4096); kf[5]=*(const __attribute__((address_space(3))) bf16x8*)(kp+4608);
  kf[6]=*(const __attribute__((address_space(3))) bf16x8*)(kp+6144); kf[7]=*(const __attribute__((address_space(3))) bf16x8*)(kp+6656);
}
__device__ __forceinline__ void kload2(bf16x8*kf,lds_cptr kp,int j){ kf[2*j]=*(const __attribute__((address_space(3))) bf16x8*)(kp+j*2048); kf[2*j+1]=*(const __attribute__((address_space(3))) bf16x8*)(kp+j*2048+512); }
__device__ __forceinline__ s16x4 vtr(lds_cptr p){ return __builtin_bit_cast(s16x4,__builtin_amdgcn_ds_read_tr16_b64_v4i16((__attribute__((address_space(3))) v4i16_t*)p)); }
__device__ __forceinline__ float rowmax(const f32x16&p0,const f32x16&p1){
  float a=max3f(p0[0],p0[1],p1[0]),b=max3f(p0[2],p0[3],p1[1]);a=max3f(a,p1[2],p1[3]);
  #pragma unroll
  for(int r=4;r<16;r+=4){a=max3f(a,p0[r],p0[r+1]);b=max3f(b,p0[r+2],p0[r+3]);a=max3f(a,p1[r],p1[r+1]);b=max3f(b,p1[r+2],p1[r+3]);}
  const float m=max2f(a,b);
  auto rr=__builtin_amdgcn_permlane32_swap(__float_as_uint(m),__float_as_uint(m),false,false);
  return max2f(__uint_as_float(rr[0]),__uint_as_float(rr[1]));
}
__device__ __forceinline__ void pv(f32x16*o,int vb,bf16x8 pa0,bf16x8 pa1,bf16x8 pa2,bf16x8 pa3){
  #pragma unroll
  for(int d0=0;d0<2;++d0){s16x4 lo[4],hi[4];
    #pragma unroll
    for(int ks=0;ks<4;++ks){
      asm volatile("ds_read_b64_tr_b16 %0,%1 offset:%c2":"=&v"(lo[ks]):"v"(vb),"i"(d0*4096+ks*1024):"memory");
      asm volatile("ds_read_b64_tr_b16 %0,%1 offset:%c2":"=&v"(hi[ks]):"v"(vb),"i"(d0*4096+ks*1024+512):"memory");}
    asm volatile("s_waitcnt lgkmcnt(0)":::"memory");SBAR();
    #define PK(k) (bf16x8){lo[k][0],lo[k][1],lo[k][2],lo[k][3],hi[k][0],hi[k][1],hi[k][2],hi[k][3]}
    o[d0]=__builtin_amdgcn_mfma_f32_32x32x16_bf16(pa0,PK(0),o[d0],0,0,0);
    o[d0]=__builtin_amdgcn_mfma_f32_32x32x16_bf16(pa1,PK(1),o[d0],0,0,0);
    o[d0]=__builtin_amdgcn_mfma_f32_32x32x16_bf16(pa2,PK(2),o[d0],0,0,0);
    o[d0]=__builtin_amdgcn_mfma_f32_32x32x16_bf16(pa3,PK(3),o[d0],0,0,0);
    #undef PK
  }
}

#ifndef ATTN_STORE16
#define ATTN_STORE16(p,v) (*(u32x4*)(p)=(v))
#endif
template<int THRL> __device__ __forceinline__ void attn_unit(int b,int h,int qb,const bf16*Q,const bf16*__restrict__ K,const bf16*__restrict__ V,bf16*O,float*SS,char*shm){
  const int tid=threadIdx.x,lane=tid&63,r32=lane&31,hi=lane>>5; const int wid=__builtin_amdgcn_readfirstlane(tid>>6);
  const long rowbase=(long)b*SEQ; const int q0=qb*QB;
  const bf16*Qw=Q+(rowbase+q0+wid*QBLK)*QP+h*D;
  const bf16*Kh=K+rowbase*KP+(h>>2)*D,*Vh=V+rowbase*KP+(h>>2)*D;
  const unsigned lds0=(unsigned)(uintptr_t)shm;
  float*wsf=(float*)(shm+LDS_WS)+wid*64;
  const bf16*ksrc=Kh+(long)lane*KP+wid*8;
  const bf16*vsrc=Vh+(long)(16*(wid&3)+(lane>>2))*KP+(wid>>2)*32+(lane&3)*8;
  const unsigned kdst=lds0+LDS_K+wid*1024, vdst=lds0+LDS_V+wid*1024;
  #define DMA_K(t,slot) glds16(ksrc+(long)(t)*KVBLK*KP,(unsigned)__builtin_amdgcn_readfirstlane(kdst+(slot)))
  #define DMA_V(t,slot) glds16(vsrc+(long)(t)*KVBLK*KP,(unsigned)__builtin_amdgcn_readfirstlane(vdst+(slot)))
  const int vb0=(int)(lds0+LDS_V)+((lane>>4)&1)*32+(lane&3)*8+(4*hi+((lane&15)>>2))*64;
  const char*Kbase=shm+LDS_K; bf16x8 kf[8];
  const lds_cptr shm3=(lds_cptr)shm; const lds_cptr kp0=shm3+LDS_K+hi*1024+r32*16; const lds_cptr vp0=shm3+LDS_V+((lane>>4)&1)*32+(lane&3)*8+(4*hi+((lane&15)>>2))*64;
  const int NT=SEQ/KVBLK;
  DMA_K(0,0);DMA_V(0,0);DMA_K(1,SLOTB);
  bf16x8 qr[4];
  #pragma unroll
  for(int d0=0;d0<4;++d0)qr[d0]=*reinterpret_cast<const bf16x8*>(&Qw[(long)r32*QP+d0*16+hi*8]);
  float mhat=0.f,l_reg=0.f;f32x16 o[2];o[0]=f32x16{};o[1]=f32x16{};f32x16 negm=f32x16{};asm volatile("":"+v"(negm));
  const int qrel=wid*QBLK+r32;
  #define CMASK(P0,P1,t) do{}while(0)
  bool resc=false;
  #define START(P0,P1) do{ const float rm=rowmax(P0,P1); resc=false; \
    { const float dl=rm; mhat=fadd_s(mhat,dl); \
      _Pragma("unroll") for(int r=0;r<16;++r){P0[r]=fsub_s(P0[r],dl);P1[r]=fsub_s(P1[r],dl);} \
      _Pragma("unroll") for(int r=0;r<16;++r)negm[r]=-mhat; asm volatile("":"+v"(negm)); } \
    _Pragma("unroll") for(int r=0;r<16;++r)P0[r]=__builtin_amdgcn_exp2f(P0[r]); }while(0)
  #define RESC() do{ if(resc){ asm volatile("s_waitcnt lgkmcnt(0)":::"memory"); \
      _Pragma("unroll") for(int d_=0;d_<2;++d_) _Pragma("unroll") for(int r=0;r<16;++r)o[d_][r]*=wsf[crow(r,hi)]; } }while(0)
  f32x16 pA0,pA1,pB0,pB1;
  int sl_prev=0,sl_cur=0,sl_next=SLOTB;
  #define ROT() do{sl_prev=sl_cur;sl_cur=sl_next;sl_next=(sl_next==(NSLOT-1)*SLOTB)?0:sl_next+SLOTB;}while(0)
  DMA_K(2,2*SLOTB);
  WAIT_BAR(3);
  qkt(pA0,pA1,Kbase,qr,negm,r32,hi);asm volatile("s_nop 15\n\ts_nop 7":"+v"(pA0),"+v"(pA1));CMASK(pA0,pA1,0);
  START(pA0,pA1);
  _Pragma("unroll") for(int r=0;r<16;++r)pA1[r]=__builtin_amdgcn_exp2f(pA1[r]);
  WAIT_BAR(0);
  DMA_K(3,0);DMA_V(1,SLOTB);
  ROT();
  kload8(kf,kp0+sl_cur);
  WAIT_BAR(2);
  s16x4 vlo[8],vhi[8]; u32x4 pw0,pw1,pw2,pw3;
  #define PKW(P,B) cvtpk_s(P[B],P[B+1])
  #define PAF(k) __builtin_bit_cast(bf16x8,pw##k)
  #define VFR(i) (bf16x8){vlo[i][0],vlo[i][1],vlo[i][2],vlo[i][3],vhi[i][0],vhi[i][1],vhi[i][2],vhi[i][3]}
  #define PIN(x) asm volatile("":"+v"(x))
  #define MX3(a,b,c) __builtin_fmaxf(__builtin_fmaxf((a),(b)),(c))
  #define GAPA(MF,A0,A1,A2,A3,W0,W1,PW) do{ MF; sacc+=A0; sacc+=A1; sacc+=A2; sacc+=A3; PIN(sacc); W0; W1; PIN(PW); SBAR(); }while(0)
  #define EX(v) __builtin_amdgcn_exp2f(v)
  #define GAPB(MF,X,B) do{ MF; X[B]=EX(X[B]); X[B+1]=EX(X[B+1]); X[B+2]=EX(X[B+2]); X[B+3]=EX(X[B+3]); PIN(X); SBAR(); }while(0)
  #define VRD(i) do{ vlo[i]=vtr(vp_+(((i)>>2)*4096+((i)&3)*1024)); vhi[i]=vtr(vp_+(((i)>>2)*4096+((i)&3)*1024+512)); }while(0)
  #define KRD(G,j) do{ if(G){ kload2(kf,kp0+sl_next,j); SBAR(); } }while(0)
  #define STEP(C0,C1,P0,P1,t,GK,GV,GL) do{ SBAR(); \
    const lds_cptr vp_=vp0+sl_prev; \
    VRD(0); SBAR(); float sacc=(P0[0]+P0[1]); \
    GAPA(C0=__builtin_amdgcn_mfma_f32_32x32x16_bf16(kf[0],qr[0],negm,0,0,0), P0[2],P0[3],P0[4],P0[5],     pw0[0]=PKW(P0,0), pw0[1]=PKW(P0,2), pw0); \
    VRD(4); SBAR(); GAPA(C1=__builtin_amdgcn_mfma_f32_32x32x16_bf16(kf[1],qr[0],negm,0,0,0), P0[6],P0[7],P0[8],P0[9],     pw0[2]=PKW(P0,4), pw0[3]=PKW(P0,6), pw0); \
    VRD(1); SBAR(); GAPA(C0=__builtin_amdgcn_mfma_f32_32x32x16_bf16(kf[2],qr[1],C0,0,0,0),   P0[10],P0[11],P0[12],P0[13], pw1[0]=PKW(P0,8), pw1[1]=PKW(P0,10), pw1); \
    VRD(5); SBAR(); GAPA(C1=__builtin_amdgcn_mfma_f32_32x32x16_bf16(kf[3],qr[1],C1,0,0,0),   P0[14],P0[15],P1[0],P1[1],   pw1[2]=PKW(P0,12),pw1[3]=PKW(P0,14), pw1); \
    VRD(2); SBAR(); GAPA(C0=__builtin_amdgcn_mfma_f32_32x32x16_bf16(kf[4],qr[2],C0,0,0,0),   P1[2],P1[3],P1[4],P1[5],     pw2[0]=PKW(P1,0), pw2[1]=PKW(P1,2), pw2); \
    VRD(6); SBAR(); GAPA(C1=__builtin_amdgcn_mfma_f32_32x32x16_bf16(kf[5],qr[2],C1,0,0,0),   P1[6],P1[7],P1[8],P1[9],     pw2[2]=PKW(P1,4), pw2[3]=PKW(P1,6), pw2); \
    VRD(3); SBAR(); GAPA(C0=__builtin_amdgcn_mfma_f32_32x32x16_bf16(kf[6],qr[3],C0,0,0,0),   P1[10],P1[11],P1[12],P1[13], pw3[0]=PKW(P1,8), pw3[1]=PKW(P1,10), pw3); \
    VRD(7); SBAR(); GAPA(C1=__builtin_amdgcn_mfma_f32_32x32x16_bf16(kf[7],qr[3],C1,0,0,0),   P1[14],P1[15],0.f,0.f,       pw3[2]=PKW(P1,12),pw3[3]=PKW(P1,14), pw3); \
    l_reg+=sacc; \
    if(GK){DMA_K((t)+3,sl_cur);} if(GV){DMA_V((t)+1,sl_next);} \
    CMASK(C0,C1,t); \
    { float a=MX3(C0[0],C0[1],C1[0]),b=MX3(C0[2],C0[3],C1[1]); a=MX3(a,C1[2],C1[3]); \
      _Pragma("unroll") for(int r=4;r<16;r+=4){a=MX3(a,C0[r],C0[r+1]);b=MX3(b,C0[r+2],C0[r+3]);a=MX3(a,C1[r],C1[r+1]);b=MX3(b,C1[r+2],C1[r+3]);} \
      float rm=__builtin_fmaxf(a,b); { auto rr=__builtin_amdgcn_permlane32_swap(__float_as_uint(rm),__float_as_uint(rm),false,false); rm=__builtin_fmaxf(__uint_as_float(rr[0]),__uint_as_float(rr[1])); } \
      resc=false; \
      if(__builtin_expect(__any(rm>(float)THRL),0)){ const float dl=__builtin_fmaxf(rm,0.f); mhat+=dl; \
        _Pragma("unroll") for(int r=0;r<16;++r){C0[r]-=dl;C1[r]-=dl;} \
        _Pragma("unroll") for(int r=0;r<16;++r)negm[r]=-mhat; asm volatile("":"+v"(negm)); \
        const float f=__builtin_amdgcn_exp2f(-dl); l_reg*=f; if(hi==0)wsf[r32]=f; resc=true; } } \
    SBAR(); \
    GAPB(o[0]=__builtin_amdgcn_mfma_f32_32x32x16_bf16(PAF(0),VFR(0),o[0],0,0,0), C0,0); \
    GAPB(o[1]=__builtin_amdgcn_mfma_f32_32x32x16_bf16(PAF(0),VFR(4),o[1],0,0,0), C0,4); \
    KRD(GL,0); GAPB(o[0]=__builtin_amdgcn_mfma_f32_32x32x16_bf16(PAF(1),VFR(1),o[0],0,0,0), C0,8); \
    KRD(GL,1); GAPB(o[1]=__builtin_amdgcn_mfma_f32_32x32x16_bf16(PAF(1),VFR(5),o[1],0,0,0), C0,12); \
    KRD(GL,2); GAPB(o[0]=__builtin_amdgcn_mfma_f32_32x32x16_bf16(PAF(2),VFR(2),o[0],0,0,0), C1,0); \
    KRD(GL,3); GAPB(o[1]=__builtin_amdgcn_mfma_f32_32x32x16_bf16(PAF(2),VFR(6),o[1],0,0,0), C1,4); \
    GAPB(o[0]=__builtin_amdgcn_mfma_f32_32x32x16_bf16(PAF(3),VFR(3),o[0],0,0,0), C1,8); \
    GAPB(o[1]=__builtin_amdgcn_mfma_f32_32x32x16_bf16(PAF(3),VFR(7),o[1],0,0,0), C1,12); \
    }while(0)
  int t=1;
  #undef CMASK
  #define CMASK(P0,P1,t) do{}while(0)
  for(;t+5<NT;t+=2){
    STEP(pB0,pB1,pA0,pA1,t,true,true,true);     WAIT_BAR(2); RESC(); ROT();
    STEP(pA0,pA1,pB0,pB1,t+1,true,true,true);   WAIT_BAR(2); RESC(); ROT();
  }
  #undef CMASK
  #define CMASK(P0,P1,t) do{}while(0)
  #define ENDW(tt) do{ if((tt)+3<NT){WAIT_BAR(2);} else if((tt)+2<NT){WAIT_BAR(1);} else {WAIT_BAR(0);} }while(0)
  for(;t+1<NT;t+=2){
    STEP(pB0,pB1,pA0,pA1,t,(t+3<NT),(t+1<NT),(t+1<NT));       ENDW(t);   RESC(); ROT();
    STEP(pA0,pA1,pB0,pB1,t+1,(t+4<NT),(t+2<NT),(t+2<NT));     ENDW(t+1); RESC(); ROT();
  }
  STEP(pB0,pB1,pA0,pA1,NT-1,false,false,false); RESC();
  { float sacc=pB0[0]+pB0[1]; _Pragma("unroll") for(int r=2;r<16;++r)sacc+=pB0[r]; _Pragma("unroll") for(int r=0;r<16;++r)sacc+=pB1[r]; l_reg+=sacc;
    pw0=(u32x4){PKW(pB0,0),PKW(pB0,2),PKW(pB0,4),PKW(pB0,6)};pw1=(u32x4){PKW(pB0,8),PKW(pB0,10),PKW(pB0,12),PKW(pB0,14)};pw2=(u32x4){PKW(pB1,0),PKW(pB1,2),PKW(pB1,4),PKW(pB1,6)};pw3=(u32x4){PKW(pB1,8),PKW(pB1,10),PKW(pB1,12),PKW(pB1,14)};
    SBAR(); pv(o,vb0+sl_cur,PAF(0),PAF(1),PAF(2),PAF(3)); }
  #undef PKW
  #undef PAF
  #undef VFR
  #undef PIN
  #undef MX3
  #undef GAPA
  #undef GAPB
  #undef EX
  #undef VRD
  #undef KRD
  #undef STEP
  #undef ENDW
  {auto rr=__builtin_amdgcn_permlane32_swap(__float_as_uint(l_reg),__float_as_uint(l_reg),false,false);l_reg=__uint_as_float(rr[0])+__uint_as_float(rr[1]);}
  if(hi==0)wsf[32+r32]=l_reg;asm volatile("s_waitcnt lgkmcnt(0)":::"memory");
  float rli[16];
  #pragma unroll
  for(int r=0;r<16;++r)rli[r]=__builtin_amdgcn_rcpf(wsf[32+crow(r,hi)]);
  bf16*Ow=O+(rowbase+q0+wid*QBLK)*OP+h*D; float*SSw=SS+((rowbase+q0+wid*QBLK)*8+h);
  { bf16*stg=(bf16*)(shm+LDS_OST)+wid*2048;
    #pragma unroll
    for(int r=0;r<16;++r){const int orow=crow(r,hi);
      #pragma unroll
      for(int d0=0;d0<2;++d0)stg[orow*64+d0*32+r32]=__float2bfloat16(o[d0][r]*rli[r]);}
    asm volatile("s_waitcnt lgkmcnt(0)":::"memory");
    #pragma unroll
    for(int i=0;i<4;++i){const int row=i*8+(lane>>3),ch=lane&7; const u32x4 v=*(const u32x4*)(stg+row*64+ch*8); ATTN_STORE16(Ow+(long)row*OP+ch*8,v);
      float ss_=0.f; _Pragma("unroll") for(int e_=0;e_<4;++e_){const unsigned w_=v[e_]; const float a_=__uint_as_float(w_<<16),b_=__uint_as_float(w_&0xffff0000u); ss_+=a_*a_+b_*b_;}
      ss_+=__shfl_xor(ss_,1); ss_+=__shfl_xor(ss_,2); ss_+=__shfl_xor(ss_,4); if(ch==0)SSw[(long)row*8]=ss_;} }
  asm volatile("s_waitcnt lgkmcnt(0)\n\ts_barrier":::"memory");
  #undef DMA_K
  #undef DMA_V
  #undef CMASK
  #undef START
  #undef RESC
  #undef ROT
}
constexpr int ATTN_LDS_BYTES=LDS_BYTES;
template<int THRL=8> __device__ __forceinline__ void attn_phase(char*lds,const bf16*Q,const bf16*K,const bf16*V,bf16*O,float*SS,int G,int vcu){
  for(int uid=vcu;uid<512;uid+=G){ const int pair=uid>>5,b=pair>>1,h=(pair&1)*4+((uid>>3)&3),qb=uid&7; attn_unit<THRL>(b,h,qb,Q,K,V,O,SS,lds); }
}
#undef SBAR
#undef WAIT_BAR
}
typedef FK_GAS unsigned gu32;
#define LAS FK_LAS
#define XB_TMO      128
#define XB_XCNT(j)  (256  + 64 * (j))
#define XB_XSUB(j)  (1280 + 64 * (j))
#define XB_XGEN(j)  (2304 + 64 * (j))
#define XB_TOP      3328
#define XB_TOPGEN   3392
#define XCD_BAR_WORDS 3456
#define XB_SPIN_CAP (1u << 18)

__device__ __forceinline__ unsigned xb_ld(unsigned* p)              { return __hip_atomic_load(p, __ATOMIC_RELAXED, __HIP_MEMORY_SCOPE_AGENT); }
__device__ __forceinline__ unsigned xb_add(unsigned* p, unsigned v) { return __hip_atomic_fetch_add(p, v, __ATOMIC_RELAXED, __HIP_MEMORY_SCOPE_AGENT); }
__device__ __forceinline__ unsigned xb_xcc_id() { return (unsigned)__builtin_amdgcn_s_getreg((3 << 11) | 20) & 0xFu; }
#define XB_SPIN(cond, bar) do { unsigned _sp = 0; while (cond) { __builtin_amdgcn_s_sleep(1); \
    if ((++_sp & 255u) == 0u) { if (xb_ld(&(bar)[XB_TMO])) break; if (_sp > XB_SPIN_CAP) { atomicAdd(&(bar)[XB_TMO], 1u); break; } } } } while (0)

struct XcdBarrier {
    unsigned* bar; unsigned x;
    volatile LAS unsigned* st;
};

__device__ __forceinline__ XcdBarrier xcd_barrier_post(unsigned* bar, volatile LAS unsigned* st) {
    XcdBarrier b; b.bar = bar; b.x = xb_xcc_id(); b.st = st;
    if (threadIdx.x == 0) (void)xb_add(&bar[XB_XCNT(b.x)], 1u);
    return b;
}
__device__ __forceinline__ void xcd_barrier_complete(unsigned* bar, unsigned x, unsigned& nloc, unsigned& nx) {
    const unsigned G = gridDim.x * gridDim.y * gridDim.z;
    unsigned sum, cnt, mine, sp = 0u;
    for (;;) {
        sum = 0u; cnt = 0u; mine = 0u;
#pragma unroll
        for (unsigned j = 0; j < 16; ++j) { const unsigned c = xb_ld(&bar[XB_XCNT(j)]); sum += c; cnt += (c > 0u) ? 1u : 0u; mine = (j == x) ? c : mine; }
        if (sum == G) break;
        __builtin_amdgcn_s_sleep(1);
        if ((++sp & 255u) == 0u) { if (xb_ld(&bar[XB_TMO])) break; if (sp > XB_SPIN_CAP) { atomicAdd(&bar[XB_TMO], 1u); break; } }
    }
    nloc = mine > 0u ? mine : 1u; nx = cnt > 0u ? cnt : 1u;
}

__device__ __forceinline__ void xcd_barrier(const XcdBarrier& b) {
    asm volatile("s_waitcnt vmcnt(0)" ::: "memory");
    __syncthreads();
    if (threadIdx.x == 0) {
        unsigned* bar = b.bar;
        __builtin_amdgcn_s_waitcnt(0);
        unsigned nloc = b.st[0], nx = b.st[1];
        if (nloc == 0u) { xcd_barrier_complete(bar, b.x, nloc, nx); b.st[0] = nloc; b.st[1] = nx; }
        const unsigned old = xb_add(&bar[XB_XSUB(b.x)], 1u);
        const unsigned gen = old / nloc;
        if (old + 1u == (gen + 1u) * nloc) {
            __builtin_amdgcn_fence(__ATOMIC_RELEASE, "agent");
            asm volatile("s_waitcnt vmcnt(0)" ::: "memory");
            const unsigned og = xb_add(&bar[XB_TOP], 1u);
            const unsigned tg = og / nx;
            if (og + 1u == (tg + 1u) * nx) xb_add(&bar[XB_TOPGEN], 1u);
            else XB_SPIN(xb_ld(&bar[XB_TOPGEN]) == tg, bar);
            __builtin_amdgcn_fence(__ATOMIC_ACQUIRE, "agent");
            xb_add(&bar[XB_XGEN(b.x)], 1u);
            asm volatile("s_waitcnt vmcnt(0)" ::: "memory");
        } else {
            XB_SPIN(xb_ld(&bar[XB_XGEN(b.x)]) == gen, bar);
            __builtin_amdgcn_fence(__ATOMIC_ACQUIRE, "agent");
            asm volatile("s_waitcnt vmcnt(0)" ::: "memory");
        }
    }
    __syncthreads();
}
#undef LAS
struct Params {
    const float* in[34];
    float* out;
    unsigned char* ws;
    int ph_lo, ph_hi;
};
using pg8::Unit; using pg8::Gemm;

constexpr int TSCR = 64 * 65 * 4;
template <class RowMap>
__device__ __forceinline__ void transpose_item(const float* W, int K, int N, const float* gain, bf16_t* WT, const RowMap& rm, FK_LAS float* scr, int item, int lane) {
    const int nblk = N / 64, kb = item / nblk, nb = item % nblk, k0 = 64 * kb, n0 = 64 * nb;
    const int nq = (lane & 15) * 4;
#pragma unroll 8
    for (int i = 0; i < 16; ++i) { const int kk = 4 * i + (lane >> 4); const float gv = gain ? gain[k0 + kk] : 1.f;
        const f32x4 v = *(const f32x4*)(W + (size_t)(k0 + kk) * N + n0 + nq) * gv;
        FK_LAS float* d = scr + kk * 65 + nq; d[0] = v[0]; d[1] = v[1]; d[2] = v[2]; d[3] = v[3]; }
    asm volatile("s_waitcnt lgkmcnt(0)" ::: "memory");
    const int c = lane & 7;
#pragma unroll
    for (int j = 0; j < 8; ++j) { const int n = (lane >> 3) + 8 * j; const FK_LAS float* sp = scr + (8 * c) * 65 + n;
        u32x4 o; o.x = pk2(sp[0 * 65], sp[1 * 65]); o.y = pk2(sp[2 * 65], sp[3 * 65]); o.z = pk2(sp[4 * 65], sp[5 * 65]); o.w = pk2(sp[6 * 65], sp[7 * 65]);
        *(u32x4*)(WT + (size_t)rm(n0 + n) * K + k0 + 8 * c) = o; }
    asm volatile("s_waitcnt lgkmcnt(0)" ::: "memory");
}
struct RmId { __device__ __forceinline__ int operator()(int n) const { return n; } };
struct RmWin { __device__ __forceinline__ int operator()(int n) const { if (n >= 768) return n; const int head = n >> 6, dim = n & 63; return 256 * (head >> 2) + 128 * (dim >> 5) + 32 * (head & 3) + (dim & 31); } };
struct RmGU { int up; __device__ __forceinline__ int operator()(int n) const { return (n >> 7) * 256 + up * 128 + (n & 127); } };

__device__ __forceinline__ void row_to_bf16(const float* xrow, bf16_t* orow, float* rout, const float* gain, bool normalise, int lane) {
    const f32x4* xr = (const f32x4*)xrow + lane;
    f32x4 v[4]; float s = 0.f;
#pragma unroll
    for (int j = 0; j < 4; ++j) { v[j] = xr[64 * j]; s += (v[j].x * v[j].x + v[j].y * v[j].y) + (v[j].z * v[j].z + v[j].w * v[j].w); }
    const float r = rsqrtf(wsum(s) * (1.f / 1024.f) + EPS);
    if (rout && lane == 0) *rout = r;
    unsigned long long* o8 = (unsigned long long*)orow + lane;
#pragma unroll
    for (int j = 0; j < 4; ++j) {
        f32x4 w = v[j];
        if (normalise) { const f32x4 gv = ((const f32x4*)gain)[lane + 64 * j]; w = w * r * gv; }
        o8[64 * j] = (unsigned long long)pk2(w.x, w.y) | ((unsigned long long)pk2(w.z, w.w) << 32);
    }
}

__device__ __forceinline__ void s5_prep_part(const Params& p, int g, int q4, FK_LAS float* L, int tid) {
    const float* lam_re = p.in[6]; const float* lam_im = p.in[7]; const float* log_step = p.in[8];
    const float* b_re = p.in[9]; const float* b_im = p.in[10]; const float* c_re = p.in[11]; const float* c_im = p.in[12]; const float* dpar = p.in[13];
    FK_LAS float* LPr = L;
    FK_LAS float* LPi = LPr + 2 * 33 * 64;
    FK_LAS float* BBr = LPi + 2 * 33 * 64;
    FK_LAS float* BBi = BBr + 2 * 1024;
    FK_LAS float* CCr = BBi + 2 * 1024;
    FK_LAS float* CCi = CCr + 2 * 1024;
    FK_LAS float* KT = CCi + 2 * 1024;
    float gbr[4], gbi[4], gcr[4], gci[4];
#pragma unroll
    for (int u = 0; u < 4; ++u) { const int idx = tid + u * NTHREADS; const int dir = idx >> 10, pp = (idx >> 4) & 63, c = idx & 15, gp = (dir * 32 + g) * 64 + pp, cc = (idx >> 6) & 15, p2 = idx & 63;
        gbr[u] = b_re[(size_t)gp * 16 + c]; gbi[u] = b_im[(size_t)gp * 16 + c];
        gcr[u] = c_re[((size_t)(dir * 32 + g) * 16 + cc) * 64 + p2]; gci[u] = c_im[((size_t)(dir * 32 + g) * 16 + cc) * 64 + p2]; }
    float f_r, f_i;
    {
        const int qd = tid >> 2, r4 = tid & 3, dir = qd >> 6, pp = qd & 63, gp = (dir * 32 + g) * 64 + pp;
        const float lr = fminf(lam_re[gp], -1e-4f), li = lam_im[gp], dt = expf(log_step[dir * 32 + g]);
        const float mag = expf(lr * dt), ab_r = mag * cosf(li * dt), ab_i = mag * sinf(li * dt);
        const float den = lr * lr + li * li, nr = ab_r - 1.f;
        f_r = (nr * lr + ab_i * li) / den; f_i = (ab_i * lr - nr * li) / den;
        const float a2r = ab_r * ab_r - ab_i * ab_i, a2i = 2.f * ab_r * ab_i;
        const float a4r = a2r * a2r - a2i * a2i, a4i = 2.f * a2r * a2i;
        const float a3r = a2r * ab_r - a2i * ab_i, a3i = a2r * ab_i + a2i * ab_r;
        float pr = r4 == 0 ? 1.f : r4 == 1 ? ab_r : r4 == 2 ? a2r : a3r, pi = r4 == 0 ? 0.f : r4 == 1 ? ab_i : r4 == 2 ? a2i : a3i;
#pragma unroll
        for (int s8 = 0; s8 < 9; ++s8) { const int e = r4 + 4 * s8;
            if (e <= 32) { LPr[(dir * 33 + e) * 64 + pp] = pr; LPi[(dir * 33 + e) * 64 + pp] = pi; }
            const float nr2 = pr * a4r - pi * a4i, ni2 = pr * a4i + pi * a4r; pr = nr2; pi = ni2; }
        FK_LAS float* FF = KT + 4096;
        if (r4 == 0) { FF[qd * 2] = f_r; FF[qd * 2 + 1] = f_i; }
    }
    __syncthreads();
    {
        const FK_LAS float* FF = KT + 4096;
#pragma unroll
        for (int u = 0; u < 4; ++u) { const int idx = tid + u * NTHREADS; const int dir = idx >> 10, pp = (idx >> 4) & 63;
            const float fr = FF[(dir * 64 + pp) * 2], fi = FF[(dir * 64 + pp) * 2 + 1];
            BBr[idx] = fr * gbr[u] - fi * gbi[u]; BBi[idx] = fr * gbi[u] + fi * gbr[u]; CCr[idx] = gcr[u]; CCi[idx] = gci[u]; }
    }
    __syncthreads();
#pragma unroll 1
    for (int w2 = 0; w2 < 2; ++w2) {
        const int wi = tid + w2 * NTHREADS;
        const int dir = wi >> 9, tau = (wi >> 4) & 31, cl = (wi >> 2) & 3, c4 = (wi & 3) * 4, cc = 4 * q4 + cl;
        const FK_LAS float* cr = CCr + dir * 1024 + cc * 64; const FK_LAS float* ci = CCi + dir * 1024 + cc * 64;
        const FK_LAS float* lr = LPr + (dir * 33 + tau) * 64; const FK_LAS float* li = LPi + (dir * 33 + tau) * 64;
        const FK_LAS float* br = BBr + dir * 1024 + c4; const FK_LAS float* bi = BBi + dir * 1024 + c4;
        f32x4 acc = {0.f, 0.f, 0.f, 0.f};
#pragma unroll 4
        for (int pp = 0; pp < 64; pp += 4) {
            const f32x4 c4r = *(const FK_LAS f32x4*)(cr + pp), c4i = *(const FK_LAS f32x4*)(ci + pp), l4r = *(const FK_LAS f32x4*)(lr + pp), l4i = *(const FK_LAS f32x4*)(li + pp);
            const f32x4 tr = c4r * l4r - c4i * l4i, ti = c4r * l4i + c4i * l4r;
#pragma unroll
            for (int u = 0; u < 4; ++u) { const f32x4 b4r = *(const FK_LAS f32x4*)(br + (pp + u) * 16), b4i = *(const FK_LAS f32x4*)(bi + (pp + u) * 16); acc = acc + b4r * tr[u] - b4i * ti[u]; }
        }
        *(FK_LAS f32x4*)(KT + ((dir * 32 + tau) * 4 + cl) * 16 + c4) = acc;
    }
    __syncthreads();
    bf16_t* W1 = (bf16_t*)(p.ws + WS_W1) + (size_t)g * 256 * 512;
#pragma unroll 2
    for (int u = 0; u < 8; ++u) {
        const int ch = tid + u * NTHREADS;
        const int n = 64 * q4 + (ch >> 6), kk0 = (ch & 63) * 8, j = kk0 >> 4, c0 = kk0 & 15;
        const int dir = n >> 7, ri = (n >> 6) & 1, pp = n & 63, e = dir ? j : 31 - j;
        const float lr = LPr[(dir * 33 + e) * 64 + pp], li = LPi[(dir * 33 + e) * 64 + pp];
        const f32x4 br0 = *(const FK_LAS f32x4*)(BBr + dir * 1024 + pp * 16 + c0), br1 = *(const FK_LAS f32x4*)(BBr + dir * 1024 + pp * 16 + c0 + 4);
        const f32x4 bi0 = *(const FK_LAS f32x4*)(BBi + dir * 1024 + pp * 16 + c0), bi1 = *(const FK_LAS f32x4*)(BBi + dir * 1024 + pp * 16 + c0 + 4);
        const f32x4 v0 = ri ? (bi0 * lr + br0 * li) : (br0 * lr - bi0 * li), v1 = ri ? (bi1 * lr + br1 * li) : (br1 * lr - bi1 * li);
        u32x4 o; o.x = pk2(v0[0], v0[1]); o.y = pk2(v0[2], v0[3]); o.z = pk2(v1[0], v1[1]); o.w = pk2(v1[2], v1[3]);
        *(u32x4*)(W1 + (size_t)n * 512 + kk0) = o;
    }
    bf16_t* W2 = (bf16_t*)(p.ws + WS_W2) + (size_t)g * 512 * SUP;
#pragma unroll 2
    for (int u = 0; u < 24; ++u) {
        const int ch = tid + u * NTHREADS;
        const int rowi = (int)(((unsigned)ch * 43691u) >> 22), kk0 = (ch - rowi * 96) * 8, j = rowi >> 2, cl = rowi & 3, cc = 4 * q4 + cl, nn = j * 16 + cc;
        f32x4 v0, v1;
        if (kk0 < 256) {
            const int dir = kk0 >> 7, ri = (kk0 >> 6) & 1, p0 = kk0 & 63, e = dir ? 32 - j : j + 1;
            const FK_LAS float* cr = CCr + dir * 1024 + cc * 64 + p0; const FK_LAS float* ci = CCi + dir * 1024 + cc * 64 + p0;
            const FK_LAS float* lr = LPr + (dir * 33 + e) * 64 + p0; const FK_LAS float* li = LPi + (dir * 33 + e) * 64 + p0;
            const f32x4 cr0 = *(const FK_LAS f32x4*)cr, cr1 = *(const FK_LAS f32x4*)(cr + 4), ci0 = *(const FK_LAS f32x4*)ci, ci1 = *(const FK_LAS f32x4*)(ci + 4);
            const f32x4 lr0 = *(const FK_LAS f32x4*)lr, lr1 = *(const FK_LAS f32x4*)(lr + 4), li0 = *(const FK_LAS f32x4*)li, li1 = *(const FK_LAS f32x4*)(li + 4);
            v0 = ri ? -(cr0 * li0 + ci0 * lr0) : (cr0 * lr0 - ci0 * li0); v1 = ri ? -(cr1 * li1 + ci1 * lr1) : (cr1 * lr1 - ci1 * li1);
        } else {
            const int j2 = (kk0 - 256) >> 4, c0 = kk0 & 15;
            v0 = (f32x4){0.f, 0.f, 0.f, 0.f}; v1 = v0;
            if (j2 <= j) { const FK_LAS float* kp = KT + ((0 * 32 + (j - j2)) * 4 + cl) * 16 + c0; v0 = v0 + *(const FK_LAS f32x4*)kp; v1 = v1 + *(const FK_LAS f32x4*)(kp + 4); }
            if (j2 >= j) { const FK_LAS float* kp = KT + ((1 * 32 + (j2 - j)) * 4 + cl) * 16 + c0; v0 = v0 + *(const FK_LAS f32x4*)kp; v1 = v1 + *(const FK_LAS f32x4*)(kp + 4); }
            if (j2 == j && (cc >> 3) == (c0 >> 3)) { const float dv = dpar[g * 16 + cc]; const int q = cc & 7;
                v0[0] += q == 0 ? dv : 0.f; v0[1] += q == 1 ? dv : 0.f; v0[2] += q == 2 ? dv : 0.f; v0[3] += q == 3 ? dv : 0.f; v1[0] += q == 4 ? dv : 0.f; v1[1] += q == 5 ? dv : 0.f; v1[2] += q == 6 ? dv : 0.f; v1[3] += q == 7 ? dv : 0.f; }
        }
        u32x4 o; o.x = pk2(v0[0], v0[1]); o.y = pk2(v0[2], v0[3]); o.z = pk2(v1[0], v1[1]); o.w = pk2(v1[2], v1[3]);
        *(u32x4*)(W2 + (size_t)nn * SUP + kk0) = o;
    }
    __syncthreads();
}

constexpr int I_WIN = 16 * 20, I_GLU = 8 * 8, I_SQ = 16 * 16, I_GU = 16 * 8, I_DN = 8 * 16;
constexpr int NIT_A = I_WIN + 3 * I_SQ;
constexpr int NIT_B = I_GLU + I_SQ;
constexpr int NIT_C = 16 * (2 * I_GU + I_DN);
__device__ __forceinline__ void convert_A(const Params& p, FK_LAS float* scr, int lane, int w, int nw, int lo, int hi) {
    unsigned char* ws = p.ws;
    for (int it = lo + w; it < hi; it += nw) {
        int r = it;
        if (r < I_WIN) { transpose_item(p.in[3], 1024, 1280, p.in[2], (bf16_t*)(ws + WS_WIN), RmWin{}, scr, r, lane); continue; } r -= I_WIN;
        if (r < I_SQ) { transpose_item(p.in[22], 1024, 1024, nullptr, (bf16_t*)(ws + WS_WK), RmId{}, scr, r, lane); continue; } r -= I_SQ;
        if (r < I_SQ) { transpose_item(p.in[23], 1024, 1024, nullptr, (bf16_t*)(ws + WS_WV), RmId{}, scr, r, lane); continue; } r -= I_SQ;
        transpose_item(p.in[24], 1024, 1024, nullptr, (bf16_t*)(ws + WS_WO), RmId{}, scr, r, lane);
    }
}
__device__ __forceinline__ void convert_B(const Params& p, FK_LAS float* scr, int lane, int w, int nw, int lo, int hi) {
    unsigned char* ws = p.ws;
    for (int it = lo + w; it < hi; it += nw) {
        int r = it;
        if (r < I_GLU) { transpose_item(p.in[14], 512, 512, nullptr, (bf16_t*)(ws + WS_GLU), RmId{}, scr, r, lane); continue; } r -= I_GLU;
        if (r < I_SQ) {
            const int kb = r / 16; const float* gain = kb < 8 ? p.in[16] : p.in[17] - 512;
            transpose_item(p.in[18], 1024, 1024, gain, (bf16_t*)(ws + WS_WOUT), RmId{}, scr, r, lane); }
    }
}
__device__ __forceinline__ void convert_C(const Params& p, FK_LAS float* scr, int lane, int w, int nw, int lo, int hi) {
    unsigned char* ws = p.ws;
    for (int it = lo + w; it < hi; it += nw) {
        int r = it;
        const int e = r / (2 * I_GU + I_DN); r -= e * (2 * I_GU + I_DN);
        bf16_t* wgu = (bf16_t*)(ws + WS_WGU) + (size_t)e * 1024 * 1024;
        if (r < I_GU) { transpose_item(p.in[30] + (size_t)e * 1024 * 512, 1024, 512, p.in[25], wgu, RmGU{0}, scr, r, lane); continue; } r -= I_GU;
        if (r < I_GU) { transpose_item(p.in[31] + (size_t)e * 1024 * 512, 1024, 512, p.in[25], wgu, RmGU{1}, scr, r, lane); continue; } r -= I_GU;
        transpose_item(p.in[32] + (size_t)e * 512 * 1024, 512, 1024, nullptr, (bf16_t*)(ws + WS_WD) + (size_t)e * 1024 * 512, RmId{}, scr, r, lane);
    }
}
#define SIDE_WAVES(first_idle) const int sw_ = (bx - (first_idle)) * NWAVES + wave, snw_ = (G - (first_idle)) * NWAVES; FK_LAS float* sscr_ = (FK_LAS float*)(lds + wave * TSCR)

__device__ __forceinline__ void p0_prologue(const Params& p, FK_LAS unsigned char* lds, int vcu, int G, int tid, int lane, int wave, bool defer) {
    unsigned char* ws = p.ws;
    if (!defer) for (int it = vcu; it < 128; it += G) s5_prep_part(p, it >> 2, it & 3, (FK_LAS float*)lds, tid);
    if (vcu == (G > 1 ? 1 : 0)) {
        bf16_t* rwt = (bf16_t*)(ws + WS_RWT);
        for (int idx = tid; idx < 32 * 1024; idx += NTHREADS) {
            const int n = idx >> 10, k = idx & 1023;
            const float v = n < 4 ? p.in[25][k] * p.in[26][k * 4 + n] : n < 20 ? p.in[25][k] * p.in[28][k * 16 + (n - 4)] : 0.f;
            const unsigned h = f2bf(v); const float lo = v - bf2f((unsigned short)h);
            rwt[idx] = (bf16_t)h; rwt[32 * 1024 + idx] = (bf16_t)f2bf(lo);
        }
    }
    if (vcu == 0) {
        for (int idx = tid; idx < 1024; idx += NTHREADS) {
            const int pos = idx >> 4, i = idx & 15;
            const float ang = (float)pos * powf(10000.f, -(float)i / 16.f);
            ((f32x2*)(ws + WS_ROPE))[idx] = (f32x2){cosf(ang), sinf(ang)};
        }
    }
    FK_LAS float* scr = (FK_LAS float*)(lds + wave * TSCR);
    const int gw = vcu * NWAVES + wave, NGW = G * NWAVES;
    convert_A(p, scr, lane, gw, NGW, 0, NIT_A);
    if (!defer) { convert_B(p, scr, lane, gw, NGW, 0, NIT_B); convert_C(p, scr, lane, gw, NGW, 0, NIT_C); }
    for (int m = gw; m < T; m += 2 * NGW) {
        const int m2 = m + NGW;
        const f32x4* xa = (const f32x4*)(p.in[0] + (size_t)m * 1024) + lane; const f32x4* xb2 = (const f32x4*)(p.in[0] + (size_t)(m2 < T ? m2 : m) * 1024) + lane;
        f32x4 va[4], vb[4]; float sa = 0.f, sb = 0.f;
#pragma unroll
        for (int j = 0; j < 4; ++j) { va[j] = xa[64 * j]; vb[j] = xb2[64 * j]; }
#pragma unroll
        for (int j = 0; j < 4; ++j) { sa += (va[j].x * va[j].x + va[j].y * va[j].y) + (va[j].z * va[j].z + va[j].w * va[j].w); sb += (vb[j].x * vb[j].x + vb[j].y * vb[j].y) + (vb[j].z * vb[j].z + vb[j].w * vb[j].w); }
        sa = wsum(sa); sb = wsum(sb);
        unsigned long long* oa = (unsigned long long*)((bf16_t*)(ws + WS_XB) + (size_t)m * 1024) + lane;
#pragma unroll
        for (int j = 0; j < 4; ++j) oa[64 * j] = (unsigned long long)pk2(va[j].x, va[j].y) | ((unsigned long long)pk2(va[j].z, va[j].w) << 32);
        if (lane == 0) ((float*)(ws + WS_R0))[m] = rsqrtf(sa * (1.f / 1024.f) + EPS);
        if (m2 < T) {
            unsigned long long* ob = (unsigned long long*)((bf16_t*)(ws + WS_XB) + (size_t)m2 * 1024) + lane;
#pragma unroll
            for (int j = 0; j < 4; ++j) ob[64 * j] = (unsigned long long)pk2(vb[j].x, vb[j].y) | ((unsigned long long)pk2(vb[j].z, vb[j].w) << 32);
            if (lane == 0) ((float*)(ws + WS_R0))[m2] = rsqrtf(sb * (1.f / 1024.f) + EPS);
        }
    }
    for (int m = gw; m < 1024; m += NGW) {
        const f32x4* xr = (const f32x4*)(p.in[21] + (size_t)m * 1024) + lane; const float gk = p.in[19][m];
        unsigned long long* o8 = (unsigned long long*)((bf16_t*)(ws + WS_WQ) + (size_t)m * 1024) + lane;
#pragma unroll
        for (int j = 0; j < 4; ++j) { const f32x4 v = xr[64 * j] * gk; o8[64 * j] = (unsigned long long)pk2(v.x, v.y) | ((unsigned long long)pk2(v.z, v.w) << 32); }
    }
    for (int m = gw; m < MTOK; m += NGW) row_to_bf16(p.in[1] + (size_t)m * 1024, (bf16_t*)(ws + WS_HM) + (size_t)m * 1024, nullptr, p.in[20], true, lane);
}

struct SchedP1 {
    int G, c;
    __device__ __forceinline__ bool next(int i, Unit& u) const {
        const int L = i * G + c;
        int pm = 0, pn = 0, kind = 0; unsigned a_off = 0, b_off = 0;
        if (L < 320) {
            pg8::tile_order(L, 64, 5, pm, pn);
            a_off = (unsigned)(WS_XB + (size_t)pm * 256 * 1024 * 2); b_off = (unsigned)(WS_WIN + (size_t)pn * 256 * 1024 * 2);
            kind = pn < 3 ? 0 : 1;
        } else if (L < 352) { const int r = L - 320; pm = r >> 2; pn = r & 3; kind = 2;
            a_off = (unsigned)(WS_HM + (size_t)pm * 256 * 1024 * 2); b_off = (unsigned)(WS_WK + (size_t)pn * 256 * 1024 * 2);
        } else { const int q = L - 352; pm = (q >> 2) & 7; pn = q & 3; kind = 3;
            a_off = (unsigned)(WS_HM + (size_t)pm * 256 * 1024 * 2); b_off = (unsigned)(WS_WV + (size_t)pn * 256 * 1024 * 2); }
        u.a_off = a_off; u.b_off = b_off; u.pm = pm; u.pn = pn; u.kind = kind; u.aux = 0;
        return L < 384;
    }
    __device__ __forceinline__ unsigned row_off(const Unit& u, int r) const { return u.a_off + (unsigned)r * 2048u; }
};
struct EpiP1 {
    static constexpr bool PERM = false, AFTER_DRAIN = false;
    unsigned char* ws; const float* qg; const float* kg;
    __device__ __forceinline__ void operator()(f32x4 (&acc)[2][2][4][2], const Unit& u, int wr, int wc, int fr, int fq, FK_LAS unsigned char*, int, int) const {
        if (u.kind == 0) {
            const int head = 4 * u.pn + wc;
            const float* r0 = (const float*)(ws + WS_R0);
            const f32x2* rope = (const f32x2*)(ws + WS_ROPE);
            if (head < 10) {
                const float* gn = head < 8 ? qg : kg;
                f32x4 gv[2][2];
#pragma unroll
                for (int bj = 0; bj < 2; ++bj)
#pragma unroll
                    for (int n = 0; n < 2; ++n) gv[bj][n] = *(const f32x4*)(gn + 32 * bj + 16 * n + 4 * fq);
                const float osc = head < 8 ? QSCALE : 1.f;
#pragma unroll
                for (int ai = 0; ai < 2; ++ai)
#pragma unroll
                    for (int m = 0; m < 4; ++m) {
                        const int row = u.pm * 256 + ai * 128 + wr * 64 + m * 16 + fr;
                        float ss = 0.f;
#pragma unroll
                        for (int bj = 0; bj < 2; ++bj)
#pragma unroll
                            for (int n = 0; n < 2; ++n) { const f32x4 x = acc[ai][bj][m][n]; ss += (x[0] * x[0] + x[1] * x[1]) + (x[2] * x[2] + x[3] * x[3]); }
                        ss += __shfl_xor(ss, 16); ss += __shfl_xor(ss, 32);
                        const float rr = r0[row];
                        const float hs = rr * rsqrtf(rr * rr * ss * (1.f / 64.f) + EPS) * osc;
                        const int s = row & (SEQ - 1);
                        bf16_t* dst = head < 8 ? (bf16_t*)(ws + WS_Q) + (size_t)row * 512 + head * 64 : (bf16_t*)(ws + WS_K) + (size_t)row * 128 + (head - 8) * 64;
#pragma unroll
                        for (int bj = 0; bj < 2; ++bj) {
                            const int pos = bj == 0 ? (s >> 6) : (s & 63);
                            f32x4 x1 = acc[ai][bj][m][0] * hs * gv[bj][0], x2 = acc[ai][bj][m][1] * hs * gv[bj][1], o1, o2;
#pragma unroll
                            for (int j = 0; j < 4; ++j) { const f32x2 cs = rope[pos * 16 + 4 * fq + j]; o1[j] = x1[j] * cs.x - x2[j] * cs.y; o2[j] = x2[j] * cs.x + x1[j] * cs.y; }
                            u32x2 w1, w2; w1.x = pg8::cvt_pk_bf16(o1[0], o1[1]); w1.y = pg8::cvt_pk_bf16(o1[2], o1[3]); w2.x = pg8::cvt_pk_bf16(o2[0], o2[1]); w2.y = pg8::cvt_pk_bf16(o2[2], o2[3]);
                            *(u32x2*)(dst + 32 * bj + 4 * fq) = w1; *(u32x2*)(dst + 32 * bj + 16 + 4 * fq) = w2;
                        }
                    }
            } else {
#pragma unroll
                for (int ai = 0; ai < 2; ++ai)
#pragma unroll
                    for (int m = 0; m < 4; ++m) {
                        const int row = u.pm * 256 + ai * 128 + wr * 64 + m * 16 + fr;
                        const float rr = r0[row];
                        bf16_t* dst = (bf16_t*)(ws + WS_V) + (size_t)row * 128 + (head - 10) * 64;
#pragma unroll
                        for (int bj = 0; bj < 2; ++bj)
#pragma unroll
                            for (int n = 0; n < 2; ++n) { const f32x4 x = acc[ai][bj][m][n] * rr; u32x2 w; w.x = pg8::cvt_pk_bf16(x[0], x[1]); w.y = pg8::cvt_pk_bf16(x[2], x[3]);
                                *(u32x2*)(dst + 32 * bj + 16 * n + 4 * fq) = w; }
                    }
            }
        } else if (u.kind == 1) {
            const float* r0 = (const float*)(ws + WS_R0);
#pragma unroll
            for (int ai = 0; ai < 2; ++ai)
#pragma unroll
                for (int m = 0; m < 4; ++m) {
                    const int row = u.pm * 256 + ai * 128 + wr * 64 + m * 16 + fr;
                    const float rr = r0[row];
                    const int b = row >> 11, s = row & (SEQ - 1), k = s >> 5, jj = s & 31;
#pragma unroll
                    for (int bj = 0; bj < 2; ++bj)
#pragma unroll
                        for (int n = 0; n < 2; ++n) {
                            const int gidx = 16 * (u.pn - 3) + 8 * bj + 2 * wc + n;
                            bf16_t* dst = (bf16_t*)(ws + WS_SU) + ((size_t)gidx * SROWS + b * NCH + k) * SUP + 256 + jj * 16 + 4 * fq;
                            const f32x4 x = acc[ai][bj][m][n] * rr; u32x2 w; w.x = pg8::cvt_pk_bf16(x[0], x[1]); w.y = pg8::cvt_pk_bf16(x[2], x[3]);
                            *(u32x2*)dst = w;
                        }
                }
        } else {
            bf16_t* base = (bf16_t*)(ws + (u.kind == 2 ? WS_KM : WS_VM)) + (size_t)u.pm * 256 * 1024 + u.pn * 256;
            const int ldc = 1024;
#pragma unroll
            for (int ai = 0; ai < 2; ++ai)
#pragma unroll
                for (int m = 0; m < 4; ++m) {
                    bf16_t* rowp = base + (size_t)(ai * 128 + wr * 64 + m * 16 + fr) * ldc + wc * 32 + 4 * fq;
#pragma unroll
                    for (int bj = 0; bj < 2; ++bj)
#pragma unroll
                        for (int n = 0; n < 2; ++n) { const f32x4 x = acc[ai][bj][m][n]; u32x2 w; w.x = pg8::cvt_pk_bf16(x[0], x[1]); w.y = pg8::cvt_pk_bf16(x[2], x[3]);
                            *(u32x2*)(rowp + 128 * bj + 16 * n) = w; }
                }
        }
    }
};
struct SchedOne {
    Unit u; unsigned a_pitch;
    __device__ __forceinline__ bool next(int i, Unit& o) const { o = u; return i == 0; }
    __device__ __forceinline__ unsigned row_off(const Unit& x, int r) const { return x.a_off + (unsigned)r * a_pitch; }
};
__device__ __forceinline__ Unit mk_unit(unsigned a_off, unsigned b_off, int pm, int pn, int kind) { Unit u; u.a_off = a_off; u.b_off = b_off; u.pm = pm; u.pn = pn; u.kind = kind; u.aux = 0; return u; }

struct EpiSloc {
    static constexpr bool PERM = false, AFTER_DRAIN = false;
    float* C;
    __device__ __forceinline__ void operator()(f32x4 (&acc)[2][2][4][2], const Unit& u, int wr, int wc, int fr, int fq, FK_LAS unsigned char*, int, int) const {
#pragma unroll
        for (int ai = 0; ai < 2; ++ai)
#pragma unroll
            for (int m = 0; m < 4; ++m) {
                float* rowp = C + (size_t)(u.pm * 256 + ai * 128 + wr * 64 + m * 16 + fr) * 256 + wc * 32 + 4 * fq;
#pragma unroll
                for (int bj = 0; bj < 2; ++bj)
#pragma unroll
                    for (int n = 0; n < 2; ++n) *(f32x4*)(rowp + 128 * bj + 16 * n) = acc[ai][bj][m][n];
            }
    }
};
__device__ __forceinline__ void s5_scan(const Params& p, int g, int mt, int tid) {
    const int bl = tid >> 7, dir = (tid >> 6) & 1, pp = tid & 63;
    const int gp = (dir * 32 + g) * 64 + pp;
    const float lr = fminf(p.in[6][gp], -1e-4f), li = p.in[7][gp], dt = expf(p.in[8][dir * 32 + g]);
    const float mag = expf(lr * dt * (float)SL), ang = li * dt * (float)SL;
    const float ar = mag * cosf(ang), ai = mag * sinf(ang);
    const float* sl = (const float*)(p.ws + WS_SLOC) + ((size_t)g * SROWS + mt * 256 + bl * 64) * 256 + dir * 128 + pp;
    bf16_t* su = (bf16_t*)(p.ws + WS_SU) + ((size_t)g * SROWS + mt * 256 + bl * 64) * SUP + dir * 128 + pp;
    float sr = 0.f, si = 0.f;
    for (int h2 = 0; h2 < 2; ++h2) {
        float lr_[32], li_[32];
#pragma unroll
        for (int i = 0; i < 32; ++i) { const int s = h2 * 32 + i, k = dir ? (NCH - 1 - s) : s; lr_[i] = sl[(size_t)k * 256]; li_[i] = sl[(size_t)k * 256 + 64]; }
#pragma unroll
        for (int i = 0; i < 32; ++i) {
            const int s = h2 * 32 + i, k = dir ? (NCH - 1 - s) : s;
            su[(size_t)k * SUP] = (bf16_t)f2bf(sr); su[(size_t)k * SUP + 64] = (bf16_t)f2bf(si);
            const float nr = ar * sr - ai * si + lr_[i], ni = ar * si + ai * sr + li_[i];
            sr = nr; si = ni;
        }
    }
}
struct EpiS5Out {
    static constexpr bool PERM = false, AFTER_DRAIN = false;
    bf16_t* Z; int g, mt, ntile;
    __device__ __forceinline__ void operator()(f32x4 (&acc)[2][2][4][2], const Unit& u, int wr, int wc, int fr, int fq, FK_LAS unsigned char*, int, int) const {
#pragma unroll
        for (int ai = 0; ai < 2; ++ai)
#pragma unroll
            for (int m = 0; m < 4; ++m) {
                const int R = mt * 256 + ai * 128 + wr * 64 + m * 16 + fr, b = R >> 6, k = R & 63;
#pragma unroll
                for (int bj = 0; bj < 2; ++bj)
#pragma unroll
                    for (int n = 0; n < 2; ++n) {
                        const int j = 16 * ntile + 8 * bj + 2 * wc + n;
                        const size_t t = (size_t)b * SEQ + k * SL + j;
                        f32x4 y = acc[ai][bj][m][n], z;
#pragma unroll
                        for (int i = 0; i < 4; ++i) { const float a2 = 1.5957691216057308f * (y[i] + 0.044715f * y[i] * y[i] * y[i]); z[i] = y[i] / (1.f + __expf(-a2)); }
                        u32x2 w; w.x = pg8::cvt_pk_bf16(z[0], z[1]); w.y = pg8::cvt_pk_bf16(z[2], z[3]);
                        *(u32x2*)(Z + t * 512 + g * 16 + 4 * fq) = w;
                    }
            }
    }
};
struct EpiGlu {
    static constexpr bool PERM = false, AFTER_DRAIN = false;
    const bf16_t* Z; bf16_t* Y; float* SS; const float* bias;
    __device__ __forceinline__ void operator()(f32x4 (&acc)[2][2][4][2], const Unit& u, int wr, int wc, int fr, int fq, FK_LAS unsigned char*, int, int) const {
        const int col0 = u.pn * 256 + wc * 32 + 4 * fq;
        f32x4 bv[2][2];
#pragma unroll
        for (int bj = 0; bj < 2; ++bj)
#pragma unroll
            for (int n = 0; n < 2; ++n) bv[bj][n] = *(const f32x4*)(bias + col0 + 128 * bj + 16 * n);
#pragma unroll
        for (int ai = 0; ai < 2; ++ai) {
            u32x2 zw[4][2][2];
#pragma unroll
            for (int m = 0; m < 4; ++m) { const size_t row = (size_t)u.pm * 256 + ai * 128 + wr * 64 + m * 16 + fr;
#pragma unroll
                for (int bj = 0; bj < 2; ++bj)
#pragma unroll
                    for (int n = 0; n < 2; ++n) zw[m][bj][n] = *(const u32x2*)(Z + row * 512 + col0 + 128 * bj + 16 * n); }
#pragma unroll
            for (int m = 0; m < 4; ++m) {
                const size_t row = (size_t)u.pm * 256 + ai * 128 + wr * 64 + m * 16 + fr;
                float ss = 0.f;
#pragma unroll
                for (int bj = 0; bj < 2; ++bj)
#pragma unroll
                    for (int n = 0; n < 2; ++n) {
                        const int col = col0 + 128 * bj + 16 * n;
                        const f32x4 lin = acc[ai][bj][m][n] + bv[bj][n];
                        const float z0 = bflo(zw[m][bj][n].x), z1 = bfhi(zw[m][bj][n].x), z2 = bflo(zw[m][bj][n].y), z3 = bfhi(zw[m][bj][n].y);
                        const float y0 = z0 / (1.f + __expf(-lin[0])), y1 = z1 / (1.f + __expf(-lin[1])), y2 = z2 / (1.f + __expf(-lin[2])), y3 = z3 / (1.f + __expf(-lin[3]));
                        u32x2 w; w.x = pg8::cvt_pk_bf16(y0, y1); w.y = pg8::cvt_pk_bf16(y2, y3);
                        *(u32x2*)(Y + row * 1024 + 512 + col) = w;
                        const float r0 = bflo(w.x), r1 = bfhi(w.x), r2 = bflo(w.y), r3 = bfhi(w.y);
                        ss += (r0 * r0 + r1 * r1) + (r2 * r2 + r3 * r3);
                    }
                ss += __shfl_xor(ss, 16); ss += __shfl_xor(ss, 32);
                if (fq == 0) SS[row * 8 + u.pn * 4 + wc] = ss;
            }
            asm volatile("" ::: "memory");
        }
    }
};
__device__ __forceinline__ float rs8(const float* ss, size_t row, float inv_n) {
    const f32x4 a = *(const f32x4*)(ss + row * 8), b = *(const f32x4*)(ss + row * 8 + 4);
    return rsqrtf(((a[0] + a[1]) + (a[2] + a[3]) + (b[0] + b[1]) + (b[2] + b[3])) * inv_n + EPS);
}
struct EpiWoutMid {
    static constexpr bool PERM = false, AFTER_DRAIN = false;
    const FK_LAS float* xt;
    __device__ __forceinline__ void operator()(f32x4 (&acc)[2][2][4][2], const Unit& u, int wr, int wc, int fr, int fq, FK_LAS unsigned char*, int, int) const {
#pragma unroll
        for (int ai = 0; ai < 2; ++ai)
#pragma unroll
            for (int m = 0; m < 4; ++m) {
                const float f = xt[ai * 128 + wr * 64 + m * 16 + fr];
#pragma unroll
                for (int bj = 0; bj < 2; ++bj)
#pragma unroll
                    for (int n = 0; n < 2; ++n) acc[ai][bj][m][n] = acc[ai][bj][m][n] * f;
            }
    }
};
struct EpiWoutFin {
    static constexpr bool PERM = false, AFTER_DRAIN = false;
    const FK_LAS float* xt; const bf16_t* XB; bf16_t* X1; float* SS1;
    __device__ __forceinline__ void operator()(f32x4 (&acc)[2][2][4][2], const Unit& u, int wr, int wc, int fr, int fq, FK_LAS unsigned char*, int, int) const {
        const int col0 = u.pn * 256 + wc * 32 + 4 * fq;
#pragma unroll
        for (int ai = 0; ai < 2; ++ai) {
            u32x2 xw[4][2][2];
#pragma unroll
            for (int m = 0; m < 4; ++m) { const size_t row = (size_t)u.pm * 256 + ai * 128 + wr * 64 + m * 16 + fr;
#pragma unroll
                for (int bj = 0; bj < 2; ++bj)
#pragma unroll
                    for (int n = 0; n < 2; ++n) xw[m][bj][n] = *(const u32x2*)(XB + row * 1024 + col0 + 128 * bj + 16 * n); }
#pragma unroll
            for (int m = 0; m < 4; ++m) {
                const size_t row = (size_t)u.pm * 256 + ai * 128 + wr * 64 + m * 16 + fr;
                const float rs = xt[256 + ai * 128 + wr * 64 + m * 16 + fr];
                float ss = 0.f;
#pragma unroll
                for (int bj = 0; bj < 2; ++bj)
#pragma unroll
                    for (int n = 0; n < 2; ++n) {
                        const int col = col0 + 128 * bj + 16 * n;
                        const f32x4 a = acc[ai][bj][m][n] * rs;
                        u32x2 w; w.x = pg8::cvt_pk_bf16(bflo(xw[m][bj][n].x) + a[0], bfhi(xw[m][bj][n].x) + a[1]); w.y = pg8::cvt_pk_bf16(bflo(xw[m][bj][n].y) + a[2], bfhi(xw[m][bj][n].y) + a[3]);
                        *(u32x2*)(X1 + row * 1024 + col) = w;
                        const float r0 = bflo(w.x), r1 = bfhi(w.x), r2 = bflo(w.y), r3 = bfhi(w.y);
                        ss += (r0 * r0 + r1 * r1) + (r2 * r2 + r3 * r3);
                    }
                ss += __shfl_xor(ss, 16); ss += __shfl_xor(ss, 32);
                if (fq == 0) SS1[row * 16 + u.pn * 4 + wc] = ss;
            }
            asm volatile("" ::: "memory");
        }
    }
};
struct EpiScaleBf16 {
    static constexpr bool PERM = false, AFTER_DRAIN = false;
    bf16_t* O; int ldc; const FK_LAS float* xt; float sc;
    __device__ __forceinline__ void operator()(f32x4 (&acc)[2][2][4][2], const Unit& u, int wr, int wc, int fr, int fq, FK_LAS unsigned char*, int, int) const {
#pragma unroll
        for (int ai = 0; ai < 2; ++ai)
#pragma unroll
            for (int m = 0; m < 4; ++m) {
                const int r = ai * 128 + wr * 64 + m * 16 + fr;
                const float f = xt ? xt[r] * sc : sc;
                bf16_t* rowp = O + (size_t)r * ldc + wc * 32 + 4 * fq;
#pragma unroll
                for (int bj = 0; bj < 2; ++bj)
#pragma unroll
                    for (int n = 0; n < 2; ++n) { const f32x4 x = acc[ai][bj][m][n] * f; u32x2 w; w.x = pg8::cvt_pk_bf16(x[0], x[1]); w.y = pg8::cvt_pk_bf16(x[2], x[3]);
                        *(u32x2*)(rowp + 128 * bj + 16 * n) = w; }
            }
    }
};
struct EpiSoftmax {
    static constexpr bool PERM = false, AFTER_DRAIN = true;
    bf16_t* O; int ldc; const FK_LAS float* xt; float sc;
    __device__ __forceinline__ void operator()(f32x4 (&acc)[2][2][4][2], const Unit& u, int wr, int wc, int fr, int fq, FK_LAS unsigned char* lds, int, int) const {
        FK_LAS float* Pm = (FK_LAS float*)lds;
        FK_LAS float* Ps = (FK_LAS float*)(lds + 4096);
#pragma unroll
        for (int ai = 0; ai < 2; ++ai)
#pragma unroll
            for (int m = 0; m < 4; ++m) {
                float mx = -INFINITY; const float f = xt[ai * 128 + wr * 64 + m * 16 + fr] * sc;
#pragma unroll
                for (int bj = 0; bj < 2; ++bj)
#pragma unroll
                    for (int n = 0; n < 2; ++n) { const f32x4 x = acc[ai][bj][m][n] * f; acc[ai][bj][m][n] = x; mx = fmaxf(mx, fmaxf(fmaxf(x[0], x[1]), fmaxf(x[2], x[3]))); }
                mx = fmaxf(mx, __shfl_xor(mx, 16)); mx = fmaxf(mx, __shfl_xor(mx, 32));
                if (fq == 0) Pm[(ai * 128 + wr * 64 + m * 16 + fr) * 4 + wc] = mx;
            }
        asm volatile("s_waitcnt lgkmcnt(0)" ::: "memory"); __builtin_amdgcn_s_barrier(); asm volatile("" ::: "memory");
#pragma unroll
        for (int ai = 0; ai < 2; ++ai)
#pragma unroll
            for (int m = 0; m < 4; ++m) {
                const int r = ai * 128 + wr * 64 + m * 16 + fr;
                const f32x4 pm4 = *(const FK_LAS f32x4*)(Pm + r * 4);
                const float M = fmaxf(fmaxf(pm4[0], pm4[1]), fmaxf(pm4[2], pm4[3]));
                float sm = 0.f;
#pragma unroll
                for (int bj = 0; bj < 2; ++bj)
#pragma unroll
                    for (int n = 0; n < 2; ++n) { f32x4 x = acc[ai][bj][m][n];
#pragma unroll
                        for (int i = 0; i < 4; ++i) { x[i] = __builtin_amdgcn_exp2f(x[i] - M); sm += x[i]; }
                        acc[ai][bj][m][n] = x; }
                sm += __shfl_xor(sm, 16); sm += __shfl_xor(sm, 32);
                if (fq == 0) Ps[r * 4 + wc] = sm;
            }
        asm volatile("s_waitcnt lgkmcnt(0)" ::: "memory"); __builtin_amdgcn_s_barrier(); asm volatile("" ::: "memory");
#pragma unroll
        for (int ai = 0; ai < 2; ++ai)
#pragma unroll
            for (int m = 0; m < 4; ++m) {
                const int r = ai * 128 + wr * 64 + m * 16 + fr;
                const f32x4 ps4 = *(const FK_LAS f32x4*)(Ps + r * 4);
                const float inv = 1.f / ((ps4[0] + ps4[1]) + (ps4[2] + ps4[3]));
                bf16_t* rowp = O + (size_t)r * ldc + wc * 32 + 4 * fq;
#pragma unroll
                for (int bj = 0; bj < 2; ++bj)
#pragma unroll
                    for (int n = 0; n < 2; ++n) { const f32x4 x = acc[ai][bj][m][n] * inv; u32x2 w; w.x = pg8::cvt_pk_bf16(x[0], x[1]); w.y = pg8::cvt_pk_bf16(x[2], x[3]);
                        *(u32x2*)(rowp + 128 * bj + 16 * n) = w; }
            }
        asm volatile("s_waitcnt lgkmcnt(0)" ::: "memory"); __builtin_amdgcn_s_barrier(); asm volatile("" ::: "memory");
    }
};
struct EpiResid {
    static constexpr bool PERM = false, AFTER_DRAIN = false;
    bf16_t* X; int ldc;
    __device__ __forceinline__ void operator()(f32x4 (&acc)[2][2][4][2], const Unit& u, int wr, int wc, int fr, int fq, FK_LAS unsigned char*, int, int) const {
#pragma unroll
        for (int ai = 0; ai < 2; ++ai) {
            u32x2 xw[4][2][2];
#pragma unroll
            for (int m = 0; m < 4; ++m) { const bf16_t* rowp = X + (size_t)(ai * 128 + wr * 64 + m * 16 + fr) * ldc + wc * 32 + 4 * fq;
#pragma unroll
                for (int bj = 0; bj < 2; ++bj)
#pragma unroll
                    for (int n = 0; n < 2; ++n) xw[m][bj][n] = *(const u32x2*)(rowp + 128 * bj + 16 * n); }
#pragma unroll
            for (int m = 0; m < 4; ++m) {
                bf16_t* rowp = X + (size_t)(ai * 128 + wr * 64 + m * 16 + fr) * ldc + wc * 32 + 4 * fq;
#pragma unroll
                for (int bj = 0; bj < 2; ++bj)
#pragma unroll
                    for (int n = 0; n < 2; ++n) { const f32x4 a = acc[ai][bj][m][n];
                        u32x2 w; w.x = pg8::cvt_pk_bf16(bflo(xw[m][bj][n].x) + a[0], bfhi(xw[m][bj][n].x) + a[1]); w.y = pg8::cvt_pk_bf16(bflo(xw[m][bj][n].y) + a[2], bfhi(xw[m][bj][n].y) + a[3]);
                        *(u32x2*)(rowp + 128 * bj + 16 * n) = w; }
            }
            asm volatile("" ::: "memory");
        }
    }
};
typedef float f32x16 __attribute__((ext_vector_type(16)));
__device__ __forceinline__ void router_phase(const Params& p, FK_LAS unsigned char* lds, int vcu, int G, int tid, int lane, int wave) {
    unsigned char* ws = p.ws;
    FK_LAS float* PL = (FK_LAS float*)lds;
    FK_LAS float* SSP = PL + 8 * 64 * 33;
    FK_LAS int* lcnt = (FK_LAS int*)(lds + XTRA_OFF);
    FK_LAS int* lbase = lcnt + 16;
    FK_LAS int* ee = lbase + 16;
    FK_LAS int* pp = ee + 128;
    FK_LAS float* ww = (FK_LAS float*)(pp + 128);
    const bf16_t* X2 = (const bf16_t*)(ws + WS_X1B);
    const bf16_t* RWT = (const bf16_t*)(ws + WS_RWT);
    int* cnt = (int*)(ws + WS_CTL) + CW_CNT; int* list = (int*)(ws + WS_LIST); float* wl = (float*)(ws + WS_WL); float* r2o = (float*)(ws + WS_R2);
    const int r32 = lane & 31, hi = lane >> 5;
    for (int chunk = vcu; chunk < T / 64; chunk += G) {
        if (tid < 16) lcnt[tid] = 0;
        const int t0 = chunk * 64;
        bf16x8 a[2][8], bh[8], bl[8];
#pragma unroll
        for (int ks = 0; ks < 8; ++ks) {
            const int k = 128 * wave + 16 * ks + 8 * hi;
            a[0][ks] = *(const bf16x8*)(X2 + (size_t)(t0 + r32) * 1024 + k);
            a[1][ks] = *(const bf16x8*)(X2 + (size_t)(t0 + 32 + r32) * 1024 + k);
            bh[ks] = *(const bf16x8*)(RWT + (size_t)r32 * 1024 + k);
            bl[ks] = *(const bf16x8*)(RWT + (size_t)(32 + r32) * 1024 + k);
        }
        f32x16 acc0 = {}, acc1 = {};
        float ss0 = 0.f, ss1 = 0.f;
#pragma unroll
        for (int ks = 0; ks < 8; ++ks) {
            acc0 = __builtin_amdgcn_mfma_f32_32x32x16_bf16(a[0][ks], bh[ks], acc0, 0, 0, 0);
            acc1 = __builtin_amdgcn_mfma_f32_32x32x16_bf16(a[1][ks], bh[ks], acc1, 0, 0, 0);
            acc0 = __builtin_amdgcn_mfma_f32_32x32x16_bf16(a[0][ks], bl[ks], acc0, 0, 0, 0);
            acc1 = __builtin_amdgcn_mfma_f32_32x32x16_bf16(a[1][ks], bl[ks], acc1, 0, 0, 0);
#pragma unroll
            for (int e = 0; e < 8; ++e) { const float x0 = bf2f((unsigned short)a[0][ks][e]), x1 = bf2f((unsigned short)a[1][ks][e]); ss0 = fmaf(x0, x0, ss0); ss1 = fmaf(x1, x1, ss1); }
        }
        ss0 += __shfl_xor(ss0, 32); ss1 += __shfl_xor(ss1, 32);
        if (hi == 0) { SSP[wave * 64 + r32] = ss0; SSP[wave * 64 + 32 + r32] = ss1; }
#pragma unroll
        for (int r = 0; r < 16; ++r) {
            const int row = (r & 3) + 8 * (r >> 2) + 4 * hi;
            PL[(wave * 64 + row) * 33 + r32] = acc0[r];
            PL[(wave * 64 + 32 + row) * 33 + r32] = acc1[r];
        }
        __syncthreads();
        if (wave == 0) {
            const int tl = lane, t = t0 + tl;
            float lg[20];
#pragma unroll
            for (int i = 0; i < 20; ++i) { float s_ = 0.f;
#pragma unroll
                for (int w8 = 0; w8 < 8; ++w8) s_ += PL[(w8 * 64 + tl) * 33 + i];
                lg[i] = s_; }
            float ss = 0.f;
#pragma unroll
            for (int w8 = 0; w8 < 8; ++w8) ss += SSP[w8 * 64 + tl];
            const float r2 = rsqrtf(ss * (1.f / 1024.f) + EPS);
#pragma unroll
            for (int i = 0; i < 20; ++i) lg[i] = lg[i] * r2 + (i < 4 ? p.in[27][i] : p.in[29][i - 4]);
            r2o[t] = r2;
            const float gm = fmaxf(fmaxf(lg[0], lg[1]), fmaxf(lg[2], lg[3]));
            const float e0 = expf(lg[0] - gm), e1 = expf(lg[1] - gm), e2 = expf(lg[2] - gm), e3 = expf(lg[3] - gm);
            const float gs = e0 + e1 + e2 + e3;
            int gsel = 0; float gbest = e0;
            if (e1 > gbest) { gbest = e1; gsel = 1; }
            if (e2 > gbest) { gbest = e2; gsel = 2; }
            if (e3 > gbest) { gbest = e3; gsel = 3; }
            const float gwt = gbest / gs;
            const float v0 = gsel == 0 ? lg[4] : gsel == 1 ? lg[8] : gsel == 2 ? lg[12] : lg[16];
            const float v1 = gsel == 0 ? lg[5] : gsel == 1 ? lg[9] : gsel == 2 ? lg[13] : lg[17];
            const float v2 = gsel == 0 ? lg[6] : gsel == 1 ? lg[10] : gsel == 2 ? lg[14] : lg[18];
            const float v3 = gsel == 0 ? lg[7] : gsel == 1 ? lg[11] : gsel == 2 ? lg[15] : lg[19];
            int i1 = 0; float b1 = v0;
            if (v1 > b1) { b1 = v1; i1 = 1; }
            if (v2 > b1) { b1 = v2; i1 = 2; }
            if (v3 > b1) { b1 = v3; i1 = 3; }
            int i2 = 0; float b2 = -INFINITY;
            if (i1 != 0 && v0 > b2) { b2 = v0; i2 = 0; }
            if (i1 != 1 && v1 > b2) { b2 = v1; i2 = 1; }
            if (i1 != 2 && v2 > b2) { b2 = v2; i2 = 2; }
            if (i1 != 3 && v3 > b2) { b2 = v3; i2 = 3; }
            const float ex2 = expf(b2 - b1);
            const float w1 = gwt / (1.f + ex2), w2 = gwt * ex2 / (1.f + ex2);
            const int ea = gsel * 4 + i1, eb = gsel * 4 + i2;
            ee[tl * 2] = ea; pp[tl * 2] = __hip_atomic_fetch_add(&lcnt[ea], 1, __ATOMIC_RELAXED, __HIP_MEMORY_SCOPE_WORKGROUP); ww[tl * 2] = w1;
            ee[tl * 2 + 1] = eb; pp[tl * 2 + 1] = __hip_atomic_fetch_add(&lcnt[eb], 1, __ATOMIC_RELAXED, __HIP_MEMORY_SCOPE_WORKGROUP); ww[tl * 2 + 1] = w2;
        }
        __syncthreads();
        if (tid < 16) lbase[tid] = atomicAdd(&cnt[tid * 64], lcnt[tid]);
        __syncthreads();
        if (tid < 128) { const int e = ee[tid], pos = lbase[e] + pp[tid]; list[e * T + pos] = (t0 + (tid >> 1)) * 2 + (tid & 1); wl[e * T + pos] = ww[tid]; }
        __syncthreads();
    }
}
struct MoeTab {
    const FK_LAS int* t;
    __device__ __forceinline__ int total_tiles() const { return __builtin_amdgcn_readfirstlane(t[16]); }
    __device__ __forceinline__ void decode(int mtile, int& e, int& mt, int& ce) const {
        int ee = 0;
#pragma unroll
        for (int j = 1; j < 16; ++j) ee += (mtile >= __builtin_amdgcn_readfirstlane(t[j])) ? 1 : 0;
        e = ee; mt = mtile - __builtin_amdgcn_readfirstlane(t[ee]); ce = __builtin_amdgcn_readfirstlane(t[17 + ee]);
    }
};
__device__ __forceinline__ void moe_tab_init(FK_LAS int* t, const int* cnt, int tid) {
    if (tid == 0) { int acc = 0; t[0] = 0;
        for (int j = 0; j < 16; ++j) { const int c = __hip_atomic_load(cnt + j * 64, __ATOMIC_RELAXED, __HIP_MEMORY_SCOPE_AGENT); t[17 + j] = c; acc += (c + 255) >> 8; t[j + 1] = acc; } }
    __syncthreads();
}
struct SchedMoe1 {
    MoeTab tab; int G, c; const FK_LAS unsigned* xo;
    __device__ __forceinline__ bool next(int i, Unit& u) const {
        const int L = i * G + c; const int nun = tab.total_tiles() * 4;
        int e, mt, ce; tab.decode(L >> 2, e, mt, ce);
        u.a_off = 0; u.b_off = (unsigned)(WS_WGU + ((size_t)e * 1024 + (L & 3) * 256) * 1024 * 2); u.pm = L >> 2; u.pn = L & 3; u.kind = e; u.aux = i;
        return L < nun;
    }
    __device__ __forceinline__ unsigned row_off(const Unit& u, int r) const { return xo[u.aux * 256 + r]; }
};
struct EpiMoe1 {
    static constexpr bool PERM = false, AFTER_DRAIN = false;
    bf16_t* ACT; const FK_LAS float* xf;
    __device__ __forceinline__ void operator()(f32x4 (&acc)[2][2][4][2], const Unit& u, int wr, int wc, int fr, int fq, FK_LAS unsigned char*, int, int) const {
#pragma unroll
        for (int ai = 0; ai < 2; ++ai)
#pragma unroll
            for (int m = 0; m < 4; ++m) {
                const int r = ai * 128 + wr * 64 + m * 16 + fr;
                const float f1 = xf[u.aux * 512 + r], f2 = xf[u.aux * 512 + 256 + r];
                bf16_t* rowp = ACT + ((size_t)u.pm * 256 + r) * 512 + u.pn * 128 + wc * 32 + 4 * fq;
#pragma unroll
                for (int n = 0; n < 2; ++n) {
                    const f32x4 g = acc[ai][0][m][n] * f1, up = acc[ai][1][m][n] * f2; f32x4 a;
#pragma unroll
                    for (int i = 0; i < 4; ++i) a[i] = g[i] / (1.f + __expf(-g[i])) * up[i];
                    u32x2 w; w.x = pg8::cvt_pk_bf16(a[0], a[1]); w.y = pg8::cvt_pk_bf16(a[2], a[3]);
                    *(u32x2*)(rowp + 16 * n) = w;
                }
            }
    }
};
struct SchedMoe2 {
    MoeTab tab; int G, c;
    __device__ __forceinline__ bool next(int i, Unit& u) const {
        const int L = i * G + c; const int nun = tab.total_tiles() * 4;
        int e, mt, ce; tab.decode(L >> 2, e, mt, ce);
        u.a_off = (unsigned)(WS_ACT + (size_t)(L >> 2) * 256 * 512 * 2); u.b_off = (unsigned)(WS_WD + ((size_t)e * 1024 + (L & 3) * 256) * 512 * 2); u.pm = L >> 2; u.pn = L & 3; u.kind = e; u.aux = i;
        return L < nun;
    }
    __device__ __forceinline__ unsigned row_off(const Unit& u, int r) const { return u.a_off + (unsigned)r * 1024u; }
};
struct EpiMoe2 {
    static constexpr bool PERM = false, AFTER_DRAIN = false;
    bf16_t* YM; const FK_LAS int* xe;
    __device__ __forceinline__ void operator()(f32x4 (&acc)[2][2][4][2], const Unit& u, int wr, int wc, int fr, int fq, FK_LAS unsigned char*, int, int) const {
#pragma unroll
        for (int ai = 0; ai < 2; ++ai)
#pragma unroll
            for (int m = 0; m < 4; ++m) {
                const int r = ai * 128 + wr * 64 + m * 16 + fr;
                const int ent = xe[u.aux * 256 + r];
                if (ent >= 0) {
                    bf16_t* rowp = YM + (size_t)ent * 1024 + u.pn * 256 + wc * 32 + 4 * fq;
#pragma unroll
                    for (int bj = 0; bj < 2; ++bj)
#pragma unroll
                        for (int n = 0; n < 2; ++n) { const f32x4 x = acc[ai][bj][m][n]; u32x2 w; w.x = pg8::cvt_pk_bf16(x[0], x[1]); w.y = pg8::cvt_pk_bf16(x[2], x[3]);
                            *(u32x2*)(rowp + 128 * bj + 16 * n) = w; }
                }
            }
    }
};
__device__ __forceinline__ void final_phase(const Params& p, int vcu, int G, int lane, int wave) {
    const bf16_t* X2 = (const bf16_t*)(p.ws + WS_X1B); const bf16_t* YM = (const bf16_t*)p.out; const float* fg = p.in[33];
    const int gwv = vcu * NWAVES + wave, NGW = G * NWAVES;
    for (int t = gwv; t < T; t += NGW) {
        float v[16]; float ss = 0.f;
#pragma unroll
        for (int j = 0; j < 2; ++j) {
            const int k0 = j * 512 + lane * 8;
            const u32x4 a = *(const u32x4*)(X2 + (size_t)t * 1024 + k0), b = *(const u32x4*)(YM + (size_t)t * 2048 + k0), c = *(const u32x4*)(YM + (size_t)t * 2048 + 1024 + k0);
#pragma unroll
            for (int e = 0; e < 4; ++e) { v[j * 8 + 2 * e] = bflo(a[e]) + bflo(b[e]) + bflo(c[e]); v[j * 8 + 2 * e + 1] = bfhi(a[e]) + bfhi(b[e]) + bfhi(c[e]); }
        }
#pragma unroll
        for (int i = 0; i < 16; ++i) ss += v[i] * v[i];
        ss = wsum(ss);
        const float r = rsqrtf(ss * (1.f / 1024.f) + EPS);
        float* orow = p.out + (size_t)t * 1024;
#pragma unroll
        for (int j = 0; j < 2; ++j) {
            const int k0 = j * 512 + lane * 8;
            const f32x4 g0 = *(const f32x4*)(fg + k0), g1 = *(const f32x4*)(fg + k0 + 4);
            f32x4 o0, o1;
#pragma unroll
            for (int e = 0; e < 4; ++e) { o0[e] = v[j * 8 + e] * r * g0[e]; o1[e] = v[j * 8 + 4 + e] * r * g1[e]; }
            *(f32x4*)(orow + k0) = o0; *(f32x4*)(orow + k0 + 4) = o1;
        }
    }
}
__global__ void __launch_bounds__(NTHREADS, 2) mk(Params p) {
    extern __shared__ __attribute__((aligned(16))) unsigned char lds_raw[];
    FK_LAS unsigned char* lds = (FK_LAS unsigned char*)lds_raw;
    const int tid0 = threadIdx.x;
    const int G = gridDim.x, bx = blockIdx.x;
    const int vcu = (G % 8 == 0) ? (bx % 8) * (G / 8) + bx / 8 : bx;
    unsigned char* ws = p.ws;
    volatile FK_LAS unsigned* bst = (volatile FK_LAS unsigned*)(lds + LDS_BYTES - 64);
    if (tid0 < 2) bst[tid0] = 0u;
    __syncthreads();
    XcdBarrier bar = xcd_barrier_post((unsigned*)(ws + WS_CTL) + CW_BAR, bst);
#define IN(k) (p.ph_lo <= (k) && (k) < p.ph_hi)
#define FRESH_IDS() int tid_f = threadIdx.x; asm volatile("" : "+v"(tid_f)); const int tid = tid_f, lane = tid_f & 63, wave = __builtin_amdgcn_readfirstlane(tid_f >> 6); (void)tid; (void)lane; (void)wave
    const bool defer = (G == 256) && p.ph_lo == 0 && p.ph_hi == 13;
#ifndef PROBE_PHASE
#define PROBE_PHASE -1
#define PROBE_N 1
#endif
#define REP(k) for (int rr_ = 0; rr_ < ((k) == PROBE_PHASE ? PROBE_N : 1); ++rr_)
#define REPBAR() do { if (rr_ > 0) xcd_barrier(bar); } while (0)
#define SEAM(k) do { if (IN(k) && IN((k) + 1)) xcd_barrier(bar); } while (0)
    if (IN(0)) { FRESH_IDS(); p0_prologue(p, lds, vcu, G, tid, lane, wave, defer);
#if PROBE_PHASE == 0
        xcd_barrier(bar); p0_prologue(p, lds, vcu, G, tid, lane, wave, defer); xcd_barrier(bar); p0_prologue(p, lds, vcu, G, tid, lane, wave, defer);
#endif
    }
    SEAM(0);
    if (IN(1)) REP(1) { REPBAR(); FRESH_IDS();
        Gemm g{(const char*)ws, (const char*)ws, 1024, 1024, 1024};
        SchedP1 S{G, bx};
        EpiP1 E{ws, p.in[4], p.in[5]};
        f32x4 acc[2][2][4][2];
        pg8::gemm_phase<EpiP1, SchedP1, true, true, false>(lds, g, S, E, acc);
        if (defer && bx >= 128) { int t2 = threadIdx.x; asm volatile("" : "+v"(t2)); for (int rs_ = 0; rs_ < (PROBE_PHASE == 101 ? PROBE_N : 1); ++rs_) for (int it = bx - 128; it < 128; it += 128) s5_prep_part(p, it >> 2, it & 3, (FK_LAS float*)lds, t2); }
    }
    SEAM(1);
    if (IN(2)) REP(2) { REPBAR(); FRESH_IDS();
        attn_body::attn_phase<8>((char*)lds_raw, (const attn_body::bf16*)(ws + WS_Q), (const attn_body::bf16*)(ws + WS_K), (const attn_body::bf16*)(ws + WS_V),
                                 (attn_body::bf16*)(ws + WS_YCAT), (float*)(ws + WS_SSATT), G, vcu);
    }
    SEAM(2);
    if (IN(3)) REP(3) { REPBAR(); FRESH_IDS();
        for (int L = bx; L < 64; L += G) {
            const int g = L >> 1, mt = L & 1;
            Gemm gm{(const char*)ws, (const char*)ws, SUP, 512, 512};
            SchedOne S{mk_unit((unsigned)(WS_SU + (((size_t)g * SROWS + mt * 256) * SUP + 256) * 2), (unsigned)(WS_W1 + (size_t)g * 256 * 512 * 2), mt, 0, 0), SUP * 2};
            EpiSloc E{(float*)(ws + WS_SLOC) + (size_t)g * SROWS * 256};
            f32x4 acc[2][2][4][2];
            pg8::gemm_phase<EpiSloc, SchedOne, false, true, false>(lds, gm, S, E, acc);
            asm volatile("s_waitcnt vmcnt(0)" ::: "memory"); __syncthreads();
            { int t2 = threadIdx.x; asm volatile("" : "+v"(t2)); s5_scan(p, g, mt, t2); }
        }
        for (int L = (bx + G - (64 % G)) % G; L < 128; L += G) {
            const int b = L >> 4, h = (L >> 2) & 3, pn = L & 3;
            Gemm gm{(const char*)ws, (const char*)ws, 1024, 1024, 256};
            SchedOne S{mk_unit((unsigned)(WS_KM + ((size_t)b * 256 * 1024 + h * 256) * 2), (unsigned)(WS_WQ + ((size_t)pn * 256 * 1024 + h * 256) * 2), 0, pn, 0), 2048};
            EpiScaleBf16 E{(bf16_t*)((unsigned char*)p.out + OUT_MT) + ((size_t)b * 1024 + h * 256) * 1024 + pn * 256, 1024, nullptr, 1.f};
            f32x4 acc[2][2][4][2];
            pg8::gemm_phase<EpiScaleBf16, SchedOne, false, true, false>(lds, gm, S, E, acc);
        }
        if (defer && bx >= 64) { SIDE_WAVES(64); convert_B(p, sscr_, lane, sw_, snw_, 0, NIT_B); convert_C(p, sscr_, lane, sw_, snw_, 0, NIT_C / 3); }
    }
    SEAM(3);
    if (IN(4)) REP(4) { REPBAR(); FRESH_IDS();
        for (int L = bx; L < 128; L += G) {
            const int g = L >> 2, mt = (L >> 1) & 1, ntile = L & 1;
            Gemm gm{(const char*)ws, (const char*)ws, SUP, SUP, SUP};
            SchedOne S{mk_unit((unsigned)(WS_SU + ((size_t)g * SROWS + mt * 256) * SUP * 2), (unsigned)(WS_W2 + ((size_t)g * 512 + ntile * 256) * SUP * 2), mt, ntile, 0), SUP * 2};
            EpiS5Out E{(bf16_t*)(ws + WS_Z), g, mt, ntile};
            f32x4 acc[2][2][4][2];
            pg8::gemm_phase<EpiS5Out, SchedOne, false, true, false>(lds, gm, S, E, acc);
        }
        for (int L = (bx + G - (128 % G)) % G; L < 128; L += G) {
            const int b = L >> 4, h = (L >> 2) & 3, pm = L & 3;
            Gemm gm{(const char*)ws, (const char*)ws, 1024, 1024, 256};
            SchedOne S{mk_unit((unsigned)(WS_WO + ((size_t)pm * 256 * 1024 + h * 256) * 2), (unsigned)(WS_VM + ((size_t)b * 256 * 1024 + h * 256) * 2), pm, 0, 0), 2048};
            EpiScaleBf16 E{(bf16_t*)((unsigned char*)p.out + OUT_NT) + ((size_t)b * 1024 + pm * 256) * 1024 + h * 256, 1024, nullptr, 1.f};
            f32x4 acc[2][2][4][2];
            pg8::gemm_phase<EpiScaleBf16, SchedOne, false, true, false>(lds, gm, S, E, acc);
        }
        if (defer && bx >= 128) { SIDE_WAVES(128); convert_C(p, sscr_, lane, sw_, snw_, NIT_C / 3, 2 * (NIT_C / 3)); }
    }
    SEAM(4);
    if (IN(5)) REP(5) { REPBAR(); FRESH_IDS();
        for (int L = bx; L < 128; L += G) {
            int pm, pn; pg8::tile_order(L, 64, 2, pm, pn);
            Gemm gm{(const char*)ws, (const char*)ws, 512, 512, 512};
            SchedOne S{mk_unit((unsigned)(WS_Z + (size_t)pm * 256 * 512 * 2), (unsigned)(WS_GLU + (size_t)pn * 256 * 512 * 2), pm, pn, 0), 512 * 2};
            EpiGlu E{(const bf16_t*)(ws + WS_Z), (bf16_t*)(ws + WS_YCAT), (float*)(ws + WS_SSSSM), p.in[15]};
            f32x4 acc[2][2][4][2];
            pg8::gemm_phase<EpiGlu, SchedOne, false, true, false>(lds, gm, S, E, acc);
        }
        if (defer && bx >= 128) { SIDE_WAVES(128); convert_C(p, sscr_, lane, sw_, snw_, 2 * (NIT_C / 3), NIT_C); }
    }
    SEAM(5);
    if (IN(6)) REP(6) { REPBAR(); FRESH_IDS();
        for (int L = bx; L < 256; L += G) {
            int pm, pn; pg8::tile_order(L, 64, 4, pm, pn);
            Gemm gm{(const char*)ws, (const char*)ws, 1024, 1024, 512};
            const unsigned a0 = (unsigned)(WS_YCAT + (size_t)pm * 256 * 1024 * 2), b0 = (unsigned)(WS_WOUT + (size_t)pn * 256 * 1024 * 2);
            f32x4 acc[2][2][4][2];
            FK_LAS float* xt = (FK_LAS float*)(lds + XTRA_OFF);
            { int t2 = threadIdx.x; asm volatile("" : "+v"(t2));
              if (t2 < 256) { const size_t row = (size_t)pm * 256 + t2; const float ra = rs8((const float*)(ws + WS_SSATT), row, 1.f / 512.f), rs = rs8((const float*)(ws + WS_SSSSM), row, 1.f / 512.f); xt[t2] = ra / rs; xt[256 + t2] = rs; }
              __syncthreads(); }
            { SchedOne S{mk_unit(a0, b0, pm, pn, 0), 2048}; EpiWoutMid E{xt};
              pg8::gemm_phase<EpiWoutMid, SchedOne, false, true, false>(lds, gm, S, E, acc); }
            { SchedOne S{mk_unit(a0 + 1024, b0 + 1024, pm, pn, 0), 2048}; EpiWoutFin E{xt, (const bf16_t*)(ws + WS_XB), (bf16_t*)(ws + WS_X1B), (float*)(ws + WS_SSX1)};
              pg8::gemm_phase<EpiWoutFin, SchedOne, false, true, true>(lds, gm, S, E, acc); }
        }
    }
    SEAM(6);
    if (IN(7)) REP(7) { REPBAR(); FRESH_IDS();
        for (int L = bx; L < 256; L += G) {
            int pm, pn; pg8::tile_order(L, 64, 4, pm, pn);
            const int b = pm >> 3;
            FK_LAS float* xt = (FK_LAS float*)(lds + XTRA_OFF);
            { if (tid < 256) { const float* s1 = (const float*)(ws + WS_SSX1) + ((size_t)pm * 256 + tid) * 16; const f32x4 a = *(const f32x4*)s1, b4 = *(const f32x4*)(s1 + 4), c = *(const f32x4*)(s1 + 8), d = *(const f32x4*)(s1 + 12);
                  xt[tid] = rsqrtf((((a[0] + a[1]) + (a[2] + a[3])) + ((b4[0] + b4[1]) + (b4[2] + b4[3])) + ((c[0] + c[1]) + (c[2] + c[3])) + ((d[0] + d[1]) + (d[2] + d[3]))) * (1.f / 1024.f) + EPS); }
              __syncthreads(); }
            const size_t tile = ((size_t)pm * 256 * 1024 + pn * 256) * 2;
            Gemm gm{(const char*)ws, (const char*)p.out, 1024, 1024, 1024};
            SchedOne S{mk_unit((unsigned)(WS_X1B + (size_t)pm * 256 * 1024 * 2), (unsigned)(OUT_MT + ((size_t)b * 1024 + pn * 256) * 1024 * 2), pm, pn, 0), 2048};
            EpiSoftmax E{(bf16_t*)(ws + WS_PB + tile), 1024, xt, XQSCALE};
            f32x4 acc[2][2][4][2];
            pg8::gemm_phase<EpiSoftmax, SchedOne, false, true, false>(lds, gm, S, E, acc);
        }
    }
    SEAM(7);
    if (IN(8)) REP(8) { REPBAR(); FRESH_IDS();
        for (int L = bx; L < 256; L += G) {
            int pm, pn; pg8::tile_order(L, 64, 4, pm, pn);
            const int b = pm >> 3;
            const size_t tile = ((size_t)pm * 256 * 1024 + pn * 256) * 2;
            Gemm gm{(const char*)ws, (const char*)p.out, 1024, 1024, 1024};
            SchedOne S{mk_unit((unsigned)(WS_PB + (size_t)pm * 256 * 1024 * 2), (unsigned)(OUT_NT + ((size_t)b * 1024 + pn * 256) * 1024 * 2), pm, pn, 0), 2048};
            EpiResid E{(bf16_t*)(ws + WS_X1B + tile), 1024};
            f32x4 acc[2][2][4][2];
            pg8::gemm_phase<EpiResid, SchedOne, false, true, false>(lds, gm, S, E, acc);
        }
    }
    SEAM(8);
    if (IN(9)) REP(9) { REPBAR(); FRESH_IDS(); if (rr_ > 0) { if (bx == 0 && tid < 16) __hip_atomic_store((int*)(ws + WS_CTL) + CW_CNT + tid * 64, 0, __ATOMIC_RELAXED, __HIP_MEMORY_SCOPE_AGENT); xcd_barrier(bar); } router_phase(p, lds, vcu, G, tid, lane, wave); }
    SEAM(9);
    if (IN(10)) REP(10) { REPBAR(); FRESH_IDS();
        FK_LAS int* tabp = (FK_LAS int*)(lds + XTRA_OFF + 15 * 1024); moe_tab_init(tabp, (const int*)(ws + WS_CTL) + CW_CNT, threadIdx.x); MoeTab tab{tabp};
        FK_LAS unsigned* xo = (FK_LAS unsigned*)(lds + XTRA_OFF);
        FK_LAS float* xf = (FK_LAS float*)(lds + XTRA_OFF + 5 * 1024);
        { int t2 = threadIdx.x; asm volatile("" : "+v"(t2));
          const int nun = tab.total_tiles() * 4; int i = 0;
          for (int L = bx; L < nun && i < 5; L += G, ++i) {
              if (t2 < 256) { int e, mt, ce; tab.decode(L >> 2, e, mt, ce); const int idx = mt * 256 + t2; const bool valid = idx < ce;
                  const int ent = valid ? ((const int*)(ws + WS_LIST))[e * T + idx] : 0; const int tok = ent >> 1;
                  xo[i * 256 + t2] = (unsigned)(WS_X1B + (size_t)tok * 2048);
                  const float r2 = ((const float*)(ws + WS_R2))[tok];
                  xf[i * 512 + t2] = r2; xf[i * 512 + 256 + t2] = valid ? r2 * ((const float*)(ws + WS_WL))[e * T + idx] : 0.f; }
          }
          __syncthreads(); }
        Gemm gm{(const char*)ws, (const char*)ws, 1024, 1024, 1024};
        SchedMoe1 S{tab, G, bx, xo};
        EpiMoe1 E{(bf16_t*)(ws + WS_ACT), xf};
        f32x4 acc[2][2][4][2];
        pg8::gemm_phase<EpiMoe1, SchedMoe1, true, true, false>(lds, gm, S, E, acc);
    }
    SEAM(10);
    if (IN(11)) REP(11) { REPBAR(); FRESH_IDS();
        FK_LAS int* tabp = (FK_LAS int*)(lds + XTRA_OFF + 15 * 1024); moe_tab_init(tabp, (const int*)(ws + WS_CTL) + CW_CNT, threadIdx.x); MoeTab tab{tabp};
        FK_LAS int* xe = (FK_LAS int*)(lds + XTRA_OFF);
        { int t2 = threadIdx.x; asm volatile("" : "+v"(t2));
          const int nun = tab.total_tiles() * 4; int i = 0;
          for (int L = bx; L < nun && i < 5; L += G, ++i) {
              if (t2 < 256) { int e, mt, ce; tab.decode(L >> 2, e, mt, ce); const int idx = mt * 256 + t2;
                  xe[i * 256 + t2] = idx < ce ? ((const int*)(ws + WS_LIST))[e * T + idx] : -1; }
          }
          __syncthreads(); }
        Gemm gm{(const char*)ws, (const char*)ws, 512, 512, 512};
        SchedMoe2 S{tab, G, bx};
        EpiMoe2 E{(bf16_t*)p.out, xe};
        f32x4 acc[2][2][4][2];
        pg8::gemm_phase<EpiMoe2, SchedMoe2, true, true, false>(lds, gm, S, E, acc);
    }
    SEAM(11);
    if (IN(12)) REP(12) { REPBAR(); FRESH_IDS(); final_phase(p, vcu, G, lane, wave); }
#undef SEAM
#undef IN
}

}
extern "C" void kernel_launch(void* const* d_in, const int* in_sizes, int n_in, void* d_out, int out_size, void* d_ws, size_t ws_size, hipStream_t stream) {
    static int grid = 0;
    if (grid == 0) {
        int dev = 0, cus = 0, per_cu = 0;
        (void)hipGetDevice(&dev);
        (void)hipDeviceGetAttribute(&cus, hipDeviceAttributeMultiprocessorCount, dev);
        (void)hipFuncSetAttribute((const void*)fk::mk, hipFuncAttributeMaxDynamicSharedMemorySize, fk::LDS_BYTES);
        (void)hipOccupancyMaxActiveBlocksPerMultiprocessor(&per_cu, (const void*)fk::mk, fk::NTHREADS, fk::LDS_BYTES);
        if (per_cu < 1 || cus < 1 || ws_size < fk::WS_END) { fprintf(stderr, "kernel_launch: cus %d per_cu %d ws %zu: cannot launch\n", cus, per_cu, ws_size); grid = -1; }
        else grid = cus;
    }
    if (grid < 0) return;
    (void)hipMemsetAsync(d_ws, 0, 1u << 20, stream);
    fk::Params p{};
    for (int i = 0; i < 34; ++i) p.in[i] = (const float*)d_in[i];
    p.out = (float*)d_out; p.ws = (unsigned char*)d_ws; p.ph_lo = 0; p.ph_hi = 13;
    void* args[] = {&p};
    hipError_t e = hipLaunchCooperativeKernel((const void*)fk::mk, dim3(grid), dim3(fk::NTHREADS), args, fk::LDS_BYTES, stream);
    if (e != hipSuccess) fprintf(stderr, "cooperative launch failed: %s (grid %d)\n", hipGetErrorString(e), grid);
}
```
